# Optimizing an MI355X kernel written in HIP

```python
import jax
import jax.numpy as jnp
from jax import lax
import numpy as np

D_MODEL = 1024
BATCH = 2
SEQ = 16384
DEPTH = 1

GRID_W = 64
CTX_LEN = 256
EPS = 1e-6
M_HEADS = 4
M_DQK = 128
M_DV = 256
M_CHUNK = 64
ROPE_BASE = 10000.0
NA_HEADS = 8
NA_DH = 64
NA_KH = 8
NA_KW = 16
N_EXPERTS = 256
TOP_K = 8
N_GROUPS = 8
TOPK_GROUPS = 4
EXPERT_FF = 256
SHARED_FF = 256
ROUTE_SCALE = 2.5
MOE_BLOCK = 256
M_QK_W = M_HEADS * M_DQK
M_V_W = M_HEADS * M_DV
NA_W = NA_HEADS * NA_DH
IN_SIZES = (M_QK_W, M_QK_W, M_V_W, M_V_W, 4 * M_HEADS, NA_W, NA_W, NA_W, D_MODEL, D_MODEL)
IN_COLS = sum(IN_SIZES)
IN_SPLITS = tuple(sum(IN_SIZES[: i + 1]) for i in range(len(IN_SIZES) - 1))

kernel_name = "hybrid_mlstm_natten_moe_dit_block"


def rms(x):
    xf = x.astype(jnp.float32)
    return (xf * lax.rsqrt(jnp.mean(xf * xf, axis=-1, keepdims=True) + EPS)).astype(x.dtype)


def modulate(x, shift, scale):
    return rms(x) * (1.0 + scale) + shift


def heads(a, n_heads):
    b, t, _ = a.shape
    return a.reshape(b, t, n_heads, -1).transpose(0, 2, 1, 3)


def merge_heads(a):
    b, h, t, d = a.shape
    return a.transpose(0, 2, 1, 3).reshape(b, t, h * d)


def axial_rope(x, row_pos, col_pos):
    half = x.shape[-1] // 2
    nf = half // 2
    inv = jnp.power(ROPE_BASE, -jnp.arange(nf, dtype=jnp.float32) / nf)

    def rot(xa, pos):
        ang = pos[:, None] * inv[None, :]
        cos, sin = jnp.cos(ang), jnp.sin(ang)
        x1 = xa[..., :nf].astype(jnp.float32)
        x2 = xa[..., nf:].astype(jnp.float32)
        return jnp.concatenate([x1 * cos - x2 * sin, x1 * sin + x2 * cos], axis=-1)

    return jnp.concatenate([rot(x[..., :half], row_pos), rot(x[..., half:], col_pos)], axis=-1).astype(x.dtype)


def in_projection(h, w_in, b_mgate, na_qn_w, na_kn_w):
    mq, mk, mv, mo, mg, nq, nk, nv, gm, gn = jnp.split(h @ w_in, IN_SPLITS, axis=-1)
    b, t, _ = h.shape
    gates = (mg + b_mgate).astype(jnp.float32).reshape(b, t, 4, M_HEADS).transpose(2, 0, 3, 1)
    mq = heads(mq, M_HEADS) * (M_DQK ** -0.5)
    nq = rms(heads(nq, NA_HEADS)) * na_qn_w * (NA_DH ** -0.5)
    nk = rms(heads(nk, NA_HEADS)) * na_kn_w
    return mq, heads(mk, M_HEADS), heads(mv, M_HEADS), mo, gates, nq, nk, heads(nv, NA_HEADS), gm, gn


def mlstm_scan(q, k, v, ig, lf, state):
    b, h, t, _ = q.shape
    nc = t // M_CHUNK

    def chunks(a):
        a = a.reshape(a.shape[:2] + (nc, M_CHUNK) + a.shape[3:])
        return jnp.moveaxis(a, 2, 0)

    causal = jnp.tril(jnp.ones((M_CHUNK, M_CHUNK), dtype=bool))

    def step(carry, xs):
        c_prev, n_prev, m_prev = carry
        qc, kc, vc, ic, fc = xs
        bcum = jnp.cumsum(fc, axis=-1)
        g = bcum[..., -1]
        dlog = jnp.where(causal, bcum[..., :, None] - bcum[..., None, :] + ic[..., None, :], -jnp.inf)
        inter = bcum + m_prev[..., None]
        m_t = jnp.maximum(inter, jnp.max(dlog, axis=-1))
        s = jnp.einsum("bhtd,bhsd->bhts", qc, kc) * jnp.exp(dlog - m_t[..., None])
        w_inter = jnp.exp(inter - m_t)
        num = jnp.einsum("bhts,bhsv->bhtv", s, vc) + w_inter[..., None] * jnp.einsum("bhtd,bhdv->bhtv", qc, c_prev)
        den = jnp.sum(s, axis=-1) + w_inter * jnp.einsum("bhtd,bhd->bht", qc, n_prev)
        h_out = num / jnp.maximum(jnp.abs(den), jnp.exp(-m_t))[..., None]
        a = g[..., None] - bcum + ic
        m_new = jnp.maximum(g + m_prev, jnp.max(a, axis=-1))
        decay = jnp.exp(g + m_prev - m_new)
        wa = jnp.exp(a - m_new[..., None])
        c_new = decay[..., None, None] * c_prev + jnp.einsum("bhs,bhsd,bhsv->bhdv", wa, kc, vc)
        n_new = decay[..., None] * n_prev + jnp.einsum("bhs,bhsd->bhd", wa, kc)
        return (c_new, n_new, m_new), h_out

    state, hs = lax.scan(step, state, (chunks(q), chunks(k), chunks(v), chunks(ig), chunks(lf)))
    hs = jnp.moveaxis(hs, 0, 2).reshape(b, h, t, -1).astype(v.dtype)
    return hs, state


def mlstm_bidir(q, k, v, gates, init_fwd, init_bwd):
    ig_f, lf_f = gates[0], jax.nn.log_sigmoid(gates[1])
    ig_b, lf_b = gates[2], jax.nn.log_sigmoid(gates[3])
    h_f, st_f = mlstm_scan(q, k, v, ig_f, lf_f, init_fwd)
    rev = lambda a: jnp.flip(a, axis=2)
    h_b, st_b = mlstm_scan(rev(q), rev(k), rev(v), rev(ig_b), rev(lf_b), init_bwd)
    return h_f + rev(h_b), st_f, st_b


def mlstm_readout(h, o_pre, m_norm_w):
    return merge_heads(rms(h)) * m_norm_w * jax.nn.sigmoid(o_pre)


def na_latent(q, k, v, k_ctx, v_ctx, rpb):
    b, h, rows, w, dh = q.shape
    kh = min(NA_KH, rows)
    cols = jnp.arange(w)
    col_idx = jnp.clip(cols - NA_KW // 2, 0, w - NA_KW)[:, None] + jnp.arange(NA_KW)[None, :]
    rpb_cols = rpb[:, :, col_idx - cols[:, None] + (NA_KW - 1)]
    n_win = kh * NA_KW

    def one_row(r):
        rs = jnp.clip(r - kh // 2, 0, rows - kh)
        q_r = lax.dynamic_index_in_dim(q, r, axis=2, keepdims=False)
        k_r = lax.dynamic_slice_in_dim(k, rs, kh, axis=2)[:, :, :, col_idx]
        v_r = lax.dynamic_slice_in_dim(v, rs, kh, axis=2)[:, :, :, col_idx]
        bias = rpb_cols[:, rs + jnp.arange(kh) - r + (NA_KH - 1)].transpose(0, 2, 1, 3)
        s_win = jnp.einsum("bhcd,bhicjd->bhcij", q_r, k_r) + bias
        s_ctx = jnp.einsum("bhcd,bhnd->bhcn", q_r, k_ctx)
        logits = jnp.concatenate([s_win.reshape(b, h, w, n_win), s_ctx], axis=-1).astype(jnp.float32)
        p = jax.nn.softmax(logits, axis=-1).astype(v.dtype)
        p_win = p[..., :n_win].reshape(b, h, w, kh, NA_KW)
        return (jnp.einsum("bhcij,bhicjd->bhcd", p_win, v_r)
                + jnp.einsum("bhcn,bhnd->bhcd", p[..., n_win:], v_ctx))

    out = lax.map(one_row, jnp.arange(rows))
    return out.transpose(1, 2, 0, 3, 4).reshape(b, h, rows * w, dh)


def na_context(q, k, v):
    p = jax.nn.softmax(jnp.einsum("bhqd,bhkd->bhqk", q, k).astype(jnp.float32), axis=-1).astype(v.dtype)
    return jnp.einsum("bhqk,bhkd->bhqd", p, v)


def token_mixer(h, hc, row_pos, col_pos, w_in, b_mgate, m_norm_w, na_qn_w, na_kn_w, na_rpb,
                w_br_m, w_br_na, w_out, with_ctx_out):
    b, t, _ = h.shape
    rows = t // GRID_W
    mq, mk, mv, mo, gates, nq, nk, nv, gm, gn = in_projection(h, w_in, b_mgate, na_qn_w, na_kn_w)
    cmq, cmk, cmv, cmo, cgates, cnq, cnk, cnv, cgm, cgn = in_projection(hc, w_in, b_mgate, na_qn_w, na_kn_w)

    zero = (jnp.zeros((b, M_HEADS, M_DQK, M_DV), jnp.float32),
            jnp.zeros((b, M_HEADS, M_DQK), jnp.float32),
            jnp.zeros((b, M_HEADS), jnp.float32))
    hm_c, st_f, st_b = mlstm_bidir(cmq, cmk, cmv, cgates, zero, zero)
    mq = axial_rope(mq, row_pos, col_pos)
    mk = axial_rope(mk, row_pos, col_pos)
    hm, _, _ = mlstm_bidir(mq, mk, mv, gates, st_f, st_b)
    y_m = mlstm_readout(hm, mo, m_norm_w)

    grid = lambda a: a.reshape(b, NA_HEADS, rows, GRID_W, NA_DH)
    y_na = merge_heads(na_latent(grid(nq), grid(nk), grid(nv), cnk, cnv, na_rpb))

    y = (jax.nn.sigmoid(gm) * (y_m @ w_br_m) + jax.nn.sigmoid(gn) * (y_na @ w_br_na)) @ w_out
    if not with_ctx_out:
        return y, None
    yc_m = mlstm_readout(hm_c, cmo, m_norm_w)
    yc_na = merge_heads(na_context(cnq, cnk, cnv))
    yc = (jax.nn.sigmoid(cgm) * (yc_m @ w_br_m) + jax.nn.sigmoid(cgn) * (yc_na @ w_br_na)) @ w_out
    return y, yc


def swiglu(x, wg, wu, wd):
    return (jax.nn.silu(x @ wg) * (x @ wu)) @ wd


def routed_experts(tok, top_e, top_w, w_gate, w_up, w_down):
    n, d = tok.shape
    a = n * TOP_K
    e_flat = top_e.reshape(-1)
    tok_id = jnp.repeat(jnp.arange(n, dtype=jnp.int32), TOP_K)
    w_flat = top_w.reshape(-1)
    order = jnp.argsort(e_flat)
    e_s, tok_s, w_s = e_flat[order], tok_id[order], w_flat[order]
    counts = jnp.bincount(e_flat, length=N_EXPERTS)
    start = jnp.cumsum(counts) - counts
    padded = (counts + MOE_BLOCK - 1) // MOE_BLOCK * MOE_BLOCK
    pend = jnp.cumsum(padded)
    pstart = pend - padded
    pos = pstart[e_s] + jnp.arange(a) - start[e_s]
    nb = -(-a // MOE_BLOCK) + N_EXPERTS
    p_rows = nb * MOE_BLOCK
    slot_tok = jnp.full((p_rows,), n, jnp.int32).at[pos].set(tok_s)
    slot_w = jnp.zeros((p_rows,), tok.dtype).at[pos].set(w_s)
    block_e = jnp.clip(jnp.searchsorted(pend, jnp.arange(nb) * MOE_BLOCK, side="right"), 0, N_EXPERTS - 1)
    tok_pad = jnp.concatenate([tok, jnp.zeros((1, d), tok.dtype)], axis=0)

    def run_block(args):
        ids, e = args
        return swiglu(tok_pad[ids], w_gate[e], w_up[e], w_down[e])

    yb = lax.map(run_block, (slot_tok.reshape(nb, MOE_BLOCK), block_e))
    out = jnp.zeros((n + 1, d), tok.dtype).at[slot_tok].add(yb.reshape(p_rows, d) * slot_w[:, None])
    return out[:n]


def moe_ffn(h, w_router, router_bias, w_exp_gate, w_exp_up, w_exp_down, w_sh_gate, w_sh_up, w_sh_down):
    b, t, d = h.shape
    tok = h.reshape(b * t, d)
    n = tok.shape[0]
    scores = jax.nn.sigmoid((tok @ w_router).astype(jnp.float32))
    sel = scores + router_bias.astype(jnp.float32)
    grp_score = jnp.sum(lax.top_k(sel.reshape(n, N_GROUPS, -1), 2)[0], axis=-1)
    _, top_g = lax.top_k(grp_score, TOPK_GROUPS)
    gmask = jnp.any(top_g[..., None] == jnp.arange(N_GROUPS), axis=1)
    sel = jnp.where(jnp.repeat(gmask, N_EXPERTS // N_GROUPS, axis=1), sel, -jnp.inf)
    _, top_e = lax.top_k(sel, TOP_K)
    top_w = jnp.take_along_axis(scores, top_e, axis=-1)
    top_w = top_w / jnp.sum(top_w, axis=-1, keepdims=True) * ROUTE_SCALE
    routed = routed_experts(tok, top_e, top_w.astype(tok.dtype), w_exp_gate, w_exp_up, w_exp_down)
    shared = swiglu(tok, w_sh_gate, w_sh_up, w_sh_down)
    return (routed + shared).reshape(b, t, d)


def setup_inputs(seed: int = 0) -> dict:
    key = jax.random.key(seed)
    ks = jax.random.split(key, 24)
    L, D = DEPTH, D_MODEL

    def nrm(k, shape, s):
        return jax.random.normal(k, shape, jnp.float32) * s

    gate_base = jnp.repeat(jnp.array([0.0, 3.0, 0.0, 3.0], jnp.float32), M_HEADS)[None, :]
    return {
        "x": nrm(ks[0], (BATCH, SEQ, D), 1.0),
        "c": nrm(ks[1], (BATCH, D), 1.0),
        "ctx": nrm(ks[2], (BATCH, CTX_LEN, D), 1.0),
        "c_ctx": nrm(ks[3], (D,), 1.0),
        "w_ada": nrm(ks[4], (L, D, 6 * D), 0.5 * D ** -0.5),
        "b_ada": nrm(ks[5], (L, 6 * D), 0.02),
        "w_in": nrm(ks[6], (L, D, IN_COLS), D ** -0.5),
        "b_mgate": gate_base + nrm(ks[7], (L, 4 * M_HEADS), 0.5),
        "m_norm_w": 1.0 + nrm(ks[8], (L, M_V_W), 0.02),
        "na_qn_w": 1.0 + nrm(ks[9], (L, NA_DH), 0.02),
        "na_kn_w": 1.0 + nrm(ks[10], (L, NA_DH), 0.02),
        "na_rpb": nrm(ks[11], (L, NA_HEADS, 2 * NA_KH - 1, 2 * NA_KW - 1), 0.1),
        "w_br_m": nrm(ks[12], (L, M_V_W, D), M_V_W ** -0.5),
        "w_br_na": nrm(ks[13], (L, NA_W, D), NA_W ** -0.5),
        "w_out": nrm(ks[14], (L, D, D), D ** -0.5),
        "w_router": nrm(ks[15], (L, D, N_EXPERTS), D ** -0.5),
        "router_bias": nrm(ks[16], (L, N_EXPERTS), 0.01),
        "w_exp_gate": nrm(ks[17], (L, N_EXPERTS, D, EXPERT_FF), D ** -0.5),
        "w_exp_up": nrm(ks[18], (L, N_EXPERTS, D, EXPERT_FF), D ** -0.5),
        "w_exp_down": nrm(ks[19], (L, N_EXPERTS, EXPERT_FF, D), EXPERT_FF ** -0.5),
        "w_sh_gate": nrm(ks[20], (L, D, SHARED_FF), D ** -0.5),
        "w_sh_up": nrm(ks[21], (L, D, SHARED_FF), D ** -0.5),
        "w_sh_down": nrm(ks[22], (L, SHARED_FF, D), SHARED_FF ** -0.5),
    }


def reference(x, c, ctx, c_ctx, w_ada, b_ada, w_in, b_mgate, m_norm_w, na_qn_w, na_kn_w, na_rpb,
              w_br_m, w_br_na, w_out, w_router, router_bias, w_exp_gate, w_exp_up, w_exp_down,
              w_sh_gate, w_sh_up, w_sh_down):
    t = jnp.arange(x.shape[1])
    row_pos = (t // GRID_W).astype(jnp.float32)
    col_pos = (t % GRID_W).astype(jnp.float32)
    for l in range(DEPTH):
        last = l == DEPTH - 1
        mod = jax.nn.silu(c) @ w_ada[l] + b_ada[l]
        mod_ctx = jax.nn.silu(c_ctx) @ w_ada[l] + b_ada[l]
        sh1, sc1, g1, sh2, sc2, g2 = jnp.split(mod[:, None, :], 6, axis=-1)
        csh1, csc1, cg1, csh2, csc2, cg2 = jnp.split(mod_ctx, 6, axis=-1)
        y, yc = token_mixer(modulate(x, sh1, sc1), modulate(ctx, csh1, csc1), row_pos, col_pos,
                            w_in[l], b_mgate[l], m_norm_w[l], na_qn_w[l], na_kn_w[l], na_rpb[l],
                            w_br_m[l], w_br_na[l], w_out[l], not last)
        x = x + g1 * y
        x = x + g2 * moe_ffn(modulate(x, sh2, sc2), w_router[l], router_bias[l], w_exp_gate[l], w_exp_up[l],
                             w_exp_down[l], w_sh_gate[l], w_sh_up[l], w_sh_down[l])
        if not last:
            ctx = ctx + cg1 * yc
            ctx = ctx + cg2 * moe_ffn(modulate(ctx, csh2, csc2), w_router[l], router_bias[l], w_exp_gate[l],
                                      w_exp_up[l], w_exp_down[l], w_sh_gate[l], w_sh_up[l], w_sh_down[l])
    return x
```

```cpp
#include <hip/hip_runtime.h>
#include <hip/hip_cooperative_groups.h>
#include <cstdio>
#include <cstdint>
namespace cg = cooperative_groups;

#ifndef MULTI_LAUNCH
#define MULTI_LAUNCH 0
#endif
#ifndef TAPC0
#define TAPC0 0
#endif
#ifndef DBG_ROPE
#define DBG_ROPE 1
#endif
#ifndef RUN_PHASES
#define RUN_PHASES 14
#endif

typedef unsigned short u16;
typedef unsigned int u32;
typedef short bf16x8 __attribute__((ext_vector_type(8)));
typedef float f32x16 __attribute__((ext_vector_type(16)));
typedef float f32x4 __attribute__((ext_vector_type(4)));
typedef u32 u32x4 __attribute__((ext_vector_type(4)));
typedef u32 u32x2 __attribute__((ext_vector_type(2)));

constexpr int DM = 1024;
constexpr int NTOK = 32768;
constexpr int TSEQ = 16384;
constexpr int MTOT = 33280;
constexpr int INC = 6672;
constexpr int PV = 6784;
constexpr int V_MQ = 0, V_MK = 512, V_MV = 1024, V_MO = 2048, V_NQ = 3072, V_NK = 3584, V_NV = 4096, V_GM = 4608, V_GN = 5632;
constexpr int NSLOT = 4160;
constexpr int SH_BASE = 294912;
constexpr int NPH = 14;
constexpr int LDS_BYTES = 76 * 1024;
constexpr int LDT = 72;
constexpr int LDQ = 136;

constexpr size_t AL(size_t x) { return (x + 255) & ~(size_t)255; }
constexpr size_t OFF_MODP = 0;
constexpr size_t OFF_CNT  = AL(OFF_MODP + (size_t)8 * 3 * 6144 * 4);
constexpr size_t OFF_G    = AL(OFF_CNT + 1024);
constexpr size_t OFF_GS   = AL(OFF_G + (size_t)MTOT * 16 * 4);
constexpr size_t OFF_ML   = AL(OFF_GS + NSLOT * 4);
constexpr size_t OFF_MP   = AL(OFF_ML + NSLOT * 4);
constexpr size_t OFF_DN   = AL(OFF_MP + NSLOT * 4);
constexpr size_t OFF_TOPE = AL(OFF_DN + (size_t)NSLOT * 128 * 4);
constexpr size_t OFF_RANK = OFF_TOPE + (size_t)NTOK * 8 * 4;
constexpr size_t OFF_TOPW = OFF_RANK + (size_t)NTOK * 8 * 4;
constexpr size_t OFF_H    = AL(OFF_TOPW + (size_t)NTOK * 8 * 4);
constexpr size_t OFF_SLOT = AL(OFF_H + (size_t)MTOT * 1024 * 2);
constexpr size_t OFF_R4   = AL(OFF_SLOT + (size_t)256 * 32768 * 4);
constexpr size_t OFF_YNA  = OFF_R4;
constexpr size_t OFF_YM   = OFF_R4 + (size_t)NTOK * 512 * 2;
constexpr size_t OFF_MRG  = OFF_YM + (size_t)NTOK * 1024 * 2;
constexpr size_t OFF_SC   = OFF_R4;
constexpr size_t OFF_HID  = OFF_R4;
constexpr size_t OFF_P    = AL(OFF_R4 + (size_t)327680 * 256 * 2);
constexpr size_t OFF_CT   = AL(OFF_P + (size_t)MTOT * PV * 2);
constexpr size_t OFF_Y    = OFF_P;
constexpr size_t WS_END   = OFF_CT + (size_t)NSLOT * 65536;
static_assert(OFF_Y + (size_t)327680 * 1024 * 2 <= WS_END, "Y must fit over P+CT");

struct Params {
    const float *x, *c, *ctx, *c_ctx, *w_ada, *b_ada, *w_in, *b_mgate, *m_norm_w, *na_qn_w, *na_kn_w, *na_rpb,
                *w_br_m, *w_br_na, *w_out, *w_router, *router_bias, *w_exp_gate, *w_exp_up, *w_exp_down,
                *w_sh_gate, *w_sh_up, *w_sh_down;
    float* out;
    unsigned char* ws;
    int ph_lo, ph_hi;
};

typedef __bf16 bf16x2_t __attribute__((ext_vector_type(2)));
__device__ __forceinline__ u32 pk2(float lo, float hi) { bf16x2_t v = {(__bf16)lo, (__bf16)hi}; return __builtin_bit_cast(u32, v); }
__device__ __forceinline__ u16 f2bf(float f) { return (u16)(pk2(f, 0.f) & 0xffffu); }
__device__ __forceinline__ float bf2f(u16 h) { return __uint_as_float(((u32)h) << 16); }
__device__ __forceinline__ float bf_lo(u32 w) { return __uint_as_float(w << 16); }
__device__ __forceinline__ float bf_hi(u32 w) { return __uint_as_float(w & 0xffff0000u); }
__device__ __forceinline__ float sigmoid_(float x) { return 1.f / (1.f + __expf(-x)); }
__device__ __forceinline__ float log_sigmoid_(float x) { return fminf(x, 0.f) - __logf(1.f + __expf(-fabsf(x))); }
__device__ __forceinline__ f32x4 mfma16(bf16x8 a, bf16x8 b, f32x4 c) { return __builtin_amdgcn_mfma_f32_16x16x32_bf16(a, b, c, 0, 0, 0); }
__device__ __forceinline__ f32x16 mfma32(bf16x8 a, bf16x8 b, f32x16 c) { return __builtin_amdgcn_mfma_f32_32x32x16_bf16(a, b, c, 0, 0, 0); }

__device__ __forceinline__ void sincos_rev(float rev, float& sn, float& cs) {
    rev -= rintf(rev);
    const float kq = rintf(rev * 4.f);
    const float th = (rev - kq * 0.25f) * 6.283185307179586f;
    const float t2 = th * th;
    const float s = th * (1.f + t2 * (-1.f / 6.f + t2 * (1.f / 120.f + t2 * (-1.f / 5040.f + t2 * (1.f / 362880.f)))));
    const float c = 1.f + t2 * (-0.5f + t2 * (1.f / 24.f + t2 * (-1.f / 720.f + t2 * (1.f / 40320.f))));
    const int k = ((int)kq) & 3;
    sn = (k == 0) ? s : (k == 1) ? c : (k == 2) ? -s : -c;
    cs = (k == 0) ? c : (k == 1) ? -s : (k == 2) ? -c : s;
}
__device__ __forceinline__ int opaque_tid() { int t = threadIdx.x; asm volatile("" : "+v"(t)); return t; }
__device__ __forceinline__ float wave_sum(float v) {
#pragma unroll
    for (int o = 1; o < 64; o <<= 1) v += __shfl_xor(v, o);
    return v;
}
__device__ __forceinline__ float wave_max(float v) {
#pragma unroll
    for (int o = 1; o < 64; o <<= 1) v = fmaxf(v, __shfl_xor(v, o));
    return v;
}
__device__ __forceinline__ float wave_incl_sum(float v, int lane) {
#pragma unroll
    for (int o = 1; o < 64; o <<= 1) { float t = __shfl_up(v, o); if (lane >= o) v += t; }
    return v;
}
__device__ __forceinline__ float wave_prefix_max(float v, int lane) {
#pragma unroll
    for (int o = 1; o < 64; o <<= 1) { float t = __shfl_up(v, o); if (lane >= o) v = fmaxf(v, t); }
    return v;
}
__device__ __forceinline__ float wave_suffix_max(float v, int lane) {
#pragma unroll
    for (int o = 1; o < 64; o <<= 1) { float t = __shfl_down(v, o); if (lane + o < 64) v = fmaxf(v, t); }
    return v;
}
__device__ __forceinline__ float mod_val(const Params& p, int vec, int j) {
    const float* mp = (const float*)(p.ws + OFF_MODP);
    float s = p.b_ada[j];
#pragma unroll
    for (int ks = 0; ks < 8; ++ks) s += mp[(ks * 3 + vec) * 6144 + j];
    return s;
}
__device__ __forceinline__ u32x4 tr8(const u32x2 (&v)[8], int cc) {
    u32x4 o;
    if (cc == 0)      { o.x = (v[0].x & 0xffffu) | (v[1].x << 16); o.y = (v[2].x & 0xffffu) | (v[3].x << 16); o.z = (v[4].x & 0xffffu) | (v[5].x << 16); o.w = (v[6].x & 0xffffu) | (v[7].x << 16); }
    else if (cc == 1) { o.x = (v[0].x >> 16) | (v[1].x & 0xffff0000u); o.y = (v[2].x >> 16) | (v[3].x & 0xffff0000u); o.z = (v[4].x >> 16) | (v[5].x & 0xffff0000u); o.w = (v[6].x >> 16) | (v[7].x & 0xffff0000u); }
    else if (cc == 2) { o.x = (v[0].y & 0xffffu) | (v[1].y << 16); o.y = (v[2].y & 0xffffu) | (v[3].y << 16); o.z = (v[4].y & 0xffffu) | (v[5].y << 16); o.w = (v[6].y & 0xffffu) | (v[7].y << 16); }
    else              { o.x = (v[0].y >> 16) | (v[1].y & 0xffff0000u); o.y = (v[2].y >> 16) | (v[3].y & 0xffff0000u); o.z = (v[4].y >> 16) | (v[5].y & 0xffff0000u); o.w = (v[6].y >> 16) | (v[7].y & 0xffff0000u); }
    return o;
}
__device__ __forceinline__ float bfsel(const u32x2& v, int cc) { return cc == 0 ? bf_lo(v.x) : cc == 1 ? bf_hi(v.x) : cc == 2 ? bf_lo(v.y) : bf_hi(v.y); }

__device__ __forceinline__ void gemm_core(f32x16 (&acc)[2][2], const u16* const (&rowp)[4], const float* bsrc, const size_t ldb, const int nk,
                                          u16* As, u16* Bs, const int tid, const int lane, const int wr, const int wc) {
    u32x4 ar[4]; f32x4 br[8];
#pragma unroll
    for (int i = 0; i < 4; ++i) ar[i] = *(const u32x4*)(rowp[i]);
#pragma unroll
    for (int i = 0; i < 8; ++i) br[i] = *(const f32x4*)(bsrc + (size_t)i * ldb);
    const int arow = tid >> 3, ach = tid & 7;
    const int r = lane & 31, hh = lane >> 5;
    for (int kt = 0; kt < nk; ++kt) {
#pragma unroll
        for (int i = 0; i < 4; ++i) *(u32x4*)(As + (arow + 32 * i) * LDT + ach * 8) = ar[i];
#pragma unroll
        for (int cc = 0; cc < 4; ++cc) {
            u32x4 w; w.x = pk2(br[0][cc], br[1][cc]); w.y = pk2(br[2][cc], br[3][cc]); w.z = pk2(br[4][cc], br[5][cc]); w.w = pk2(br[6][cc], br[7][cc]);
            *(u32x4*)(Bs + (arow * 4 + cc) * LDT + ach * 8) = w;
        }
        __syncthreads();
        if (kt + 1 < nk) {
            const int k1 = (kt + 1) * 64;
#pragma unroll
            for (int i = 0; i < 4; ++i) ar[i] = *(const u32x4*)(rowp[i] + k1);
            const float* bp = bsrc + (size_t)k1 * ldb;
#pragma unroll
            for (int i = 0; i < 8; ++i) br[i] = *(const f32x4*)(bp + (size_t)i * ldb);
        }
#pragma unroll
        for (int kk = 0; kk < 4; ++kk) {
            bf16x8 a[2], b[2];
#pragma unroll
            for (int mi = 0; mi < 2; ++mi) a[mi] = *(const bf16x8*)(As + (wr * 64 + mi * 32 + r) * LDT + kk * 16 + hh * 8);
#pragma unroll
            for (int ni = 0; ni < 2; ++ni) b[ni] = *(const bf16x8*)(Bs + (wc * 64 + ni * 32 + r) * LDT + kk * 16 + hh * 8);
#pragma unroll
            for (int mi = 0; mi < 2; ++mi)
#pragma unroll
                for (int ni = 0; ni < 2; ++ni) acc[mi][ni] = mfma32(a[mi], b[ni], acc[mi][ni]);
        }
        __syncthreads();
    }
}
#define ACC_ROW(mi, reg) ((mi) * 32 + ((reg) & 3) + 8 * ((reg) >> 2))

__device__ __forceinline__ void phase_ada(const Params& p, unsigned char* smem) {
    const int tid = opaque_tid();
    float* red = (float*)smem;
    float* mp = (float*)(p.ws + OFF_MODP);
    if (blockIdx.x == 0) ((int*)(p.ws + OFF_CNT))[tid] = 0;
    for (int it = blockIdx.x; it < 192; it += gridDim.x) {
        const int cb = it % 24, ks = it / 24, cq = tid & 63, kq = tid >> 6;
        float a0[4] = {0, 0, 0, 0}, a1[4] = {0, 0, 0, 0}, a2[4] = {0, 0, 0, 0};
        for (int kk = 0; kk < 32; ++kk) {
            const int k = ks * 128 + kq * 32 + kk;
            const f32x4 w = *(const f32x4*)(p.w_ada + (size_t)k * 6144 + cb * 256 + cq * 4);
            float c0 = p.c[k], c1 = p.c[1024 + k], c2 = p.c_ctx[k];
            c0 *= sigmoid_(c0); c1 *= sigmoid_(c1); c2 *= sigmoid_(c2);
#pragma unroll
            for (int j = 0; j < 4; ++j) { a0[j] += c0 * w[j]; a1[j] += c1 * w[j]; a2[j] += c2 * w[j]; }
        }
#pragma unroll
        for (int j = 0; j < 4; ++j) { red[(kq * 3 + 0) * 256 + cq * 4 + j] = a0[j]; red[(kq * 3 + 1) * 256 + cq * 4 + j] = a1[j]; red[(kq * 3 + 2) * 256 + cq * 4 + j] = a2[j]; }
        __syncthreads();
#pragma unroll
        for (int v = 0; v < 3; ++v) {
            const float s = (red[(0 * 3 + v) * 256 + tid] + red[(1 * 3 + v) * 256 + tid]) + (red[(2 * 3 + v) * 256 + tid] + red[(3 * 3 + v) * 256 + tid]);
            mp[(ks * 3 + v) * 6144 + cb * 256 + tid] = s;
        }
        __syncthreads();
    }
}

__device__ __forceinline__ void phase_norm(const Params& p, unsigned char* smem, const bool second) {
    const int tid = opaque_tid(), lane = tid & 63, wid = tid >> 6;
    float* tsh = (float*)smem; float* tsc = tsh + 1024;
    u16* H = (u16*)(p.ws + OFF_H);
    const int nrows = second ? NTOK : MTOT;
    const int rpb = (nrows + gridDim.x - 1) / gridDim.x;
    const int r0 = blockIdx.x * rpb, r1 = min(r0 + rpb, nrows);
    const int sh_off = second ? 3072 : 0, sc_off = second ? 4096 : 1024;
    for (int vec = 0; vec < 3; ++vec) {
        const int vlo = vec == 0 ? 0 : (vec == 1 ? TSEQ : NTOK), vhi = vec == 0 ? TSEQ : (vec == 1 ? NTOK : MTOT);
        const int lo = max(r0, vlo), hi = min(r1, vhi);
        if (lo >= hi) continue;
        for (int j = tid; j < 1024; j += 256) { tsh[j] = mod_val(p, vec, sh_off + j); tsc[j] = 1.f + mod_val(p, vec, sc_off + j); }
        __syncthreads();
        for (int row = lo + wid; row < hi; row += 4) {
            const float* src = second ? (p.out + (size_t)row * 1024) : (row < NTOK ? p.x + (size_t)row * 1024 : p.ctx + (size_t)(row - NTOK) * 1024);
            f32x4 v[4]; float ss = 0.f;
#pragma unroll
            for (int j = 0; j < 4; ++j) { v[j] = *(const f32x4*)(src + j * 256 + lane * 4); ss += (v[j].x * v[j].x + v[j].y * v[j].y) + (v[j].z * v[j].z + v[j].w * v[j].w); }
            ss = wave_sum(ss);
            const float rstd = rsqrtf(ss * (1.f / 1024.f) + 1e-6f);
#pragma unroll
            for (int j = 0; j < 4; ++j) {
                const int k = j * 256 + lane * 4;
                const f32x4 sc = *(const f32x4*)(tsc + k), sh = *(const f32x4*)(tsh + k);
                u32x2 o; o.x = pk2(v[j].x * rstd * sc.x + sh.x, v[j].y * rstd * sc.y + sh.y); o.y = pk2(v[j].z * rstd * sc.z + sh.z, v[j].w * rstd * sc.w + sh.w);
                *(u32x2*)(H + (size_t)row * 1024 + k) = o;
            }
        }
        __syncthreads();
    }
}

__device__ __forceinline__ void phase_inproj(const Params& p, unsigned char* smem) {
    u16* As = (u16*)smem; u16* Bs = (u16*)(smem + 18432);
    const u16* H = (const u16*)(p.ws + OFF_H);
    u16* P = (u16*)(p.ws + OFF_P); float* G = (float*)(p.ws + OFF_G);
    const int tid = opaque_tid(), lane = tid & 63, wid = tid >> 6, wr = wid >> 1, wc = wid & 1;
    const int r = lane & 31, hh = lane >> 5;
    constexpr int NTM = 260, NTN = 53;
    for (int tile = blockIdx.x; tile < NTM * NTN; tile += gridDim.x) {
        const int nt = tile / NTM, mt = tile % NTM;
        const int realn0 = nt < 24 ? nt * 128 : (nt < 52 ? nt * 128 + 16 : 3072);
        const u16* rowp[4];
#pragma unroll
        for (int i = 0; i < 4; ++i) rowp[i] = H + (size_t)(mt * 128 + (tid >> 3) + 32 * i) * 1024 + (tid & 7) * 8;
        const float* bsrc = p.w_in + (size_t)((tid & 7) * 8) * INC + realn0 + (tid >> 3) * 4;
        f32x16 acc[2][2] = {};
        gemm_core(acc, rowp, bsrc, INC, 16, As, Bs, tid, lane, wr, wc);
        const int mb = mt * 128 + wr * 64 + 4 * hh;
        const int vc = nt * 128 + wc * 64 + r;
        if (nt < 8) {
            const bool latent = mt < 256 && DBG_ROPE;
            const float scale = nt < 4 ? 0.08838834764831845f : 1.f;
            const float inv = exp2f(-(float)r * (13.287712379549449f / 32.f));
#pragma unroll
            for (int mi = 0; mi < 2; ++mi)
#pragma unroll
                for (int reg = 0; reg < 16; ++reg) {
                    const int m = mb + ACC_ROW(mi, reg);
                    float x1 = acc[mi][0][reg] * scale, x2 = acc[mi][1][reg] * scale;
                    if (latent) {
                        const int t = m & (TSEQ - 1);
                        const float pos = (float)(wc == 0 ? (t >> 6) : (t & 63));
                        float sn, cs; sincos_rev(pos * inv * 0.15915494309189535f, sn, cs);
#if DBG_ROPE == 2
                        sn = 0.6f; cs = 0.8f;
#elif DBG_ROPE == 3
                        sincos_rev(inv * 0.15915494309189535f, sn, cs);
#elif DBG_ROPE == 4
                        sincos_rev(pos * 0.01f, sn, cs);
#endif
                        float a = x1 * cs; asm volatile("" : "+v"(a), "+v"(x1), "+v"(x2));
                        float o1 = fmaf(-x2, sn, a); asm volatile("" : "+v"(o1), "+v"(x1), "+v"(x2));
                        float bq = x1 * sn; asm volatile("" : "+v"(bq), "+v"(x2));
                        float o2 = fmaf(x2, cs, bq); asm volatile("" : "+v"(o2));
                        x1 = o1; x2 = o2;
                    }
                    P[(size_t)m * PV + vc] = f2bf(x1); P[(size_t)m * PV + vc + 32] = f2bf(x2);
                }
        } else if (nt >= 24 && nt < 32) {
            const float* nw = nt < 28 ? p.na_qn_w : p.na_kn_w;
            const float sc = nt < 28 ? 0.125f : 1.f;
            const float w0 = nw[r] * sc, w1 = nw[32 + r] * sc;
#pragma unroll
            for (int mi = 0; mi < 2; ++mi)
#pragma unroll
                for (int reg = 0; reg < 16; ++reg) {
                    const int m = mb + ACC_ROW(mi, reg);
                    const float a0 = acc[mi][0][reg], a1 = acc[mi][1][reg];
                    float s = a0 * a0 + a1 * a1;
                    s += __shfl_xor(s, 1); s += __shfl_xor(s, 2); s += __shfl_xor(s, 4); s += __shfl_xor(s, 8); s += __shfl_xor(s, 16);
                    const float rstd = rsqrtf(s * (1.f / 64.f) + 1e-6f);
                    P[(size_t)m * PV + vc] = f2bf(a0 * rstd * w0); P[(size_t)m * PV + vc + 32] = f2bf(a1 * rstd * w1);
                }
        } else if (nt >= 36 && nt < 52) {
#pragma unroll
            for (int mi = 0; mi < 2; ++mi)
#pragma unroll
                for (int reg = 0; reg < 16; ++reg) {
                    const int m = mb + ACC_ROW(mi, reg);
                    P[(size_t)m * PV + vc] = f2bf(sigmoid_(acc[mi][0][reg])); P[(size_t)m * PV + vc + 32] = f2bf(sigmoid_(acc[mi][1][reg]));
                }
        } else if (nt == 52) {
            if (wc == 0 && r < 16) {
                const float bg = p.b_mgate[r];
#pragma unroll
                for (int mi = 0; mi < 2; ++mi)
#pragma unroll
                    for (int reg = 0; reg < 16; ++reg) { const int m = mb + ACC_ROW(mi, reg); G[(size_t)m * 16 + r] = acc[mi][0][reg] + bg; }
            }
        } else {
#pragma unroll
            for (int mi = 0; mi < 2; ++mi)
#pragma unroll
                for (int reg = 0; reg < 16; ++reg) {
                    const int m = mb + ACC_ROW(mi, reg);
                    P[(size_t)m * PV + vc] = f2bf(acc[mi][0][reg]); P[(size_t)m * PV + vc + 32] = f2bf(acc[mi][1][reg]);
                }
        }
    }
}

__device__ __forceinline__ void mlstm_passA(const Params& p, unsigned char* smem, const int it) {
    const int tid = opaque_tid(), lane = tid & 63, wid = tid >> 6;
    const int c = it % 260, bh = it / 260, b = bh >> 2, h = bh & 3;
    const int base = c < 4 ? NTOK + b * 256 + c * 64 : b * TSEQ + (c - 4) * 64;
    const u16* P = (const u16*)(p.ws + OFF_P); const float* G = (const float*)(p.ws + OFF_G);
    float* gsum = (float*)(p.ws + OFF_GS); float* mloc = (float*)(p.ws + OFF_ML); float* dn = (float*)(p.ws + OFF_DN);
    u16* CT = (u16*)(p.ws + OFF_CT);
    u16* KTf = (u16*)smem; u16* KTb = (u16*)(smem + 18432); u16* VT = (u16*)(smem + 36864);
    float* wf = (float*)(smem + 73728); float* wb = wf + 64;
    const int slot_f = bh * 2 * 260 + c, slot_b = slot_f + 260;
    if (wid == 0) {
        const float* g = G + (size_t)(base + lane) * 16;
        const float igf = g[h], ff = g[4 + h], igb = g[8 + h], fb = g[12 + h];
        const float lff = log_sigmoid_(ff), lfb = log_sigmoid_(fb);
        const float bfc = wave_incl_sum(lff, lane), gf = __shfl(bfc, 63);
        const float uf = igf - bfc, umf = wave_max(uf);
        wf[lane] = __expf(uf - umf);
        const float pb = wave_incl_sum(lfb, lane), gb = __shfl(pb, 63);
        const float bb = gb - pb + lfb, ub = igb - bb, umb = wave_max(ub);
        wb[lane] = __expf(ub - umb);
        if (lane == 0) { gsum[slot_f] = gf; mloc[slot_f] = gf + umf; gsum[slot_b] = gb; mloc[slot_b] = gb + umb; }
    }
    __syncthreads();
    const int cgp = tid >> 3, tg = tid & 7;
    {
        const u16* src = P + (size_t)(base + tg * 8) * PV + V_MK + h * 128 + cgp * 4;
        u32x2 kv[8];
#pragma unroll
        for (int i = 0; i < 8; ++i) kv[i] = *(const u32x2*)(src + (size_t)i * PV);
        float wfi[8], wbi[8];
#pragma unroll
        for (int i = 0; i < 8; ++i) { wfi[i] = wf[tg * 8 + i]; wbi[i] = wb[tg * 8 + i]; }
#pragma unroll
        for (int cc = 0; cc < 4; ++cc) {
            float e[8];
#pragma unroll
            for (int i = 0; i < 8; ++i) e[i] = bfsel(kv[i], cc);
            u32x4 of, ob;
            of.x = pk2(e[0] * wfi[0], e[1] * wfi[1]); of.y = pk2(e[2] * wfi[2], e[3] * wfi[3]); of.z = pk2(e[4] * wfi[4], e[5] * wfi[5]); of.w = pk2(e[6] * wfi[6], e[7] * wfi[7]);
            ob.x = pk2(e[0] * wbi[0], e[1] * wbi[1]); ob.y = pk2(e[2] * wbi[2], e[3] * wbi[3]); ob.z = pk2(e[4] * wbi[4], e[5] * wbi[5]); ob.w = pk2(e[6] * wbi[6], e[7] * wbi[7]);
            *(u32x4*)(KTf + (cgp * 4 + cc) * LDT + tg * 8) = of;
            *(u32x4*)(KTb + (cgp * 4 + cc) * LDT + tg * 8) = ob;
        }
    }
#pragma unroll
    for (int vp = 0; vp < 2; ++vp) {
        const u16* src = P + (size_t)(base + tg * 8) * PV + V_MV + h * 256 + vp * 128 + cgp * 4;
        u32x2 vv[8];
#pragma unroll
        for (int i = 0; i < 8; ++i) vv[i] = *(const u32x2*)(src + (size_t)i * PV);
#pragma unroll
        for (int cc = 0; cc < 4; ++cc) *(u32x4*)(VT + (vp * 128 + cgp * 4 + cc) * LDT + tg * 8) = tr8(vv, cc);
    }
    __syncthreads();
    if (tid < 128) {
        float sf = 0.f, sb = 0.f;
#pragma unroll
        for (int j = 0; j < 8; ++j) {
            const u32x4 a = *(const u32x4*)(KTf + tid * LDT + j * 8), bq = *(const u32x4*)(KTb + tid * LDT + j * 8);
            sf += (bf_lo(a.x) + bf_hi(a.x)) + (bf_lo(a.y) + bf_hi(a.y)) + (bf_lo(a.z) + bf_hi(a.z)) + (bf_lo(a.w) + bf_hi(a.w));
            sb += (bf_lo(bq.x) + bf_hi(bq.x)) + (bf_lo(bq.y) + bf_hi(bq.y)) + (bf_lo(bq.z) + bf_hi(bq.z)) + (bf_lo(bq.w) + bf_hi(bq.w));
        }
        dn[(size_t)slot_f * 128 + tid] = sf; dn[(size_t)slot_b * 128 + tid] = sb;
    }
    const int r = lane & 31, hh = lane >> 5;
#pragma unroll 1
    for (int dir = 0; dir < 2; ++dir) {
        const u16* Bt = dir ? KTb : KTf;
        u16* dst = CT + (size_t)(dir ? slot_b : slot_f) * 32768;
#pragma unroll 1
        for (int nh = 0; nh < 2; ++nh) {
            f32x16 acc[2][2] = {};
#pragma unroll
            for (int kk = 0; kk < 4; ++kk) {
                bf16x8 a[2], bq[2];
#pragma unroll
                for (int mi = 0; mi < 2; ++mi) a[mi] = *(const bf16x8*)(VT + (wid * 64 + mi * 32 + r) * LDT + kk * 16 + hh * 8);
#pragma unroll
                for (int ni = 0; ni < 2; ++ni) bq[ni] = *(const bf16x8*)(Bt + (nh * 64 + ni * 32 + r) * LDT + kk * 16 + hh * 8);
#pragma unroll
                for (int mi = 0; mi < 2; ++mi)
#pragma unroll
                    for (int ni = 0; ni < 2; ++ni) acc[mi][ni] = mfma32(a[mi], bq[ni], acc[mi][ni]);
            }
#pragma unroll
            for (int mi = 0; mi < 2; ++mi)
#pragma unroll
                for (int ni = 0; ni < 2; ++ni)
#pragma unroll
                    for (int reg = 0; reg < 16; ++reg) {
                        const int v = wid * 64 + 4 * hh + ACC_ROW(mi, reg), d = nh * 64 + ni * 32 + r;
                        dst[v * 128 + d] = f2bf(acc[mi][ni][reg]);
                    }
        }
    }
    __syncthreads();
}

__device__ __forceinline__ void na_item(const Params& p, unsigned char* smem, const int it) {
    const int tid = opaque_tid(), lane = tid & 63, wid = tid >> 6;
    const int row = it & 255, h = (it >> 8) & 7, b = it >> 11;
    const u16* P = (const u16*)(p.ws + OFF_P);
    u16* YNA = (u16*)(p.ws + OFF_YNA);
    u16* Ks = (u16*)smem; u16* VTs = (u16*)(smem + 9216); u16* Ps = (u16*)(smem + 18432);
    const int l15 = lane & 15, l4 = lane >> 4;
    const int qtok = b * TSEQ + row * 64 + wid * 16 + l15;
    const u16* qsrc = P + (size_t)qtok * PV + V_NQ + h * 64 + l4 * 8;
    const bf16x8 qa0 = *(const bf16x8*)qsrc, qa1 = *(const bf16x8*)(qsrc + 32);
    const int rs = min(max(row - 4, 0), 248);
    f32x4 O[4] = {};
    float mrun[4], lrun[4];
#pragma unroll
    for (int i = 0; i < 4; ++i) { mrun[i] = -INFINITY; lrun[i] = 0.f; }
    for (int blk = 0; blk < 12; ++blk) {
        const int kbase = blk < 8 ? b * TSEQ + (rs + blk) * 64 : NTOK + b * 256 + (blk - 8) * 64;
#pragma unroll
        for (int i = 0; i < 2; ++i) {
            const int id = tid + i * 256, kr = id >> 3, ch = id & 7;
            *(u32x4*)(Ks + kr * LDT + ch * 8) = *(const u32x4*)(P + (size_t)(kbase + kr) * PV + V_NK + h * 64 + ch * 8);
        }
        if (tid < 128) {
            const int cgp = tid >> 3, tg = tid & 7;
            const u16* src = P + (size_t)(kbase + tg * 8) * PV + V_NV + h * 64 + cgp * 4;
            u32x2 vv[8];
#pragma unroll
            for (int i = 0; i < 8; ++i) vv[i] = *(const u32x2*)(src + (size_t)i * PV);
#pragma unroll
            for (int cc = 0; cc < 4; ++cc) *(u32x4*)(VTs + (cgp * 4 + cc) * LDT + tg * 8) = tr8(vv, cc);
        }
        __syncthreads();
        f32x4 S[4] = {};
#pragma unroll
        for (int nt = 0; nt < 4; ++nt) {
            const bf16x8 b0 = *(const bf16x8*)(Ks + (nt * 16 + l15) * LDT + l4 * 8), b1 = *(const bf16x8*)(Ks + (nt * 16 + l15) * LDT + 32 + l4 * 8);
            S[nt] = mfma16(qa0, b0, S[nt]); S[nt] = mfma16(qa1, b1, S[nt]);
        }
        if (blk < 8) {
            const float* rpb = p.na_rpb + (h * 15 + (rs + blk - row + 7)) * 31;
#pragma unroll
            for (int reg = 0; reg < 4; ++reg) {
                const int qc = wid * 16 + l4 * 4 + reg, cs = min(max(qc - 8, 0), 48);
#pragma unroll
                for (int nt = 0; nt < 4; ++nt) {
                    const int kc = nt * 16 + l15;
                    const bool valid = kc >= cs && kc < cs + 16;
                    float bias = 0.f;
                    if (valid) bias = rpb[kc - qc + 15];
                    S[nt][reg] = valid ? S[nt][reg] + bias : -INFINITY;
                }
            }
        }
#pragma unroll
        for (int reg = 0; reg < 4; ++reg) {
            float mx = fmaxf(fmaxf(S[0][reg], S[1][reg]), fmaxf(S[2][reg], S[3][reg]));
            mx = fmaxf(mx, __shfl_xor(mx, 1)); mx = fmaxf(mx, __shfl_xor(mx, 2)); mx = fmaxf(mx, __shfl_xor(mx, 4)); mx = fmaxf(mx, __shfl_xor(mx, 8));
            const float mnew = fmaxf(mrun[reg], mx);
            const float alpha = __expf(mrun[reg] - mnew);
            float ps = 0.f;
#pragma unroll
            for (int nt = 0; nt < 4; ++nt) {
                const float pe = __expf(S[nt][reg] - mnew);
                ps += pe;
                Ps[(wid * 16 + l4 * 4 + reg) * LDT + nt * 16 + l15] = f2bf(pe);
                O[nt][reg] *= alpha;
            }
            ps += __shfl_xor(ps, 1); ps += __shfl_xor(ps, 2); ps += __shfl_xor(ps, 4); ps += __shfl_xor(ps, 8);
            lrun[reg] = lrun[reg] * alpha + ps; mrun[reg] = mnew;
        }
        __syncthreads();
#pragma unroll
        for (int kk = 0; kk < 2; ++kk) {
            const bf16x8 a = *(const bf16x8*)(Ps + (wid * 16 + l15) * LDT + kk * 32 + l4 * 8);
#pragma unroll
            for (int nt = 0; nt < 4; ++nt) {
                const bf16x8 bv = *(const bf16x8*)(VTs + (nt * 16 + l15) * LDT + kk * 32 + l4 * 8);
                O[nt] = mfma16(a, bv, O[nt]);
            }
        }
        __syncthreads();
    }
#pragma unroll
    for (int reg = 0; reg < 4; ++reg) {
        const float il = 1.f / lrun[reg];
        const size_t tok = (size_t)b * TSEQ + row * 64 + wid * 16 + l4 * 4 + reg;
#pragma unroll
        for (int nt = 0; nt < 4; ++nt) YNA[tok * 512 + h * 64 + nt * 16 + l15] = f2bf(O[nt][reg] * il);
    }
}

__device__ __forceinline__ int scan_cidx(int i, int dir) { return dir == 0 ? i : (i < 4 ? 3 - i : 263 - i); }
__device__ __forceinline__ void phase_scan(const Params& p, unsigned char* smem) {
    const int tid = opaque_tid();
    float* gl = (float*)smem; float* ml = gl + 260; float* al = ml + 260; float* be = al + 260;
    const float* gsum = (const float*)(p.ws + OFF_GS); const float* mloc = (const float*)(p.ws + OFF_ML);
    float* mprev = (float*)(p.ws + OFF_MP); float* dn = (float*)(p.ws + OFF_DN);
    for (int it = blockIdx.x; it < 1024; it += gridDim.x) {
        const int bhd = it >> 6, eb = it & 63, dir = bhd & 1, slot0 = bhd * 260;
        for (int j = tid; j < 260; j += 256) { gl[j] = gsum[slot0 + j]; ml[j] = mloc[slot0 + j]; }
        __syncthreads();
        if (tid == 0) {
            float m = 0.f;
            for (int i = 0; i < 260; ++i) {
                const int c = scan_cidx(i, dir);
                const float g = gl[c], mn = fmaxf(g + m, ml[c]);
                al[i] = __expf(g + m - mn); be[i] = __expf(ml[c] - mn);
                if (eb == 0) mprev[slot0 + c] = m;
                m = mn;
            }
        }
        __syncthreads();
        u32* basep = (u32*)(p.ws + OFF_CT) + (size_t)slot0 * 16384 + eb * 256 + tid;
        float C0 = 0.f, C1 = 0.f;
        for (int i = 0; i < 260; i += 4) {
            u32* q0 = basep + (size_t)scan_cidx(i, dir) * 16384; u32* q1 = basep + (size_t)scan_cidx(i + 1, dir) * 16384;
            u32* q2 = basep + (size_t)scan_cidx(i + 2, dir) * 16384; u32* q3 = basep + (size_t)scan_cidx(i + 3, dir) * 16384;
            const u32 v0 = *q0, v1 = *q1, v2 = *q2, v3 = *q3;
            *q0 = pk2(C0, C1); C0 = al[i] * C0 + be[i] * bf_lo(v0); C1 = al[i] * C1 + be[i] * bf_hi(v0);
            *q1 = pk2(C0, C1); C0 = al[i + 1] * C0 + be[i + 1] * bf_lo(v1); C1 = al[i + 1] * C1 + be[i + 1] * bf_hi(v1);
            *q2 = pk2(C0, C1); C0 = al[i + 2] * C0 + be[i + 2] * bf_lo(v2); C1 = al[i + 2] * C1 + be[i + 2] * bf_hi(v2);
            *q3 = pk2(C0, C1); C0 = al[i + 3] * C0 + be[i + 3] * bf_lo(v3); C1 = al[i + 3] * C1 + be[i + 3] * bf_hi(v3);
        }
        if (eb == 0 && tid < 128) {
            float n = 0.f;
            for (int i = 0; i < 260; ++i) {
                float* q = dn + (size_t)(slot0 + scan_cidx(i, dir)) * 128 + tid;
                const float v = *q; *q = n; n = al[i] * n + be[i] * v;
            }
        }
        __syncthreads();
    }
}

__device__ __forceinline__ void mlstm_passC(const Params& p, unsigned char* smem, const int it) {
    const int tid = opaque_tid(), lane = tid & 63, wid = tid >> 6;
    const int cl = it & 255, bh = it >> 8, b = bh >> 2, h = bh & 3, c = cl + 4;
    const int base = b * TSEQ + cl * 64;
    const int slot_f = bh * 2 * 260 + c, slot_b = slot_f + 260;
    const u16* P = (const u16*)(p.ws + OFF_P); const float* G = (const float*)(p.ws + OFF_G);
    const float* mprev = (const float*)(p.ws + OFF_MP); const float* dn = (const float*)(p.ws + OFF_DN);
    const u16* CT = (const u16*)(p.ws + OFF_CT);
    u16* YM = (u16*)(p.ws + OFF_YM);
    u16* Ks = (u16*)smem;
    u16* CTf = (u16*)smem; u16* CTb = (u16*)(smem + 17408);
    u16* VTs = (u16*)(smem + 34816);
    u16* Spf = (u16*)(smem + 44032); u16* Spb = (u16*)(smem + 53248);
    float* ga = (float*)(smem + 62464);
    float *uf_s = ga, *Mf_s = ga + 64, *ub_s = ga + 128, *Mb_s = ga + 192, *clf = ga + 256, *clb = ga + 320, *wif = ga + 384, *wib = ga + 448;
    const int l15 = lane & 15, l4 = lane >> 4;
    if (wid == 0) {
        const float* g = G + (size_t)(base + lane) * 16;
        const float igf = g[h], ff = g[4 + h], igb = g[8 + h], fb = g[12 + h];
        const float lff = log_sigmoid_(ff), lfb = log_sigmoid_(fb);
        const float bfc = wave_incl_sum(lff, lane);
        const float uf = igf - bfc;
        const float pb = wave_incl_sum(lfb, lane), gb = __shfl(pb, 63);
        const float bb = gb - pb + lfb, ub = igb - bb;
        const float mpf = mprev[slot_f], mpb = mprev[slot_b];
        const float Mf = fmaxf(mpf, wave_prefix_max(uf, lane)), Mb = fmaxf(mpb, wave_suffix_max(ub, lane));
        uf_s[lane] = uf; Mf_s[lane] = Mf; clf[lane] = __expf(-(bfc + Mf)); wif[lane] = __expf(mpf - Mf);
        ub_s[lane] = ub; Mb_s[lane] = Mb; clb[lane] = __expf(-(bb + Mb)); wib[lane] = __expf(mpb - Mb);
    }
    bf16x8 qa[4];
    {
        const u16* qsrc = P + (size_t)(base + wid * 16 + l15) * PV + V_MQ + h * 128 + l4 * 8;
#pragma unroll
        for (int kk = 0; kk < 4; ++kk) qa[kk] = *(const bf16x8*)(qsrc + kk * 32);
    }
#pragma unroll
    for (int i = 0; i < 4; ++i) {
        const int id = tid + i * 256, kr = id >> 4, ch = id & 15;
        *(u32x4*)(Ks + kr * LDQ + ch * 8) = *(const u32x4*)(P + (size_t)(base + kr) * PV + V_MK + h * 128 + ch * 8);
    }
    __syncthreads();
    f32x4 S[4] = {};
#pragma unroll
    for (int nt = 0; nt < 4; ++nt)
#pragma unroll
        for (int kk = 0; kk < 4; ++kk) {
            const bf16x8 bq = *(const bf16x8*)(Ks + (nt * 16 + l15) * LDQ + kk * 32 + l4 * 8);
            S[nt] = mfma16(qa[kk], bq, S[nt]);
        }
    float qnf = 0.f, qnb = 0.f;
    {
        const float* nf = dn + (size_t)slot_f * 128; const float* nb = dn + (size_t)slot_b * 128;
#pragma unroll
        for (int kk = 0; kk < 4; ++kk)
#pragma unroll
            for (int j = 0; j < 8; ++j) {
                const int d = kk * 32 + l4 * 8 + j;
                const float qv = bf2f((u16)qa[kk][j]);
                qnf += qv * nf[d]; qnb += qv * nb[d];
            }
        qnf += __shfl_xor(qnf, 16); qnf += __shfl_xor(qnf, 32);
        qnb += __shfl_xor(qnb, 16); qnb += __shfl_xor(qnb, 32);
    }
    float denf[4], denb[4], cpf[4], cpb[4];
#pragma unroll
    for (int reg = 0; reg < 4; ++reg) {
        const int t = wid * 16 + l4 * 4 + reg;
        const float Mft = Mf_s[t], Mbt = Mb_s[t];
        float rsf = 0.f, rsb = 0.f;
#pragma unroll
        for (int nt = 0; nt < 4; ++nt) {
            const int s = nt * 16 + l15;
            const float sv = S[nt][reg];
            const float pf = (s <= t) ? sv * __expf(uf_s[s] - Mft) : 0.f;
            const float pbv = (s >= t) ? sv * __expf(ub_s[s] - Mbt) : 0.f;
            rsf += pf; rsb += pbv;
            Spf[t * LDT + s] = f2bf(pf); Spb[t * LDT + s] = f2bf(pbv);
        }
        rsf += __shfl_xor(rsf, 1); rsf += __shfl_xor(rsf, 2); rsf += __shfl_xor(rsf, 4); rsf += __shfl_xor(rsf, 8);
        rsb += __shfl_xor(rsb, 1); rsb += __shfl_xor(rsb, 2); rsb += __shfl_xor(rsb, 4); rsb += __shfl_xor(rsb, 8);
        const float qf = __shfl(qnf, l4 * 4 + reg), qb = __shfl(qnb, l4 * 4 + reg);
        denf[reg] = rsf + wif[t] * qf; denb[reg] = rsb + wib[t] * qb;
        cpf[reg] = clf[t]; cpb[reg] = clb[t];
    }
    bf16x8 qwf[4], qwb[4];
    {
        const float wfr = wif[wid * 16 + l15], wbr = wib[wid * 16 + l15];
#pragma unroll
        for (int kk = 0; kk < 4; ++kk) {
            u32x4 of, ob;
            const float q0 = bf2f((u16)qa[kk][0]), q1 = bf2f((u16)qa[kk][1]), q2 = bf2f((u16)qa[kk][2]), q3 = bf2f((u16)qa[kk][3]);
            const float q4 = bf2f((u16)qa[kk][4]), q5 = bf2f((u16)qa[kk][5]), q6 = bf2f((u16)qa[kk][6]), q7 = bf2f((u16)qa[kk][7]);
            of.x = pk2(q0 * wfr, q1 * wfr); of.y = pk2(q2 * wfr, q3 * wfr); of.z = pk2(q4 * wfr, q5 * wfr); of.w = pk2(q6 * wfr, q7 * wfr);
            ob.x = pk2(q0 * wbr, q1 * wbr); ob.y = pk2(q2 * wbr, q3 * wbr); ob.z = pk2(q4 * wbr, q5 * wbr); ob.w = pk2(q6 * wbr, q7 * wbr);
            qwf[kk] = __builtin_bit_cast(bf16x8, of); qwb[kk] = __builtin_bit_cast(bf16x8, ob);
        }
    }
    __syncthreads();
    float ssq[4] = {0.f, 0.f, 0.f, 0.f};
#pragma unroll 1
    for (int vb = 0; vb < 4; ++vb) {
        if (tid < 128) {
            const int cgp = tid >> 3, tg = tid & 7;
            const u16* src = P + (size_t)(base + tg * 8) * PV + V_MV + h * 256 + vb * 64 + cgp * 4;
            u32x2 vv[8];
#pragma unroll
            for (int i = 0; i < 8; ++i) vv[i] = *(const u32x2*)(src + (size_t)i * PV);
#pragma unroll
            for (int cc = 0; cc < 4; ++cc) *(u32x4*)(VTs + (cgp * 4 + cc) * LDT + tg * 8) = tr8(vv, cc);
        }
#pragma unroll
        for (int i = 0; i < 4; ++i) {
            const int id = tid + i * 256, vr = id >> 4, ch = id & 15;
            *(u32x4*)(CTf + vr * LDQ + ch * 8) = *(const u32x4*)(CT + (size_t)slot_f * 32768 + (vb * 64 + vr) * 128 + ch * 8);
            *(u32x4*)(CTb + vr * LDQ + ch * 8) = *(const u32x4*)(CT + (size_t)slot_b * 32768 + (vb * 64 + vr) * 128 + ch * 8);
        }
        __syncthreads();
        f32x4 af[4] = {}, ab[4] = {};
#pragma unroll
        for (int kk = 0; kk < 2; ++kk) {
            const bf16x8 a_f = *(const bf16x8*)(Spf + (wid * 16 + l15) * LDT + kk * 32 + l4 * 8);
            const bf16x8 a_b = *(const bf16x8*)(Spb + (wid * 16 + l15) * LDT + kk * 32 + l4 * 8);
#pragma unroll
            for (int nt = 0; nt < 4; ++nt) {
                const bf16x8 bv = *(const bf16x8*)(VTs + (nt * 16 + l15) * LDT + kk * 32 + l4 * 8);
                af[nt] = mfma16(a_f, bv, af[nt]); ab[nt] = mfma16(a_b, bv, ab[nt]);
            }
        }
#pragma unroll
        for (int kk = 0; kk < 4; ++kk)
#pragma unroll
            for (int nt = 0; nt < 4; ++nt) {
                const bf16x8 cf = *(const bf16x8*)(CTf + (nt * 16 + l15) * LDQ + kk * 32 + l4 * 8);
                const bf16x8 cb = *(const bf16x8*)(CTb + (nt * 16 + l15) * LDQ + kk * 32 + l4 * 8);
                af[nt] = mfma16(qwf[kk], cf, af[nt]); ab[nt] = mfma16(qwb[kk], cb, ab[nt]);
            }
#pragma unroll
        for (int reg = 0; reg < 4; ++reg) {
            const size_t tok = (size_t)base + wid * 16 + l4 * 4 + reg;
            const float idf = 1.f / fmaxf(fabsf(denf[reg]), cpf[reg]), idb = 1.f / fmaxf(fabsf(denb[reg]), cpb[reg]);
#pragma unroll
            for (int nt = 0; nt < 4; ++nt) {
                const float hv = af[nt][reg] * idf + ab[nt][reg] * idb;
                ssq[reg] += hv * hv;
                const int v = h * 256 + vb * 64 + nt * 16 + l15;
                const float o = bf2f(P[tok * PV + V_MO + v]);
                YM[tok * 1024 + v] = f2bf(hv * p.m_norm_w[v] * sigmoid_(o));
            }
        }
        __syncthreads();
    }
    float rstd[4];
#pragma unroll
    for (int reg = 0; reg < 4; ++reg) {
        float ss = ssq[reg];
        ss += __shfl_xor(ss, 1); ss += __shfl_xor(ss, 2); ss += __shfl_xor(ss, 4); ss += __shfl_xor(ss, 8);
        rstd[reg] = rsqrtf(ss * (1.f / 256.f) + 1e-6f);
    }
#pragma unroll 1
    for (int vb = 0; vb < 4; ++vb) {
#pragma unroll
        for (int reg = 0; reg < 4; ++reg) {
            const size_t tok = (size_t)base + wid * 16 + l4 * 4 + reg;
#pragma unroll
            for (int nt = 0; nt < 4; ++nt) {
                u16* q = YM + tok * 1024 + h * 256 + vb * 64 + nt * 16 + l15;
                *q = f2bf(bf2f(*q) * rstd[reg]);
            }
        }
    }
}

__device__ __forceinline__ void phase_merge(const Params& p, unsigned char* smem, const bool second) {
    u16* As = (u16*)smem; u16* Bs = (u16*)(smem + 18432);
    const u16* P = (const u16*)(p.ws + OFF_P);
    const u16* YM = (const u16*)(p.ws + OFF_YM); const u16* YNA = (const u16*)(p.ws + OFF_YNA);
    u16* MRG = (u16*)(p.ws + OFF_MRG);
    const int tid = opaque_tid(), lane = tid & 63, wid = tid >> 6, wr = wid >> 1, wc = wid & 1;
    const int r = lane & 31, hh = lane >> 5;
    const u16* abase = second ? YNA : YM; const int lda = second ? 512 : 1024;
    const float* wsel = second ? p.w_br_na : p.w_br_m;
    const int gcol = second ? V_GN : V_GM;
    for (int tile = blockIdx.x; tile < 2048; tile += gridDim.x) {
        const int mt = tile & 255, nt = tile >> 8;
        const int mb = mt * 128 + wr * 64 + 4 * hh, col = nt * 128 + wc * 64 + r;
        const u16* rowp[4];
#pragma unroll
        for (int i = 0; i < 4; ++i) rowp[i] = abase + (size_t)(mt * 128 + (tid >> 3) + 32 * i) * lda + (tid & 7) * 8;
        const float* bsrc = wsel + (size_t)((tid & 7) * 8) * 1024 + nt * 128 + (tid >> 3) * 4;
        f32x16 acc[2][2] = {};
        gemm_core(acc, rowp, bsrc, 1024, second ? 8 : 16, As, Bs, tid, lane, wr, wc);
#pragma unroll
        for (int mi = 0; mi < 2; ++mi)
#pragma unroll
            for (int ni = 0; ni < 2; ++ni)
#pragma unroll
                for (int reg = 0; reg < 16; ++reg) {
                    const size_t m = mb + ACC_ROW(mi, reg);
                    u16* q = MRG + m * 1024 + col + ni * 32;
                    float o = acc[mi][ni][reg] * bf2f(P[m * PV + gcol + col + ni * 32]);
                    if (second) o += bf2f(*q);
                    *q = f2bf(o);
                }
    }
}

__device__ __forceinline__ void phase_outproj(const Params& p, unsigned char* smem) {
    u16* As = (u16*)smem; u16* Bs = (u16*)(smem + 18432);
    const u16* MRG = (const u16*)(p.ws + OFF_MRG);
    const int tid = opaque_tid(), lane = tid & 63, wid = tid >> 6, wr = wid >> 1, wc = wid & 1;
    const int r = lane & 31, hh = lane >> 5;
    for (int tile = blockIdx.x; tile < 2048; tile += gridDim.x) {
        const int mt = tile & 255, nt = tile >> 8;
        const int mb = mt * 128 + wr * 64 + 4 * hh, col = nt * 128 + wc * 64 + r;
        const u16* rowp[4];
#pragma unroll
        for (int i = 0; i < 4; ++i) rowp[i] = MRG + (size_t)(mt * 128 + (tid >> 3) + 32 * i) * 1024 + (tid & 7) * 8;
        const float* bsrc = p.w_out + (size_t)((tid & 7) * 8) * 1024 + nt * 128 + (tid >> 3) * 4;
        f32x16 acc[2][2] = {};
        gemm_core(acc, rowp, bsrc, 1024, 16, As, Bs, tid, lane, wr, wc);
        const int bvec = mt >> 7;
        const float g0 = mod_val(p, bvec, 2048 + col), g1 = mod_val(p, bvec, 2048 + col + 32);
#pragma unroll
        for (int mi = 0; mi < 2; ++mi)
#pragma unroll
            for (int reg = 0; reg < 16; ++reg) {
                const size_t m = mb + ACC_ROW(mi, reg);
                p.out[m * 1024 + col] = p.x[m * 1024 + col] + g0 * acc[mi][0][reg];
                p.out[m * 1024 + col + 32] = p.x[m * 1024 + col + 32] + g1 * acc[mi][1][reg];
            }
    }
}

__device__ __forceinline__ void phase_router(const Params& p, unsigned char* smem) {
    u16* As = (u16*)smem; u16* Bs = (u16*)(smem + 18432);
    const u16* H = (const u16*)(p.ws + OFF_H);
    float* SC = (float*)(p.ws + OFF_SC);
    const int tid = opaque_tid(), lane = tid & 63, wid = tid >> 6, wr = wid >> 1, wc = wid & 1;
    const int r = lane & 31, hh = lane >> 5;
    for (int tile = blockIdx.x; tile < 512; tile += gridDim.x) {
        const int mt = tile & 255, nt = tile >> 8;
        const int mb = mt * 128 + wr * 64 + 4 * hh, col = nt * 128 + wc * 64 + r;
        const u16* rowp[4];
#pragma unroll
        for (int i = 0; i < 4; ++i) rowp[i] = H + (size_t)(mt * 128 + (tid >> 3) + 32 * i) * 1024 + (tid & 7) * 8;
        const float* bsrc = p.w_router + (size_t)((tid & 7) * 8) * 256 + nt * 128 + (tid >> 3) * 4;
        f32x16 acc[2][2] = {};
        gemm_core(acc, rowp, bsrc, 256, 16, As, Bs, tid, lane, wr, wc);
#pragma unroll
        for (int mi = 0; mi < 2; ++mi)
#pragma unroll
            for (int ni = 0; ni < 2; ++ni)
#pragma unroll
                for (int reg = 0; reg < 16; ++reg) {
                    const size_t m = mb + ACC_ROW(mi, reg);
                    SC[m * 256 + col + ni * 32] = sigmoid_(acc[mi][ni][reg]);
                }
    }
}

__device__ __forceinline__ void phase_route(const Params& p) {
    const int tid = opaque_tid(), lane = tid & 63, wid = tid >> 6;
    const float* SC = (const float*)(p.ws + OFF_SC);
    int* cnt = (int*)(p.ws + OFF_CNT); int* slot_tok = (int*)(p.ws + OFF_SLOT);
    int* tope = (int*)(p.ws + OFF_TOPE); int* rnk = (int*)(p.ws + OFF_RANK); float* topw = (float*)(p.ws + OFF_TOPW);
    const f32x4 rb = *(const f32x4*)(p.router_bias + lane * 4);
    for (int tok = blockIdx.x * 4 + wid; tok < NTOK; tok += gridDim.x * 4) {
        const f32x4 sc = *(const f32x4*)(SC + (size_t)tok * 256 + lane * 4);
        float s0 = sc.x + rb.x, s1 = sc.y + rb.y, s2 = sc.z + rb.z, s3 = sc.w + rb.w;
        float a1 = fmaxf(s0, s1), a2 = fminf(s0, s1);
        { const float b1 = fmaxf(s2, s3), b2 = fminf(s2, s3); const float n1 = fmaxf(a1, b1), n2 = fmaxf(fminf(a1, b1), fmaxf(a2, b2)); a1 = n1; a2 = n2; }
#pragma unroll
        for (int o = 1; o < 8; o <<= 1) {
            const float b1 = __shfl_xor(a1, o), b2 = __shfl_xor(a2, o);
            const float n1 = fmaxf(a1, b1), n2 = fmaxf(fminf(a1, b1), fmaxf(a2, b2)); a1 = n1; a2 = n2;
        }
        const float gs = a1 + a2; const int mygrp = lane >> 3;
        int gcnt = 0;
#pragma unroll
        for (int g = 0; g < 8; ++g) { const float og = __shfl(gs, g * 8); gcnt += (og > gs || (og == gs && g < mygrp)) ? 1 : 0; }
        if (gcnt >= 4) { s0 = -INFINITY; s1 = -INFINITY; s2 = -INFINITY; s3 = -INFINITY; }
        int my_e = 0; float my_s = 0.f, wsum = 0.f;
#pragma unroll
        for (int k = 0; k < 8; ++k) {
            float bv = s0; int bi = lane * 4;
            if (s1 > bv) { bv = s1; bi = lane * 4 + 1; }
            if (s2 > bv) { bv = s2; bi = lane * 4 + 2; }
            if (s3 > bv) { bv = s3; bi = lane * 4 + 3; }
#pragma unroll
            for (int o = 1; o < 64; o <<= 1) {
                const float ov = __shfl_xor(bv, o); const int oi = __shfl_xor(bi, o);
                if (ov > bv || (ov == bv && oi < bi)) { bv = ov; bi = oi; }
            }
            const int own = bi >> 2, sub = bi & 3;
            const float mine = sub == 0 ? sc.x : sub == 1 ? sc.y : sub == 2 ? sc.z : sc.w;
            const float sel_sc = __shfl(mine, own);
            if (lane == own) { if (sub == 0) s0 = -INFINITY; else if (sub == 1) s1 = -INFINITY; else if (sub == 2) s2 = -INFINITY; else s3 = -INFINITY; }
            wsum += sel_sc;
            if (lane == k) { my_e = bi; my_s = sel_sc; }
        }
        if (lane < 8) {
            const int rk = atomicAdd(cnt + my_e, 1);
            slot_tok[(size_t)my_e * NTOK + rk] = tok;
            tope[tok * 8 + lane] = my_e; rnk[tok * 8 + lane] = rk; topw[tok * 8 + lane] = my_s / wsum * 2.5f;
        }
    }
}

__device__ __forceinline__ int* build_tile_table(const Params& p, unsigned char* smem) {
    int* tstart = (int*)(smem + 40960); int* cn = tstart + 260;
    const int tid = opaque_tid();
    cn[tid] = ((const int*)(p.ws + OFF_CNT))[tid];
    __syncthreads();
    if (tid == 0) { int s = 0; for (int e = 0; e < 256; ++e) { tstart[e] = s; s += (cn[e] + 127) >> 7; } tstart[256] = s; }
    __syncthreads();
    return tstart;
}
__device__ __forceinline__ int find_expert(const int* tstart, int mtile) {
    int lo = 0, hi = 256;
    while (hi - lo > 1) { const int mid = (lo + hi) >> 1; if (tstart[mid] <= mtile) lo = mid; else hi = mid; }
    return lo;
}

__device__ __forceinline__ void phase_moe1(const Params& p, unsigned char* smem) {
    u16* As = (u16*)smem; u16* Bs = (u16*)(smem + 18432);
    const int* tstart = build_tile_table(p, smem); const int* cn = tstart + 260;
    const u16* H2 = (const u16*)(p.ws + OFF_H);
    const int* slot_tok = (const int*)(p.ws + OFF_SLOT);
    u16* HID = (u16*)(p.ws + OFF_HID);
    const int tid = opaque_tid(), lane = tid & 63, wid = tid >> 6, wr = wid >> 1, wc = wid & 1;
    const int r = lane & 31, hh = lane >> 5;
    const int total = tstart[256];
    const int nitems = total * 4 + 1024;
    for (int it = blockIdx.x; it < nitems; it += gridDim.x) {
        const bool shared = it >= total * 4;
        const int idx = shared ? it - total * 4 : it;
        const int mtile = idx >> 2, nq = idx & 3;
        int e = 0, j = 0, cnt_e = 0;
        if (!shared) { e = find_expert(tstart, mtile); j = mtile - tstart[e]; cnt_e = cn[e]; }
        const u16* rowp[4];
#pragma unroll
        for (int i = 0; i < 4; ++i) {
            const int ri = (tid >> 3) + 32 * i;
            int tok;
            if (shared) tok = mtile * 128 + ri;
            else { const int pos = j * 128 + ri; tok = pos < cnt_e ? slot_tok[(size_t)e * NTOK + pos] : 0; }
            rowp[i] = H2 + (size_t)tok * 1024 + (tid & 7) * 8;
        }
        const int R0 = (tid >> 3) * 4, bwc = R0 >> 6, bni = (R0 >> 5) & 1, bj = R0 & 31;
        const float* wsel = shared ? (bni ? p.w_sh_up : p.w_sh_gate) : ((bni ? p.w_exp_up : p.w_exp_gate) + (size_t)e * 1024 * 256);
        const float* bsrc = wsel + (size_t)((tid & 7) * 8) * 256 + nq * 64 + bwc * 32 + bj;
        f32x16 acc[2][2] = {};
        gemm_core(acc, rowp, bsrc, 256, 16, As, Bs, tid, lane, wr, wc);
        const size_t hrow0 = shared ? (size_t)SH_BASE + mtile * 128 : (size_t)mtile * 128;
#pragma unroll
        for (int mi = 0; mi < 2; ++mi)
#pragma unroll
            for (int reg = 0; reg < 16; ++reg) {
                const size_t hr = hrow0 + wr * 64 + 4 * hh + ACC_ROW(mi, reg);
                const float g = acc[mi][0][reg], u = acc[mi][1][reg];
                HID[hr * 256 + nq * 64 + wc * 32 + r] = f2bf(g * sigmoid_(g) * u);
            }
    }
}

__device__ __forceinline__ void phase_moe2(const Params& p, unsigned char* smem) {
    u16* As = (u16*)smem; u16* Bs = (u16*)(smem + 18432);
    const int* tstart = build_tile_table(p, smem);
    const u16* HID = (const u16*)(p.ws + OFF_HID);
    u16* Y = (u16*)(p.ws + OFF_Y);
    const int tid = opaque_tid(), lane = tid & 63, wid = tid >> 6, wr = wid >> 1, wc = wid & 1;
    const int r = lane & 31, hh = lane >> 5;
    const int total = tstart[256];
    const int nitems = total * 8 + 2048;
    for (int it = blockIdx.x; it < nitems; it += gridDim.x) {
        const bool shared = it >= total * 8;
        const int idx = shared ? it - total * 8 : it;
        const int mtile = idx >> 3, nt = idx & 7;
        int e = 0;
        if (!shared) e = find_expert(tstart, mtile);
        const size_t hrow0 = shared ? (size_t)SH_BASE + mtile * 128 : (size_t)mtile * 128;
        const u16* rowp[4];
#pragma unroll
        for (int i = 0; i < 4; ++i) rowp[i] = HID + (hrow0 + (tid >> 3) + 32 * i) * 256 + (tid & 7) * 8;
        const float* wsel = shared ? p.w_sh_down : p.w_exp_down + (size_t)e * 256 * 1024;
        const float* bsrc = wsel + (size_t)((tid & 7) * 8) * 1024 + nt * 128 + (tid >> 3) * 4;
        f32x16 acc[2][2] = {};
        gemm_core(acc, rowp, bsrc, 1024, 4, As, Bs, tid, lane, wr, wc);
#pragma unroll
        for (int mi = 0; mi < 2; ++mi)
#pragma unroll
            for (int ni = 0; ni < 2; ++ni)
#pragma unroll
                for (int reg = 0; reg < 16; ++reg) {
                    const size_t yr = hrow0 + wr * 64 + 4 * hh + ACC_ROW(mi, reg);
                    Y[yr * 1024 + nt * 128 + wc * 64 + ni * 32 + r] = f2bf(acc[mi][ni][reg]);
                }
    }
}

__device__ __forceinline__ void phase_combine(const Params& p, unsigned char* smem) {
    const int* tstart = build_tile_table(p, smem);
    float* g2t = (float*)smem;
    const int tid = opaque_tid(), lane = tid & 63, wid = tid >> 6;
    for (int j = tid; j < 2048; j += 256) g2t[j] = mod_val(p, j >> 10, 5120 + (j & 1023));
    __syncthreads();
    const u16* Y = (const u16*)(p.ws + OFF_Y);
    const int* tope = (const int*)(p.ws + OFF_TOPE); const int* rnk = (const int*)(p.ws + OFF_RANK); const float* topw = (const float*)(p.ws + OFF_TOPW);
    for (int tok = blockIdx.x * 4 + wid; tok < NTOK; tok += gridDim.x * 4) {
        int myrow = 0; float myw = 0.f;
        if (lane < 8) { const int e = tope[tok * 8 + lane]; myrow = tstart[e] * 128 + rnk[tok * 8 + lane]; myw = topw[tok * 8 + lane]; }
        if (lane == 8) { myrow = SH_BASE + tok; myw = 1.f; }
        const float* g2 = g2t + (tok >> 14) * 1024;
        f32x4 a[4];
#pragma unroll
        for (int j = 0; j < 4; ++j) a[j] = (f32x4){0.f, 0.f, 0.f, 0.f};
#pragma unroll
        for (int k = 0; k < 9; ++k) {
            const int row = __shfl(myrow, k); const float w = __shfl(myw, k);
            const u16* yr = Y + (size_t)row * 1024 + lane * 4;
#pragma unroll
            for (int j = 0; j < 4; ++j) {
                const u32x2 v = *(const u32x2*)(yr + j * 256);
                a[j].x += w * bf_lo(v.x); a[j].y += w * bf_hi(v.x); a[j].z += w * bf_lo(v.y); a[j].w += w * bf_hi(v.y);
            }
        }
#pragma unroll
        for (int j = 0; j < 4; ++j) {
            const int col = j * 256 + lane * 4;
            float* op = p.out + (size_t)tok * 1024 + col;
            const f32x4 x1 = *(const f32x4*)op, g = *(const f32x4*)(g2 + col);
            f32x4 o; o.x = x1.x + g.x * a[j].x; o.y = x1.y + g.y * a[j].y; o.z = x1.z + g.z * a[j].z; o.w = x1.w + g.w * a[j].w;
            *(f32x4*)op = o;
        }
    }
}

__global__ void __launch_bounds__(256, 2) mega(Params p) {
    extern __shared__ __attribute__((aligned(16))) unsigned char smem[];
    cg::grid_group grid = cg::this_grid();
#define PHASE_BEGIN(k) if (p.ph_lo <= (k) && (k) < p.ph_hi) {
#define PHASE_END(k) if ((k) + 1 < p.ph_hi) grid.sync(); }
    PHASE_BEGIN(0) phase_ada(p, smem); PHASE_END(0)
    PHASE_BEGIN(1) phase_norm(p, smem, false); PHASE_END(1)
    PHASE_BEGIN(2) phase_inproj(p, smem); PHASE_END(2)
    PHASE_BEGIN(3)
        for (int it = blockIdx.x; it < 2080 + 4096; it += gridDim.x) { if (it < 2080) mlstm_passA(p, smem, it); else na_item(p, smem, it - 2080); }
    PHASE_END(3)
    PHASE_BEGIN(4) phase_scan(p, smem); PHASE_END(4)
    PHASE_BEGIN(5) for (int it = blockIdx.x; it < 2048; it += gridDim.x) mlstm_passC(p, smem, it); PHASE_END(5)
    PHASE_BEGIN(6) phase_merge(p, smem, false); phase_merge(p, smem, true); PHASE_END(6)
    PHASE_BEGIN(7) phase_outproj(p, smem); PHASE_END(7)
    PHASE_BEGIN(8) phase_norm(p, smem, true); PHASE_END(8)
    PHASE_BEGIN(9) phase_router(p, smem); PHASE_END(9)
    PHASE_BEGIN(10) phase_route(p); PHASE_END(10)
    PHASE_BEGIN(11) phase_moe1(p, smem); PHASE_END(11)
    PHASE_BEGIN(12) phase_moe2(p, smem); PHASE_END(12)
    PHASE_BEGIN(13) phase_combine(p, smem); PHASE_END(13)
#if RUN_PHASES < 8
    if (!MULTI_LAUNCH) grid.sync();
    if (p.ph_lo == 100 || !MULTI_LAUNCH) {
        const size_t NOUT = (size_t)NTOK * 1024;
        for (size_t i = (size_t)blockIdx.x * 256 + threadIdx.x; i < NOUT; i += (size_t)gridDim.x * 256) {
            float s = 0.f;
#define TAPB(off, n) { const u16* bb_ = (const u16*)(p.ws + (off)); for (size_t j = i; j < (size_t)(n); j += NOUT) s += bf2f(bb_[j]); }
#define TAPF(off, n) { const float* bb_ = (const float*)(p.ws + (off)); for (size_t j = i; j < (size_t)(n); j += NOUT) s += bb_[j]; }
#if RUN_PHASES == 1
            TAPF(OFF_MODP, 8 * 3 * 6144)
#elif RUN_PHASES == 2
            TAPB(OFF_H, (size_t)MTOT * 1024)
#elif RUN_PHASES == 3
            { const u16* bb_ = (const u16*)(p.ws + OFF_P); for (size_t j = i; j < (size_t)MTOT * 1024; j += NOUT) s += bf2f(bb_[(j / 1024) * PV + TAPC0 + (j % 1024)]); }
#elif RUN_PHASES == 4
            TAPB(OFF_YNA, (size_t)NTOK * 512) TAPB(OFF_CT, (size_t)NSLOT * 32768) TAPF(OFF_DN, NSLOT * 128) TAPF(OFF_GS, NSLOT) TAPF(OFF_ML, NSLOT)
#elif RUN_PHASES == 5
            TAPB(OFF_CT, (size_t)NSLOT * 32768) TAPF(OFF_DN, NSLOT * 128) TAPF(OFF_MP, NSLOT)
#elif RUN_PHASES == 6
            TAPB(OFF_YM, (size_t)NTOK * 1024)
#elif RUN_PHASES == 7
            TAPB(OFF_MRG, (size_t)NTOK * 1024)
#endif
            p.out[i] = p.x[i] + s;
        }
    }
#endif
}

extern "C" void kernel_launch(void* const* d_in, const int* in_sizes, int n_in, void* d_out, int out_size, void* d_ws, size_t ws_size, hipStream_t stream) {
    static int grid_blocks = 0;
    if (!grid_blocks) {
        int dev = 0, cus = 0, per_cu = 0;
        (void)hipGetDevice(&dev);
        (void)hipDeviceGetAttribute(&cus, hipDeviceAttributeMultiprocessorCount, dev);
        (void)hipFuncSetAttribute((const void*)mega, hipFuncAttributeMaxDynamicSharedMemorySize, LDS_BYTES);
        (void)hipOccupancyMaxActiveBlocksPerMultiprocessor(&per_cu, mega, 256, LDS_BYTES);
        if (per_cu > 2) per_cu = 2;
        if (per_cu < 1) per_cu = 1;
        grid_blocks = cus * per_cu;
        if (ws_size < WS_END) fprintf(stderr, "kernel_launch: workspace too small: %zu < %zu\n", ws_size, (size_t)WS_END);
    }
    Params p{};
    const float** pp = (const float**)&p;
    for (int i = 0; i < 23; ++i) pp[i] = (const float*)d_in[i];
    p.out = (float*)d_out; p.ws = (unsigned char*)d_ws;
#if MULTI_LAUNCH
    for (int ph = 0; ph < (RUN_PHASES < 1 ? 1 : (RUN_PHASES < NPH ? RUN_PHASES : NPH)); ++ph) {
        p.ph_lo = ph; p.ph_hi = ph + 1;
        void* args[] = {&p};
        hipError_t e = hipLaunchCooperativeKernel((void*)mega, dim3(grid_blocks), dim3(256), args, LDS_BYTES, stream);
        if (e != hipSuccess) fprintf(stderr, "cooperative launch failed: %s (grid %d)\n", hipGetErrorString(e), grid_blocks);
    }
#if RUN_PHASES < 8
    { p.ph_lo = 100; p.ph_hi = 100; void* args[] = {&p};
      (void)hipLaunchCooperativeKernel((void*)mega, dim3(grid_blocks), dim3(256), args, LDS_BYTES, stream); }
#endif
#else
    p.ph_lo = 0; p.ph_hi = RUN_PHASES < NPH ? RUN_PHASES : NPH;
    void* args[] = {&p};
    hipError_t e = hipLaunchCooperativeKernel((void*)mega, dim3(grid_blocks), dim3(256), args, LDS_BYTES, stream);
    if (e != hipSuccess) fprintf(stderr, "cooperative launch failed: %s (grid %d)\n", hipGetErrorString(e), grid_blocks);
#endif
}
```

```cpp
#include <hip/hip_runtime.h>
#include <hip/hip_cooperative_groups.h>
#include <cstdio>
#include <cstdint>
namespace cg = cooperative_groups;

#ifndef MULTI_LAUNCH
#define MULTI_LAUNCH 0
#endif
#ifndef TAPC0
#define TAPC0 0
#endif
#ifndef DBG_ROPE
#define DBG_ROPE 1
#endif
#ifndef DUP_PHASE
#define DUP_PHASE -1
#endif
#ifndef RUN_PHASES
#define RUN_PHASES 15
#endif

typedef unsigned short u16;
typedef unsigned int u32;
typedef short bf16x8 __attribute__((ext_vector_type(8)));
typedef float f32x16 __attribute__((ext_vector_type(16)));
typedef float f32x4 __attribute__((ext_vector_type(4)));
typedef u32 u32x4 __attribute__((ext_vector_type(4)));
typedef u32 u32x2 __attribute__((ext_vector_type(2)));

constexpr int DM = 1024;
constexpr int NTOK = 32768;
constexpr int TSEQ = 16384;
constexpr int MTOT = 33280;
constexpr int INC = 6672;
constexpr int PV = 6784;
constexpr int V_MQ = 0, V_MK = 512, V_MV = 1024, V_MO = 2048, V_NQ = 3072, V_NK = 3584, V_NV = 4096, V_GM = 4608, V_GN = 5632;
constexpr int NSLOT = 4160;
constexpr int SH_BASE = 294912;
constexpr int NPH = 15;
constexpr int LDS_BYTES = 76 * 1024;
constexpr int LDT = 72;
constexpr int LDQ = 136;

constexpr size_t AL(size_t x) { return (x + 255) & ~(size_t)255; }
constexpr size_t OFF_MODP = 0;
constexpr size_t OFF_CNT  = AL(OFF_MODP + (size_t)8 * 3 * 6144 * 4);
constexpr size_t OFF_G    = AL(OFF_CNT + 1024);
constexpr size_t OFF_GS   = AL(OFF_G + (size_t)MTOT * 16 * 4);
constexpr size_t OFF_ML   = AL(OFF_GS + NSLOT * 4);
constexpr size_t OFF_MP   = AL(OFF_ML + NSLOT * 4);
constexpr size_t OFF_DN   = AL(OFF_MP + NSLOT * 4);
constexpr size_t OFF_TOPE = AL(OFF_DN + (size_t)NSLOT * 128 * 4);
constexpr size_t OFF_RANK = OFF_TOPE + (size_t)NTOK * 8 * 4;
constexpr size_t OFF_TOPW = OFF_RANK + (size_t)NTOK * 8 * 4;
constexpr size_t OFF_H    = AL(OFF_TOPW + (size_t)NTOK * 8 * 4);
constexpr size_t OFF_SLOT = AL(OFF_H + (size_t)MTOT * 1024 * 2);
constexpr size_t OFF_R4   = AL(OFF_SLOT + (size_t)256 * 32768 * 4);
constexpr size_t OFF_YNA  = OFF_R4;
constexpr size_t OFF_YM   = OFF_R4 + (size_t)NTOK * 512 * 2;
constexpr size_t OFF_MRG  = OFF_YM + (size_t)NTOK * 1024 * 2;
constexpr size_t OFF_SC   = OFF_R4;
constexpr size_t OFF_HID  = OFF_R4;
constexpr size_t OFF_P    = AL(OFF_R4 + (size_t)327680 * 256 * 2);
constexpr size_t OFF_CT   = AL(OFF_P + (size_t)MTOT * PV * 2);
constexpr size_t OFF_Y    = OFF_P;
constexpr size_t OFF_WINT = AL(OFF_CT + (size_t)NSLOT * 65536);
constexpr size_t OFF_BRMT = AL(OFF_WINT + (size_t)6912 * 1024 * 2);
constexpr size_t OFF_BRNT = AL(OFF_BRMT + (size_t)1024 * 1024 * 2);
constexpr size_t OFF_OUTT = AL(OFF_BRNT + (size_t)1024 * 512 * 2);
constexpr size_t OFF_RTT  = AL(OFF_OUTT + (size_t)1024 * 1024 * 2);
constexpr size_t OFF_HIST = AL(OFF_RTT + (size_t)256 * 1024 * 2);
constexpr size_t WS_END   = OFF_HIST + (size_t)1024 * 256 * 4;
static_assert(OFF_Y + (size_t)327680 * 1024 * 2 <= OFF_WINT, "Y must fit over P+CT");
static_assert(WS_END <= (size_t)1073741824, "workspace budget");

struct Params {
    const float *x, *c, *ctx, *c_ctx, *w_ada, *b_ada, *w_in, *b_mgate, *m_norm_w, *na_qn_w, *na_kn_w, *na_rpb,
                *w_br_m, *w_br_na, *w_out, *w_router, *router_bias, *w_exp_gate, *w_exp_up, *w_exp_down,
                *w_sh_gate, *w_sh_up, *w_sh_down;
    float* out;
    unsigned char* ws;
    int ph_lo, ph_hi;
};

typedef __bf16 bf16x2_t __attribute__((ext_vector_type(2)));
__device__ __forceinline__ u32 pk2(float lo, float hi) { bf16x2_t v = {(__bf16)lo, (__bf16)hi}; return __builtin_bit_cast(u32, v); }
__device__ __forceinline__ u16 f2bf(float f) { return (u16)(pk2(f, 0.f) & 0xffffu); }
__device__ __forceinline__ float bf2f(u16 h) { return __uint_as_float(((u32)h) << 16); }
__device__ __forceinline__ float bf_lo(u32 w) { return __uint_as_float(w << 16); }
__device__ __forceinline__ float bf_hi(u32 w) { return __uint_as_float(w & 0xffff0000u); }
__device__ __forceinline__ float sigmoid_(float x) { return 1.f / (1.f + __expf(-x)); }
__device__ __forceinline__ float log_sigmoid_(float x) { return fminf(x, 0.f) - __logf(1.f + __expf(-fabsf(x))); }
__device__ __forceinline__ f32x4 mfma16(bf16x8 a, bf16x8 b, f32x4 c) { return __builtin_amdgcn_mfma_f32_16x16x32_bf16(a, b, c, 0, 0, 0); }
__device__ __forceinline__ f32x16 mfma32(bf16x8 a, bf16x8 b, f32x16 c) { return __builtin_amdgcn_mfma_f32_32x32x16_bf16(a, b, c, 0, 0, 0); }

__device__ __forceinline__ void sincos_rev(float rev, float& sn, float& cs) {
    rev -= rintf(rev);
    const float kq = rintf(rev * 4.f);
    const float th = (rev - kq * 0.25f) * 6.283185307179586f;
    const float t2 = th * th;
    const float s = th * (1.f + t2 * (-1.f / 6.f + t2 * (1.f / 120.f + t2 * (-1.f / 5040.f + t2 * (1.f / 362880.f)))));
    const float c = 1.f + t2 * (-0.5f + t2 * (1.f / 24.f + t2 * (-1.f / 720.f + t2 * (1.f / 40320.f))));
    const int k = ((int)kq) & 3;
    sn = (k == 0) ? s : (k == 1) ? c : (k == 2) ? -s : -c;
    cs = (k == 0) ? c : (k == 1) ? -s : (k == 2) ? -c : s;
}
__device__ __forceinline__ int opaque_tid() { int t = threadIdx.x; asm volatile("" : "+v"(t)); return t; }
__device__ __forceinline__ float wave_sum(float v) {
#pragma unroll
    for (int o = 1; o < 64; o <<= 1) v += __shfl_xor(v, o);
    return v;
}
__device__ __forceinline__ float wave_max(float v) {
#pragma unroll
    for (int o = 1; o < 64; o <<= 1) v = fmaxf(v, __shfl_xor(v, o));
    return v;
}
__device__ __forceinline__ float wave_incl_sum(float v, int lane) {
#pragma unroll
    for (int o = 1; o < 64; o <<= 1) { float t = __shfl_up(v, o); if (lane >= o) v += t; }
    return v;
}
__device__ __forceinline__ float wave_prefix_max(float v, int lane) {
#pragma unroll
    for (int o = 1; o < 64; o <<= 1) { float t = __shfl_up(v, o); if (lane >= o) v = fmaxf(v, t); }
    return v;
}
__device__ __forceinline__ float wave_suffix_max(float v, int lane) {
#pragma unroll
    for (int o = 1; o < 64; o <<= 1) { float t = __shfl_down(v, o); if (lane + o < 64) v = fmaxf(v, t); }
    return v;
}
__device__ __forceinline__ float mod_val(const Params& p, int vec, int j) {
    const float* mp = (const float*)(p.ws + OFF_MODP);
    float s = p.b_ada[j];
#pragma unroll
    for (int ks = 0; ks < 8; ++ks) s += mp[(ks * 3 + vec) * 6144 + j];
    return s;
}
__device__ __forceinline__ u32x4 tr8(const u32x2 (&v)[8], int cc) {
    u32x4 o;
    if (cc == 0)      { o.x = (v[0].x & 0xffffu) | (v[1].x << 16); o.y = (v[2].x & 0xffffu) | (v[3].x << 16); o.z = (v[4].x & 0xffffu) | (v[5].x << 16); o.w = (v[6].x & 0xffffu) | (v[7].x << 16); }
    else if (cc == 1) { o.x = (v[0].x >> 16) | (v[1].x & 0xffff0000u); o.y = (v[2].x >> 16) | (v[3].x & 0xffff0000u); o.z = (v[4].x >> 16) | (v[5].x & 0xffff0000u); o.w = (v[6].x >> 16) | (v[7].x & 0xffff0000u); }
    else if (cc == 2) { o.x = (v[0].y & 0xffffu) | (v[1].y << 16); o.y = (v[2].y & 0xffffu) | (v[3].y << 16); o.z = (v[4].y & 0xffffu) | (v[5].y << 16); o.w = (v[6].y & 0xffffu) | (v[7].y << 16); }
    else              { o.x = (v[0].y >> 16) | (v[1].y & 0xffff0000u); o.y = (v[2].y >> 16) | (v[3].y & 0xffff0000u); o.z = (v[4].y >> 16) | (v[5].y & 0xffff0000u); o.w = (v[6].y >> 16) | (v[7].y & 0xffff0000u); }
    return o;
}
__device__ __forceinline__ float bfsel(const u32x2& v, int cc) { return cc == 0 ? bf_lo(v.x) : cc == 1 ? bf_hi(v.x) : cc == 2 ? bf_lo(v.y) : bf_hi(v.y); }

__device__ __forceinline__ void gemm_core(f32x16 (&acc)[2][2], const u16* const (&rowp)[4], const float* bsrc, const size_t ldb, const int nk,
                                          u16* As, u16* Bs, const int tid, const int lane, const int wr, const int wc) {
    u32x4 ar[4]; f32x4 br[8];
#pragma unroll
    for (int i = 0; i < 4; ++i) ar[i] = *(const u32x4*)(rowp[i]);
#pragma unroll
    for (int i = 0; i < 8; ++i) br[i] = *(const f32x4*)(bsrc + (size_t)i * ldb);
    const int arow = tid >> 3, ach = tid & 7;
    const int r = lane & 31, hh = lane >> 5;
#pragma unroll
    for (int i = 0; i < 4; ++i) *(u32x4*)(As + (arow + 32 * i) * LDT + ach * 8) = ar[i];
#pragma unroll
    for (int cc = 0; cc < 4; ++cc) {
        u32x4 w; w.x = pk2(br[0][cc], br[1][cc]); w.y = pk2(br[2][cc], br[3][cc]); w.z = pk2(br[4][cc], br[5][cc]); w.w = pk2(br[6][cc], br[7][cc]);
        *(u32x4*)(Bs + (arow * 4 + cc) * LDT + ach * 8) = w;
    }
    for (int kt = 0; kt < nk; ++kt) {
        __syncthreads();
        const int so = (kt & 1) * 18432;
        if (kt + 1 < nk) {
            const int k1 = (kt + 1) * 64;
#pragma unroll
            for (int i = 0; i < 4; ++i) ar[i] = *(const u32x4*)(rowp[i] + k1);
            const float* bp = bsrc + (size_t)k1 * ldb;
#pragma unroll
            for (int i = 0; i < 8; ++i) br[i] = *(const f32x4*)(bp + (size_t)i * ldb);
        }
#pragma unroll
        for (int kk = 0; kk < 4; ++kk) {
            bf16x8 a[2], b[2];
#pragma unroll
            for (int mi = 0; mi < 2; ++mi) a[mi] = *(const bf16x8*)(As + so + (wr * 64 + mi * 32 + r) * LDT + kk * 16 + hh * 8);
#pragma unroll
            for (int ni = 0; ni < 2; ++ni) b[ni] = *(const bf16x8*)(Bs + so + (wc * 64 + ni * 32 + r) * LDT + kk * 16 + hh * 8);
#pragma unroll
            for (int mi = 0; mi < 2; ++mi)
#pragma unroll
                for (int ni = 0; ni < 2; ++ni) acc[mi][ni] = mfma32(b[ni], a[mi], acc[mi][ni]);
        }
        if (kt + 1 < nk) {
            const int sn = ((kt + 1) & 1) * 18432;
#pragma unroll
            for (int i = 0; i < 4; ++i) *(u32x4*)(As + sn + (arow + 32 * i) * LDT + ach * 8) = ar[i];
#pragma unroll
            for (int cc = 0; cc < 4; ++cc) {
                u32x4 w; w.x = pk2(br[0][cc], br[1][cc]); w.y = pk2(br[2][cc], br[3][cc]); w.z = pk2(br[4][cc], br[5][cc]); w.w = pk2(br[6][cc], br[7][cc]);
                *(u32x4*)(Bs + sn + (arow * 4 + cc) * LDT + ach * 8) = w;
            }
        }
    }
    __syncthreads();
}
__device__ __forceinline__ void gemm_core2(f32x16 (&acc)[2][2], const u16* a0, const size_t a32, const u16* b0, const size_t b32, const int nk,
                                           unsigned char* smem, const int tid, const int lane, const int wr, const int wc) {
    typedef __attribute__((address_space(3))) unsigned lds_u32;
    const int r = lane & 31, hh = lane >> 5;
    {
        unsigned char* sa = smem + tid * 16;
#pragma unroll
        for (int i = 0; i < 4; ++i) {
            __builtin_amdgcn_global_load_lds((const unsigned*)(a0 + i * a32), (lds_u32*)(sa + i * 4096), 16, 0, 0);
            __builtin_amdgcn_global_load_lds((const unsigned*)(b0 + i * b32), (lds_u32*)(sa + 16384 + i * 4096), 16, 0, 0);
        }
    }
    for (int kt = 0; kt < nk; ++kt) {
        __syncthreads();
        if (kt + 1 < nk) {
            unsigned char* sa = smem + ((kt + 1) & 1) * 32768 + tid * 16;
            const u16* ap = a0 + (kt + 1) * 64; const u16* bp = b0 + (kt + 1) * 64;
#pragma unroll
            for (int i = 0; i < 4; ++i) {
                __builtin_amdgcn_global_load_lds((const unsigned*)(ap + i * a32), (lds_u32*)(sa + i * 4096), 16, 0, 0);
                __builtin_amdgcn_global_load_lds((const unsigned*)(bp + i * b32), (lds_u32*)(sa + 16384 + i * 4096), 16, 0, 0);
            }
        }
        const unsigned char* sa = smem + (kt & 1) * 32768; const unsigned char* sb = sa + 16384;
#pragma unroll
        for (int kk = 0; kk < 4; ++kk) {
            bf16x8 a[2], b[2];
            const int ch = ((kk * 2 + hh) ^ (r & 7)) * 16;
#pragma unroll
            for (int mi = 0; mi < 2; ++mi) a[mi] = *(const bf16x8*)(sa + (wr * 64 + mi * 32 + r) * 128 + ch);
#pragma unroll
            for (int ni = 0; ni < 2; ++ni) b[ni] = *(const bf16x8*)(sb + (wc * 64 + ni * 32 + r) * 128 + ch);
#pragma unroll
            for (int mi = 0; mi < 2; ++mi)
#pragma unroll
                for (int ni = 0; ni < 2; ++ni) acc[mi][ni] = mfma32(b[ni], a[mi], acc[mi][ni]);
        }
    }
}
#define RAW_BARRIER() do { asm volatile("s_waitcnt lgkmcnt(0)" ::: "memory"); __builtin_amdgcn_s_barrier(); } while (0)
__device__ __forceinline__ void gemm_core3(f32x16 (&acc)[2][4], const u16* a0, const size_t a64, const u16* b0, const size_t b64, const int nk,
                                           unsigned char* smem, const int tid, const int lane, const int wr, const int wc) {
    typedef __attribute__((address_space(3))) unsigned lds_u32;
    const int r = lane & 31, hh = lane >> 5;
#pragma unroll
    for (int s = 0; s < 2; ++s) {
        unsigned char* sa = smem + s * 24576 + tid * 16;
#pragma unroll
        for (int i = 0; i < 2; ++i) __builtin_amdgcn_global_load_lds((const unsigned*)(a0 + s * 32 + i * a64), (lds_u32*)(sa + i * 4096), 16, 0, 0);
#pragma unroll
        for (int i = 0; i < 4; ++i) __builtin_amdgcn_global_load_lds((const unsigned*)(b0 + s * 32 + i * b64), (lds_u32*)(sa + 8192 + i * 4096), 16, 0, 0);
    }
    int cur = 0;
    for (int kt = 0; kt < nk; ++kt) {
        if (kt + 1 < nk) asm volatile("s_waitcnt vmcnt(6)" ::: "memory"); else asm volatile("s_waitcnt vmcnt(0)" ::: "memory");
        RAW_BARRIER();
        if (kt + 2 < nk) {
            const int nx = cur == 0 ? 2 : cur - 1;
            unsigned char* sa = smem + nx * 24576 + tid * 16;
            const u16* ap = a0 + (kt + 2) * 32; const u16* bp = b0 + (kt + 2) * 32;
#pragma unroll
            for (int i = 0; i < 2; ++i) __builtin_amdgcn_global_load_lds((const unsigned*)(ap + i * a64), (lds_u32*)(sa + i * 4096), 16, 0, 0);
#pragma unroll
            for (int i = 0; i < 4; ++i) __builtin_amdgcn_global_load_lds((const unsigned*)(bp + i * b64), (lds_u32*)(sa + 8192 + i * 4096), 16, 0, 0);
        }
        const unsigned char* sa = smem + cur * 24576; const unsigned char* sb = sa + 8192;
#pragma unroll
        for (int kk = 0; kk < 2; ++kk) {
            bf16x8 a[2], b[4];
            const int ch = ((kk * 2 + hh) ^ ((r >> 2) & 3)) * 16;
#pragma unroll
            for (int mi = 0; mi < 2; ++mi) a[mi] = *(const bf16x8*)(sa + (wr * 64 + mi * 32 + r) * 64 + ch);
#pragma unroll
            for (int ni = 0; ni < 4; ++ni) b[ni] = *(const bf16x8*)(sb + (wc * 128 + ni * 32 + r) * 64 + ch);
#pragma unroll
            for (int mi = 0; mi < 2; ++mi)
#pragma unroll
                for (int ni = 0; ni < 4; ++ni) acc[mi][ni] = mfma32(b[ni], a[mi], acc[mi][ni]);
        }
        cur = cur == 2 ? 0 : cur + 1;
    }
}
constexpr int CT3_LD = 264;
__device__ __forceinline__ void ct_write3(u16* Ct, const f32x16 (&v)[2][4], const int wr, const int wc, const int lane) {
    const int r = lane & 31, hh = lane >> 5;
#pragma unroll
    for (int mi = 0; mi < 2; ++mi)
#pragma unroll
        for (int ni = 0; ni < 4; ++ni) {
            u16* base = Ct + (wr * 64 + mi * 32 + r) * CT3_LD + wc * 128 + ni * 32 + 4 * hh;
#pragma unroll
            for (int g = 0; g < 4; ++g) {
                u32x2 w; w.x = pk2(v[mi][ni][4 * g], v[mi][ni][4 * g + 1]); w.y = pk2(v[mi][ni][4 * g + 2], v[mi][ni][4 * g + 3]);
                *(u32x2*)(base + 8 * g) = w;
            }
        }
}
__device__ __forceinline__ bool sched_tile(const int i, const int ntm, const int ntn, const int W, int& mt, int& nt) {
    const int nx = gridDim.x >> 3;
    const int o = ((blockIdx.x & 7) + 8 * i) * nx + (blockIdx.x >> 3);
    if (o >= ntm * ntn) return false;
    const int full = ntn / W, fo = full * W * ntm;
    if (o < fo) { const int G = o / (W * ntm), rem = o - G * (W * ntm); mt = rem / W; nt = G * W + (rem - mt * W); }
    else { const int W2 = ntn - full * W, rem = o - fo; mt = rem / W2; nt = full * W + (rem - mt * W2); }
    return true;
}
__device__ __forceinline__ void conv_item(const float* W, const int ldw, const int k0, const int nreal0, u16* WT, const int K, const int nvirt0, float* T, const int tid) {
    const int kr = tid >> 4, c4 = tid & 15;
#pragma unroll
    for (int ps = 0; ps < 4; ++ps) {
        const int k = ps * 16 + kr;
        const f32x4 v = *(const f32x4*)(W + (size_t)(k0 + k) * ldw + nreal0 + c4 * 4);
        T[k * 65 + c4 * 4 + 0] = v.x; T[k * 65 + c4 * 4 + 1] = v.y; T[k * 65 + c4 * 4 + 2] = v.z; T[k * 65 + c4 * 4 + 3] = v.w;
    }
    __syncthreads();
    const int n = tid >> 2, kq = tid & 3;
    u32x4 o0, o1;
    const float* t = T + (kq * 16) * 65 + n;
    o0.x = pk2(t[0 * 65], t[1 * 65]); o0.y = pk2(t[2 * 65], t[3 * 65]); o0.z = pk2(t[4 * 65], t[5 * 65]); o0.w = pk2(t[6 * 65], t[7 * 65]);
    o1.x = pk2(t[8 * 65], t[9 * 65]); o1.y = pk2(t[10 * 65], t[11 * 65]); o1.z = pk2(t[12 * 65], t[13 * 65]); o1.w = pk2(t[14 * 65], t[15 * 65]);
    u16* dst = WT + (size_t)(nvirt0 + n) * K + k0 + kq * 16;
    *(u32x4*)dst = o0; *(u32x4*)(dst + 8) = o1;
    __syncthreads();
}
#define ACC_COL(reg) (((reg) & 3) + 8 * ((reg) >> 2))
#define ACC_ROW(mi, reg) ((mi) * 32 + ((reg) & 3) + 8 * ((reg) >> 2))
constexpr int CT_LD = 136;
__device__ __forceinline__ void ct_write(u16* Ct, const f32x16 (&v)[2][2], const int wr, const int wc, const int lane) {
    const int r = lane & 31, hh = lane >> 5;
#pragma unroll
    for (int mi = 0; mi < 2; ++mi)
#pragma unroll
        for (int ni = 0; ni < 2; ++ni) {
            u16* base = Ct + (wr * 64 + mi * 32 + r) * CT_LD + wc * 64 + ni * 32 + 4 * hh;
#pragma unroll
            for (int g = 0; g < 4; ++g) {
                u32x2 w; w.x = pk2(v[mi][ni][4 * g], v[mi][ni][4 * g + 1]); w.y = pk2(v[mi][ni][4 * g + 2], v[mi][ni][4 * g + 3]);
                *(u32x2*)(base + 8 * g) = w;
            }
        }
}
__device__ __forceinline__ void ct_store(const u16* Ct, u16* dst, const size_t ldd, const int tid) {
#pragma unroll
    for (int i = 0; i < 8; ++i) {
        const int idx = tid + i * 256, row = idx >> 4, ch = idx & 15;
        *(u32x4*)(dst + (size_t)row * ldd + ch * 8) = *(const u32x4*)(Ct + row * CT_LD + ch * 8);
    }
}

__device__ __forceinline__ void phase_ada(const Params& p, unsigned char* smem) {
    const int tid = opaque_tid();
    float* red = (float*)smem;
    float* mp = (float*)(p.ws + OFF_MODP);
    for (int it = blockIdx.x; it < 192; it += gridDim.x) {
        const int cb = it % 24, ks = it / 24, cq = tid & 63, kq = tid >> 6;
        float a0[4] = {0, 0, 0, 0}, a1[4] = {0, 0, 0, 0}, a2[4] = {0, 0, 0, 0};
        for (int kk = 0; kk < 32; ++kk) {
            const int k = ks * 128 + kq * 32 + kk;
            const f32x4 w = *(const f32x4*)(p.w_ada + (size_t)k * 6144 + cb * 256 + cq * 4);
            float c0 = p.c[k], c1 = p.c[1024 + k], c2 = p.c_ctx[k];
            c0 *= sigmoid_(c0); c1 *= sigmoid_(c1); c2 *= sigmoid_(c2);
#pragma unroll
            for (int j = 0; j < 4; ++j) { a0[j] += c0 * w[j]; a1[j] += c1 * w[j]; a2[j] += c2 * w[j]; }
        }
#pragma unroll
        for (int j = 0; j < 4; ++j) { red[(kq * 3 + 0) * 256 + cq * 4 + j] = a0[j]; red[(kq * 3 + 1) * 256 + cq * 4 + j] = a1[j]; red[(kq * 3 + 2) * 256 + cq * 4 + j] = a2[j]; }
        __syncthreads();
#pragma unroll
        for (int v = 0; v < 3; ++v) {
            const float s = (red[(0 * 3 + v) * 256 + tid] + red[(1 * 3 + v) * 256 + tid]) + (red[(2 * 3 + v) * 256 + tid] + red[(3 * 3 + v) * 256 + tid]);
            mp[(ks * 3 + v) * 6144 + cb * 256 + tid] = s;
        }
        __syncthreads();
    }
    for (int it = blockIdx.x; it < 2400; it += gridDim.x) {
        if (it < 1696) {
            const int nb = it >> 4, kb = it & 15, nv = nb * 64;
            const int nr = nv < 3072 ? nv : (nv < 6656 ? nv + 16 : 3072 + (nv - 6656));
            conv_item(p.w_in, INC, kb * 64, nr, (u16*)(p.ws + OFF_WINT), 1024, nv, red, tid);
        } else if (it < 1952) { const int q = it - 1696; conv_item(p.w_br_m, 1024, (q & 15) * 64, (q >> 4) * 64, (u16*)(p.ws + OFF_BRMT), 1024, (q >> 4) * 64, red, tid); }
        else if (it < 2080) { const int q = it - 1952; conv_item(p.w_br_na, 1024, (q & 7) * 64, (q >> 3) * 64, (u16*)(p.ws + OFF_BRNT), 512, (q >> 3) * 64, red, tid); }
        else if (it < 2336) { const int q = it - 2080; conv_item(p.w_out, 1024, (q & 15) * 64, (q >> 4) * 64, (u16*)(p.ws + OFF_OUTT), 1024, (q >> 4) * 64, red, tid); }
        else { const int q = it - 2336; conv_item(p.w_router, 256, (q & 15) * 64, (q >> 4) * 64, (u16*)(p.ws + OFF_RTT), 1024, (q >> 4) * 64, red, tid); }
    }
}

__device__ __forceinline__ void phase_norm(const Params& p, unsigned char* smem, const bool second) {
    const int tid = opaque_tid(), lane = tid & 63, wid = tid >> 6;
    float* tsh = (float*)smem; float* tsc = tsh + 1024;
    u16* H = (u16*)(p.ws + OFF_H);
    const int nrows = second ? NTOK : MTOT;
    const int rpb = (nrows + gridDim.x - 1) / gridDim.x;
    const int r0 = blockIdx.x * rpb, r1 = min(r0 + rpb, nrows);
    const int sh_off = second ? 3072 : 0, sc_off = second ? 4096 : 1024;
    for (int vec = 0; vec < 3; ++vec) {
        const int vlo = vec == 0 ? 0 : (vec == 1 ? TSEQ : NTOK), vhi = vec == 0 ? TSEQ : (vec == 1 ? NTOK : MTOT);
        const int lo = max(r0, vlo), hi = min(r1, vhi);
        if (lo >= hi) continue;
        for (int j = tid; j < 1024; j += 256) { tsh[j] = mod_val(p, vec, sh_off + j); tsc[j] = 1.f + mod_val(p, vec, sc_off + j); }
        __syncthreads();
        for (int row = lo + wid; row < hi; row += 4) {
            const float* src = second ? (p.out + (size_t)row * 1024) : (row < NTOK ? p.x + (size_t)row * 1024 : p.ctx + (size_t)(row - NTOK) * 1024);
            f32x4 v[4]; float ss = 0.f;
#pragma unroll
            for (int j = 0; j < 4; ++j) { v[j] = *(const f32x4*)(src + j * 256 + lane * 4); ss += (v[j].x * v[j].x + v[j].y * v[j].y) + (v[j].z * v[j].z + v[j].w * v[j].w); }
            ss = wave_sum(ss);
            const float rstd = rsqrtf(ss * (1.f / 1024.f) + 1e-6f);
#pragma unroll
            for (int j = 0; j < 4; ++j) {
                const int k = j * 256 + lane * 4;
                const f32x4 sc = *(const f32x4*)(tsc + k), sh = *(const f32x4*)(tsh + k);
                u32x2 o; o.x = pk2(v[j].x * rstd * sc.x + sh.x, v[j].y * rstd * sc.y + sh.y); o.y = pk2(v[j].z * rstd * sc.z + sh.z, v[j].w * rstd * sc.w + sh.w);
                *(u32x2*)(H + (size_t)row * 1024 + k) = o;
            }
        }
        __syncthreads();
    }
}

__device__ __forceinline__ void phase_inproj(const Params& p, unsigned char* smem) {
    const u16* H = (const u16*)(p.ws + OFF_H);
    u16* P = (u16*)(p.ws + OFF_P); float* G = (float*)(p.ws + OFF_G);
    const int tid = opaque_tid(), lane = tid & 63, wid = tid >> 6, wr = wid >> 1, wc = wid & 1;
    const int r = lane & 31, hh = lane >> 5;
    const u16* WT = (const u16*)(p.ws + OFF_WINT);
    const int sw = ((tid & 7) ^ ((tid >> 3) & 7)) * 8;
    for (int ti = 0;; ++ti) {
        int mt, nt;
        if (!sched_tile(ti, 260, 53, 8, mt, nt)) break;
        f32x16 acc[2][2] = {};
        gemm_core2(acc, H + (size_t)(mt * 128 + (tid >> 3)) * 1024 + sw, 32 * 1024, WT + (size_t)(nt * 128 + (tid >> 3)) * 1024 + sw, 32 * 1024, 16, smem, tid, lane, wr, wc);
        if (nt < 8) {
            const float scale = nt < 4 ? 0.08838834764831845f : 1.f;
            const bool latent = mt < 256;
#pragma unroll
            for (int mi = 0; mi < 2; ++mi) {
                const int t = (mt * 128 + wr * 64 + mi * 32 + r) & (TSEQ - 1);
                const float posr = (float)(wc == 0 ? (t >> 6) : (t & 63)) * 0.15915494309189535f;
#pragma unroll
                for (int reg = 0; reg < 16; ++reg) {
                    float x1 = acc[mi][0][reg] * scale, x2 = acc[mi][1][reg] * scale;
                    if (latent) {
                        const float inv = exp2f(-(float)(ACC_COL(reg) + 4 * hh) * (13.287712379549449f / 32.f));
                        float sn, cs; sincos_rev(posr * inv, sn, cs);
                        float a = x1 * cs; asm volatile("" : "+v"(a), "+v"(x1), "+v"(x2));
                        float o1 = fmaf(-x2, sn, a); asm volatile("" : "+v"(o1), "+v"(x1), "+v"(x2));
                        float bq = x1 * sn; asm volatile("" : "+v"(bq), "+v"(x2));
                        float o2 = fmaf(x2, cs, bq); asm volatile("" : "+v"(o2));
                        x1 = o1; x2 = o2;
                    }
                    acc[mi][0][reg] = x1; acc[mi][1][reg] = x2;
                }
            }
        } else if (nt >= 24 && nt < 32) {
            const float* nw = nt < 28 ? p.na_qn_w : p.na_kn_w;
            const float sc = nt < 28 ? 0.125f : 1.f;
#pragma unroll
            for (int mi = 0; mi < 2; ++mi) {
                float s = 0.f;
#pragma unroll
                for (int ni = 0; ni < 2; ++ni)
#pragma unroll
                    for (int reg = 0; reg < 16; ++reg) s += acc[mi][ni][reg] * acc[mi][ni][reg];
                s += __shfl_xor(s, 32);
                const float rstd = rsqrtf(s * (1.f / 64.f) + 1e-6f) * sc;
#pragma unroll
                for (int ni = 0; ni < 2; ++ni)
#pragma unroll
                    for (int reg = 0; reg < 16; ++reg) acc[mi][ni][reg] *= rstd * nw[ni * 32 + ACC_COL(reg) + 4 * hh];
            }
        } else if (nt >= 36 && nt < 52) {
#pragma unroll
            for (int mi = 0; mi < 2; ++mi)
#pragma unroll
                for (int ni = 0; ni < 2; ++ni)
#pragma unroll
                    for (int reg = 0; reg < 16; ++reg) acc[mi][ni][reg] = sigmoid_(acc[mi][ni][reg]);
        }
        if (nt == 52) {
            if (wc == 0) {
                const f32x4 b0 = *(const f32x4*)(p.b_mgate + 4 * hh), b1 = *(const f32x4*)(p.b_mgate + 8 + 4 * hh);
#pragma unroll
                for (int mi = 0; mi < 2; ++mi) {
                    float* g = G + (size_t)(mt * 128 + wr * 64 + mi * 32 + r) * 16 + 4 * hh;
                    f32x4 o0, o1;
                    o0.x = acc[mi][0][0] + b0.x; o0.y = acc[mi][0][1] + b0.y; o0.z = acc[mi][0][2] + b0.z; o0.w = acc[mi][0][3] + b0.w;
                    o1.x = acc[mi][0][4] + b1.x; o1.y = acc[mi][0][5] + b1.y; o1.z = acc[mi][0][6] + b1.z; o1.w = acc[mi][0][7] + b1.w;
                    *(f32x4*)g = o0; *(f32x4*)(g + 8) = o1;
                }
            }
        } else {
            u16* Ct = (u16*)smem;
            __syncthreads();
            ct_write(Ct, acc, wr, wc, lane);
            __syncthreads();
            ct_store(Ct, P + (size_t)(mt * 128) * PV + nt * 128, PV, tid);
        }
        __syncthreads();
    }
}

__device__ __forceinline__ void mlstm_passA(const Params& p, unsigned char* smem, const int it) {
    const int tid = opaque_tid(), lane = tid & 63, wid = tid >> 6;
    const int c = it % 260, bh = it / 260, b = bh >> 2, h = bh & 3;
    const int base = c < 4 ? NTOK + b * 256 + c * 64 : b * TSEQ + (c - 4) * 64;
    const u16* P = (const u16*)(p.ws + OFF_P); const float* G = (const float*)(p.ws + OFF_G);
    float* gsum = (float*)(p.ws + OFF_GS); float* mloc = (float*)(p.ws + OFF_ML); float* dn = (float*)(p.ws + OFF_DN);
    u16* CT = (u16*)(p.ws + OFF_CT);
    u16* KTf = (u16*)smem; u16* KTb = (u16*)(smem + 18432); u16* VT = (u16*)(smem + 36864);
    float* wf = (float*)(smem + 73728); float* wb = wf + 64;
    const int slot_f = bh * 2 * 260 + c, slot_b = slot_f + 260;
    if (wid == 0) {
        const float* g = G + (size_t)(base + lane) * 16;
        const float igf = g[h], ff = g[4 + h], igb = g[8 + h], fb = g[12 + h];
        const float lff = log_sigmoid_(ff), lfb = log_sigmoid_(fb);
        const float bfc = wave_incl_sum(lff, lane), gf = __shfl(bfc, 63);
        const float uf = igf - bfc, umf = wave_max(uf);
        wf[lane] = __expf(uf - umf);
        const float pb = wave_incl_sum(lfb, lane), gb = __shfl(pb, 63);
        const float bb = gb - pb + lfb, ub = igb - bb, umb = wave_max(ub);
        wb[lane] = __expf(ub - umb);
        if (lane == 0) { gsum[slot_f] = gf; mloc[slot_f] = gf + umf; gsum[slot_b] = gb; mloc[slot_b] = gb + umb; }
    }
    __syncthreads();
    const int cgp = tid >> 3, tg = tid & 7;
    {
        const u16* src = P + (size_t)(base + tg * 8) * PV + V_MK + h * 128 + cgp * 4;
        u32x2 kv[8];
#pragma unroll
        for (int i = 0; i < 8; ++i) kv[i] = *(const u32x2*)(src + (size_t)i * PV);
        float wfi[8], wbi[8];
#pragma unroll
        for (int i = 0; i < 8; ++i) { wfi[i] = wf[tg * 8 + i]; wbi[i] = wb[tg * 8 + i]; }
#pragma unroll
        for (int cc = 0; cc < 4; ++cc) {
            float e[8];
#pragma unroll
            for (int i = 0; i < 8; ++i) e[i] = bfsel(kv[i], cc);
            u32x4 of, ob;
            of.x = pk2(e[0] * wfi[0], e[1] * wfi[1]); of.y = pk2(e[2] * wfi[2], e[3] * wfi[3]); of.z = pk2(e[4] * wfi[4], e[5] * wfi[5]); of.w = pk2(e[6] * wfi[6], e[7] * wfi[7]);
            ob.x = pk2(e[0] * wbi[0], e[1] * wbi[1]); ob.y = pk2(e[2] * wbi[2], e[3] * wbi[3]); ob.z = pk2(e[4] * wbi[4], e[5] * wbi[5]); ob.w = pk2(e[6] * wbi[6], e[7] * wbi[7]);
            *(u32x4*)(KTf + (cgp * 4 + cc) * LDT + tg * 8) = of;
            *(u32x4*)(KTb + (cgp * 4 + cc) * LDT + tg * 8) = ob;
        }
    }
#pragma unroll
    for (int vp = 0; vp < 2; ++vp) {
        const u16* src = P + (size_t)(base + tg * 8) * PV + V_MV + h * 256 + vp * 128 + cgp * 4;
        u32x2 vv[8];
#pragma unroll
        for (int i = 0; i < 8; ++i) vv[i] = *(const u32x2*)(src + (size_t)i * PV);
#pragma unroll
        for (int cc = 0; cc < 4; ++cc) *(u32x4*)(VT + (vp * 128 + cgp * 4 + cc) * LDT + tg * 8) = tr8(vv, cc);
    }
    __syncthreads();
    if (tid < 128) {
        float sf = 0.f, sb = 0.f;
#pragma unroll
        for (int j = 0; j < 8; ++j) {
            const u32x4 a = *(const u32x4*)(KTf + tid * LDT + j * 8), bq = *(const u32x4*)(KTb + tid * LDT + j * 8);
            sf += (bf_lo(a.x) + bf_hi(a.x)) + (bf_lo(a.y) + bf_hi(a.y)) + (bf_lo(a.z) + bf_hi(a.z)) + (bf_lo(a.w) + bf_hi(a.w));
            sb += (bf_lo(bq.x) + bf_hi(bq.x)) + (bf_lo(bq.y) + bf_hi(bq.y)) + (bf_lo(bq.z) + bf_hi(bq.z)) + (bf_lo(bq.w) + bf_hi(bq.w));
        }
        dn[(size_t)slot_f * 128 + tid] = sf; dn[(size_t)slot_b * 128 + tid] = sb;
    }
    const int r = lane & 31, hh = lane >> 5;
#pragma unroll 1
    for (int dir = 0; dir < 2; ++dir) {
        const u16* Bt = dir ? KTb : KTf;
        u16* dst = CT + (size_t)(dir ? slot_b : slot_f) * 32768;
#pragma unroll 1
        for (int nh = 0; nh < 2; ++nh) {
            f32x16 acc[2][2] = {};
#pragma unroll
            for (int kk = 0; kk < 4; ++kk) {
                bf16x8 a[2], bq[2];
#pragma unroll
                for (int mi = 0; mi < 2; ++mi) a[mi] = *(const bf16x8*)(VT + (wid * 64 + mi * 32 + r) * LDT + kk * 16 + hh * 8);
#pragma unroll
                for (int ni = 0; ni < 2; ++ni) bq[ni] = *(const bf16x8*)(Bt + (nh * 64 + ni * 32 + r) * LDT + kk * 16 + hh * 8);
#pragma unroll
                for (int mi = 0; mi < 2; ++mi)
#pragma unroll
                    for (int ni = 0; ni < 2; ++ni) acc[mi][ni] = mfma32(bq[ni], a[mi], acc[mi][ni]);
            }
#pragma unroll
            for (int mi = 0; mi < 2; ++mi)
#pragma unroll
                for (int ni = 0; ni < 2; ++ni) {
                    u16* drow = dst + (wid * 64 + mi * 32 + r) * 128 + nh * 64 + ni * 32 + 4 * hh;
#pragma unroll
                    for (int g = 0; g < 4; ++g) {
                        u32x2 w; w.x = pk2(acc[mi][ni][4 * g], acc[mi][ni][4 * g + 1]); w.y = pk2(acc[mi][ni][4 * g + 2], acc[mi][ni][4 * g + 3]);
                        *(u32x2*)(drow + 8 * g) = w;
                    }
                }
        }
    }
    __syncthreads();
}

__device__ __forceinline__ void na_item(const Params& p, unsigned char* smem, const int it) {
    const int tid = opaque_tid(), lane = tid & 63, wid = tid >> 6;
    const int row = it & 255, h = (it >> 8) & 7, b = it >> 11;
    const u16* P = (const u16*)(p.ws + OFF_P);
    u16* YNA = (u16*)(p.ws + OFF_YNA);
    u16* Ks = (u16*)smem; u16* VTs = (u16*)(smem + 9216); u16* Ps = (u16*)(smem + 18432);
    const int l15 = lane & 15, l4 = lane >> 4;
    const int qtok = b * TSEQ + row * 64 + wid * 16 + l15;
    const u16* qsrc = P + (size_t)qtok * PV + V_NQ + h * 64 + l4 * 8;
    const bf16x8 qa0 = *(const bf16x8*)qsrc, qa1 = *(const bf16x8*)(qsrc + 32);
    const int rs = min(max(row - 4, 0), 248);
    f32x4 O[4] = {};
    float mrun[4], lrun[4];
#pragma unroll
    for (int i = 0; i < 4; ++i) { mrun[i] = -INFINITY; lrun[i] = 0.f; }
    float* rpb_s = (float*)(smem + 27648);
    for (int j = tid; j < 465; j += 256) rpb_s[j] = p.na_rpb[h * 465 + j];
    u32x4 kreg[2]; u32x2 vreg[8];
    const int cgp = (tid >> 3) & 15, tg = tid & 7;
    {
        const int kbase = b * TSEQ + rs * 64;
#pragma unroll
        for (int i = 0; i < 2; ++i) { const int id = tid + i * 256; kreg[i] = *(const u32x4*)(P + (size_t)(kbase + (id >> 3)) * PV + V_NK + h * 64 + (id & 7) * 8); }
        const u16* src = P + (size_t)(kbase + tg * 8) * PV + V_NV + h * 64 + cgp * 4;
#pragma unroll
        for (int i = 0; i < 8; ++i) vreg[i] = *(const u32x2*)(src + (size_t)i * PV);
    }
    for (int blk = 0; blk < 12; ++blk) {
#pragma unroll
        for (int i = 0; i < 2; ++i) { const int id = tid + i * 256; *(u32x4*)(Ks + (id >> 3) * LDT + (id & 7) * 8) = kreg[i]; }
        if (tid < 128) {
#pragma unroll
            for (int cc = 0; cc < 4; ++cc) *(u32x4*)(VTs + (cgp * 4 + cc) * LDT + tg * 8) = tr8(vreg, cc);
        }
        __syncthreads();
        if (blk + 1 < 12) {
            const int nb = blk + 1;
            const int kbase = nb < 8 ? b * TSEQ + (rs + nb) * 64 : NTOK + b * 256 + (nb - 8) * 64;
#pragma unroll
            for (int i = 0; i < 2; ++i) { const int id = tid + i * 256; kreg[i] = *(const u32x4*)(P + (size_t)(kbase + (id >> 3)) * PV + V_NK + h * 64 + (id & 7) * 8); }
            const u16* src = P + (size_t)(kbase + tg * 8) * PV + V_NV + h * 64 + cgp * 4;
#pragma unroll
            for (int i = 0; i < 8; ++i) vreg[i] = *(const u32x2*)(src + (size_t)i * PV);
        }
        f32x4 S[4] = {};
#pragma unroll
        for (int nt = 0; nt < 4; ++nt) {
            const bf16x8 b0 = *(const bf16x8*)(Ks + (nt * 16 + l15) * LDT + l4 * 8), b1 = *(const bf16x8*)(Ks + (nt * 16 + l15) * LDT + 32 + l4 * 8);
            S[nt] = mfma16(qa0, b0, S[nt]); S[nt] = mfma16(qa1, b1, S[nt]);
        }
        if (blk < 8) {
            const float* rpb = rpb_s + (rs + blk - row + 7) * 31;
#pragma unroll
            for (int reg = 0; reg < 4; ++reg) {
                const int qc = wid * 16 + l4 * 4 + reg, cs = min(max(qc - 8, 0), 48);
#pragma unroll
                for (int nt = 0; nt < 4; ++nt) {
                    const int kc = nt * 16 + l15;
                    const bool valid = kc >= cs && kc < cs + 16;
                    float bias = 0.f;
                    if (valid) bias = rpb[kc - qc + 15];
                    S[nt][reg] = valid ? S[nt][reg] + bias : -INFINITY;
                }
            }
        }
#pragma unroll
        for (int reg = 0; reg < 4; ++reg) {
            float mx = fmaxf(fmaxf(S[0][reg], S[1][reg]), fmaxf(S[2][reg], S[3][reg]));
            mx = fmaxf(mx, __shfl_xor(mx, 1)); mx = fmaxf(mx, __shfl_xor(mx, 2)); mx = fmaxf(mx, __shfl_xor(mx, 4)); mx = fmaxf(mx, __shfl_xor(mx, 8));
            const float mnew = fmaxf(mrun[reg], mx);
            const float alpha = __expf(mrun[reg] - mnew);
            float ps = 0.f;
#pragma unroll
            for (int nt = 0; nt < 4; ++nt) {
                const float pe = __expf(S[nt][reg] - mnew);
                ps += pe;
                Ps[(wid * 16 + l4 * 4 + reg) * LDT + nt * 16 + l15] = f2bf(pe);
                O[nt][reg] *= alpha;
            }
            ps += __shfl_xor(ps, 1); ps += __shfl_xor(ps, 2); ps += __shfl_xor(ps, 4); ps += __shfl_xor(ps, 8);
            lrun[reg] = lrun[reg] * alpha + ps; mrun[reg] = mnew;
        }
        asm volatile("s_waitcnt lgkmcnt(0)" ::: "memory");
#pragma unroll
        for (int kk = 0; kk < 2; ++kk) {
            const bf16x8 a = *(const bf16x8*)(Ps + (wid * 16 + l15) * LDT + kk * 32 + l4 * 8);
#pragma unroll
            for (int nt = 0; nt < 4; ++nt) {
                const bf16x8 bv = *(const bf16x8*)(VTs + (nt * 16 + l15) * LDT + kk * 32 + l4 * 8);
                O[nt] = mfma16(a, bv, O[nt]);
            }
        }
        __syncthreads();
    }
#pragma unroll
    for (int reg = 0; reg < 4; ++reg) {
        const float il = 1.f / lrun[reg];
        const size_t tok = (size_t)b * TSEQ + row * 64 + wid * 16 + l4 * 4 + reg;
#pragma unroll
        for (int nt = 0; nt < 4; ++nt) YNA[tok * 512 + h * 64 + nt * 16 + l15] = f2bf(O[nt][reg] * il);
    }
}

__device__ __forceinline__ int scan_cidx(int i, int dir) { return dir == 0 ? i : (i < 4 ? 3 - i : 263 - i); }
__device__ __forceinline__ void phase_scan(const Params& p, unsigned char* smem) {
    const int tid = opaque_tid(), lane = tid & 63, wid = tid >> 6;
    float* al = (float*)smem; float* be = al + 260;
    const float* gsum = (const float*)(p.ws + OFF_GS); const float* mloc = (const float*)(p.ws + OFF_ML);
    float* mprev = (float*)(p.ws + OFF_MP); float* dn = (float*)(p.ws + OFF_DN);
    for (int it = blockIdx.x; it < 512; it += gridDim.x) {
        const int bhd = it >> 5, eb = it & 31, dir = bhd & 1, slot0 = bhd * 260;
        if (wid == 0) {
            float g[5], ml[5]; int cc[5];
            float a = 0.f, b = -INFINITY;
#pragma unroll
            for (int j = 0; j < 5; ++j) {
                const int i = lane * 5 + j; const bool ok = i < 260;
                cc[j] = ok ? scan_cidx(i, dir) : 0;
                g[j] = ok ? gsum[slot0 + cc[j]] : 0.f; ml[j] = ok ? mloc[slot0 + cc[j]] : -INFINITY;
                b = fmaxf(b + g[j], ml[j]); a += g[j];
            }
#pragma unroll
            for (int o = 1; o < 64; o <<= 1) {
                const float pa = __shfl_up(a, o), pb = __shfl_up(b, o);
                if (lane >= o) { b = fmaxf(pb + a, b); a = pa + a; }
            }
            float ea = __shfl_up(a, 1), eb2 = __shfl_up(b, 1);
            if (lane == 0) { ea = 0.f; eb2 = -INFINITY; }
            float m = fmaxf(0.f + ea, eb2);
#pragma unroll
            for (int j = 0; j < 5; ++j) {
                const int i = lane * 5 + j;
                if (i < 260) {
                    const float mn = fmaxf(g[j] + m, ml[j]);
                    al[i] = __expf(g[j] + m - mn); be[i] = __expf(ml[j] - mn);
                    if (eb == 0) mprev[slot0 + cc[j]] = m;
                    m = mn;
                }
            }
        }
        __syncthreads();
        u32x2* basep = (u32x2*)(p.ws + OFF_CT) + (size_t)slot0 * 8192 + eb * 256 + tid;
        float C0 = 0.f, C1 = 0.f, C2 = 0.f, C3 = 0.f;
        for (int i = 0; i < 260; i += 13) {
            u32x2 v[13];
#pragma unroll
            for (int j = 0; j < 13; ++j) v[j] = basep[(size_t)scan_cidx(i + j, dir) * 8192];
#pragma unroll
            for (int j = 0; j < 13; ++j) {
                u32x2 o; o.x = pk2(C0, C1); o.y = pk2(C2, C3);
                basep[(size_t)scan_cidx(i + j, dir) * 8192] = o;
                const float a = al[i + j], bt = be[i + j];
                C0 = fmaf(a, C0, bt * bf_lo(v[j].x)); C1 = fmaf(a, C1, bt * bf_hi(v[j].x)); C2 = fmaf(a, C2, bt * bf_lo(v[j].y)); C3 = fmaf(a, C3, bt * bf_hi(v[j].y));
            }
        }
        if (eb == 0 && tid < 128) {
            float n = 0.f;
            for (int i = 0; i < 260; ++i) {
                float* q = dn + (size_t)(slot0 + scan_cidx(i, dir)) * 128 + tid;
                const float v = *q; *q = n; n = al[i] * n + be[i] * v;
            }
        }
        __syncthreads();
    }
}

__device__ __forceinline__ void mlstm_passC(const Params& p, unsigned char* smem, const int it) {
    const int tid = opaque_tid(), lane = tid & 63, wid = tid >> 6;
    const int cl = it & 255, bh = it >> 8, b = bh >> 2, h = bh & 3, c = cl + 4;
    const int base = b * TSEQ + cl * 64;
    const int slot_f = bh * 2 * 260 + c, slot_b = slot_f + 260;
    const u16* P = (const u16*)(p.ws + OFF_P); const float* G = (const float*)(p.ws + OFF_G);
    const float* mprev = (const float*)(p.ws + OFF_MP); const float* dn = (const float*)(p.ws + OFF_DN);
    const u16* CT = (const u16*)(p.ws + OFF_CT);
    u16* YM = (u16*)(p.ws + OFF_YM);
    u16* Ks = (u16*)smem;
    u16* CTf = (u16*)smem; u16* CTb = (u16*)(smem + 17408);
    u16* VTs = (u16*)(smem + 34816);
    u16* Spf = (u16*)(smem + 44032); u16* Spb = (u16*)(smem + 53248);
    float* ga = (float*)(smem + 62464);
    float *uf_s = ga, *Mf_s = ga + 64, *ub_s = ga + 128, *Mb_s = ga + 192, *clf = ga + 256, *clb = ga + 320, *wif = ga + 384, *wib = ga + 448;
    const int l15 = lane & 15, l4 = lane >> 4;
    if (wid == 0) {
        const float* g = G + (size_t)(base + lane) * 16;
        const float igf = g[h], ff = g[4 + h], igb = g[8 + h], fb = g[12 + h];
        const float lff = log_sigmoid_(ff), lfb = log_sigmoid_(fb);
        const float bfc = wave_incl_sum(lff, lane);
        const float uf = igf - bfc;
        const float pb = wave_incl_sum(lfb, lane), gb = __shfl(pb, 63);
        const float bb = gb - pb + lfb, ub = igb - bb;
        const float mpf = mprev[slot_f], mpb = mprev[slot_b];
        const float Mf = fmaxf(mpf, wave_prefix_max(uf, lane)), Mb = fmaxf(mpb, wave_suffix_max(ub, lane));
        uf_s[lane] = uf; Mf_s[lane] = Mf; clf[lane] = __expf(-(bfc + Mf)); wif[lane] = __expf(mpf - Mf);
        ub_s[lane] = ub; Mb_s[lane] = Mb; clb[lane] = __expf(-(bb + Mb)); wib[lane] = __expf(mpb - Mb);
    }
    bf16x8 qa[4];
    {
        const u16* qsrc = P + (size_t)(base + wid * 16 + l15) * PV + V_MQ + h * 128 + l4 * 8;
#pragma unroll
        for (int kk = 0; kk < 4; ++kk) qa[kk] = *(const bf16x8*)(qsrc + kk * 32);
    }
#pragma unroll
    for (int i = 0; i < 4; ++i) {
        const int id = tid + i * 256, kr = id >> 4, ch = id & 15;
        *(u32x4*)(Ks + kr * LDQ + ch * 8) = *(const u32x4*)(P + (size_t)(base + kr) * PV + V_MK + h * 128 + ch * 8);
    }
    __syncthreads();
    f32x4 S[4] = {};
#pragma unroll
    for (int nt = 0; nt < 4; ++nt)
#pragma unroll
        for (int kk = 0; kk < 4; ++kk) {
            const bf16x8 bq = *(const bf16x8*)(Ks + (nt * 16 + l15) * LDQ + kk * 32 + l4 * 8);
            S[nt] = mfma16(qa[kk], bq, S[nt]);
        }
    float qnf = 0.f, qnb = 0.f;
    {
        const float* nf = dn + (size_t)slot_f * 128; const float* nb = dn + (size_t)slot_b * 128;
#pragma unroll
        for (int kk = 0; kk < 4; ++kk)
#pragma unroll
            for (int j = 0; j < 8; ++j) {
                const int d = kk * 32 + l4 * 8 + j;
                const float qv = bf2f((u16)qa[kk][j]);
                qnf += qv * nf[d]; qnb += qv * nb[d];
            }
        qnf += __shfl_xor(qnf, 16); qnf += __shfl_xor(qnf, 32);
        qnb += __shfl_xor(qnb, 16); qnb += __shfl_xor(qnb, 32);
    }
    float denf[4], denb[4], cpf[4], cpb[4];
#pragma unroll
    for (int reg = 0; reg < 4; ++reg) {
        const int t = wid * 16 + l4 * 4 + reg;
        const float Mft = Mf_s[t], Mbt = Mb_s[t];
        float rsf = 0.f, rsb = 0.f;
#pragma unroll
        for (int nt = 0; nt < 4; ++nt) {
            const int s = nt * 16 + l15;
            const float sv = S[nt][reg];
            const float pf = (s <= t) ? sv * __expf(uf_s[s] - Mft) : 0.f;
            const float pbv = (s >= t) ? sv * __expf(ub_s[s] - Mbt) : 0.f;
            rsf += pf; rsb += pbv;
            Spf[t * LDT + s] = f2bf(pf); Spb[t * LDT + s] = f2bf(pbv);
        }
        rsf += __shfl_xor(rsf, 1); rsf += __shfl_xor(rsf, 2); rsf += __shfl_xor(rsf, 4); rsf += __shfl_xor(rsf, 8);
        rsb += __shfl_xor(rsb, 1); rsb += __shfl_xor(rsb, 2); rsb += __shfl_xor(rsb, 4); rsb += __shfl_xor(rsb, 8);
        const float qf = __shfl(qnf, l4 * 4 + reg), qb = __shfl(qnb, l4 * 4 + reg);
        denf[reg] = rsf + wif[t] * qf; denb[reg] = rsb + wib[t] * qb;
        cpf[reg] = clf[t]; cpb[reg] = clb[t];
    }
    bf16x8 qwf[4], qwb[4];
    {
        const float wfr = wif[wid * 16 + l15], wbr = wib[wid * 16 + l15];
#pragma unroll
        for (int kk = 0; kk < 4; ++kk) {
            u32x4 of, ob;
            const float q0 = bf2f((u16)qa[kk][0]), q1 = bf2f((u16)qa[kk][1]), q2 = bf2f((u16)qa[kk][2]), q3 = bf2f((u16)qa[kk][3]);
            const float q4 = bf2f((u16)qa[kk][4]), q5 = bf2f((u16)qa[kk][5]), q6 = bf2f((u16)qa[kk][6]), q7 = bf2f((u16)qa[kk][7]);
            of.x = pk2(q0 * wfr, q1 * wfr); of.y = pk2(q2 * wfr, q3 * wfr); of.z = pk2(q4 * wfr, q5 * wfr); of.w = pk2(q6 * wfr, q7 * wfr);
            ob.x = pk2(q0 * wbr, q1 * wbr); ob.y = pk2(q2 * wbr, q3 * wbr); ob.z = pk2(q4 * wbr, q5 * wbr); ob.w = pk2(q6 * wbr, q7 * wbr);
            qwf[kk] = __builtin_bit_cast(bf16x8, of); qwb[kk] = __builtin_bit_cast(bf16x8, ob);
        }
    }
    __syncthreads();
    float ssq[4] = {0.f, 0.f, 0.f, 0.f};
#pragma unroll 1
    for (int vb = 0; vb < 4; ++vb) {
        if (tid < 128) {
            const int cgp = tid >> 3, tg = tid & 7;
            const u16* src = P + (size_t)(base + tg * 8) * PV + V_MV + h * 256 + vb * 64 + cgp * 4;
            u32x2 vv[8];
#pragma unroll
            for (int i = 0; i < 8; ++i) vv[i] = *(const u32x2*)(src + (size_t)i * PV);
#pragma unroll
            for (int cc = 0; cc < 4; ++cc) *(u32x4*)(VTs + (cgp * 4 + cc) * LDT + tg * 8) = tr8(vv, cc);
        }
#pragma unroll
        for (int i = 0; i < 4; ++i) {
            const int id = tid + i * 256, vr = id >> 4, ch = id & 15;
            *(u32x4*)(CTf + vr * LDQ + ch * 8) = *(const u32x4*)(CT + (size_t)slot_f * 32768 + (vb * 64 + vr) * 128 + ch * 8);
            *(u32x4*)(CTb + vr * LDQ + ch * 8) = *(const u32x4*)(CT + (size_t)slot_b * 32768 + (vb * 64 + vr) * 128 + ch * 8);
        }
        __syncthreads();
        f32x4 af[4] = {}, ab[4] = {};
#pragma unroll
        for (int kk = 0; kk < 2; ++kk) {
            const bf16x8 a_f = *(const bf16x8*)(Spf + (wid * 16 + l15) * LDT + kk * 32 + l4 * 8);
            const bf16x8 a_b = *(const bf16x8*)(Spb + (wid * 16 + l15) * LDT + kk * 32 + l4 * 8);
#pragma unroll
            for (int nt = 0; nt < 4; ++nt) {
                const bf16x8 bv = *(const bf16x8*)(VTs + (nt * 16 + l15) * LDT + kk * 32 + l4 * 8);
                af[nt] = mfma16(a_f, bv, af[nt]); ab[nt] = mfma16(a_b, bv, ab[nt]);
            }
        }
#pragma unroll
        for (int kk = 0; kk < 4; ++kk)
#pragma unroll
            for (int nt = 0; nt < 4; ++nt) {
                const bf16x8 cf = *(const bf16x8*)(CTf + (nt * 16 + l15) * LDQ + kk * 32 + l4 * 8);
                const bf16x8 cb = *(const bf16x8*)(CTb + (nt * 16 + l15) * LDQ + kk * 32 + l4 * 8);
                af[nt] = mfma16(qwf[kk], cf, af[nt]); ab[nt] = mfma16(qwb[kk], cb, ab[nt]);
            }
#pragma unroll
        for (int reg = 0; reg < 4; ++reg) {
            const size_t tok = (size_t)base + wid * 16 + l4 * 4 + reg;
            const float idf = 1.f / fmaxf(fabsf(denf[reg]), cpf[reg]), idb = 1.f / fmaxf(fabsf(denb[reg]), cpb[reg]);
#pragma unroll
            for (int nt = 0; nt < 4; ++nt) {
                const float hv = af[nt][reg] * idf + ab[nt][reg] * idb;
                ssq[reg] += hv * hv;
                const int v = h * 256 + vb * 64 + nt * 16 + l15;
                const float o = bf2f(P[tok * PV + V_MO + v]);
                YM[tok * 1024 + v] = f2bf(hv * p.m_norm_w[v] * sigmoid_(o));
            }
        }
        __syncthreads();
    }
    float rstd[4];
#pragma unroll
    for (int reg = 0; reg < 4; ++reg) {
        float ss = ssq[reg];
        ss += __shfl_xor(ss, 1); ss += __shfl_xor(ss, 2); ss += __shfl_xor(ss, 4); ss += __shfl_xor(ss, 8);
        rstd[reg] = rsqrtf(ss * (1.f / 256.f) + 1e-6f);
    }
#pragma unroll 1
    for (int vb = 0; vb < 4; ++vb) {
#pragma unroll
        for (int reg = 0; reg < 4; ++reg) {
            const size_t tok = (size_t)base + wid * 16 + l4 * 4 + reg;
#pragma unroll
            for (int nt = 0; nt < 4; ++nt) {
                u16* q = YM + tok * 1024 + h * 256 + vb * 64 + nt * 16 + l15;
                *q = f2bf(bf2f(*q) * rstd[reg]);
            }
        }
    }
}

__device__ __forceinline__ void phase_merge(const Params& p, unsigned char* smem, const bool second) {
    const u16* P = (const u16*)(p.ws + OFF_P);
    const u16* YM = (const u16*)(p.ws + OFF_YM); const u16* YNA = (const u16*)(p.ws + OFF_YNA);
    u16* MRG = (u16*)(p.ws + OFF_MRG);
    const int tid = opaque_tid(), lane = tid & 63, wid = tid >> 6, wr = wid >> 1, wc = wid & 1;
    const u16* abase = second ? YNA : YM; const int lda = second ? 512 : 1024;
    const u16* wt = (const u16*)(p.ws + (second ? OFF_BRNT : OFF_BRMT));
    const int gcol = second ? V_GN : V_GM;
    const int sw = ((tid & 3) ^ ((tid >> 4) & 3)) * 8;
    for (int ti = 0;; ++ti) {
        int mt, nt;
        if (!sched_tile(ti, 256, 4, 4, mt, nt)) break;
        f32x16 acc[2][4] = {};
        gemm_core3(acc, abase + (size_t)(mt * 128 + (tid >> 2)) * lda + sw, (size_t)64 * lda, wt + (size_t)(nt * 256 + (tid >> 2)) * lda + sw, (size_t)64 * lda, second ? 16 : 32, smem, tid, lane, wr, wc);
        u16* Ct = (u16*)smem;
        RAW_BARRIER();
        ct_write3(Ct, acc, wr, wc, lane);
        __syncthreads();
#pragma unroll 4
        for (int i = 0; i < 16; ++i) {
            const int idx = tid + i * 256, row = idx >> 5, ch = idx & 31;
            const size_t m = (size_t)mt * 128 + row;
            const u32x4 cv = *(const u32x4*)(Ct + row * CT3_LD + ch * 8);
            const u32x4 gv = *(const u32x4*)(P + m * PV + gcol + nt * 256 + ch * 8);
            u16* q = MRG + m * 1024 + nt * 256 + ch * 8;
            float o[8];
            o[0] = bf_lo(cv.x) * bf_lo(gv.x); o[1] = bf_hi(cv.x) * bf_hi(gv.x); o[2] = bf_lo(cv.y) * bf_lo(gv.y); o[3] = bf_hi(cv.y) * bf_hi(gv.y);
            o[4] = bf_lo(cv.z) * bf_lo(gv.z); o[5] = bf_hi(cv.z) * bf_hi(gv.z); o[6] = bf_lo(cv.w) * bf_lo(gv.w); o[7] = bf_hi(cv.w) * bf_hi(gv.w);
            if (second) {
                const u32x4 pv = *(const u32x4*)q;
                o[0] += bf_lo(pv.x); o[1] += bf_hi(pv.x); o[2] += bf_lo(pv.y); o[3] += bf_hi(pv.y); o[4] += bf_lo(pv.z); o[5] += bf_hi(pv.z); o[6] += bf_lo(pv.w); o[7] += bf_hi(pv.w);
            }
            u32x4 w; w.x = pk2(o[0], o[1]); w.y = pk2(o[2], o[3]); w.z = pk2(o[4], o[5]); w.w = pk2(o[6], o[7]);
            *(u32x4*)q = w;
        }
        __syncthreads();
    }
}

__device__ __forceinline__ void phase_outproj(const Params& p, unsigned char* smem) {
    const u16* MRG = (const u16*)(p.ws + OFF_MRG);
    const int tid = opaque_tid(), lane = tid & 63, wid = tid >> 6, wr = wid >> 1, wc = wid & 1;
    const u16* wt = (const u16*)(p.ws + OFF_OUTT);
    const int sw = ((tid & 3) ^ ((tid >> 4) & 3)) * 8;
    for (int ti = 0;; ++ti) {
        int mt, nt;
        if (!sched_tile(ti, 256, 4, 4, mt, nt)) break;
        f32x16 acc[2][4] = {};
        gemm_core3(acc, MRG + (size_t)(mt * 128 + (tid >> 2)) * 1024 + sw, 64 * 1024, wt + (size_t)(nt * 256 + (tid >> 2)) * 1024 + sw, 64 * 1024, 32, smem, tid, lane, wr, wc);
        u16* Ct = (u16*)smem;
        RAW_BARRIER();
        ct_write3(Ct, acc, wr, wc, lane);
        __syncthreads();
        {
            const int bvec = mt >> 7, ch = tid & 31;
            float g1[8];
#pragma unroll
            for (int j = 0; j < 8; ++j) g1[j] = mod_val(p, bvec, 2048 + nt * 256 + ch * 8 + j);
#pragma unroll 4
            for (int i = 0; i < 16; ++i) {
                const int row = (tid >> 5) + i * 8;
                const size_t off = ((size_t)mt * 128 + row) * 1024 + nt * 256 + ch * 8;
                const u32x4 cv = *(const u32x4*)(Ct + row * CT3_LD + ch * 8);
                const f32x4 x0 = *(const f32x4*)(p.x + off), x1 = *(const f32x4*)(p.x + off + 4);
                f32x4 o0, o1;
                o0.x = x0.x + g1[0] * bf_lo(cv.x); o0.y = x0.y + g1[1] * bf_hi(cv.x); o0.z = x0.z + g1[2] * bf_lo(cv.y); o0.w = x0.w + g1[3] * bf_hi(cv.y);
                o1.x = x1.x + g1[4] * bf_lo(cv.z); o1.y = x1.y + g1[5] * bf_hi(cv.z); o1.z = x1.z + g1[6] * bf_lo(cv.w); o1.w = x1.w + g1[7] * bf_hi(cv.w);
                *(f32x4*)(p.out + off) = o0; *(f32x4*)(p.out + off + 4) = o1;
            }
        }
        __syncthreads();
    }
}

__device__ __forceinline__ void phase_router(const Params& p, unsigned char* smem) {
    const u16* H = (const u16*)(p.ws + OFF_H);
    float* SC = (float*)(p.ws + OFF_SC);
    const int tid = opaque_tid(), lane = tid & 63, wid = tid >> 6, wr = wid >> 1, wc = wid & 1;
    const int r = lane & 31, hh = lane >> 5;
    const u16* wt = (const u16*)(p.ws + OFF_RTT);
    const int sw = ((tid & 7) ^ ((tid >> 3) & 7)) * 8;
    for (int ti = 0;; ++ti) {
        int mt, nt;
        if (!sched_tile(ti, 256, 2, 2, mt, nt)) break;
        f32x16 acc[2][2] = {};
        gemm_core2(acc, H + (size_t)(mt * 128 + (tid >> 3)) * 1024 + sw, 32 * 1024, wt + (size_t)(nt * 128 + (tid >> 3)) * 1024 + sw, 32 * 1024, 16, smem, tid, lane, wr, wc);
#pragma unroll
        for (int mi = 0; mi < 2; ++mi)
#pragma unroll
            for (int ni = 0; ni < 2; ++ni) {
                float* srow = SC + ((size_t)mt * 128 + wr * 64 + mi * 32 + r) * 256 + nt * 128 + wc * 64 + ni * 32 + 4 * hh;
#pragma unroll
                for (int g = 0; g < 4; ++g) {
                    f32x4 o; o.x = sigmoid_(acc[mi][ni][4 * g]); o.y = sigmoid_(acc[mi][ni][4 * g + 1]); o.z = sigmoid_(acc[mi][ni][4 * g + 2]); o.w = sigmoid_(acc[mi][ni][4 * g + 3]);
                    *(f32x4*)(srow + 8 * g) = o;
                }
            }
        __syncthreads();
    }
}

__device__ __forceinline__ void phase_route(const Params& p, unsigned char* smem) {
    const int tid = opaque_tid(), lane = tid & 63, wid = tid >> 6;
    const float* SC = (const float*)(p.ws + OFF_SC);
    int* tope = (int*)(p.ws + OFF_TOPE); float* topw = (float*)(p.ws + OFF_TOPW);
    int* lh = (int*)smem;
    lh[tid] = 0;
    __syncthreads();
    const f32x4 rb = *(const f32x4*)(p.router_bias + lane * 4);
    for (int tok = blockIdx.x * 4 + wid; tok < NTOK; tok += gridDim.x * 4) {
        const f32x4 sc = *(const f32x4*)(SC + (size_t)tok * 256 + lane * 4);
        float s0 = sc.x + rb.x, s1 = sc.y + rb.y, s2 = sc.z + rb.z, s3 = sc.w + rb.w;
        float a1 = fmaxf(s0, s1), a2 = fminf(s0, s1);
        { const float b1 = fmaxf(s2, s3), b2 = fminf(s2, s3); const float n1 = fmaxf(a1, b1), n2 = fmaxf(fminf(a1, b1), fmaxf(a2, b2)); a1 = n1; a2 = n2; }
#pragma unroll
        for (int o = 1; o < 8; o <<= 1) {
            const float b1 = __shfl_xor(a1, o), b2 = __shfl_xor(a2, o);
            const float n1 = fmaxf(a1, b1), n2 = fmaxf(fminf(a1, b1), fmaxf(a2, b2)); a1 = n1; a2 = n2;
        }
        const float gs = a1 + a2; const int mygrp = lane >> 3;
        int gcnt = 0;
#pragma unroll
        for (int g = 0; g < 8; ++g) { const float og = __shfl(gs, g * 8); gcnt += (og > gs || (og == gs && g < mygrp)) ? 1 : 0; }
        if (gcnt >= 4) { s0 = -INFINITY; s1 = -INFINITY; s2 = -INFINITY; s3 = -INFINITY; }
        int my_e = 0; float my_s = 0.f, wsum = 0.f;
#pragma unroll
        for (int k = 0; k < 8; ++k) {
            float bv = s0; int bi = lane * 4;
            if (s1 > bv) { bv = s1; bi = lane * 4 + 1; }
            if (s2 > bv) { bv = s2; bi = lane * 4 + 2; }
            if (s3 > bv) { bv = s3; bi = lane * 4 + 3; }
#pragma unroll
            for (int o = 1; o < 64; o <<= 1) {
                const float ov = __shfl_xor(bv, o); const int oi = __shfl_xor(bi, o);
                if (ov > bv || (ov == bv && oi < bi)) { bv = ov; bi = oi; }
            }
            const int own = bi >> 2, sub = bi & 3;
            const float mine = sub == 0 ? sc.x : sub == 1 ? sc.y : sub == 2 ? sc.z : sc.w;
            const float sel_sc = __shfl(mine, own);
            if (lane == own) { if (sub == 0) s0 = -INFINITY; else if (sub == 1) s1 = -INFINITY; else if (sub == 2) s2 = -INFINITY; else s3 = -INFINITY; }
            wsum += sel_sc;
            if (lane == k) { my_e = bi; my_s = sel_sc; }
        }
        if (lane < 8) {
            atomicAdd(lh + my_e, 1);
            tope[tok * 8 + lane] = my_e; topw[tok * 8 + lane] = my_s / wsum * 2.5f;
        }
    }
    __syncthreads();
    ((int*)(p.ws + OFF_HIST))[blockIdx.x * 256 + tid] = lh[tid];
}
__device__ __forceinline__ void phase_assign(const Params& p, unsigned char* smem) {
    const int tid = opaque_tid(), lane = tid & 63, wid = tid >> 6;
    int* offs = (int*)smem; int* lc = offs + 256;
    const int* hist = (const int*)(p.ws + OFF_HIST);
    int* slot_tok = (int*)(p.ws + OFF_SLOT);
    const int* tope = (const int*)(p.ws + OFF_TOPE); int* rnk = (int*)(p.ws + OFF_RANK);
    {
        int run = 0, mine = 0;
        const int nb = gridDim.x, me = blockIdx.x;
        for (int b0 = 0; b0 < nb; b0 += 8) {
            int v[8];
#pragma unroll
            for (int j = 0; j < 8; ++j) v[j] = (b0 + j < nb) ? hist[(b0 + j) * 256 + tid] : 0;
#pragma unroll
            for (int j = 0; j < 8; ++j) { if (b0 + j == me) mine = run; run += v[j]; }
        }
        offs[tid] = mine; lc[tid] = 0;
        if (me == 0) ((int*)(p.ws + OFF_CNT))[tid] = run;
    }
    __syncthreads();
    for (int tok = blockIdx.x * 4 + wid; tok < NTOK; tok += gridDim.x * 4) {
        if (lane < 8) {
            const int e = tope[tok * 8 + lane];
            const int rk = offs[e] + atomicAdd(lc + e, 1);
            rnk[tok * 8 + lane] = rk; slot_tok[(size_t)e * NTOK + rk] = tok;
        }
    }
}

__device__ __forceinline__ int* build_tile_table(const Params& p, unsigned char* smem) {
    int* tstart = (int*)(smem + 73728); int* cn = tstart + 260;
    const int tid = opaque_tid();
    cn[tid] = ((const int*)(p.ws + OFF_CNT))[tid];
    __syncthreads();
    if (tid == 0) { int s = 0; for (int e = 0; e < 256; ++e) { tstart[e] = s; s += (cn[e] + 127) >> 7; } tstart[256] = s; }
    __syncthreads();
    return tstart;
}
__device__ __forceinline__ int find_expert(const int* tstart, int mtile) {
    int lo = 0, hi = 256;
    while (hi - lo > 1) { const int mid = (lo + hi) >> 1; if (tstart[mid] <= mtile) lo = mid; else hi = mid; }
    return lo;
}

__device__ __forceinline__ void phase_moe1(const Params& p, unsigned char* smem) {
    u16* As = (u16*)smem; u16* Bs = (u16*)(smem + 18432);
    const int* tstart = build_tile_table(p, smem); const int* cn = tstart + 260;
    const u16* H2 = (const u16*)(p.ws + OFF_H);
    const int* slot_tok = (const int*)(p.ws + OFF_SLOT);
    u16* HID = (u16*)(p.ws + OFF_HID);
    const int tid = opaque_tid(), lane = tid & 63, wid = tid >> 6, wr = wid >> 1, wc = wid & 1;
    const int r = lane & 31, hh = lane >> 5;
    const int total = tstart[256];
    const int nitems = total * 4 + 1024;
    for (int ii = 0;; ++ii) {
        const int it = ((blockIdx.x & 7) + 8 * ii) * (gridDim.x >> 3) + (blockIdx.x >> 3);
        if (it >= nitems) break;
        const bool shared = it >= total * 4;
        const int idx = shared ? it - total * 4 : it;
        const int mtile = idx >> 2, nq = idx & 3;
        int e = 0, j = 0, cnt_e = 0;
        if (!shared) { e = find_expert(tstart, mtile); j = mtile - tstart[e]; cnt_e = cn[e]; }
        const u16* rowp[4];
#pragma unroll
        for (int i = 0; i < 4; ++i) {
            const int ri = (tid >> 3) + 32 * i;
            int tok;
            if (shared) tok = mtile * 128 + ri;
            else { const int pos = j * 128 + ri; tok = pos < cnt_e ? slot_tok[(size_t)e * NTOK + pos] : 0; }
            rowp[i] = H2 + (size_t)tok * 1024 + (tid & 7) * 8;
        }
        const int R0 = (tid >> 3) * 4, bwc = R0 >> 6, bni = (R0 >> 5) & 1, bj = R0 & 31;
        const float* wsel = shared ? (bni ? p.w_sh_up : p.w_sh_gate) : ((bni ? p.w_exp_up : p.w_exp_gate) + (size_t)e * 1024 * 256);
        const float* bsrc = wsel + (size_t)((tid & 7) * 8) * 256 + nq * 64 + bwc * 32 + bj;
        f32x16 acc[2][2] = {};
        gemm_core(acc, rowp, bsrc, 256, 16, As, Bs, tid, lane, wr, wc);
        const size_t hrow0 = shared ? (size_t)SH_BASE + mtile * 128 : (size_t)mtile * 128;
        u16* Ct = (u16*)smem;
        {
#pragma unroll
            for (int mi = 0; mi < 2; ++mi) {
                u16* base = Ct + (wr * 64 + mi * 32 + r) * LDT + wc * 32 + 4 * hh;
#pragma unroll
                for (int g = 0; g < 4; ++g) {
                    float hv[4];
#pragma unroll
                    for (int j = 0; j < 4; ++j) { const float gt = acc[mi][0][4 * g + j], u = acc[mi][1][4 * g + j]; hv[j] = gt * sigmoid_(gt) * u; }
                    u32x2 w; w.x = pk2(hv[0], hv[1]); w.y = pk2(hv[2], hv[3]);
                    *(u32x2*)(base + 8 * g) = w;
                }
            }
        }
        __syncthreads();
#pragma unroll
        for (int i = 0; i < 4; ++i) {
            const int idx = tid + i * 256, row = idx >> 3, ch = idx & 7;
            *(u32x4*)(HID + (hrow0 + row) * 256 + nq * 64 + ch * 8) = *(const u32x4*)(Ct + row * LDT + ch * 8);
        }
        __syncthreads();
    }
}

__device__ __forceinline__ void phase_moe2(const Params& p, unsigned char* smem) {
    u16* As = (u16*)smem; u16* Bs = (u16*)(smem + 18432);
    const int* tstart = build_tile_table(p, smem);
    const u16* HID = (const u16*)(p.ws + OFF_HID);
    u16* Y = (u16*)(p.ws + OFF_Y);
    const int tid = opaque_tid(), lane = tid & 63, wid = tid >> 6, wr = wid >> 1, wc = wid & 1;
    const int r = lane & 31, hh = lane >> 5;
    const int total = tstart[256];
    const int nitems = total * 8 + 2048;
    for (int ii = 0;; ++ii) {
        const int it = ((blockIdx.x & 7) + 8 * ii) * (gridDim.x >> 3) + (blockIdx.x >> 3);
        if (it >= nitems) break;
        const bool shared = it >= total * 8;
        const int idx = shared ? it - total * 8 : it;
        const int mtile = idx >> 3, nt = idx & 7;
        int e = 0;
        if (!shared) e = find_expert(tstart, mtile);
        const size_t hrow0 = shared ? (size_t)SH_BASE + mtile * 128 : (size_t)mtile * 128;
        const u16* rowp[4];
#pragma unroll
        for (int i = 0; i < 4; ++i) rowp[i] = HID + (hrow0 + (tid >> 3) + 32 * i) * 256 + (tid & 7) * 8;
        const float* wsel = shared ? p.w_sh_down : p.w_exp_down + (size_t)e * 256 * 1024;
        const float* bsrc = wsel + (size_t)((tid & 7) * 8) * 1024 + nt * 128 + (tid >> 3) * 4;
        f32x16 acc[2][2] = {};
        gemm_core(acc, rowp, bsrc, 1024, 4, As, Bs, tid, lane, wr, wc);
        u16* Ct = (u16*)smem;
        ct_write(Ct, acc, wr, wc, lane);
        __syncthreads();
        ct_store(Ct, Y + hrow0 * 1024 + nt * 128, 1024, tid);
        __syncthreads();
    }
}

__device__ __forceinline__ void phase_combine(const Params& p, unsigned char* smem) {
    const int* tstart = build_tile_table(p, smem);
    float* g2t = (float*)smem;
    const int tid = opaque_tid(), lane = tid & 63, wid = tid >> 6;
    for (int j = tid; j < 2048; j += 256) g2t[j] = mod_val(p, j >> 10, 5120 + (j & 1023));
    __syncthreads();
    const u16* Y = (const u16*)(p.ws + OFF_Y);
    const int* tope = (const int*)(p.ws + OFF_TOPE); const int* rnk = (const int*)(p.ws + OFF_RANK); const float* topw = (const float*)(p.ws + OFF_TOPW);
    for (int tok = blockIdx.x * 4 + wid; tok < NTOK; tok += gridDim.x * 4) {
        int myrow = 0; float myw = 0.f;
        if (lane < 8) { const int e = tope[tok * 8 + lane]; myrow = tstart[e] * 128 + rnk[tok * 8 + lane]; myw = topw[tok * 8 + lane]; }
        if (lane == 8) { myrow = SH_BASE + tok; myw = 1.f; }
        const float* g2 = g2t + (tok >> 14) * 1024;
        f32x4 a[4];
#pragma unroll
        for (int j = 0; j < 4; ++j) a[j] = (f32x4){0.f, 0.f, 0.f, 0.f};
#pragma unroll
        for (int k = 0; k < 9; ++k) {
            const int row = __shfl(myrow, k); const float w = __shfl(myw, k);
            const u16* yr = Y + (size_t)row * 1024 + lane * 4;
#pragma unroll
            for (int j = 0; j < 4; ++j) {
                const u32x2 v = *(const u32x2*)(yr + j * 256);
                a[j].x += w * bf_lo(v.x); a[j].y += w * bf_hi(v.x); a[j].z += w * bf_lo(v.y); a[j].w += w * bf_hi(v.y);
            }
        }
#pragma unroll
        for (int j = 0; j < 4; ++j) {
            const int col = j * 256 + lane * 4;
            float* op = p.out + (size_t)tok * 1024 + col;
            const f32x4 x1 = *(const f32x4*)op, g = *(const f32x4*)(g2 + col);
            f32x4 o; o.x = x1.x + g.x * a[j].x; o.y = x1.y + g.y * a[j].y; o.z = x1.z + g.z * a[j].z; o.w = x1.w + g.w * a[j].w;
            *(f32x4*)op = o;
        }
    }
}

__global__ void __launch_bounds__(256, 2) mega(Params p) {
    extern __shared__ __attribute__((aligned(16))) unsigned char smem[];
    cg::grid_group grid = cg::this_grid();
#define PHASE_BEGIN(k) if (p.ph_lo <= (k) && (k) < p.ph_hi) {
#define PHASE_END(k) if ((k) + 1 < p.ph_hi) grid.sync(); }
    PHASE_BEGIN(0) phase_ada(p, smem); if (DUP_PHASE == 0) { grid.sync(); phase_ada(p, smem); } PHASE_END(0)
    PHASE_BEGIN(1) phase_norm(p, smem, false); if (DUP_PHASE == 1) { grid.sync(); phase_norm(p, smem, false); } PHASE_END(1)
    PHASE_BEGIN(2) phase_inproj(p, smem); if (DUP_PHASE == 2) { grid.sync(); phase_inproj(p, smem); } PHASE_END(2)
    PHASE_BEGIN(3)
        for (int it = blockIdx.x; it < 2080 + 4096; it += gridDim.x) { if (it < 2080) mlstm_passA(p, smem, it); else na_item(p, smem, it - 2080); }
        if (DUP_PHASE == 3) { grid.sync(); for (int it = blockIdx.x; it < 2080; it += gridDim.x) mlstm_passA(p, smem, it); }
        if (DUP_PHASE == 30) { grid.sync(); for (int it = blockIdx.x; it < 4096; it += gridDim.x) na_item(p, smem, it); }
    PHASE_END(3)
    PHASE_BEGIN(4) phase_scan(p, smem); if (DUP_PHASE == 34) { grid.sync(); for (int it = blockIdx.x; it < 2080; it += gridDim.x) mlstm_passA(p, smem, it); grid.sync(); phase_scan(p, smem); } PHASE_END(4)
    PHASE_BEGIN(5) for (int it = blockIdx.x; it < 2048; it += gridDim.x) mlstm_passC(p, smem, it); if (DUP_PHASE == 5) { grid.sync(); for (int it = blockIdx.x; it < 2048; it += gridDim.x) mlstm_passC(p, smem, it); } PHASE_END(5)
    PHASE_BEGIN(6) phase_merge(p, smem, false); phase_merge(p, smem, true); if (DUP_PHASE == 6) { grid.sync(); phase_merge(p, smem, false); phase_merge(p, smem, true); } PHASE_END(6)
    PHASE_BEGIN(7) phase_outproj(p, smem); if (DUP_PHASE == 7) { grid.sync(); phase_outproj(p, smem); } PHASE_END(7)
    PHASE_BEGIN(8) phase_norm(p, smem, true); if (DUP_PHASE == 8) { grid.sync(); phase_norm(p, smem, true); } PHASE_END(8)
    PHASE_BEGIN(9) phase_router(p, smem); if (DUP_PHASE == 9) { grid.sync(); phase_router(p, smem); } PHASE_END(9)
    PHASE_BEGIN(10) phase_route(p, smem); PHASE_END(10)
    PHASE_BEGIN(11) phase_assign(p, smem); PHASE_END(11)
    PHASE_BEGIN(12) phase_moe1(p, smem); if (DUP_PHASE == 12) { grid.sync(); phase_moe1(p, smem); } PHASE_END(12)
    PHASE_BEGIN(13) phase_moe2(p, smem); if (DUP_PHASE == 13) { grid.sync(); phase_moe2(p, smem); } PHASE_END(13)
    PHASE_BEGIN(14) phase_combine(p, smem);
        if (DUP_PHASE == 100) { grid.sync(); phase_route(p, smem); grid.sync(); phase_assign(p, smem); }
    PHASE_END(14)
#if RUN_PHASES < 8
    if (!MULTI_LAUNCH) grid.sync();
    if (p.ph_lo == 100 || !MULTI_LAUNCH) {
        const size_t NOUT = (size_t)NTOK * 1024;
        for (size_t i = (size_t)blockIdx.x * 256 + threadIdx.x; i < NOUT; i += (size_t)gridDim.x * 256) {
            float s = 0.f;
#define TAPB(off, n) { const u16* bb_ = (const u16*)(p.ws + (off)); for (size_t j = i; j < (size_t)(n); j += NOUT) s += bf2f(bb_[j]); }
#define TAPF(off, n) { const float* bb_ = (const float*)(p.ws + (off)); for (size_t j = i; j < (size_t)(n); j += NOUT) s += bb_[j]; }
#if RUN_PHASES == 1
            TAPF(OFF_MODP, 8 * 3 * 6144)
#elif RUN_PHASES == 2
            TAPB(OFF_H, (size_t)MTOT * 1024)
#elif RUN_PHASES == 3
            { const u16* bb_ = (const u16*)(p.ws + OFF_P); for (size_t j = i; j < (size_t)MTOT * 1024; j += NOUT) s += bf2f(bb_[(j / 1024) * PV + TAPC0 + (j % 1024)]); }
#elif RUN_PHASES == 4
            TAPB(OFF_YNA, (size_t)NTOK * 512) TAPB(OFF_CT, (size_t)NSLOT * 32768) TAPF(OFF_DN, NSLOT * 128) TAPF(OFF_GS, NSLOT) TAPF(OFF_ML, NSLOT)
#elif RUN_PHASES == 5
            TAPB(OFF_CT, (size_t)NSLOT * 32768) TAPF(OFF_DN, NSLOT * 128) TAPF(OFF_MP, NSLOT)
#elif RUN_PHASES == 6
            TAPB(OFF_YM, (size_t)NTOK * 1024)
#elif RUN_PHASES == 7
            TAPB(OFF_MRG, (size_t)NTOK * 1024)
#endif
            p.out[i] = p.x[i] + s;
        }
    }
#endif
}

extern "C" void kernel_launch(void* const* d_in, const int* in_sizes, int n_in, void* d_out, int out_size, void* d_ws, size_t ws_size, hipStream_t stream) {
    static int grid_blocks = 0;
    if (!grid_blocks) {
        int dev = 0, cus = 0, per_cu = 0;
        (void)hipGetDevice(&dev);
        (void)hipDeviceGetAttribute(&cus, hipDeviceAttributeMultiprocessorCount, dev);
        (void)hipFuncSetAttribute((const void*)mega, hipFuncAttributeMaxDynamicSharedMemorySize, LDS_BYTES);
        (void)hipOccupancyMaxActiveBlocksPerMultiprocessor(&per_cu, mega, 256, LDS_BYTES);
        if (per_cu > 2) per_cu = 2;
        if (per_cu < 1) per_cu = 1;
        grid_blocks = cus * per_cu;
        if (ws_size < WS_END) fprintf(stderr, "kernel_launch: workspace too small: %zu < %zu\n", ws_size, (size_t)WS_END);
    }
    Params p{};
    const float** pp = (const float**)&p;
    for (int i = 0; i < 23; ++i) pp[i] = (const float*)d_in[i];
    p.out = (float*)d_out; p.ws = (unsigned char*)d_ws;
#if MULTI_LAUNCH
    for (int ph = 0; ph < (RUN_PHASES < 1 ? 1 : (RUN_PHASES < NPH ? RUN_PHASES : NPH)); ++ph) {
        p.ph_lo = ph; p.ph_hi = ph + 1;
        void* args[] = {&p};
        hipError_t e = hipLaunchCooperativeKernel((void*)mega, dim3(grid_blocks), dim3(256), args, LDS_BYTES, stream);
        if (e != hipSuccess) fprintf(stderr, "cooperative launch failed: %s (grid %d)\n", hipGetErrorString(e), grid_blocks);
    }
#if RUN_PHASES < 8
    { p.ph_lo = 100; p.ph_hi = 100; void* args[] = {&p};
      (void)hipLaunchCooperativeKernel((void*)mega, dim3(grid_blocks), dim3(256), args, LDS_BYTES, stream); }
#endif
#else
    p.ph_lo = 0; p.ph_hi = RUN_PHASES < NPH ? RUN_PHASES : NPH;
    void* args[] = {&p};
    hipError_t e = hipLaunchCooperativeKernel((void*)mega, dim3(grid_blocks), dim3(256), args, LDS_BYTES, stream);
    if (e != hipSuccess) fprintf(stderr, "cooperative launch failed: %s (grid %d)\n", hipGetErrorString(e), grid_blocks);
#endif
}
```

```cpp
#include <hip/hip_runtime.h>
#include <hip/hip_cooperative_groups.h>
#include <cstdio>
#include <cstdint>
namespace cg = cooperative_groups;

#ifndef MULTI_LAUNCH
#define MULTI_LAUNCH 0
#endif
#ifndef TAPC0
#define TAPC0 0
#endif
#ifndef DBG_ROPE
#define DBG_ROPE 1
#endif
#ifndef DUP_PHASE
#define DUP_PHASE -1
#endif
#ifndef RUN_PHASES
#define RUN_PHASES 15
#endif

typedef unsigned short u16;
typedef unsigned int u32;
typedef short bf16x8 __attribute__((ext_vector_type(8)));
typedef float f32x16 __attribute__((ext_vector_type(16)));
typedef float f32x4 __attribute__((ext_vector_type(4)));
typedef u32 u32x4 __attribute__((ext_vector_type(4)));
typedef u32 u32x2 __attribute__((ext_vector_type(2)));

constexpr int DM = 1024;
constexpr int NTOK = 32768;
constexpr int TSEQ = 16384;
constexpr int MTOT = 33280;
constexpr int INC = 6672;
constexpr int PV = 6784;
constexpr int V_MQ = 0, V_MK = 512, V_MV = 1024, V_MO = 2048, V_NQ = 3072, V_NK = 3584, V_NV = 4096, V_GM = 4608, V_GN = 5632;
constexpr int NSLOT = 4160;
constexpr int SH_BASE = 294912;
constexpr int NPH = 15;
constexpr int LDS_BYTES = 76 * 1024;
constexpr int LDT = 72;
constexpr int LDQ = 136;

constexpr size_t AL(size_t x) { return (x + 255) & ~(size_t)255; }
constexpr size_t OFF_MODP = 0;
constexpr size_t OFF_CNT  = AL(OFF_MODP + (size_t)8 * 3 * 6144 * 4);
constexpr size_t OFF_G    = AL(OFF_CNT + 1024);
constexpr size_t OFF_GS   = AL(OFF_G + (size_t)MTOT * 16 * 4);
constexpr size_t OFF_ML   = AL(OFF_GS + NSLOT * 4);
constexpr size_t OFF_MP   = AL(OFF_ML + NSLOT * 4);
constexpr size_t OFF_DN   = AL(OFF_MP + NSLOT * 4);
constexpr size_t OFF_TOPE = AL(OFF_DN + (size_t)NSLOT * 128 * 4);
constexpr size_t OFF_RANK = OFF_TOPE + (size_t)NTOK * 8 * 4;
constexpr size_t OFF_TOPW = OFF_RANK + (size_t)NTOK * 8 * 4;
constexpr size_t OFF_H    = AL(OFF_TOPW + (size_t)NTOK * 8 * 4);
constexpr size_t OFF_SLOT = AL(OFF_H + (size_t)MTOT * 1024 * 2);
constexpr size_t OFF_R4   = AL(OFF_SLOT + (size_t)256 * 32768 * 4);
constexpr size_t OFF_YNA  = OFF_R4;
constexpr size_t OFF_YM   = OFF_R4 + (size_t)NTOK * 512 * 2;
constexpr size_t OFF_MRG  = OFF_YM + (size_t)NTOK * 1024 * 2;
constexpr size_t OFF_SC   = OFF_R4;
constexpr size_t OFF_HID  = OFF_R4;
constexpr size_t OFF_P    = AL(OFF_R4 + (size_t)327680 * 256 * 2);
constexpr size_t OFF_CT   = AL(OFF_P + (size_t)MTOT * PV * 2);
constexpr size_t OFF_Y    = OFF_P;
constexpr size_t OFF_WINT = AL(OFF_CT + (size_t)NSLOT * 65536);
constexpr size_t OFF_BRMT = AL(OFF_WINT + (size_t)6912 * 1024 * 2);
constexpr size_t OFF_BRNT = AL(OFF_BRMT + (size_t)1024 * 1024 * 2);
constexpr size_t OFF_OUTT = AL(OFF_BRNT + (size_t)1024 * 512 * 2);
constexpr size_t OFF_RTT  = AL(OFF_OUTT + (size_t)1024 * 1024 * 2);
constexpr size_t OFF_HIST = AL(OFF_RTT + (size_t)256 * 1024 * 2);
constexpr size_t WS_END   = OFF_HIST + (size_t)1024 * 256 * 4;
static_assert(OFF_Y + (size_t)327680 * 1024 * 2 <= OFF_WINT, "Y must fit over P+CT");
static_assert(WS_END <= (size_t)1073741824, "workspace budget");

struct Params {
    const float *x, *c, *ctx, *c_ctx, *w_ada, *b_ada, *w_in, *b_mgate, *m_norm_w, *na_qn_w, *na_kn_w, *na_rpb,
                *w_br_m, *w_br_na, *w_out, *w_router, *router_bias, *w_exp_gate, *w_exp_up, *w_exp_down,
                *w_sh_gate, *w_sh_up, *w_sh_down;
    float* out;
    unsigned char* ws;
    int ph_lo, ph_hi;
};

typedef __bf16 bf16x2_t __attribute__((ext_vector_type(2)));
__device__ __forceinline__ u32 pk2(float lo, float hi) { bf16x2_t v = {(__bf16)lo, (__bf16)hi}; return __builtin_bit_cast(u32, v); }
__device__ __forceinline__ u16 f2bf(float f) { return (u16)(pk2(f, 0.f) & 0xffffu); }
__device__ __forceinline__ float bf2f(u16 h) { return __uint_as_float(((u32)h) << 16); }
__device__ __forceinline__ float bf_lo(u32 w) { return __uint_as_float(w << 16); }
__device__ __forceinline__ float bf_hi(u32 w) { return __uint_as_float(w & 0xffff0000u); }
__device__ __forceinline__ float sigmoid_(float x) { return 1.f / (1.f + __expf(-x)); }
__device__ __forceinline__ float log_sigmoid_(float x) { return fminf(x, 0.f) - __logf(1.f + __expf(-fabsf(x))); }
__device__ __forceinline__ f32x4 mfma16(bf16x8 a, bf16x8 b, f32x4 c) { return __builtin_amdgcn_mfma_f32_16x16x32_bf16(a, b, c, 0, 0, 0); }
__device__ __forceinline__ f32x16 mfma32(bf16x8 a, bf16x8 b, f32x16 c) { return __builtin_amdgcn_mfma_f32_32x32x16_bf16(a, b, c, 0, 0, 0); }

__device__ __forceinline__ void sincos_rev(float rev, float& sn, float& cs) {
    rev -= rintf(rev);
    const float kq = rintf(rev * 4.f);
    const float th = (rev - kq * 0.25f) * 6.283185307179586f;
    const float t2 = th * th;
    const float s = th * (1.f + t2 * (-1.f / 6.f + t2 * (1.f / 120.f + t2 * (-1.f / 5040.f + t2 * (1.f / 362880.f)))));
    const float c = 1.f + t2 * (-0.5f + t2 * (1.f / 24.f + t2 * (-1.f / 720.f + t2 * (1.f / 40320.f))));
    const int k = ((int)kq) & 3;
    sn = (k == 0) ? s : (k == 1) ? c : (k == 2) ? -s : -c;
    cs = (k == 0) ? c : (k == 1) ? -s : (k == 2) ? -c : s;
}
__device__ __forceinline__ int opaque_tid() { int t = threadIdx.x; asm volatile("" : "+v"(t)); return t; }
__device__ __forceinline__ float wave_sum(float v) {
#pragma unroll
    for (int o = 1; o < 64; o <<= 1) v += __shfl_xor(v, o);
    return v;
}
__device__ __forceinline__ float wave_max(float v) {
#pragma unroll
    for (int o = 1; o < 64; o <<= 1) v = fmaxf(v, __shfl_xor(v, o));
    return v;
}
__device__ __forceinline__ float wave_incl_sum(float v, int lane) {
#pragma unroll
    for (int o = 1; o < 64; o <<= 1) { float t = __shfl_up(v, o); if (lane >= o) v += t; }
    return v;
}
__device__ __forceinline__ float wave_prefix_max(float v, int lane) {
#pragma unroll
    for (int o = 1; o < 64; o <<= 1) { float t = __shfl_up(v, o); if (lane >= o) v = fmaxf(v, t); }
    return v;
}
__device__ __forceinline__ float wave_suffix_max(float v, int lane) {
#pragma unroll
    for (int o = 1; o < 64; o <<= 1) { float t = __shfl_down(v, o); if (lane + o < 64) v = fmaxf(v, t); }
    return v;
}
__device__ __forceinline__ float mod_val(const Params& p, int vec, int j) {
    const float* mp = (const float*)(p.ws + OFF_MODP);
    float s = p.b_ada[j];
#pragma unroll
    for (int ks = 0; ks < 8; ++ks) s += mp[(ks * 3 + vec) * 6144 + j];
    return s;
}
__device__ __forceinline__ u32x4 tr8(const u32x2 (&v)[8], int cc) {
    u32x4 o;
    if (cc == 0)      { o.x = (v[0].x & 0xffffu) | (v[1].x << 16); o.y = (v[2].x & 0xffffu) | (v[3].x << 16); o.z = (v[4].x & 0xffffu) | (v[5].x << 16); o.w = (v[6].x & 0xffffu) | (v[7].x << 16); }
    else if (cc == 1) { o.x = (v[0].x >> 16) | (v[1].x & 0xffff0000u); o.y = (v[2].x >> 16) | (v[3].x & 0xffff0000u); o.z = (v[4].x >> 16) | (v[5].x & 0xffff0000u); o.w = (v[6].x >> 16) | (v[7].x & 0xffff0000u); }
    else if (cc == 2) { o.x = (v[0].y & 0xffffu) | (v[1].y << 16); o.y = (v[2].y & 0xffffu) | (v[3].y << 16); o.z = (v[4].y & 0xffffu) | (v[5].y << 16); o.w = (v[6].y & 0xffffu) | (v[7].y << 16); }
    else              { o.x = (v[0].y >> 16) | (v[1].y & 0xffff0000u); o.y = (v[2].y >> 16) | (v[3].y & 0xffff0000u); o.z = (v[4].y >> 16) | (v[5].y & 0xffff0000u); o.w = (v[6].y >> 16) | (v[7].y & 0xffff0000u); }
    return o;
}
__device__ __forceinline__ float bfsel(const u32x2& v, int cc) { return cc == 0 ? bf_lo(v.x) : cc == 1 ? bf_hi(v.x) : cc == 2 ? bf_lo(v.y) : bf_hi(v.y); }

__device__ __forceinline__ void gemm_core2(f32x16 (&acc)[2][2], const u16* a0, const size_t a32, const u16* b0, const size_t b32, const int nk,
                                           unsigned char* smem, const int tid, const int lane, const int wr, const int wc) {
    typedef __attribute__((address_space(3))) unsigned lds_u32;
    const int r = lane & 31, hh = lane >> 5;
    {
        unsigned char* sa = smem + tid * 16;
#pragma unroll
        for (int i = 0; i < 4; ++i) {
            __builtin_amdgcn_global_load_lds((const unsigned*)(a0 + i * a32), (lds_u32*)(sa + i * 4096), 16, 0, 0);
            __builtin_amdgcn_global_load_lds((const unsigned*)(b0 + i * b32), (lds_u32*)(sa + 16384 + i * 4096), 16, 0, 0);
        }
    }
    for (int kt = 0; kt < nk; ++kt) {
        __syncthreads();
        if (kt + 1 < nk) {
            unsigned char* sa = smem + ((kt + 1) & 1) * 32768 + tid * 16;
            const u16* ap = a0 + (kt + 1) * 64; const u16* bp = b0 + (kt + 1) * 64;
#pragma unroll
            for (int i = 0; i < 4; ++i) {
                __builtin_amdgcn_global_load_lds((const unsigned*)(ap + i * a32), (lds_u32*)(sa + i * 4096), 16, 0, 0);
                __builtin_amdgcn_global_load_lds((const unsigned*)(bp + i * b32), (lds_u32*)(sa + 16384 + i * 4096), 16, 0, 0);
            }
        }
        const unsigned char* sa = smem + (kt & 1) * 32768; const unsigned char* sb = sa + 16384;
#pragma unroll
        for (int kk = 0; kk < 4; ++kk) {
            bf16x8 a[2], b[2];
            const int ch = ((kk * 2 + hh) ^ (r & 7)) * 16;
#pragma unroll
            for (int mi = 0; mi < 2; ++mi) a[mi] = *(const bf16x8*)(sa + (wr * 64 + mi * 32 + r) * 128 + ch);
#pragma unroll
            for (int ni = 0; ni < 2; ++ni) b[ni] = *(const bf16x8*)(sb + (wc * 64 + ni * 32 + r) * 128 + ch);
#pragma unroll
            for (int mi = 0; mi < 2; ++mi)
#pragma unroll
                for (int ni = 0; ni < 2; ++ni) acc[mi][ni] = mfma32(b[ni], a[mi], acc[mi][ni]);
        }
    }
}
#define RAW_BARRIER() do { asm volatile("s_waitcnt lgkmcnt(0)" ::: "memory"); __builtin_amdgcn_s_barrier(); } while (0)
__device__ __forceinline__ void gemm_core3(f32x16 (&acc)[2][4], const u16* a0, const size_t a64, const u16* b0, const size_t b64, const int nk,
                                           unsigned char* smem, const int tid, const int lane, const int wr, const int wc) {
    typedef __attribute__((address_space(3))) unsigned lds_u32;
    const int r = lane & 31, hh = lane >> 5;
#pragma unroll
    for (int s = 0; s < 2; ++s) {
        unsigned char* sa = smem + s * 24576 + tid * 16;
#pragma unroll
        for (int i = 0; i < 2; ++i) __builtin_amdgcn_global_load_lds((const unsigned*)(a0 + s * 32 + i * a64), (lds_u32*)(sa + i * 4096), 16, 0, 0);
#pragma unroll
        for (int i = 0; i < 4; ++i) __builtin_amdgcn_global_load_lds((const unsigned*)(b0 + s * 32 + i * b64), (lds_u32*)(sa + 8192 + i * 4096), 16, 0, 0);
    }
    int cur = 0;
    for (int kt = 0; kt < nk; ++kt) {
        if (kt + 1 < nk) asm volatile("s_waitcnt vmcnt(6)" ::: "memory"); else asm volatile("s_waitcnt vmcnt(0)" ::: "memory");
        RAW_BARRIER();
        if (kt + 2 < nk) {
            const int nx = cur == 0 ? 2 : cur - 1;
            unsigned char* sa = smem + nx * 24576 + tid * 16;
            const u16* ap = a0 + (kt + 2) * 32; const u16* bp = b0 + (kt + 2) * 32;
#pragma unroll
            for (int i = 0; i < 2; ++i) __builtin_amdgcn_global_load_lds((const unsigned*)(ap + i * a64), (lds_u32*)(sa + i * 4096), 16, 0, 0);
#pragma unroll
            for (int i = 0; i < 4; ++i) __builtin_amdgcn_global_load_lds((const unsigned*)(bp + i * b64), (lds_u32*)(sa + 8192 + i * 4096), 16, 0, 0);
        }
        const unsigned char* sa = smem + cur * 24576; const unsigned char* sb = sa + 8192;
#pragma unroll
        for (int kk = 0; kk < 2; ++kk) {
            bf16x8 a[2], b[4];
            const int ch = ((kk * 2 + hh) ^ ((r >> 2) & 3)) * 16;
#pragma unroll
            for (int mi = 0; mi < 2; ++mi) a[mi] = *(const bf16x8*)(sa + (wr * 64 + mi * 32 + r) * 64 + ch);
#pragma unroll
            for (int ni = 0; ni < 4; ++ni) b[ni] = *(const bf16x8*)(sb + (wc * 128 + ni * 32 + r) * 64 + ch);
#pragma unroll
            for (int mi = 0; mi < 2; ++mi)
#pragma unroll
                for (int ni = 0; ni < 4; ++ni) acc[mi][ni] = mfma32(b[ni], a[mi], acc[mi][ni]);
        }
        cur = cur == 2 ? 0 : cur + 1;
    }
}
constexpr int CT3_LD = 264;
__device__ __forceinline__ void ct_write3(u16* Ct, const f32x16 (&v)[2][4], const int wr, const int wc, const int lane) {
    const int r = lane & 31, hh = lane >> 5;
#pragma unroll
    for (int mi = 0; mi < 2; ++mi)
#pragma unroll
        for (int ni = 0; ni < 4; ++ni) {
            u16* base = Ct + (wr * 64 + mi * 32 + r) * CT3_LD + wc * 128 + ni * 32 + 4 * hh;
#pragma unroll
            for (int g = 0; g < 4; ++g) {
                u32x2 w; w.x = pk2(v[mi][ni][4 * g], v[mi][ni][4 * g + 1]); w.y = pk2(v[mi][ni][4 * g + 2], v[mi][ni][4 * g + 3]);
                *(u32x2*)(base + 8 * g) = w;
            }
        }
}
__device__ __forceinline__ bool sched_tile(const int i, const int ntm, const int ntn, const int W, int& mt, int& nt) {
    const int nx = gridDim.x >> 3;
    const int o = ((blockIdx.x & 7) + 8 * i) * nx + (blockIdx.x >> 3);
    if (o >= ntm * ntn) return false;
    const int full = ntn / W, fo = full * W * ntm;
    if (o < fo) { const int G = o / (W * ntm), rem = o - G * (W * ntm); mt = rem / W; nt = G * W + (rem - mt * W); }
    else { const int W2 = ntn - full * W, rem = o - fo; mt = rem / W2; nt = full * W + (rem - mt * W2); }
    return true;
}
__device__ __forceinline__ void conv_item(const float* W, const int ldw, const int k0, const int nreal0, u16* WT, const int K, const int nvirt0, float* T, const int tid) {
    const int kr = tid >> 4, c4 = tid & 15;
#pragma unroll
    for (int ps = 0; ps < 4; ++ps) {
        const int k = ps * 16 + kr;
        const f32x4 v = *(const f32x4*)(W + (size_t)(k0 + k) * ldw + nreal0 + c4 * 4);
        T[k * 65 + c4 * 4 + 0] = v.x; T[k * 65 + c4 * 4 + 1] = v.y; T[k * 65 + c4 * 4 + 2] = v.z; T[k * 65 + c4 * 4 + 3] = v.w;
    }
    __syncthreads();
    const int n = tid >> 2, kq = tid & 3;
    u32x4 o0, o1;
    const float* t = T + (kq * 16) * 65 + n;
    o0.x = pk2(t[0 * 65], t[1 * 65]); o0.y = pk2(t[2 * 65], t[3 * 65]); o0.z = pk2(t[4 * 65], t[5 * 65]); o0.w = pk2(t[6 * 65], t[7 * 65]);
    o1.x = pk2(t[8 * 65], t[9 * 65]); o1.y = pk2(t[10 * 65], t[11 * 65]); o1.z = pk2(t[12 * 65], t[13 * 65]); o1.w = pk2(t[14 * 65], t[15 * 65]);
    u16* dst = WT + (size_t)(nvirt0 + n) * K + k0 + kq * 16;
    *(u32x4*)dst = o0; *(u32x4*)(dst + 8) = o1;
    __syncthreads();
}
#define ACC_COL(reg) (((reg) & 3) + 8 * ((reg) >> 2))
#define ACC_ROW(mi, reg) ((mi) * 32 + ((reg) & 3) + 8 * ((reg) >> 2))
constexpr int CT_LD = 136;
__device__ __forceinline__ void ct_write(u16* Ct, const f32x16 (&v)[2][2], const int wr, const int wc, const int lane) {
    const int r = lane & 31, hh = lane >> 5;
#pragma unroll
    for (int mi = 0; mi < 2; ++mi)
#pragma unroll
        for (int ni = 0; ni < 2; ++ni) {
            u16* base = Ct + (wr * 64 + mi * 32 + r) * CT_LD + wc * 64 + ni * 32 + 4 * hh;
#pragma unroll
            for (int g = 0; g < 4; ++g) {
                u32x2 w; w.x = pk2(v[mi][ni][4 * g], v[mi][ni][4 * g + 1]); w.y = pk2(v[mi][ni][4 * g + 2], v[mi][ni][4 * g + 3]);
                *(u32x2*)(base + 8 * g) = w;
            }
        }
}
__device__ __forceinline__ void ct_store(const u16* Ct, u16* dst, const size_t ldd, const int tid) {
#pragma unroll
    for (int i = 0; i < 8; ++i) {
        const int idx = tid + i * 256, row = idx >> 4, ch = idx & 15;
        *(u32x4*)(dst + (size_t)row * ldd + ch * 8) = *(const u32x4*)(Ct + row * CT_LD + ch * 8);
    }
}

__device__ __forceinline__ void phase_ada(const Params& p, unsigned char* smem) {
    const int tid = opaque_tid();
    float* red = (float*)smem;
    float* mp = (float*)(p.ws + OFF_MODP);
    for (int it = blockIdx.x; it < 192; it += gridDim.x) {
        const int cb = it % 24, ks = it / 24, cq = tid & 63, kq = tid >> 6;
        float a0[4] = {0, 0, 0, 0}, a1[4] = {0, 0, 0, 0}, a2[4] = {0, 0, 0, 0};
        for (int kk = 0; kk < 32; ++kk) {
            const int k = ks * 128 + kq * 32 + kk;
            const f32x4 w = *(const f32x4*)(p.w_ada + (size_t)k * 6144 + cb * 256 + cq * 4);
            float c0 = p.c[k], c1 = p.c[1024 + k], c2 = p.c_ctx[k];
            c0 *= sigmoid_(c0); c1 *= sigmoid_(c1); c2 *= sigmoid_(c2);
#pragma unroll
            for (int j = 0; j < 4; ++j) { a0[j] += c0 * w[j]; a1[j] += c1 * w[j]; a2[j] += c2 * w[j]; }
        }
#pragma unroll
        for (int j = 0; j < 4; ++j) { red[(kq * 3 + 0) * 256 + cq * 4 + j] = a0[j]; red[(kq * 3 + 1) * 256 + cq * 4 + j] = a1[j]; red[(kq * 3 + 2) * 256 + cq * 4 + j] = a2[j]; }
        __syncthreads();
#pragma unroll
        for (int v = 0; v < 3; ++v) {
            const float s = (red[(0 * 3 + v) * 256 + tid] + red[(1 * 3 + v) * 256 + tid]) + (red[(2 * 3 + v) * 256 + tid] + red[(3 * 3 + v) * 256 + tid]);
            mp[(ks * 3 + v) * 6144 + cb * 256 + tid] = s;
        }
        __syncthreads();
    }
    for (int it = blockIdx.x; it < 2400; it += gridDim.x) {
        if (it < 1696) {
            const int nb = it >> 4, kb = it & 15, nv = nb * 64;
            const int nr = nv < 3072 ? nv : (nv < 6656 ? nv + 16 : 3072 + (nv - 6656));
            conv_item(p.w_in, INC, kb * 64, nr, (u16*)(p.ws + OFF_WINT), 1024, nv, red, tid);
        } else if (it < 1952) { const int q = it - 1696; conv_item(p.w_br_m, 1024, (q & 15) * 64, (q >> 4) * 64, (u16*)(p.ws + OFF_BRMT), 1024, (q >> 4) * 64, red, tid); }
        else if (it < 2080) { const int q = it - 1952; conv_item(p.w_br_na, 1024, (q & 7) * 64, (q >> 3) * 64, (u16*)(p.ws + OFF_BRNT), 512, (q >> 3) * 64, red, tid); }
        else if (it < 2336) { const int q = it - 2080; conv_item(p.w_out, 1024, (q & 15) * 64, (q >> 4) * 64, (u16*)(p.ws + OFF_OUTT), 1024, (q >> 4) * 64, red, tid); }
        else { const int q = it - 2336; conv_item(p.w_router, 256, (q & 15) * 64, (q >> 4) * 64, (u16*)(p.ws + OFF_RTT), 1024, (q >> 4) * 64, red, tid); }
    }
}

__device__ __forceinline__ void phase_norm(const Params& p, unsigned char* smem, const bool second) {
    const int tid = opaque_tid(), lane = tid & 63, wid = tid >> 6;
    float* tsh = (float*)smem; float* tsc = tsh + 1024;
    u16* H = (u16*)(p.ws + OFF_H);
    const int nrows = second ? NTOK : MTOT;
    const int rpb = (nrows + gridDim.x - 1) / gridDim.x;
    const int r0 = blockIdx.x * rpb, r1 = min(r0 + rpb, nrows);
    const int sh_off = second ? 3072 : 0, sc_off = second ? 4096 : 1024;
    for (int vec = 0; vec < 3; ++vec) {
        const int vlo = vec == 0 ? 0 : (vec == 1 ? TSEQ : NTOK), vhi = vec == 0 ? TSEQ : (vec == 1 ? NTOK : MTOT);
        const int lo = max(r0, vlo), hi = min(r1, vhi);
        if (lo >= hi) continue;
        for (int j = tid; j < 1024; j += 256) { tsh[j] = mod_val(p, vec, sh_off + j); tsc[j] = 1.f + mod_val(p, vec, sc_off + j); }
        __syncthreads();
        for (int row = lo + wid; row < hi; row += 4) {
            const float* src = second ? (p.out + (size_t)row * 1024) : (row < NTOK ? p.x + (size_t)row * 1024 : p.ctx + (size_t)(row - NTOK) * 1024);
            f32x4 v[4]; float ss = 0.f;
#pragma unroll
            for (int j = 0; j < 4; ++j) { v[j] = *(const f32x4*)(src + j * 256 + lane * 4); ss += (v[j].x * v[j].x + v[j].y * v[j].y) + (v[j].z * v[j].z + v[j].w * v[j].w); }
            ss = wave_sum(ss);
            const float rstd = rsqrtf(ss * (1.f / 1024.f) + 1e-6f);
#pragma unroll
            for (int j = 0; j < 4; ++j) {
                const int k = j * 256 + lane * 4;
                const f32x4 sc = *(const f32x4*)(tsc + k), sh = *(const f32x4*)(tsh + k);
                u32x2 o; o.x = pk2(v[j].x * rstd * sc.x + sh.x, v[j].y * rstd * sc.y + sh.y); o.y = pk2(v[j].z * rstd * sc.z + sh.z, v[j].w * rstd * sc.w + sh.w);
                *(u32x2*)(H + (size_t)row * 1024 + k) = o;
            }
        }
        __syncthreads();
    }
}

__device__ __forceinline__ void phase_inproj(const Params& p, unsigned char* smem) {
    const u16* H = (const u16*)(p.ws + OFF_H);
    u16* P = (u16*)(p.ws + OFF_P); float* G = (float*)(p.ws + OFF_G);
    const int tid = opaque_tid(), lane = tid & 63, wid = tid >> 6, wr = wid >> 1, wc = wid & 1;
    const int r = lane & 31, hh = lane >> 5;
    const u16* WT = (const u16*)(p.ws + OFF_WINT);
    const int sw = ((tid & 7) ^ ((tid >> 3) & 7)) * 8;
    for (int ti = 0;; ++ti) {
        int mt, nt;
        if (!sched_tile(ti, 260, 53, 8, mt, nt)) break;
        f32x16 acc[2][2] = {};
        gemm_core2(acc, H + (size_t)(mt * 128 + (tid >> 3)) * 1024 + sw, 32 * 1024, WT + (size_t)(nt * 128 + (tid >> 3)) * 1024 + sw, 32 * 1024, 16, smem, tid, lane, wr, wc);
        if (nt < 8) {
            const float scale = nt < 4 ? 0.08838834764831845f : 1.f;
            const bool latent = mt < 256;
#pragma unroll
            for (int mi = 0; mi < 2; ++mi) {
                const int t = (mt * 128 + wr * 64 + mi * 32 + r) & (TSEQ - 1);
                const float posr = (float)(wc == 0 ? (t >> 6) : (t & 63)) * 0.15915494309189535f;
#pragma unroll
                for (int reg = 0; reg < 16; ++reg) {
                    float x1 = acc[mi][0][reg] * scale, x2 = acc[mi][1][reg] * scale;
                    if (latent) {
                        const float inv = exp2f(-(float)(ACC_COL(reg) + 4 * hh) * (13.287712379549449f / 32.f));
                        float sn, cs; sincos_rev(posr * inv, sn, cs);
                        float a = x1 * cs; asm volatile("" : "+v"(a), "+v"(x1), "+v"(x2));
                        float o1 = fmaf(-x2, sn, a); asm volatile("" : "+v"(o1), "+v"(x1), "+v"(x2));
                        float bq = x1 * sn; asm volatile("" : "+v"(bq), "+v"(x2));
                        float o2 = fmaf(x2, cs, bq); asm volatile("" : "+v"(o2));
                        x1 = o1; x2 = o2;
                    }
                    acc[mi][0][reg] = x1; acc[mi][1][reg] = x2;
                }
            }
        } else if (nt >= 24 && nt < 32) {
            const float* nw = nt < 28 ? p.na_qn_w : p.na_kn_w;
            const float sc = nt < 28 ? 0.125f : 1.f;
#pragma unroll
            for (int mi = 0; mi < 2; ++mi) {
                float s = 0.f;
#pragma unroll
                for (int ni = 0; ni < 2; ++ni)
#pragma unroll
                    for (int reg = 0; reg < 16; ++reg) s += acc[mi][ni][reg] * acc[mi][ni][reg];
                s += __shfl_xor(s, 32);
                const float rstd = rsqrtf(s * (1.f / 64.f) + 1e-6f) * sc;
#pragma unroll
                for (int ni = 0; ni < 2; ++ni)
#pragma unroll
                    for (int reg = 0; reg < 16; ++reg) acc[mi][ni][reg] *= rstd * nw[ni * 32 + ACC_COL(reg) + 4 * hh];
            }
        } else if (nt >= 36 && nt < 52) {
#pragma unroll
            for (int mi = 0; mi < 2; ++mi)
#pragma unroll
                for (int ni = 0; ni < 2; ++ni)
#pragma unroll
                    for (int reg = 0; reg < 16; ++reg) acc[mi][ni][reg] = sigmoid_(acc[mi][ni][reg]);
        }
        if (nt == 52) {
            if (wc == 0) {
                const f32x4 b0 = *(const f32x4*)(p.b_mgate + 4 * hh), b1 = *(const f32x4*)(p.b_mgate + 8 + 4 * hh);
#pragma unroll
                for (int mi = 0; mi < 2; ++mi) {
                    float* g = G + (size_t)(mt * 128 + wr * 64 + mi * 32 + r) * 16 + 4 * hh;
                    f32x4 o0, o1;
                    o0.x = acc[mi][0][0] + b0.x; o0.y = acc[mi][0][1] + b0.y; o0.z = acc[mi][0][2] + b0.z; o0.w = acc[mi][0][3] + b0.w;
                    o1.x = acc[mi][0][4] + b1.x; o1.y = acc[mi][0][5] + b1.y; o1.z = acc[mi][0][6] + b1.z; o1.w = acc[mi][0][7] + b1.w;
                    *(f32x4*)g = o0; *(f32x4*)(g + 8) = o1;
                }
            }
        } else {
            u16* Ct = (u16*)smem;
            __syncthreads();
            ct_write(Ct, acc, wr, wc, lane);
            __syncthreads();
            ct_store(Ct, P + (size_t)(mt * 128) * PV + nt * 128, PV, tid);
        }
        __syncthreads();
    }
}

__device__ __forceinline__ void mlstm_passA(const Params& p, unsigned char* smem, const int it) {
    const int tid = opaque_tid(), lane = tid & 63, wid = tid >> 6;
    const int c = it % 260, bh = it / 260, b = bh >> 2, h = bh & 3;
    const int base = c < 4 ? NTOK + b * 256 + c * 64 : b * TSEQ + (c - 4) * 64;
    const u16* P = (const u16*)(p.ws + OFF_P); const float* G = (const float*)(p.ws + OFF_G);
    float* gsum = (float*)(p.ws + OFF_GS); float* mloc = (float*)(p.ws + OFF_ML); float* dn = (float*)(p.ws + OFF_DN);
    u16* CT = (u16*)(p.ws + OFF_CT);
    u16* KTf = (u16*)smem; u16* KTb = (u16*)(smem + 18432); u16* VT = (u16*)(smem + 36864);
    float* wf = (float*)(smem + 73728); float* wb = wf + 64;
    const int slot_f = bh * 2 * 260 + c, slot_b = slot_f + 260;
    if (wid == 0) {
        const float* g = G + (size_t)(base + lane) * 16;
        const float igf = g[h], ff = g[4 + h], igb = g[8 + h], fb = g[12 + h];
        const float lff = log_sigmoid_(ff), lfb = log_sigmoid_(fb);
        const float bfc = wave_incl_sum(lff, lane), gf = __shfl(bfc, 63);
        const float uf = igf - bfc, umf = wave_max(uf);
        wf[lane] = __expf(uf - umf);
        const float pb = wave_incl_sum(lfb, lane), gb = __shfl(pb, 63);
        const float bb = gb - pb + lfb, ub = igb - bb, umb = wave_max(ub);
        wb[lane] = __expf(ub - umb);
        if (lane == 0) { gsum[slot_f] = gf; mloc[slot_f] = gf + umf; gsum[slot_b] = gb; mloc[slot_b] = gb + umb; }
    }
    __syncthreads();
    const int cgp = tid >> 3, tg = tid & 7;
    {
        const u16* src = P + (size_t)(base + tg * 8) * PV + V_MK + h * 128 + cgp * 4;
        u32x2 kv[8];
#pragma unroll
        for (int i = 0; i < 8; ++i) kv[i] = *(const u32x2*)(src + (size_t)i * PV);
        float wfi[8], wbi[8];
#pragma unroll
        for (int i = 0; i < 8; ++i) { wfi[i] = wf[tg * 8 + i]; wbi[i] = wb[tg * 8 + i]; }
#pragma unroll
        for (int cc = 0; cc < 4; ++cc) {
            float e[8];
#pragma unroll
            for (int i = 0; i < 8; ++i) e[i] = bfsel(kv[i], cc);
            u32x4 of, ob;
            of.x = pk2(e[0] * wfi[0], e[1] * wfi[1]); of.y = pk2(e[2] * wfi[2], e[3] * wfi[3]); of.z = pk2(e[4] * wfi[4], e[5] * wfi[5]); of.w = pk2(e[6] * wfi[6], e[7] * wfi[7]);
            ob.x = pk2(e[0] * wbi[0], e[1] * wbi[1]); ob.y = pk2(e[2] * wbi[2], e[3] * wbi[3]); ob.z = pk2(e[4] * wbi[4], e[5] * wbi[5]); ob.w = pk2(e[6] * wbi[6], e[7] * wbi[7]);
            *(u32x4*)(KTf + (cgp * 4 + cc) * LDT + tg * 8) = of;
            *(u32x4*)(KTb + (cgp * 4 + cc) * LDT + tg * 8) = ob;
        }
    }
#pragma unroll
    for (int vp = 0; vp < 2; ++vp) {
        const u16* src = P + (size_t)(base + tg * 8) * PV + V_MV + h * 256 + vp * 128 + cgp * 4;
        u32x2 vv[8];
#pragma unroll
        for (int i = 0; i < 8; ++i) vv[i] = *(const u32x2*)(src + (size_t)i * PV);
#pragma unroll
        for (int cc = 0; cc < 4; ++cc) *(u32x4*)(VT + (vp * 128 + cgp * 4 + cc) * LDT + tg * 8) = tr8(vv, cc);
    }
    __syncthreads();
    if (tid < 128) {
        float sf = 0.f, sb = 0.f;
#pragma unroll
        for (int j = 0; j < 8; ++j) {
            const u32x4 a = *(const u32x4*)(KTf + tid * LDT + j * 8), bq = *(const u32x4*)(KTb + tid * LDT + j * 8);
            sf += (bf_lo(a.x) + bf_hi(a.x)) + (bf_lo(a.y) + bf_hi(a.y)) + (bf_lo(a.z) + bf_hi(a.z)) + (bf_lo(a.w) + bf_hi(a.w));
            sb += (bf_lo(bq.x) + bf_hi(bq.x)) + (bf_lo(bq.y) + bf_hi(bq.y)) + (bf_lo(bq.z) + bf_hi(bq.z)) + (bf_lo(bq.w) + bf_hi(bq.w));
        }
        dn[(size_t)slot_f * 128 + tid] = sf; dn[(size_t)slot_b * 128 + tid] = sb;
    }
    const int r = lane & 31, hh = lane >> 5;
#pragma unroll 1
    for (int dir = 0; dir < 2; ++dir) {
        const u16* Bt = dir ? KTb : KTf;
        u16* dst = CT + (size_t)(dir ? slot_b : slot_f) * 32768;
#pragma unroll 1
        for (int nh = 0; nh < 2; ++nh) {
            f32x16 acc[2][2] = {};
#pragma unroll
            for (int kk = 0; kk < 4; ++kk) {
                bf16x8 a[2], bq[2];
#pragma unroll
                for (int mi = 0; mi < 2; ++mi) a[mi] = *(const bf16x8*)(VT + (wid * 64 + mi * 32 + r) * LDT + kk * 16 + hh * 8);
#pragma unroll
                for (int ni = 0; ni < 2; ++ni) bq[ni] = *(const bf16x8*)(Bt + (nh * 64 + ni * 32 + r) * LDT + kk * 16 + hh * 8);
#pragma unroll
                for (int mi = 0; mi < 2; ++mi)
#pragma unroll
                    for (int ni = 0; ni < 2; ++ni) acc[mi][ni] = mfma32(bq[ni], a[mi], acc[mi][ni]);
            }
#pragma unroll
            for (int mi = 0; mi < 2; ++mi)
#pragma unroll
                for (int ni = 0; ni < 2; ++ni) {
                    u16* drow = dst + (wid * 64 + mi * 32 + r) * 128 + nh * 64 + ni * 32 + 4 * hh;
#pragma unroll
                    for (int g = 0; g < 4; ++g) {
                        u32x2 w; w.x = pk2(acc[mi][ni][4 * g], acc[mi][ni][4 * g + 1]); w.y = pk2(acc[mi][ni][4 * g + 2], acc[mi][ni][4 * g + 3]);
                        *(u32x2*)(drow + 8 * g) = w;
                    }
                }
        }
    }
    __syncthreads();
}

__device__ __forceinline__ void na_item(const Params& p, unsigned char* smem, const int it) {
    const int tid = opaque_tid(), lane = tid & 63, wid = tid >> 6;
    const int row = it & 255, h = (it >> 8) & 7, b = it >> 11;
    const u16* P = (const u16*)(p.ws + OFF_P);
    u16* YNA = (u16*)(p.ws + OFF_YNA);
    float* rpb_s = (float*)(smem + 36864);
    const int l15 = lane & 15, l4 = lane >> 4;
    const int qc = wid * 16 + l15;
    const size_t qtok = (size_t)b * TSEQ + row * 64 + qc;
    const u16* qsrc = P + qtok * PV + V_NQ + h * 64 + l4 * 8;
    const bf16x8 qa0 = *(const bf16x8*)qsrc, qa1 = *(const bf16x8*)(qsrc + 32);
    const int rs = min(max(row - 4, 0), 248);
    const int cs = min(max(qc - 8, 0), 48);
    for (int j = tid; j < 465; j += 256) rpb_s[j] = p.na_rpb[h * 465 + j];
    f32x4 O[4] = {};
    float mrun = -INFINITY, lrun = 0.f;
    u32x4 kreg[2]; u32x2 vreg[8];
    const int cgp = (tid >> 3) & 15, tg = tid & 7;
    {
        const int kbase = b * TSEQ + rs * 64;
#pragma unroll
        for (int i = 0; i < 2; ++i) { const int id = tid + i * 256; kreg[i] = *(const u32x4*)(P + (size_t)(kbase + (id >> 3)) * PV + V_NK + h * 64 + (id & 7) * 8); }
        const u16* src = P + (size_t)(kbase + tg * 8) * PV + V_NV + h * 64 + cgp * 4;
#pragma unroll
        for (int i = 0; i < 8; ++i) vreg[i] = *(const u32x2*)(src + (size_t)i * PV);
    }
    for (int blk = 0; blk < 12; ++blk) {
        u16* Ks = (u16*)(smem + (blk & 1) * 18432); u16* VTs = Ks + 4608;
#pragma unroll
        for (int i = 0; i < 2; ++i) { const int id = tid + i * 256; *(u32x4*)(Ks + (id >> 3) * LDT + (id & 7) * 8) = kreg[i]; }
        if (tid < 128) {
#pragma unroll
            for (int cc = 0; cc < 4; ++cc) *(u32x4*)(VTs + (cgp * 4 + cc) * LDT + tg * 8) = tr8(vreg, cc);
        }
        __syncthreads();
        if (blk + 1 < 12) {
            const int nb = blk + 1;
            const int kbase = nb < 8 ? b * TSEQ + (rs + nb) * 64 : NTOK + b * 256 + (nb - 8) * 64;
#pragma unroll
            for (int i = 0; i < 2; ++i) { const int id = tid + i * 256; kreg[i] = *(const u32x4*)(P + (size_t)(kbase + (id >> 3)) * PV + V_NK + h * 64 + (id & 7) * 8); }
            const u16* src = P + (size_t)(kbase + tg * 8) * PV + V_NV + h * 64 + cgp * 4;
#pragma unroll
            for (int i = 0; i < 8; ++i) vreg[i] = *(const u32x2*)(src + (size_t)i * PV);
        }
        f32x4 S[4] = {};
#pragma unroll
        for (int t = 0; t < 4; ++t) {
            const bf16x8 k0 = *(const bf16x8*)(Ks + (t * 16 + l15) * LDT + l4 * 8), k1 = *(const bf16x8*)(Ks + (t * 16 + l15) * LDT + 32 + l4 * 8);
            S[t] = mfma16(k0, qa0, S[t]); S[t] = mfma16(k1, qa1, S[t]);
        }
        if (blk < 8) {
            const float* rpb = rpb_s + (rs + blk - row + 7) * 31 + 15 - qc;
#pragma unroll
            for (int t = 0; t < 4; ++t)
#pragma unroll
                for (int reg = 0; reg < 4; ++reg) {
                    const int kc = t * 16 + l4 * 4 + reg;
                    const bool valid = kc >= cs && kc < cs + 16;
                    float bias = 0.f;
                    if (valid) bias = rpb[kc];
                    S[t][reg] = valid ? S[t][reg] + bias : -INFINITY;
                }
        }
        float mx = -INFINITY;
#pragma unroll
        for (int t = 0; t < 4; ++t) mx = fmaxf(mx, fmaxf(fmaxf(S[t][0], S[t][1]), fmaxf(S[t][2], S[t][3])));
        mx = fmaxf(mx, __shfl_xor(mx, 16)); mx = fmaxf(mx, __shfl_xor(mx, 32));
        const float mnew = fmaxf(mrun, mx);
        const float alpha = __expf(mrun - mnew);
        float ps = 0.f;
#pragma unroll
        for (int t = 0; t < 4; ++t)
#pragma unroll
            for (int reg = 0; reg < 4; ++reg) { const float pe = __expf(S[t][reg] - mnew); S[t][reg] = pe; ps += pe; }
        ps += __shfl_xor(ps, 16); ps += __shfl_xor(ps, 32);
        lrun = lrun * alpha + ps; mrun = mnew;
#pragma unroll
        for (int t = 0; t < 4; ++t) { O[t][0] *= alpha; O[t][1] *= alpha; O[t][2] *= alpha; O[t][3] *= alpha; }
#pragma unroll
        for (int s = 0; s < 2; ++s) {
            u32x4 pb; pb.x = pk2(S[2 * s][0], S[2 * s][1]); pb.y = pk2(S[2 * s][2], S[2 * s][3]); pb.z = pk2(S[2 * s + 1][0], S[2 * s + 1][1]); pb.w = pk2(S[2 * s + 1][2], S[2 * s + 1][3]);
            const bf16x8 pfrag = __builtin_bit_cast(bf16x8, pb);
#pragma unroll
            for (int t = 0; t < 4; ++t) {
                const u16* vrow = VTs + (t * 16 + l15) * LDT + s * 32 + l4 * 4;
                const u32x2 v0 = *(const u32x2*)vrow, v1 = *(const u32x2*)(vrow + 16);
                u32x4 va; va.x = v0.x; va.y = v0.y; va.z = v1.x; va.w = v1.y;
                O[t] = mfma16(__builtin_bit_cast(bf16x8, va), pfrag, O[t]);
            }
        }
    }
    {
        const float il = 1.f / lrun;
#pragma unroll
        for (int t = 0; t < 4; ++t) {
            u32x2 w; w.x = pk2(O[t][0] * il, O[t][1] * il); w.y = pk2(O[t][2] * il, O[t][3] * il);
            *(u32x2*)(YNA + qtok * 512 + h * 64 + t * 16 + l4 * 4) = w;
        }
    }
    __syncthreads();
}

__device__ __forceinline__ int scan_cidx(int i, int dir) { return dir == 0 ? i : (i < 4 ? 3 - i : 263 - i); }
__device__ __forceinline__ void phase_scan(const Params& p, unsigned char* smem) {
    const int tid = opaque_tid(), lane = tid & 63, wid = tid >> 6;
    float* al = (float*)smem; float* be = al + 260;
    const float* gsum = (const float*)(p.ws + OFF_GS); const float* mloc = (const float*)(p.ws + OFF_ML);
    float* mprev = (float*)(p.ws + OFF_MP); float* dn = (float*)(p.ws + OFF_DN);
    for (int it = blockIdx.x; it < 512; it += gridDim.x) {
        const int bhd = it >> 5, eb = it & 31, dir = bhd & 1, slot0 = bhd * 260;
        if (wid == 0) {
            float g[5], ml[5]; int cc[5];
            float a = 0.f, b = -INFINITY;
#pragma unroll
            for (int j = 0; j < 5; ++j) {
                const int i = lane * 5 + j; const bool ok = i < 260;
                cc[j] = ok ? scan_cidx(i, dir) : 0;
                g[j] = ok ? gsum[slot0 + cc[j]] : 0.f; ml[j] = ok ? mloc[slot0 + cc[j]] : -INFINITY;
                b = fmaxf(b + g[j], ml[j]); a += g[j];
            }
#pragma unroll
            for (int o = 1; o < 64; o <<= 1) {
                const float pa = __shfl_up(a, o), pb = __shfl_up(b, o);
                if (lane >= o) { b = fmaxf(pb + a, b); a = pa + a; }
            }
            float ea = __shfl_up(a, 1), eb2 = __shfl_up(b, 1);
            if (lane == 0) { ea = 0.f; eb2 = -INFINITY; }
            float m = fmaxf(0.f + ea, eb2);
#pragma unroll
            for (int j = 0; j < 5; ++j) {
                const int i = lane * 5 + j;
                if (i < 260) {
                    const float mn = fmaxf(g[j] + m, ml[j]);
                    al[i] = __expf(g[j] + m - mn); be[i] = __expf(ml[j] - mn);
                    if (eb == 0) mprev[slot0 + cc[j]] = m;
                    m = mn;
                }
            }
        }
        __syncthreads();
        u32x2* basep = (u32x2*)(p.ws + OFF_CT) + (size_t)slot0 * 8192 + eb * 256 + tid;
        float C0 = 0.f, C1 = 0.f, C2 = 0.f, C3 = 0.f;
        for (int i = 0; i < 260; i += 13) {
            u32x2 v[13];
#pragma unroll
            for (int j = 0; j < 13; ++j) v[j] = basep[(size_t)scan_cidx(i + j, dir) * 8192];
#pragma unroll
            for (int j = 0; j < 13; ++j) {
                u32x2 o; o.x = pk2(C0, C1); o.y = pk2(C2, C3);
                basep[(size_t)scan_cidx(i + j, dir) * 8192] = o;
                const float a = al[i + j], bt = be[i + j];
                C0 = fmaf(a, C0, bt * bf_lo(v[j].x)); C1 = fmaf(a, C1, bt * bf_hi(v[j].x)); C2 = fmaf(a, C2, bt * bf_lo(v[j].y)); C3 = fmaf(a, C3, bt * bf_hi(v[j].y));
            }
        }
        if (eb == 0 && tid < 128) {
            float n = 0.f;
            for (int i = 0; i < 260; ++i) {
                float* q = dn + (size_t)(slot0 + scan_cidx(i, dir)) * 128 + tid;
                const float v = *q; *q = n; n = al[i] * n + be[i] * v;
            }
        }
        __syncthreads();
    }
}

__device__ __forceinline__ void mlstm_passC(const Params& p, unsigned char* smem, const int it) {
    const int tid = opaque_tid(), lane = tid & 63, wid = tid >> 6;
    const int cl = it & 255, bh = it >> 8, b = bh >> 2, h = bh & 3, c = cl + 4;
    const int base = b * TSEQ + cl * 64;
    const int slot_f = bh * 2 * 260 + c, slot_b = slot_f + 260;
    const u16* P = (const u16*)(p.ws + OFF_P); const float* G = (const float*)(p.ws + OFF_G);
    const float* mprev = (const float*)(p.ws + OFF_MP); const float* dn = (const float*)(p.ws + OFF_DN);
    const u16* CT = (const u16*)(p.ws + OFF_CT);
    u16* YM = (u16*)(p.ws + OFF_YM);
    u16* Ks = (u16*)smem;
    u16* CTf = (u16*)smem; u16* CTb = (u16*)(smem + 17408);
    u16* VTs = (u16*)(smem + 34816);
    u16* Spf = (u16*)(smem + 44032); u16* Spb = (u16*)(smem + 53248);
    float* ga = (float*)(smem + 62464);
    float *uf_s = ga, *Mf_s = ga + 64, *ub_s = ga + 128, *Mb_s = ga + 192, *clf = ga + 256, *clb = ga + 320, *wif = ga + 384, *wib = ga + 448;
    const int l15 = lane & 15, l4 = lane >> 4;
    if (wid == 0) {
        const float* g = G + (size_t)(base + lane) * 16;
        const float igf = g[h], ff = g[4 + h], igb = g[8 + h], fb = g[12 + h];
        const float lff = log_sigmoid_(ff), lfb = log_sigmoid_(fb);
        const float bfc = wave_incl_sum(lff, lane);
        const float uf = igf - bfc;
        const float pb = wave_incl_sum(lfb, lane), gb = __shfl(pb, 63);
        const float bb = gb - pb + lfb, ub = igb - bb;
        const float mpf = mprev[slot_f], mpb = mprev[slot_b];
        const float Mf = fmaxf(mpf, wave_prefix_max(uf, lane)), Mb = fmaxf(mpb, wave_suffix_max(ub, lane));
        uf_s[lane] = uf; Mf_s[lane] = Mf; clf[lane] = __expf(-(bfc + Mf)); wif[lane] = __expf(mpf - Mf);
        ub_s[lane] = ub; Mb_s[lane] = Mb; clb[lane] = __expf(-(bb + Mb)); wib[lane] = __expf(mpb - Mb);
    }
    bf16x8 qa[4];
    {
        const u16* qsrc = P + (size_t)(base + wid * 16 + l15) * PV + V_MQ + h * 128 + l4 * 8;
#pragma unroll
        for (int kk = 0; kk < 4; ++kk) qa[kk] = *(const bf16x8*)(qsrc + kk * 32);
    }
#pragma unroll
    for (int i = 0; i < 4; ++i) {
        const int id = tid + i * 256, kr = id >> 4, ch = id & 15;
        *(u32x4*)(Ks + kr * LDQ + ch * 8) = *(const u32x4*)(P + (size_t)(base + kr) * PV + V_MK + h * 128 + ch * 8);
    }
    __syncthreads();
    f32x4 S[4] = {};
#pragma unroll
    for (int nt = 0; nt < 4; ++nt)
#pragma unroll
        for (int kk = 0; kk < 4; ++kk) {
            const bf16x8 bq = *(const bf16x8*)(Ks + (nt * 16 + l15) * LDQ + kk * 32 + l4 * 8);
            S[nt] = mfma16(qa[kk], bq, S[nt]);
        }
    float qnf = 0.f, qnb = 0.f;
    {
        const float* nf = dn + (size_t)slot_f * 128; const float* nb = dn + (size_t)slot_b * 128;
#pragma unroll
        for (int kk = 0; kk < 4; ++kk)
#pragma unroll
            for (int j = 0; j < 8; ++j) {
                const int d = kk * 32 + l4 * 8 + j;
                const float qv = bf2f((u16)qa[kk][j]);
                qnf += qv * nf[d]; qnb += qv * nb[d];
            }
        qnf += __shfl_xor(qnf, 16); qnf += __shfl_xor(qnf, 32);
        qnb += __shfl_xor(qnb, 16); qnb += __shfl_xor(qnb, 32);
    }
    float denf[4], denb[4], cpf[4], cpb[4];
#pragma unroll
    for (int reg = 0; reg < 4; ++reg) {
        const int t = wid * 16 + l4 * 4 + reg;
        const float Mft = Mf_s[t], Mbt = Mb_s[t];
        float rsf = 0.f, rsb = 0.f;
#pragma unroll
        for (int nt = 0; nt < 4; ++nt) {
            const int s = nt * 16 + l15;
            const float sv = S[nt][reg];
            const float pf = (s <= t) ? sv * __expf(uf_s[s] - Mft) : 0.f;
            const float pbv = (s >= t) ? sv * __expf(ub_s[s] - Mbt) : 0.f;
            rsf += pf; rsb += pbv;
            Spf[t * LDT + s] = f2bf(pf); Spb[t * LDT + s] = f2bf(pbv);
        }
        rsf += __shfl_xor(rsf, 1); rsf += __shfl_xor(rsf, 2); rsf += __shfl_xor(rsf, 4); rsf += __shfl_xor(rsf, 8);
        rsb += __shfl_xor(rsb, 1); rsb += __shfl_xor(rsb, 2); rsb += __shfl_xor(rsb, 4); rsb += __shfl_xor(rsb, 8);
        const float qf = __shfl(qnf, l4 * 4 + reg), qb = __shfl(qnb, l4 * 4 + reg);
        denf[reg] = rsf + wif[t] * qf; denb[reg] = rsb + wib[t] * qb;
        cpf[reg] = clf[t]; cpb[reg] = clb[t];
    }
    bf16x8 qwf[4], qwb[4];
    {
        const float wfr = wif[wid * 16 + l15], wbr = wib[wid * 16 + l15];
#pragma unroll
        for (int kk = 0; kk < 4; ++kk) {
            u32x4 of, ob;
            const float q0 = bf2f((u16)qa[kk][0]), q1 = bf2f((u16)qa[kk][1]), q2 = bf2f((u16)qa[kk][2]), q3 = bf2f((u16)qa[kk][3]);
            const float q4 = bf2f((u16)qa[kk][4]), q5 = bf2f((u16)qa[kk][5]), q6 = bf2f((u16)qa[kk][6]), q7 = bf2f((u16)qa[kk][7]);
            of.x = pk2(q0 * wfr, q1 * wfr); of.y = pk2(q2 * wfr, q3 * wfr); of.z = pk2(q4 * wfr, q5 * wfr); of.w = pk2(q6 * wfr, q7 * wfr);
            ob.x = pk2(q0 * wbr, q1 * wbr); ob.y = pk2(q2 * wbr, q3 * wbr); ob.z = pk2(q4 * wbr, q5 * wbr); ob.w = pk2(q6 * wbr, q7 * wbr);
            qwf[kk] = __builtin_bit_cast(bf16x8, of); qwb[kk] = __builtin_bit_cast(bf16x8, ob);
        }
    }
    __syncthreads();
    float ssq[4] = {0.f, 0.f, 0.f, 0.f};
#pragma unroll 1
    for (int vb = 0; vb < 4; ++vb) {
        if (tid < 128) {
            const int cgp = tid >> 3, tg = tid & 7;
            const u16* src = P + (size_t)(base + tg * 8) * PV + V_MV + h * 256 + vb * 64 + cgp * 4;
            u32x2 vv[8];
#pragma unroll
            for (int i = 0; i < 8; ++i) vv[i] = *(const u32x2*)(src + (size_t)i * PV);
#pragma unroll
            for (int cc = 0; cc < 4; ++cc) *(u32x4*)(VTs + (cgp * 4 + cc) * LDT + tg * 8) = tr8(vv, cc);
        }
#pragma unroll
        for (int i = 0; i < 4; ++i) {
            const int id = tid + i * 256, vr = id >> 4, ch = id & 15;
            *(u32x4*)(CTf + vr * LDQ + ch * 8) = *(const u32x4*)(CT + (size_t)slot_f * 32768 + (vb * 64 + vr) * 128 + ch * 8);
            *(u32x4*)(CTb + vr * LDQ + ch * 8) = *(const u32x4*)(CT + (size_t)slot_b * 32768 + (vb * 64 + vr) * 128 + ch * 8);
        }
        __syncthreads();
        f32x4 af[4] = {}, ab[4] = {};
#pragma unroll
        for (int kk = 0; kk < 2; ++kk) {
            const bf16x8 a_f = *(const bf16x8*)(Spf + (wid * 16 + l15) * LDT + kk * 32 + l4 * 8);
            const bf16x8 a_b = *(const bf16x8*)(Spb + (wid * 16 + l15) * LDT + kk * 32 + l4 * 8);
#pragma unroll
            for (int nt = 0; nt < 4; ++nt) {
                const bf16x8 bv = *(const bf16x8*)(VTs + (nt * 16 + l15) * LDT + kk * 32 + l4 * 8);
                af[nt] = mfma16(a_f, bv, af[nt]); ab[nt] = mfma16(a_b, bv, ab[nt]);
            }
        }
#pragma unroll
        for (int kk = 0; kk < 4; ++kk)
#pragma unroll
            for (int nt = 0; nt < 4; ++nt) {
                const bf16x8 cf = *(const bf16x8*)(CTf + (nt * 16 + l15) * LDQ + kk * 32 + l4 * 8);
                const bf16x8 cb = *(const bf16x8*)(CTb + (nt * 16 + l15) * LDQ + kk * 32 + l4 * 8);
                af[nt] = mfma16(qwf[kk], cf, af[nt]); ab[nt] = mfma16(qwb[kk], cb, ab[nt]);
            }
#pragma unroll
        for (int reg = 0; reg < 4; ++reg) {
            const size_t tok = (size_t)base + wid * 16 + l4 * 4 + reg;
            const float idf = 1.f / fmaxf(fabsf(denf[reg]), cpf[reg]), idb = 1.f / fmaxf(fabsf(denb[reg]), cpb[reg]);
#pragma unroll
            for (int nt = 0; nt < 4; ++nt) {
                const float hv = af[nt][reg] * idf + ab[nt][reg] * idb;
                ssq[reg] += hv * hv;
                const int v = h * 256 + vb * 64 + nt * 16 + l15;
                const float o = bf2f(P[tok * PV + V_MO + v]);
                YM[tok * 1024 + v] = f2bf(hv * p.m_norm_w[v] * sigmoid_(o));
            }
        }
        __syncthreads();
    }
    float rstd[4];
#pragma unroll
    for (int reg = 0; reg < 4; ++reg) {
        float ss = ssq[reg];
        ss += __shfl_xor(ss, 1); ss += __shfl_xor(ss, 2); ss += __shfl_xor(ss, 4); ss += __shfl_xor(ss, 8);
        rstd[reg] = rsqrtf(ss * (1.f / 256.f) + 1e-6f);
    }
#pragma unroll 1
    for (int vb = 0; vb < 4; ++vb) {
#pragma unroll
        for (int reg = 0; reg < 4; ++reg) {
            const size_t tok = (size_t)base + wid * 16 + l4 * 4 + reg;
#pragma unroll
            for (int nt = 0; nt < 4; ++nt) {
                u16* q = YM + tok * 1024 + h * 256 + vb * 64 + nt * 16 + l15;
                *q = f2bf(bf2f(*q) * rstd[reg]);
            }
        }
    }
}

__device__ __forceinline__ void phase_merge(const Params& p, unsigned char* smem, const bool second) {
    const u16* P = (const u16*)(p.ws + OFF_P);
    const u16* YM = (const u16*)(p.ws + OFF_YM); const u16* YNA = (const u16*)(p.ws + OFF_YNA);
    u16* MRG = (u16*)(p.ws + OFF_MRG);
    const int tid = opaque_tid(), lane = tid & 63, wid = tid >> 6, wr = wid >> 1, wc = wid & 1;
    const u16* abase = second ? YNA : YM; const int lda = second ? 512 : 1024;
    const u16* wt = (const u16*)(p.ws + (second ? OFF_BRNT : OFF_BRMT));
    const int gcol = second ? V_GN : V_GM;
    const int sw = ((tid & 3) ^ ((tid >> 4) & 3)) * 8;
    for (int ti = 0;; ++ti) {
        int mt, nt;
        if (!sched_tile(ti, 256, 4, 4, mt, nt)) break;
        f32x16 acc[2][4] = {};
        gemm_core3(acc, abase + (size_t)(mt * 128 + (tid >> 2)) * lda + sw, (size_t)64 * lda, wt + (size_t)(nt * 256 + (tid >> 2)) * lda + sw, (size_t)64 * lda, second ? 16 : 32, smem, tid, lane, wr, wc);
        u16* Ct = (u16*)smem;
        RAW_BARRIER();
        ct_write3(Ct, acc, wr, wc, lane);
        __syncthreads();
#pragma unroll 4
        for (int i = 0; i < 16; ++i) {
            const int idx = tid + i * 256, row = idx >> 5, ch = idx & 31;
            const size_t m = (size_t)mt * 128 + row;
            const u32x4 cv = *(const u32x4*)(Ct + row * CT3_LD + ch * 8);
            const u32x4 gv = *(const u32x4*)(P + m * PV + gcol + nt * 256 + ch * 8);
            u16* q = MRG + m * 1024 + nt * 256 + ch * 8;
            float o[8];
            o[0] = bf_lo(cv.x) * bf_lo(gv.x); o[1] = bf_hi(cv.x) * bf_hi(gv.x); o[2] = bf_lo(cv.y) * bf_lo(gv.y); o[3] = bf_hi(cv.y) * bf_hi(gv.y);
            o[4] = bf_lo(cv.z) * bf_lo(gv.z); o[5] = bf_hi(cv.z) * bf_hi(gv.z); o[6] = bf_lo(cv.w) * bf_lo(gv.w); o[7] = bf_hi(cv.w) * bf_hi(gv.w);
            if (second) {
                const u32x4 pv = *(const u32x4*)q;
                o[0] += bf_lo(pv.x); o[1] += bf_hi(pv.x); o[2] += bf_lo(pv.y); o[3] += bf_hi(pv.y); o[4] += bf_lo(pv.z); o[5] += bf_hi(pv.z); o[6] += bf_lo(pv.w); o[7] += bf_hi(pv.w);
            }
            u32x4 w; w.x = pk2(o[0], o[1]); w.y = pk2(o[2], o[3]); w.z = pk2(o[4], o[5]); w.w = pk2(o[6], o[7]);
            *(u32x4*)q = w;
        }
        __syncthreads();
    }
}

__device__ __forceinline__ void phase_outproj(const Params& p, unsigned char* smem) {
    const u16* MRG = (const u16*)(p.ws + OFF_MRG);
    const int tid = opaque_tid(), lane = tid & 63, wid = tid >> 6, wr = wid >> 1, wc = wid & 1;
    const u16* wt = (const u16*)(p.ws + OFF_OUTT);
    const int sw = ((tid & 3) ^ ((tid >> 4) & 3)) * 8;
    for (int ti = 0;; ++ti) {
        int mt, nt;
        if (!sched_tile(ti, 256, 4, 4, mt, nt)) break;
        f32x16 acc[2][4] = {};
        gemm_core3(acc, MRG + (size_t)(mt * 128 + (tid >> 2)) * 1024 + sw, 64 * 1024, wt + (size_t)(nt * 256 + (tid >> 2)) * 1024 + sw, 64 * 1024, 32, smem, tid, lane, wr, wc);
        u16* Ct = (u16*)smem;
        RAW_BARRIER();
        ct_write3(Ct, acc, wr, wc, lane);
        __syncthreads();
        {
            const int bvec = mt >> 7, ch = tid & 31;
            float g1[8];
#pragma unroll
            for (int j = 0; j < 8; ++j) g1[j] = mod_val(p, bvec, 2048 + nt * 256 + ch * 8 + j);
#pragma unroll 4
            for (int i = 0; i < 16; ++i) {
                const int row = (tid >> 5) + i * 8;
                const size_t off = ((size_t)mt * 128 + row) * 1024 + nt * 256 + ch * 8;
                const u32x4 cv = *(const u32x4*)(Ct + row * CT3_LD + ch * 8);
                const f32x4 x0 = *(const f32x4*)(p.x + off), x1 = *(const f32x4*)(p.x + off + 4);
                f32x4 o0, o1;
                o0.x = x0.x + g1[0] * bf_lo(cv.x); o0.y = x0.y + g1[1] * bf_hi(cv.x); o0.z = x0.z + g1[2] * bf_lo(cv.y); o0.w = x0.w + g1[3] * bf_hi(cv.y);
                o1.x = x1.x + g1[4] * bf_lo(cv.z); o1.y = x1.y + g1[5] * bf_hi(cv.z); o1.z = x1.z + g1[6] * bf_lo(cv.w); o1.w = x1.w + g1[7] * bf_hi(cv.w);
                *(f32x4*)(p.out + off) = o0; *(f32x4*)(p.out + off + 4) = o1;
            }
        }
        __syncthreads();
    }
}

__device__ __forceinline__ void phase_router(const Params& p, unsigned char* smem) {
    const u16* H = (const u16*)(p.ws + OFF_H);
    float* SC = (float*)(p.ws + OFF_SC);
    const int tid = opaque_tid(), lane = tid & 63, wid = tid >> 6, wr = wid >> 1, wc = wid & 1;
    const int r = lane & 31, hh = lane >> 5;
    const u16* wt = (const u16*)(p.ws + OFF_RTT);
    const int sw = ((tid & 7) ^ ((tid >> 3) & 7)) * 8;
    for (int ti = 0;; ++ti) {
        int mt, nt;
        if (!sched_tile(ti, 256, 2, 2, mt, nt)) break;
        f32x16 acc[2][2] = {};
        gemm_core2(acc, H + (size_t)(mt * 128 + (tid >> 3)) * 1024 + sw, 32 * 1024, wt + (size_t)(nt * 128 + (tid >> 3)) * 1024 + sw, 32 * 1024, 16, smem, tid, lane, wr, wc);
#pragma unroll
        for (int mi = 0; mi < 2; ++mi)
#pragma unroll
            for (int ni = 0; ni < 2; ++ni) {
                float* srow = SC + ((size_t)mt * 128 + wr * 64 + mi * 32 + r) * 256 + nt * 128 + wc * 64 + ni * 32 + 4 * hh;
#pragma unroll
                for (int g = 0; g < 4; ++g) {
                    f32x4 o; o.x = sigmoid_(acc[mi][ni][4 * g]); o.y = sigmoid_(acc[mi][ni][4 * g + 1]); o.z = sigmoid_(acc[mi][ni][4 * g + 2]); o.w = sigmoid_(acc[mi][ni][4 * g + 3]);
                    *(f32x4*)(srow + 8 * g) = o;
                }
            }
        __syncthreads();
    }
}

__device__ __forceinline__ void phase_route(const Params& p, unsigned char* smem) {
    const int tid = opaque_tid(), lane = tid & 63, wid = tid >> 6;
    const float* SC = (const float*)(p.ws + OFF_SC);
    int* tope = (int*)(p.ws + OFF_TOPE); float* topw = (float*)(p.ws + OFF_TOPW);
    int* lh = (int*)smem;
    lh[tid] = 0;
    __syncthreads();
    const f32x4 rb = *(const f32x4*)(p.router_bias + lane * 4);
    for (int tok = blockIdx.x * 4 + wid; tok < NTOK; tok += gridDim.x * 4) {
        const f32x4 sc = *(const f32x4*)(SC + (size_t)tok * 256 + lane * 4);
        float s0 = sc.x + rb.x, s1 = sc.y + rb.y, s2 = sc.z + rb.z, s3 = sc.w + rb.w;
        float a1 = fmaxf(s0, s1), a2 = fminf(s0, s1);
        { const float b1 = fmaxf(s2, s3), b2 = fminf(s2, s3); const float n1 = fmaxf(a1, b1), n2 = fmaxf(fminf(a1, b1), fmaxf(a2, b2)); a1 = n1; a2 = n2; }
#pragma unroll
        for (int o = 1; o < 8; o <<= 1) {
            const float b1 = __shfl_xor(a1, o), b2 = __shfl_xor(a2, o);
            const float n1 = fmaxf(a1, b1), n2 = fmaxf(fminf(a1, b1), fmaxf(a2, b2)); a1 = n1; a2 = n2;
        }
        const float gs = a1 + a2; const int mygrp = lane >> 3;
        int gcnt = 0;
#pragma unroll
        for (int g = 0; g < 8; ++g) { const float og = __shfl(gs, g * 8); gcnt += (og > gs || (og == gs && g < mygrp)) ? 1 : 0; }
        if (gcnt >= 4) { s0 = -INFINITY; s1 = -INFINITY; s2 = -INFINITY; s3 = -INFINITY; }
        int my_e = 0; float my_s = 0.f, wsum = 0.f;
#pragma unroll
        for (int k = 0; k < 8; ++k) {
            float bv = s0; int bi = lane * 4;
            if (s1 > bv) { bv = s1; bi = lane * 4 + 1; }
            if (s2 > bv) { bv = s2; bi = lane * 4 + 2; }
            if (s3 > bv) { bv = s3; bi = lane * 4 + 3; }
#pragma unroll
            for (int o = 1; o < 64; o <<= 1) {
                const float ov = __shfl_xor(bv, o); const int oi = __shfl_xor(bi, o);
                if (ov > bv || (ov == bv && oi < bi)) { bv = ov; bi = oi; }
            }
            const int own = bi >> 2, sub = bi & 3;
            const float mine = sub == 0 ? sc.x : sub == 1 ? sc.y : sub == 2 ? sc.z : sc.w;
            const float sel_sc = __shfl(mine, own);
            if (lane == own) { if (sub == 0) s0 = -INFINITY; else if (sub == 1) s1 = -INFINITY; else if (sub == 2) s2 = -INFINITY; else s3 = -INFINITY; }
            wsum += sel_sc;
            if (lane == k) { my_e = bi; my_s = sel_sc; }
        }
        if (lane < 8) {
            atomicAdd(lh + my_e, 1);
            tope[tok * 8 + lane] = my_e; topw[tok * 8 + lane] = my_s / wsum * 2.5f;
        }
    }
    __syncthreads();
    ((int*)(p.ws + OFF_HIST))[blockIdx.x * 256 + tid] = lh[tid];
}
__device__ __forceinline__ void phase_assign(const Params& p, unsigned char* smem) {
    const int tid = opaque_tid(), lane = tid & 63, wid = tid >> 6;
    int* offs = (int*)smem; int* lc = offs + 256;
    const int* hist = (const int*)(p.ws + OFF_HIST);
    int* slot_tok = (int*)(p.ws + OFF_SLOT);
    const int* tope = (const int*)(p.ws + OFF_TOPE); int* rnk = (int*)(p.ws + OFF_RANK);
    {
        int run = 0, mine = 0;
        const int nb = gridDim.x, me = blockIdx.x;
        for (int b0 = 0; b0 < nb; b0 += 8) {
            int v[8];
#pragma unroll
            for (int j = 0; j < 8; ++j) v[j] = (b0 + j < nb) ? hist[(b0 + j) * 256 + tid] : 0;
#pragma unroll
            for (int j = 0; j < 8; ++j) { if (b0 + j == me) mine = run; run += v[j]; }
        }
        offs[tid] = mine; lc[tid] = 0;
        if (me == 0) ((int*)(p.ws + OFF_CNT))[tid] = run;
    }
    __syncthreads();
    for (int tok = blockIdx.x * 4 + wid; tok < NTOK; tok += gridDim.x * 4) {
        if (lane < 8) {
            const int e = tope[tok * 8 + lane];
            const int rk = offs[e] + atomicAdd(lc + e, 1);
            rnk[tok * 8 + lane] = rk; slot_tok[(size_t)e * NTOK + rk] = tok;
        }
    }
}

__device__ __forceinline__ int* build_tile_table(const Params& p, unsigned char* smem) {
    int* tstart = (int*)(smem + 73728); int* cn = tstart + 260; int* pstart = cn + 256;
    const int tid = opaque_tid();
    cn[tid] = ((const int*)(p.ws + OFF_CNT))[tid];
    __syncthreads();
    if (tid == 0) {
        int s = 0, q = 0;
        for (int e = 0; e < 256; ++e) { const int t = (cn[e] + 127) >> 7; tstart[e] = s; pstart[e] = q; s += t; q += (t + 1) >> 1; }
        tstart[256] = s; pstart[256] = q;
    }
    __syncthreads();
    return tstart;
}
__device__ __forceinline__ int find_pair_expert(const int* pstart, int mp) {
    int lo = 0, hi = 256;
    while (hi - lo > 1) { const int mid = (lo + hi) >> 1; if (pstart[mid] <= mp) lo = mid; else hi = mid; }
    return lo;
}

__device__ __forceinline__ void gemm_core_m256(f32x16 (&acc)[4][2], const u16* abase, const int (&roff)[8], const float* bsrc, const size_t ldb, const int nk,
                                               unsigned char* smem, const int tid, const int lane, const int wr, const int wc) {
    typedef __attribute__((address_space(3))) unsigned lds_u32;
    u16* Bs = (u16*)(smem + 32768);
    f32x4 br[8];
#pragma unroll
    for (int i = 0; i < 8; ++i) br[i] = *(const f32x4*)(bsrc + (size_t)i * ldb);
    const int arow = tid >> 3, ach = tid & 7;
    const int r = lane & 31, hh = lane >> 5;
    for (int kt = 0; kt < nk; ++kt) {
        __syncthreads();
        {
            unsigned char* sa = smem + tid * 16;
#pragma unroll
            for (int i = 0; i < 8; ++i) __builtin_amdgcn_global_load_lds((const unsigned*)(abase + roff[i] + kt * 64), (lds_u32*)(sa + i * 4096), 16, 0, 0);
        }
#pragma unroll
        for (int cc = 0; cc < 4; ++cc) {
            u32x4 w; w.x = pk2(br[0][cc], br[1][cc]); w.y = pk2(br[2][cc], br[3][cc]); w.z = pk2(br[4][cc], br[5][cc]); w.w = pk2(br[6][cc], br[7][cc]);
            *(u32x4*)(Bs + (arow * 4 + cc) * LDT + ach * 8) = w;
        }
        __syncthreads();
        if (kt + 1 < nk) {
            const float* bp = bsrc + (size_t)(kt + 1) * 64 * ldb;
#pragma unroll
            for (int i = 0; i < 8; ++i) br[i] = *(const f32x4*)(bp + (size_t)i * ldb);
        }
#pragma unroll 1
        for (int kk = 0; kk < 4; ++kk) {
            bf16x8 a[4], b[2];
            const int ch = ((kk * 2 + hh) ^ (r & 7)) * 16;
#pragma unroll
            for (int mi = 0; mi < 4; ++mi) a[mi] = *(const bf16x8*)(smem + (wr * 128 + mi * 32 + r) * 128 + ch);
#pragma unroll
            for (int ni = 0; ni < 2; ++ni) b[ni] = *(const bf16x8*)(Bs + (wc * 64 + ni * 32 + r) * LDT + kk * 16 + hh * 8);
#pragma unroll
            for (int mi = 0; mi < 4; ++mi)
#pragma unroll
                for (int ni = 0; ni < 2; ++ni) acc[mi][ni] = mfma32(b[ni], a[mi], acc[mi][ni]);
        }
    }
    __syncthreads();
}

__device__ __forceinline__ void phase_moe1(const Params& p, unsigned char* smem) {
    const int* tstart = build_tile_table(p, smem); const int* cn = tstart + 260; const int* pstart = cn + 256;
    const u16* H2 = (const u16*)(p.ws + OFF_H);
    const int* slot_tok = (const int*)(p.ws + OFF_SLOT);
    u16* HID = (u16*)(p.ws + OFF_HID);
    const int tid = opaque_tid(), lane = tid & 63, wid = tid >> 6, wr = wid >> 1, wc = wid & 1;
    const int r = lane & 31, hh = lane >> 5;
    const int totalp = pstart[256];
    const int nitems = totalp * 4 + 512;
    const int sw = ((tid & 7) ^ ((tid >> 3) & 7)) * 8;
    for (int ii = 0;; ++ii) {
        const int it = ((blockIdx.x & 7) + 8 * ii) * (gridDim.x >> 3) + (blockIdx.x >> 3);
        if (it >= nitems) break;
        const bool shared = it >= totalp * 4;
        const int idx = shared ? it - totalp * 4 : it;
        const int mp = idx >> 2, nq = idx & 3;
        int e = 0, jp = 0, cnt_e = 0, vrows = 256;
        size_t hrow0;
        if (!shared) {
            e = find_pair_expert(pstart, mp); jp = mp - pstart[e]; cnt_e = cn[e];
            const int te = (cnt_e + 127) >> 7;
            vrows = (2 * jp + 1 < te) ? 256 : 128;
            hrow0 = (size_t)tstart[e] * 128 + jp * 256;
        } else hrow0 = (size_t)SH_BASE + mp * 256;
        int roff[8];
#pragma unroll
        for (int i = 0; i < 8; ++i) {
            const int ri = (tid >> 3) + 32 * i;
            int tok;
            if (shared) tok = mp * 256 + ri;
            else { const int pos = jp * 256 + ri; tok = pos < cnt_e ? slot_tok[(size_t)e * NTOK + pos] : 0; }
            roff[i] = tok * 1024 + sw;
        }
        const int R0 = (tid >> 3) * 4, bwc = R0 >> 6, bni = (R0 >> 5) & 1, bj = R0 & 31;
        const float* wsel = shared ? (bni ? p.w_sh_up : p.w_sh_gate) : ((bni ? p.w_exp_up : p.w_exp_gate) + (size_t)e * 1024 * 256);
        const float* bsrc = wsel + (size_t)((tid & 7) * 8) * 256 + nq * 64 + bwc * 32 + bj;
        f32x16 acc[4][2] = {};
        gemm_core_m256(acc, H2, roff, bsrc, 256, 16, smem, tid, lane, wr, wc);
        u16* Ct = (u16*)smem;
#pragma unroll
        for (int mi = 0; mi < 4; ++mi) {
            u16* base = Ct + (wr * 128 + mi * 32 + r) * LDT + wc * 32 + 4 * hh;
#pragma unroll
            for (int g = 0; g < 4; ++g) {
                float hv[4];
#pragma unroll
                for (int j = 0; j < 4; ++j) { const float gt = acc[mi][0][4 * g + j], u = acc[mi][1][4 * g + j]; hv[j] = gt * sigmoid_(gt) * u; }
                u32x2 w; w.x = pk2(hv[0], hv[1]); w.y = pk2(hv[2], hv[3]);
                *(u32x2*)(base + 8 * g) = w;
            }
        }
        __syncthreads();
#pragma unroll
        for (int i = 0; i < 8; ++i) {
            const int id2 = tid + i * 256, row = id2 >> 3, ch = id2 & 7;
            if (row < vrows) *(u32x4*)(HID + (hrow0 + row) * 256 + nq * 64 + ch * 8) = *(const u32x4*)(Ct + row * LDT + ch * 8);
        }
        __syncthreads();
    }
}

__device__ __forceinline__ void phase_moe2(const Params& p, unsigned char* smem) {
    const int* tstart = build_tile_table(p, smem); const int* cn = tstart + 260; const int* pstart = cn + 256;
    const u16* HID = (const u16*)(p.ws + OFF_HID);
    u16* Y = (u16*)(p.ws + OFF_Y);
    const int tid = opaque_tid(), lane = tid & 63, wid = tid >> 6, wr = wid >> 1, wc = wid & 1;
    const int r = lane & 31, hh = lane >> 5;
    const int totalp = pstart[256];
    const int nitems = totalp * 8 + 1024;
    const int sw = ((tid & 7) ^ ((tid >> 3) & 7)) * 8;
    for (int ii = 0;; ++ii) {
        const int it = ((blockIdx.x & 7) + 8 * ii) * (gridDim.x >> 3) + (blockIdx.x >> 3);
        if (it >= nitems) break;
        const bool shared = it >= totalp * 8;
        const int idx = shared ? it - totalp * 8 : it;
        const int mp = idx >> 3, nt = idx & 7;
        int e = 0, vrows = 256;
        size_t hrow0;
        if (!shared) {
            e = find_pair_expert(pstart, mp); const int jp = mp - pstart[e];
            const int te = (cn[e] + 127) >> 7;
            vrows = (2 * jp + 1 < te) ? 256 : 128;
            hrow0 = (size_t)tstart[e] * 128 + jp * 256;
        } else hrow0 = (size_t)SH_BASE + mp * 256;
        int roff[8];
#pragma unroll
        for (int i = 0; i < 8; ++i) {
            const int ri = (tid >> 3) + 32 * i;
            roff[i] = (int)(hrow0 + (ri < vrows ? ri : ri - 128)) * 256 + sw;
        }
        const float* wsel = shared ? p.w_sh_down : p.w_exp_down + (size_t)e * 256 * 1024;
        const float* bsrc = wsel + (size_t)((tid & 7) * 8) * 1024 + nt * 128 + (tid >> 3) * 4;
        f32x16 acc[4][2] = {};
        gemm_core_m256(acc, HID, roff, bsrc, 1024, 4, smem, tid, lane, wr, wc);
        u16* Ct = (u16*)smem;
#pragma unroll
        for (int mi = 0; mi < 4; ++mi)
#pragma unroll
            for (int ni = 0; ni < 2; ++ni) {
                u16* base = Ct + (wr * 128 + mi * 32 + r) * CT_LD + wc * 64 + ni * 32 + 4 * hh;
#pragma unroll
                for (int g = 0; g < 4; ++g) {
                    u32x2 w; w.x = pk2(acc[mi][ni][4 * g], acc[mi][ni][4 * g + 1]); w.y = pk2(acc[mi][ni][4 * g + 2], acc[mi][ni][4 * g + 3]);
                    *(u32x2*)(base + 8 * g) = w;
                }
            }
        __syncthreads();
#pragma unroll 4
        for (int i = 0; i < 16; ++i) {
            const int id2 = tid + i * 256, row = id2 >> 4, ch = id2 & 15;
            if (row < vrows) *(u32x4*)(Y + (hrow0 + row) * 1024 + nt * 128 + ch * 8) = *(const u32x4*)(Ct + row * CT_LD + ch * 8);
        }
        __syncthreads();
    }
}

__device__ __forceinline__ void phase_combine(const Params& p, unsigned char* smem) {
    const int* tstart = build_tile_table(p, smem);
    float* g2t = (float*)smem;
    const int tid = opaque_tid(), lane = tid & 63, wid = tid >> 6;
    for (int j = tid; j < 2048; j += 256) g2t[j] = mod_val(p, j >> 10, 5120 + (j & 1023));
    __syncthreads();
    const u16* Y = (const u16*)(p.ws + OFF_Y);
    const int* tope = (const int*)(p.ws + OFF_TOPE); const int* rnk = (const int*)(p.ws + OFF_RANK); const float* topw = (const float*)(p.ws + OFF_TOPW);
    for (int tok = blockIdx.x * 4 + wid; tok < NTOK; tok += gridDim.x * 4) {
        int myrow = 0; float myw = 0.f;
        if (lane < 8) { const int e = tope[tok * 8 + lane]; myrow = tstart[e] * 128 + rnk[tok * 8 + lane]; myw = topw[tok * 8 + lane]; }
        if (lane == 8) { myrow = SH_BASE + tok; myw = 1.f; }
        const float* g2 = g2t + (tok >> 14) * 1024;
        f32x4 a[4];
#pragma unroll
        for (int j = 0; j < 4; ++j) a[j] = (f32x4){0.f, 0.f, 0.f, 0.f};
#pragma unroll
        for (int k = 0; k < 9; ++k) {
            const int row = __shfl(myrow, k); const float w = __shfl(myw, k);
            const u16* yr = Y + (size_t)row * 1024 + lane * 4;
#pragma unroll
            for (int j = 0; j < 4; ++j) {
                const u32x2 v = *(const u32x2*)(yr + j * 256);
                a[j].x += w * bf_lo(v.x); a[j].y += w * bf_hi(v.x); a[j].z += w * bf_lo(v.y); a[j].w += w * bf_hi(v.y);
            }
        }
#pragma unroll
        for (int j = 0; j < 4; ++j) {
            const int col = j * 256 + lane * 4;
            float* op = p.out + (size_t)tok * 1024 + col;
            const f32x4 x1 = *(const f32x4*)op, g = *(const f32x4*)(g2 + col);
            f32x4 o; o.x = x1.x + g.x * a[j].x; o.y = x1.y + g.y * a[j].y; o.z = x1.z + g.z * a[j].z; o.w = x1.w + g.w * a[j].w;
            *(f32x4*)op = o;
        }
    }
}

__global__ void __launch_bounds__(256, 2) mega(Params p) {
    extern __shared__ __attribute__((aligned(16))) unsigned char smem[];
    cg::grid_group grid = cg::this_grid();
#define PHASE_BEGIN(k) if (p.ph_lo <= (k) && (k) < p.ph_hi) {
#define PHASE_END(k) if ((k) + 1 < p.ph_hi) grid.sync(); }
    PHASE_BEGIN(0) phase_ada(p, smem); if (DUP_PHASE == 0) { grid.sync(); phase_ada(p, smem); } PHASE_END(0)
    PHASE_BEGIN(1) phase_norm(p, smem, false); if (DUP_PHASE == 1) { grid.sync(); phase_norm(p, smem, false); } PHASE_END(1)
    PHASE_BEGIN(2) phase_inproj(p, smem); if (DUP_PHASE == 2) { grid.sync(); phase_inproj(p, smem); } PHASE_END(2)
    PHASE_BEGIN(3)
        for (int it = blockIdx.x; it < 2080 + 4096; it += gridDim.x) { if (it < 2080) mlstm_passA(p, smem, it); else na_item(p, smem, it - 2080); }
        if (DUP_PHASE == 3) { grid.sync(); for (int it = blockIdx.x; it < 2080; it += gridDim.x) mlstm_passA(p, smem, it); }
        if (DUP_PHASE == 30) { grid.sync(); for (int it = blockIdx.x; it < 4096; it += gridDim.x) na_item(p, smem, it); }
    PHASE_END(3)
    PHASE_BEGIN(4) phase_scan(p, smem); if (DUP_PHASE == 34) { grid.sync(); for (int it = blockIdx.x; it < 2080; it += gridDim.x) mlstm_passA(p, smem, it); grid.sync(); phase_scan(p, smem); } PHASE_END(4)
    PHASE_BEGIN(5) for (int it = blockIdx.x; it < 2048; it += gridDim.x) mlstm_passC(p, smem, it); if (DUP_PHASE == 5) { grid.sync(); for (int it = blockIdx.x; it < 2048; it += gridDim.x) mlstm_passC(p, smem, it); } PHASE_END(5)
    PHASE_BEGIN(6) phase_merge(p, smem, false); phase_merge(p, smem, true); if (DUP_PHASE == 6) { grid.sync(); phase_merge(p, smem, false); phase_merge(p, smem, true); } PHASE_END(6)
    PHASE_BEGIN(7) phase_outproj(p, smem); if (DUP_PHASE == 7) { grid.sync(); phase_outproj(p, smem); } PHASE_END(7)
    PHASE_BEGIN(8) phase_norm(p, smem, true); if (DUP_PHASE == 8) { grid.sync(); phase_norm(p, smem, true); } PHASE_END(8)
    PHASE_BEGIN(9) phase_router(p, smem); if (DUP_PHASE == 9) { grid.sync(); phase_router(p, smem); } PHASE_END(9)
    PHASE_BEGIN(10) phase_route(p, smem); PHASE_END(10)
    PHASE_BEGIN(11) phase_assign(p, smem); PHASE_END(11)
    PHASE_BEGIN(12) phase_moe1(p, smem); if (DUP_PHASE == 12) { grid.sync(); phase_moe1(p, smem); } PHASE_END(12)
    PHASE_BEGIN(13) phase_moe2(p, smem); if (DUP_PHASE == 13) { grid.sync(); phase_moe2(p, smem); } PHASE_END(13)
    PHASE_BEGIN(14) phase_combine(p, smem);
        if (DUP_PHASE == 100) { grid.sync(); phase_route(p, smem); grid.sync(); phase_assign(p, smem); }
    PHASE_END(14)
#if RUN_PHASES < 8
    if (!MULTI_LAUNCH) grid.sync();
    if (p.ph_lo == 100 || !MULTI_LAUNCH) {
        const size_t NOUT = (size_t)NTOK * 1024;
        for (size_t i = (size_t)blockIdx.x * 256 + threadIdx.x; i < NOUT; i += (size_t)gridDim.x * 256) {
            float s = 0.f;
#define TAPB(off, n) { const u16* bb_ = (const u16*)(p.ws + (off)); for (size_t j = i; j < (size_t)(n); j += NOUT) s += bf2f(bb_[j]); }
#define TAPF(off, n) { const float* bb_ = (const float*)(p.ws + (off)); for (size_t j = i; j < (size_t)(n); j += NOUT) s += bb_[j]; }
#if RUN_PHASES == 1
            TAPF(OFF_MODP, 8 * 3 * 6144)
#elif RUN_PHASES == 2
            TAPB(OFF_H, (size_t)MTOT * 1024)
#elif RUN_PHASES == 3
            { const u16* bb_ = (const u16*)(p.ws + OFF_P); for (size_t j = i; j < (size_t)MTOT * 1024; j += NOUT) s += bf2f(bb_[(j / 1024) * PV + TAPC0 + (j % 1024)]); }
#elif RUN_PHASES == 4
            TAPB(OFF_YNA, (size_t)NTOK * 512) TAPB(OFF_CT, (size_t)NSLOT * 32768) TAPF(OFF_DN, NSLOT * 128) TAPF(OFF_GS, NSLOT) TAPF(OFF_ML, NSLOT)
#elif RUN_PHASES == 5
            TAPB(OFF_CT, (size_t)NSLOT * 32768) TAPF(OFF_DN, NSLOT * 128) TAPF(OFF_MP, NSLOT)
#elif RUN_PHASES == 6
            TAPB(OFF_YM, (size_t)NTOK * 1024)
#elif RUN_PHASES == 7
            TAPB(OFF_MRG, (size_t)NTOK * 1024)
#endif
            p.out[i] = p.x[i] + s;
        }
    }
#endif
}

extern "C" void kernel_launch(void* const* d_in, const int* in_sizes, int n_in, void* d_out, int out_size, void* d_ws, size_t ws_size, hipStream_t stream) {
    static int grid_blocks = 0;
    if (!grid_blocks) {
        int dev = 0, cus = 0, per_cu = 0;
        (void)hipGetDevice(&dev);
        (void)hipDeviceGetAttribute(&cus, hipDeviceAttributeMultiprocessorCount, dev);
        (void)hipFuncSetAttribute((const void*)mega, hipFuncAttributeMaxDynamicSharedMemorySize, LDS_BYTES);
        (void)hipOccupancyMaxActiveBlocksPerMultiprocessor(&per_cu, mega, 256, LDS_BYTES);
        if (per_cu > 2) per_cu = 2;
        if (per_cu < 1) per_cu = 1;
        grid_blocks = cus * per_cu;
        if (ws_size < WS_END) fprintf(stderr, "kernel_launch: workspace too small: %zu < %zu\n", ws_size, (size_t)WS_END);
    }
    Params p{};
    const float** pp = (const float**)&p;
    for (int i = 0; i < 23; ++i) pp[i] = (const float*)d_in[i];
    p.out = (float*)d_out; p.ws = (unsigned char*)d_ws;
#if MULTI_LAUNCH
    for (int ph = 0; ph < (RUN_PHASES < 1 ? 1 : (RUN_PHASES < NPH ? RUN_PHASES : NPH)); ++ph) {
        p.ph_lo = ph; p.ph_hi = ph + 1;
        void* args[] = {&p};
        hipError_t e = hipLaunchCooperativeKernel((void*)mega, dim3(grid_blocks), dim3(256), args, LDS_BYTES, stream);
        if (e != hipSuccess) fprintf(stderr, "cooperative launch failed: %s (grid %d)\n", hipGetErrorString(e), grid_blocks);
    }
#if RUN_PHASES < 8
    { p.ph_lo = 100; p.ph_hi = 100; void* args[] = {&p};
      (void)hipLaunchCooperativeKernel((void*)mega, dim3(grid_blocks), dim3(256), args, LDS_BYTES, stream); }
#endif
#else
    p.ph_lo = 0; p.ph_hi = RUN_PHASES < NPH ? RUN_PHASES : NPH;
    void* args[] = {&p};
    hipError_t e = hipLaunchCooperativeKernel((void*)mega, dim3(grid_blocks), dim3(256), args, LDS_BYTES, stream);
    if (e != hipSuccess) fprintf(stderr, "cooperative launch failed: %s (grid %d)\n", hipGetErrorString(e), grid_blocks);
#endif
}
```

```cpp
#include <hip/hip_runtime.h>
#include <hip/hip_cooperative_groups.h>
#include <cstdio>
#include <cstdint>
namespace cg = cooperative_groups;

#ifndef MULTI_LAUNCH
#define MULTI_LAUNCH 0
#endif
#ifndef TAPC0
#define TAPC0 0
#endif
#ifndef DBG_ROPE
#define DBG_ROPE 1
#endif
#ifndef DUP_PHASE
#define DUP_PHASE -1
#endif
#ifndef RUN_PHASES
#define RUN_PHASES 15
#endif

typedef unsigned short u16;
typedef unsigned int u32;
typedef short bf16x8 __attribute__((ext_vector_type(8)));
typedef float f32x16 __attribute__((ext_vector_type(16)));
typedef float f32x4 __attribute__((ext_vector_type(4)));
typedef u32 u32x4 __attribute__((ext_vector_type(4)));
typedef u32 u32x2 __attribute__((ext_vector_type(2)));

constexpr int DM = 1024;
constexpr int NTOK = 32768;
constexpr int TSEQ = 16384;
constexpr int MTOT = 33280;
constexpr int INC = 6672;
constexpr int PV = 6784;
constexpr int V_MQ = 0, V_MK = 512, V_MV = 1024, V_MO = 2048, V_NQ = 3072, V_NK = 3584, V_NV = 4096, V_GM = 4608, V_GN = 5632;
constexpr int NSLOT = 4160;
constexpr int SH_BASE = 294912;
constexpr int NPH = 15;
constexpr int LDS_BYTES = 76 * 1024;
constexpr int LDT = 72;
constexpr int LDQ = 136;

constexpr size_t AL(size_t x) { return (x + 255) & ~(size_t)255; }
constexpr size_t OFF_MODP = 0;
constexpr size_t OFF_CNT  = AL(OFF_MODP + (size_t)8 * 3 * 6144 * 4);
constexpr size_t OFF_G    = AL(OFF_CNT + 1024);
constexpr size_t OFF_GS   = AL(OFF_G + (size_t)MTOT * 16 * 4);
constexpr size_t OFF_ML   = AL(OFF_GS + NSLOT * 4);
constexpr size_t OFF_MP   = AL(OFF_ML + NSLOT * 4);
constexpr size_t OFF_DN   = AL(OFF_MP + NSLOT * 4);
constexpr size_t OFF_TOPE = AL(OFF_DN + (size_t)NSLOT * 128 * 4);
constexpr size_t OFF_RANK = OFF_TOPE + (size_t)NTOK * 8 * 4;
constexpr size_t OFF_TOPW = OFF_RANK + (size_t)NTOK * 8 * 4;
constexpr size_t OFF_H    = AL(OFF_TOPW + (size_t)NTOK * 8 * 4);
constexpr size_t OFF_SLOT = AL(OFF_H + (size_t)MTOT * 1024 * 2);
constexpr size_t OFF_R4   = AL(OFF_SLOT + (size_t)256 * 32768 * 4);
constexpr size_t OFF_YNA  = OFF_R4;
constexpr size_t OFF_YM   = OFF_R4 + (size_t)NTOK * 512 * 2;
constexpr size_t OFF_MRG  = OFF_YM + (size_t)NTOK * 1024 * 2;
constexpr size_t OFF_SC   = OFF_R4;
constexpr size_t OFF_HID  = OFF_R4;
constexpr size_t OFF_P    = AL(OFF_R4 + (size_t)327680 * 256 * 2);
constexpr size_t OFF_CT   = AL(OFF_P + (size_t)MTOT * PV * 2);
constexpr size_t OFF_Y    = OFF_P;
constexpr size_t OFF_WINT = AL(OFF_CT + (size_t)NSLOT * 65536);
constexpr size_t OFF_BRMT = AL(OFF_WINT + (size_t)6912 * 1024 * 2);
constexpr size_t OFF_BRNT = AL(OFF_BRMT + (size_t)1024 * 1024 * 2);
constexpr size_t OFF_OUTT = AL(OFF_BRNT + (size_t)1024 * 512 * 2);
constexpr size_t OFF_RTT  = AL(OFF_OUTT + (size_t)1024 * 1024 * 2);
constexpr size_t OFF_HIST = AL(OFF_RTT + (size_t)256 * 1024 * 2);
constexpr size_t OFF_BAR  = AL(OFF_HIST + (size_t)1024 * 256 * 4);
constexpr size_t WS_END   = OFF_BAR + 16384;
static_assert(OFF_Y + (size_t)327680 * 1024 * 2 <= OFF_WINT, "Y must fit over P+CT");
static_assert(WS_END <= (size_t)1073741824, "workspace budget");

struct Params {
    const float *x, *c, *ctx, *c_ctx, *w_ada, *b_ada, *w_in, *b_mgate, *m_norm_w, *na_qn_w, *na_kn_w, *na_rpb,
                *w_br_m, *w_br_na, *w_out, *w_router, *router_bias, *w_exp_gate, *w_exp_up, *w_exp_down,
                *w_sh_gate, *w_sh_up, *w_sh_down;
    float* out;
    unsigned char* ws;
    int ph_lo, ph_hi;
};

typedef __bf16 bf16x2_t __attribute__((ext_vector_type(2)));
__device__ __forceinline__ u32 pk2(float lo, float hi) { bf16x2_t v = {(__bf16)lo, (__bf16)hi}; return __builtin_bit_cast(u32, v); }
__device__ __forceinline__ u16 f2bf(float f) { return (u16)(pk2(f, 0.f) & 0xffffu); }
__device__ __forceinline__ float bf2f(u16 h) { return __uint_as_float(((u32)h) << 16); }
__device__ __forceinline__ float bf_lo(u32 w) { return __uint_as_float(w << 16); }
__device__ __forceinline__ float bf_hi(u32 w) { return __uint_as_float(w & 0xffff0000u); }
__device__ __forceinline__ float sigmoid_(float x) { return 1.f / (1.f + __expf(-x)); }
__device__ __forceinline__ float log_sigmoid_(float x) { return fminf(x, 0.f) - __logf(1.f + __expf(-fabsf(x))); }
__device__ __forceinline__ f32x4 mfma16(bf16x8 a, bf16x8 b, f32x4 c) { return __builtin_amdgcn_mfma_f32_16x16x32_bf16(a, b, c, 0, 0, 0); }
__device__ __forceinline__ f32x16 mfma32(bf16x8 a, bf16x8 b, f32x16 c) { return __builtin_amdgcn_mfma_f32_32x32x16_bf16(a, b, c, 0, 0, 0); }

__device__ __forceinline__ void sincos_rev(float rev, float& sn, float& cs) {
    rev -= rintf(rev);
    const float kq = rintf(rev * 4.f);
    const float th = (rev - kq * 0.25f) * 6.283185307179586f;
    const float t2 = th * th;
    const float s = th * (1.f + t2 * (-1.f / 6.f + t2 * (1.f / 120.f + t2 * (-1.f / 5040.f + t2 * (1.f / 362880.f)))));
    const float c = 1.f + t2 * (-0.5f + t2 * (1.f / 24.f + t2 * (-1.f / 720.f + t2 * (1.f / 40320.f))));
    const int k = ((int)kq) & 3;
    sn = (k == 0) ? s : (k == 1) ? c : (k == 2) ? -s : -c;
    cs = (k == 0) ? c : (k == 1) ? -s : (k == 2) ? -c : s;
}
__device__ __forceinline__ int opaque_tid() { int t = threadIdx.x; asm volatile("" : "+v"(t)); return t; }
__device__ __forceinline__ float wave_sum(float v) {
#pragma unroll
    for (int o = 1; o < 64; o <<= 1) v += __shfl_xor(v, o);
    return v;
}
__device__ __forceinline__ float wave_max(float v) {
#pragma unroll
    for (int o = 1; o < 64; o <<= 1) v = fmaxf(v, __shfl_xor(v, o));
    return v;
}
__device__ __forceinline__ float wave_incl_sum(float v, int lane) {
#pragma unroll
    for (int o = 1; o < 64; o <<= 1) { float t = __shfl_up(v, o); if (lane >= o) v += t; }
    return v;
}
__device__ __forceinline__ float wave_prefix_max(float v, int lane) {
#pragma unroll
    for (int o = 1; o < 64; o <<= 1) { float t = __shfl_up(v, o); if (lane >= o) v = fmaxf(v, t); }
    return v;
}
__device__ __forceinline__ float wave_suffix_max(float v, int lane) {
#pragma unroll
    for (int o = 1; o < 64; o <<= 1) { float t = __shfl_down(v, o); if (lane + o < 64) v = fmaxf(v, t); }
    return v;
}
__device__ __forceinline__ float mod_val(const Params& p, int vec, int j) {
    const float* mp = (const float*)(p.ws + OFF_MODP);
    float s = p.b_ada[j];
#pragma unroll
    for (int ks = 0; ks < 8; ++ks) s += mp[(ks * 3 + vec) * 6144 + j];
    return s;
}
__device__ __forceinline__ u32x4 tr8(const u32x2 (&v)[8], int cc) {
    u32x4 o;
    if (cc == 0)      { o.x = (v[0].x & 0xffffu) | (v[1].x << 16); o.y = (v[2].x & 0xffffu) | (v[3].x << 16); o.z = (v[4].x & 0xffffu) | (v[5].x << 16); o.w = (v[6].x & 0xffffu) | (v[7].x << 16); }
    else if (cc == 1) { o.x = (v[0].x >> 16) | (v[1].x & 0xffff0000u); o.y = (v[2].x >> 16) | (v[3].x & 0xffff0000u); o.z = (v[4].x >> 16) | (v[5].x & 0xffff0000u); o.w = (v[6].x >> 16) | (v[7].x & 0xffff0000u); }
    else if (cc == 2) { o.x = (v[0].y & 0xffffu) | (v[1].y << 16); o.y = (v[2].y & 0xffffu) | (v[3].y << 16); o.z = (v[4].y & 0xffffu) | (v[5].y << 16); o.w = (v[6].y & 0xffffu) | (v[7].y << 16); }
    else              { o.x = (v[0].y >> 16) | (v[1].y & 0xffff0000u); o.y = (v[2].y >> 16) | (v[3].y & 0xffff0000u); o.z = (v[4].y >> 16) | (v[5].y & 0xffff0000u); o.w = (v[6].y >> 16) | (v[7].y & 0xffff0000u); }
    return o;
}
__device__ __forceinline__ float bfsel(const u32x2& v, int cc) { return cc == 0 ? bf_lo(v.x) : cc == 1 ? bf_hi(v.x) : cc == 2 ? bf_lo(v.y) : bf_hi(v.y); }

__device__ __forceinline__ void gemm_core2(f32x16 (&acc)[2][2], const u16* a0, const size_t a32, const u16* b0, const size_t b32, const int nk,
                                           unsigned char* smem, const int tid, const int lane, const int wr, const int wc) {
    typedef __attribute__((address_space(3))) unsigned lds_u32;
    const int r = lane & 31, hh = lane >> 5;
    {
        unsigned char* sa = smem + tid * 16;
#pragma unroll
        for (int i = 0; i < 4; ++i) {
            __builtin_amdgcn_global_load_lds((const unsigned*)(a0 + i * a32), (lds_u32*)(sa + i * 4096), 16, 0, 0);
            __builtin_amdgcn_global_load_lds((const unsigned*)(b0 + i * b32), (lds_u32*)(sa + 16384 + i * 4096), 16, 0, 0);
        }
    }
    for (int kt = 0; kt < nk; ++kt) {
        __syncthreads();
        if (kt + 1 < nk) {
            unsigned char* sa = smem + ((kt + 1) & 1) * 32768 + tid * 16;
            const u16* ap = a0 + (kt + 1) * 64; const u16* bp = b0 + (kt + 1) * 64;
#pragma unroll
            for (int i = 0; i < 4; ++i) {
                __builtin_amdgcn_global_load_lds((const unsigned*)(ap + i * a32), (lds_u32*)(sa + i * 4096), 16, 0, 0);
                __builtin_amdgcn_global_load_lds((const unsigned*)(bp + i * b32), (lds_u32*)(sa + 16384 + i * 4096), 16, 0, 0);
            }
        }
        const unsigned char* sa = smem + (kt & 1) * 32768; const unsigned char* sb = sa + 16384;
#pragma unroll
        for (int kk = 0; kk < 4; ++kk) {
            bf16x8 a[2], b[2];
            const int ch = ((kk * 2 + hh) ^ (r & 7)) * 16;
#pragma unroll
            for (int mi = 0; mi < 2; ++mi) a[mi] = *(const bf16x8*)(sa + (wr * 64 + mi * 32 + r) * 128 + ch);
#pragma unroll
            for (int ni = 0; ni < 2; ++ni) b[ni] = *(const bf16x8*)(sb + (wc * 64 + ni * 32 + r) * 128 + ch);
#pragma unroll
            for (int mi = 0; mi < 2; ++mi)
#pragma unroll
                for (int ni = 0; ni < 2; ++ni) acc[mi][ni] = mfma32(b[ni], a[mi], acc[mi][ni]);
        }
    }
}
#define RAW_BARRIER() do { asm volatile("s_waitcnt lgkmcnt(0)" ::: "memory"); __builtin_amdgcn_s_barrier(); } while (0)
__device__ __forceinline__ void gemm_core3(f32x16 (&acc)[2][4], const u16* a0, const size_t a64, const u16* b0, const size_t b64, const int nk,
                                           unsigned char* smem, const int tid, const int lane, const int wr, const int wc) {
    typedef __attribute__((address_space(3))) unsigned lds_u32;
    const int r = lane & 31, hh = lane >> 5;
#pragma unroll
    for (int s = 0; s < 2; ++s) {
        unsigned char* sa = smem + s * 24576 + tid * 16;
#pragma unroll
        for (int i = 0; i < 2; ++i) __builtin_amdgcn_global_load_lds((const unsigned*)(a0 + s * 32 + i * a64), (lds_u32*)(sa + i * 4096), 16, 0, 0);
#pragma unroll
        for (int i = 0; i < 4; ++i) __builtin_amdgcn_global_load_lds((const unsigned*)(b0 + s * 32 + i * b64), (lds_u32*)(sa + 8192 + i * 4096), 16, 0, 0);
    }
    int cur = 0;
    for (int kt = 0; kt < nk; ++kt) {
        if (kt + 1 < nk) asm volatile("s_waitcnt vmcnt(6)" ::: "memory"); else asm volatile("s_waitcnt vmcnt(0)" ::: "memory");
        RAW_BARRIER();
        if (kt + 2 < nk) {
            const int nx = cur == 0 ? 2 : cur - 1;
            unsigned char* sa = smem + nx * 24576 + tid * 16;
            const u16* ap = a0 + (kt + 2) * 32; const u16* bp = b0 + (kt + 2) * 32;
#pragma unroll
            for (int i = 0; i < 2; ++i) __builtin_amdgcn_global_load_lds((const unsigned*)(ap + i * a64), (lds_u32*)(sa + i * 4096), 16, 0, 0);
#pragma unroll
            for (int i = 0; i < 4; ++i) __builtin_amdgcn_global_load_lds((const unsigned*)(bp + i * b64), (lds_u32*)(sa + 8192 + i * 4096), 16, 0, 0);
        }
        const unsigned char* sa = smem + cur * 24576; const unsigned char* sb = sa + 8192;
#pragma unroll
        for (int kk = 0; kk < 2; ++kk) {
            bf16x8 a[2], b[4];
            const int ch = ((kk * 2 + hh) ^ ((r >> 2) & 3)) * 16;
#pragma unroll
            for (int mi = 0; mi < 2; ++mi) a[mi] = *(const bf16x8*)(sa + (wr * 64 + mi * 32 + r) * 64 + ch);
#pragma unroll
            for (int ni = 0; ni < 4; ++ni) b[ni] = *(const bf16x8*)(sb + (wc * 128 + ni * 32 + r) * 64 + ch);
#pragma unroll
            for (int mi = 0; mi < 2; ++mi)
#pragma unroll
                for (int ni = 0; ni < 4; ++ni) acc[mi][ni] = mfma32(b[ni], a[mi], acc[mi][ni]);
        }
        cur = cur == 2 ? 0 : cur + 1;
    }
}
constexpr int CT3_LD = 264;
__device__ __forceinline__ void ct_write3(u16* Ct, const f32x16 (&v)[2][4], const int wr, const int wc, const int lane) {
    const int r = lane & 31, hh = lane >> 5;
#pragma unroll
    for (int mi = 0; mi < 2; ++mi)
#pragma unroll
        for (int ni = 0; ni < 4; ++ni) {
            u16* base = Ct + (wr * 64 + mi * 32 + r) * CT3_LD + wc * 128 + ni * 32 + 4 * hh;
#pragma unroll
            for (int g = 0; g < 4; ++g) {
                u32x2 w; w.x = pk2(v[mi][ni][4 * g], v[mi][ni][4 * g + 1]); w.y = pk2(v[mi][ni][4 * g + 2], v[mi][ni][4 * g + 3]);
                *(u32x2*)(base + 8 * g) = w;
            }
        }
}
__device__ __forceinline__ bool sched_tile(const int i, const int ntm, const int ntn, const int W, int& mt, int& nt) {
    const int nx = gridDim.x >> 3;
    const int o = ((blockIdx.x & 7) + 8 * i) * nx + (blockIdx.x >> 3);
    if (o >= ntm * ntn) return false;
    const int full = ntn / W, fo = full * W * ntm;
    if (o < fo) { const int G = o / (W * ntm), rem = o - G * (W * ntm); mt = rem / W; nt = G * W + (rem - mt * W); }
    else { const int W2 = ntn - full * W, rem = o - fo; mt = rem / W2; nt = full * W + (rem - mt * W2); }
    return true;
}
__device__ __forceinline__ void conv_item(const float* W, const int ldw, const int k0, const int nreal0, u16* WT, const int K, const int nvirt0, float* T, const int tid) {
    const int kr = tid >> 4, c4 = tid & 15;
#pragma unroll
    for (int ps = 0; ps < 4; ++ps) {
        const int k = ps * 16 + kr;
        const f32x4 v = *(const f32x4*)(W + (size_t)(k0 + k) * ldw + nreal0 + c4 * 4);
        T[k * 65 + c4 * 4 + 0] = v.x; T[k * 65 + c4 * 4 + 1] = v.y; T[k * 65 + c4 * 4 + 2] = v.z; T[k * 65 + c4 * 4 + 3] = v.w;
    }
    __syncthreads();
    const int n = tid >> 2, kq = tid & 3;
    u32x4 o0, o1;
    const float* t = T + (kq * 16) * 65 + n;
    o0.x = pk2(t[0 * 65], t[1 * 65]); o0.y = pk2(t[2 * 65], t[3 * 65]); o0.z = pk2(t[4 * 65], t[5 * 65]); o0.w = pk2(t[6 * 65], t[7 * 65]);
    o1.x = pk2(t[8 * 65], t[9 * 65]); o1.y = pk2(t[10 * 65], t[11 * 65]); o1.z = pk2(t[12 * 65], t[13 * 65]); o1.w = pk2(t[14 * 65], t[15 * 65]);
    u16* dst = WT + (size_t)(nvirt0 + n) * K + k0 + kq * 16;
    *(u32x4*)dst = o0; *(u32x4*)(dst + 8) = o1;
    __syncthreads();
}
#define ACC_COL(reg) (((reg) & 3) + 8 * ((reg) >> 2))
#define ACC_ROW(mi, reg) ((mi) * 32 + ((reg) & 3) + 8 * ((reg) >> 2))
constexpr int CT_LD = 136;
__device__ __forceinline__ void ct_write(u16* Ct, const f32x16 (&v)[2][2], const int wr, const int wc, const int lane) {
    const int r = lane & 31, hh = lane >> 5;
#pragma unroll
    for (int mi = 0; mi < 2; ++mi)
#pragma unroll
        for (int ni = 0; ni < 2; ++ni) {
            u16* base = Ct + (wr * 64 + mi * 32 + r) * CT_LD + wc * 64 + ni * 32 + 4 * hh;
#pragma unroll
            for (int g = 0; g < 4; ++g) {
                u32x2 w; w.x = pk2(v[mi][ni][4 * g], v[mi][ni][4 * g + 1]); w.y = pk2(v[mi][ni][4 * g + 2], v[mi][ni][4 * g + 3]);
                *(u32x2*)(base + 8 * g) = w;
            }
        }
}
__device__ __forceinline__ void ct_store(const u16* Ct, u16* dst, const size_t ldd, const int tid) {
#pragma unroll
    for (int i = 0; i < 8; ++i) {
        const int idx = tid + i * 256, row = idx >> 4, ch = idx & 15;
        *(u32x4*)(dst + (size_t)row * ldd + ch * 8) = *(const u32x4*)(Ct + row * CT_LD + ch * 8);
    }
}

__device__ __forceinline__ void phase_ada(const Params& p, unsigned char* smem) {
    const int tid = opaque_tid();
    float* red = (float*)smem;
    float* mp = (float*)(p.ws + OFF_MODP);
    for (int it = blockIdx.x; it < 192; it += gridDim.x) {
        const int cb = it % 24, ks = it / 24, cq = tid & 63, kq = tid >> 6;
        float a0[4] = {0, 0, 0, 0}, a1[4] = {0, 0, 0, 0}, a2[4] = {0, 0, 0, 0};
        for (int kk = 0; kk < 32; ++kk) {
            const int k = ks * 128 + kq * 32 + kk;
            const f32x4 w = *(const f32x4*)(p.w_ada + (size_t)k * 6144 + cb * 256 + cq * 4);
            float c0 = p.c[k], c1 = p.c[1024 + k], c2 = p.c_ctx[k];
            c0 *= sigmoid_(c0); c1 *= sigmoid_(c1); c2 *= sigmoid_(c2);
#pragma unroll
            for (int j = 0; j < 4; ++j) { a0[j] += c0 * w[j]; a1[j] += c1 * w[j]; a2[j] += c2 * w[j]; }
        }
#pragma unroll
        for (int j = 0; j < 4; ++j) { red[(kq * 3 + 0) * 256 + cq * 4 + j] = a0[j]; red[(kq * 3 + 1) * 256 + cq * 4 + j] = a1[j]; red[(kq * 3 + 2) * 256 + cq * 4 + j] = a2[j]; }
        __syncthreads();
#pragma unroll
        for (int v = 0; v < 3; ++v) {
            const float s = (red[(0 * 3 + v) * 256 + tid] + red[(1 * 3 + v) * 256 + tid]) + (red[(2 * 3 + v) * 256 + tid] + red[(3 * 3 + v) * 256 + tid]);
            mp[(ks * 3 + v) * 6144 + cb * 256 + tid] = s;
        }
        __syncthreads();
    }
    for (int it = blockIdx.x; it < 2400; it += gridDim.x) {
        if (it < 1696) {
            const int nb = it >> 4, kb = it & 15, nv = nb * 64;
            const int nr = nv < 3072 ? nv : (nv < 6656 ? nv + 16 : 3072 + (nv - 6656));
            conv_item(p.w_in, INC, kb * 64, nr, (u16*)(p.ws + OFF_WINT), 1024, nv, red, tid);
        } else if (it < 1952) { const int q = it - 1696; conv_item(p.w_br_m, 1024, (q & 15) * 64, (q >> 4) * 64, (u16*)(p.ws + OFF_BRMT), 1024, (q >> 4) * 64, red, tid); }
        else if (it < 2080) { const int q = it - 1952; conv_item(p.w_br_na, 1024, (q & 7) * 64, (q >> 3) * 64, (u16*)(p.ws + OFF_BRNT), 512, (q >> 3) * 64, red, tid); }
        else if (it < 2336) { const int q = it - 2080; conv_item(p.w_out, 1024, (q & 15) * 64, (q >> 4) * 64, (u16*)(p.ws + OFF_OUTT), 1024, (q >> 4) * 64, red, tid); }
        else { const int q = it - 2336; conv_item(p.w_router, 256, (q & 15) * 64, (q >> 4) * 64, (u16*)(p.ws + OFF_RTT), 1024, (q >> 4) * 64, red, tid); }
    }
}

__device__ __forceinline__ void phase_norm(const Params& p, unsigned char* smem, const bool second) {
    const int tid = opaque_tid(), lane = tid & 63, wid = tid >> 6;
    float* tsh = (float*)smem; float* tsc = tsh + 1024;
    u16* H = (u16*)(p.ws + OFF_H);
    const int nrows = second ? NTOK : MTOT;
    const int rpb = (nrows + gridDim.x - 1) / gridDim.x;
    const int r0 = blockIdx.x * rpb, r1 = min(r0 + rpb, nrows);
    const int sh_off = second ? 3072 : 0, sc_off = second ? 4096 : 1024;
    for (int vec = 0; vec < 3; ++vec) {
        const int vlo = vec == 0 ? 0 : (vec == 1 ? TSEQ : NTOK), vhi = vec == 0 ? TSEQ : (vec == 1 ? NTOK : MTOT);
        const int lo = max(r0, vlo), hi = min(r1, vhi);
        if (lo >= hi) continue;
        for (int j = tid; j < 1024; j += 256) { tsh[j] = mod_val(p, vec, sh_off + j); tsc[j] = 1.f + mod_val(p, vec, sc_off + j); }
        __syncthreads();
        for (int row = lo + wid; row < hi; row += 4) {
            const float* src = second ? (p.out + (size_t)row * 1024) : (row < NTOK ? p.x + (size_t)row * 1024 : p.ctx + (size_t)(row - NTOK) * 1024);
            f32x4 v[4]; float ss = 0.f;
#pragma unroll
            for (int j = 0; j < 4; ++j) { v[j] = *(const f32x4*)(src + j * 256 + lane * 4); ss += (v[j].x * v[j].x + v[j].y * v[j].y) + (v[j].z * v[j].z + v[j].w * v[j].w); }
            ss = wave_sum(ss);
            const float rstd = rsqrtf(ss * (1.f / 1024.f) + 1e-6f);
#pragma unroll
            for (int j = 0; j < 4; ++j) {
                const int k = j * 256 + lane * 4;
                const f32x4 sc = *(const f32x4*)(tsc + k), sh = *(const f32x4*)(tsh + k);
                u32x2 o; o.x = pk2(v[j].x * rstd * sc.x + sh.x, v[j].y * rstd * sc.y + sh.y); o.y = pk2(v[j].z * rstd * sc.z + sh.z, v[j].w * rstd * sc.w + sh.w);
                *(u32x2*)(H + (size_t)row * 1024 + k) = o;
            }
        }
        __syncthreads();
    }
}

__device__ __forceinline__ void phase_inproj(const Params& p, unsigned char* smem) {
    const u16* H = (const u16*)(p.ws + OFF_H);
    u16* P = (u16*)(p.ws + OFF_P); float* G = (float*)(p.ws + OFF_G);
    const int tid = opaque_tid(), lane = tid & 63, wid = tid >> 6, wr = wid >> 1, wc = wid & 1;
    const int r = lane & 31, hh = lane >> 5;
    const u16* WT = (const u16*)(p.ws + OFF_WINT);
    const int sw = ((tid & 7) ^ ((tid >> 3) & 7)) * 8;
    for (int ti = 0;; ++ti) {
        int mt, nt;
        if (!sched_tile(ti, 260, 53, 8, mt, nt)) break;
        f32x16 acc[2][2] = {};
        gemm_core2(acc, H + (size_t)(mt * 128 + (tid >> 3)) * 1024 + sw, 32 * 1024, WT + (size_t)(nt * 128 + (tid >> 3)) * 1024 + sw, 32 * 1024, 16, smem, tid, lane, wr, wc);
        if (nt < 8) {
            const float scale = nt < 4 ? 0.08838834764831845f : 1.f;
            const bool latent = mt < 256;
#pragma unroll
            for (int mi = 0; mi < 2; ++mi) {
                const int t = (mt * 128 + wr * 64 + mi * 32 + r) & (TSEQ - 1);
                const float posr = (float)(wc == 0 ? (t >> 6) : (t & 63)) * 0.15915494309189535f;
#pragma unroll
                for (int reg = 0; reg < 16; ++reg) {
                    float x1 = acc[mi][0][reg] * scale, x2 = acc[mi][1][reg] * scale;
                    if (latent) {
                        const float inv = exp2f(-(float)(ACC_COL(reg) + 4 * hh) * (13.287712379549449f / 32.f));
                        float sn, cs; sincos_rev(posr * inv, sn, cs);
                        float a = x1 * cs; asm volatile("" : "+v"(a), "+v"(x1), "+v"(x2));
                        float o1 = fmaf(-x2, sn, a); asm volatile("" : "+v"(o1), "+v"(x1), "+v"(x2));
                        float bq = x1 * sn; asm volatile("" : "+v"(bq), "+v"(x2));
                        float o2 = fmaf(x2, cs, bq); asm volatile("" : "+v"(o2));
                        x1 = o1; x2 = o2;
                    }
                    acc[mi][0][reg] = x1; acc[mi][1][reg] = x2;
                }
            }
        } else if (nt >= 24 && nt < 32) {
            const float* nw = nt < 28 ? p.na_qn_w : p.na_kn_w;
            const float sc = nt < 28 ? 0.125f : 1.f;
#pragma unroll
            for (int mi = 0; mi < 2; ++mi) {
                float s = 0.f;
#pragma unroll
                for (int ni = 0; ni < 2; ++ni)
#pragma unroll
                    for (int reg = 0; reg < 16; ++reg) s += acc[mi][ni][reg] * acc[mi][ni][reg];
                s += __shfl_xor(s, 32);
                const float rstd = rsqrtf(s * (1.f / 64.f) + 1e-6f) * sc;
#pragma unroll
                for (int ni = 0; ni < 2; ++ni)
#pragma unroll
                    for (int reg = 0; reg < 16; ++reg) acc[mi][ni][reg] *= rstd * nw[ni * 32 + ACC_COL(reg) + 4 * hh];
            }
        } else if (nt >= 36 && nt < 52) {
#pragma unroll
            for (int mi = 0; mi < 2; ++mi)
#pragma unroll
                for (int ni = 0; ni < 2; ++ni)
#pragma unroll
                    for (int reg = 0; reg < 16; ++reg) acc[mi][ni][reg] = sigmoid_(acc[mi][ni][reg]);
        }
        if (nt == 52) {
            if (wc == 0) {
                const f32x4 b0 = *(const f32x4*)(p.b_mgate + 4 * hh), b1 = *(const f32x4*)(p.b_mgate + 8 + 4 * hh);
#pragma unroll
                for (int mi = 0; mi < 2; ++mi) {
                    float* g = G + (size_t)(mt * 128 + wr * 64 + mi * 32 + r) * 16 + 4 * hh;
                    f32x4 o0, o1;
                    o0.x = acc[mi][0][0] + b0.x; o0.y = acc[mi][0][1] + b0.y; o0.z = acc[mi][0][2] + b0.z; o0.w = acc[mi][0][3] + b0.w;
                    o1.x = acc[mi][0][4] + b1.x; o1.y = acc[mi][0][5] + b1.y; o1.z = acc[mi][0][6] + b1.z; o1.w = acc[mi][0][7] + b1.w;
                    *(f32x4*)g = o0; *(f32x4*)(g + 8) = o1;
                }
            }
        } else {
            u16* Ct = (u16*)smem;
            __syncthreads();
            ct_write(Ct, acc, wr, wc, lane);
            __syncthreads();
            ct_store(Ct, P + (size_t)(mt * 128) * PV + nt * 128, PV, tid);
        }
        __syncthreads();
    }
}

__device__ __forceinline__ void mlstm_passA(const Params& p, unsigned char* smem, const int it) {
    const int tid = opaque_tid(), lane = tid & 63, wid = tid >> 6;
    const int c = it % 260, bh = it / 260, b = bh >> 2, h = bh & 3;
    const int base = c < 4 ? NTOK + b * 256 + c * 64 : b * TSEQ + (c - 4) * 64;
    const u16* P = (const u16*)(p.ws + OFF_P); const float* G = (const float*)(p.ws + OFF_G);
    float* gsum = (float*)(p.ws + OFF_GS); float* mloc = (float*)(p.ws + OFF_ML); float* dn = (float*)(p.ws + OFF_DN);
    u16* CT = (u16*)(p.ws + OFF_CT);
    u16* KTf = (u16*)smem; u16* KTb = (u16*)(smem + 18432); u16* VT = (u16*)(smem + 36864);
    float* wf = (float*)(smem + 73728); float* wb = wf + 64;
    const int slot_f = bh * 2 * 260 + c, slot_b = slot_f + 260;
    if (wid == 0) {
        const float* g = G + (size_t)(base + lane) * 16;
        const float igf = g[h], ff = g[4 + h], igb = g[8 + h], fb = g[12 + h];
        const float lff = log_sigmoid_(ff), lfb = log_sigmoid_(fb);
        const float bfc = wave_incl_sum(lff, lane), gf = __shfl(bfc, 63);
        const float uf = igf - bfc, umf = wave_max(uf);
        wf[lane] = __expf(uf - umf);
        const float pb = wave_incl_sum(lfb, lane), gb = __shfl(pb, 63);
        const float bb = gb - pb + lfb, ub = igb - bb, umb = wave_max(ub);
        wb[lane] = __expf(ub - umb);
        if (lane == 0) { gsum[slot_f] = gf; mloc[slot_f] = gf + umf; gsum[slot_b] = gb; mloc[slot_b] = gb + umb; }
    }
    __syncthreads();
    const int cgp = tid >> 3, tg = tid & 7;
    {
        const u16* src = P + (size_t)(base + tg * 8) * PV + V_MK + h * 128 + cgp * 4;
        u32x2 kv[8];
#pragma unroll
        for (int i = 0; i < 8; ++i) kv[i] = *(const u32x2*)(src + (size_t)i * PV);
        float wfi[8], wbi[8];
#pragma unroll
        for (int i = 0; i < 8; ++i) { wfi[i] = wf[tg * 8 + i]; wbi[i] = wb[tg * 8 + i]; }
#pragma unroll
        for (int cc = 0; cc < 4; ++cc) {
            float e[8];
#pragma unroll
            for (int i = 0; i < 8; ++i) e[i] = bfsel(kv[i], cc);
            u32x4 of, ob;
            of.x = pk2(e[0] * wfi[0], e[1] * wfi[1]); of.y = pk2(e[2] * wfi[2], e[3] * wfi[3]); of.z = pk2(e[4] * wfi[4], e[5] * wfi[5]); of.w = pk2(e[6] * wfi[6], e[7] * wfi[7]);
            ob.x = pk2(e[0] * wbi[0], e[1] * wbi[1]); ob.y = pk2(e[2] * wbi[2], e[3] * wbi[3]); ob.z = pk2(e[4] * wbi[4], e[5] * wbi[5]); ob.w = pk2(e[6] * wbi[6], e[7] * wbi[7]);
            *(u32x4*)(KTf + (cgp * 4 + cc) * LDT + tg * 8) = of;
            *(u32x4*)(KTb + (cgp * 4 + cc) * LDT + tg * 8) = ob;
        }
    }
#pragma unroll
    for (int vp = 0; vp < 2; ++vp) {
        const u16* src = P + (size_t)(base + tg * 8) * PV + V_MV + h * 256 + vp * 128 + cgp * 4;
        u32x2 vv[8];
#pragma unroll
        for (int i = 0; i < 8; ++i) vv[i] = *(const u32x2*)(src + (size_t)i * PV);
#pragma unroll
        for (int cc = 0; cc < 4; ++cc) *(u32x4*)(VT + (vp * 128 + cgp * 4 + cc) * LDT + tg * 8) = tr8(vv, cc);
    }
    __syncthreads();
    if (tid < 128) {
        float sf = 0.f, sb = 0.f;
#pragma unroll
        for (int j = 0; j < 8; ++j) {
            const u32x4 a = *(const u32x4*)(KTf + tid * LDT + j * 8), bq = *(const u32x4*)(KTb + tid * LDT + j * 8);
            sf += (bf_lo(a.x) + bf_hi(a.x)) + (bf_lo(a.y) + bf_hi(a.y)) + (bf_lo(a.z) + bf_hi(a.z)) + (bf_lo(a.w) + bf_hi(a.w));
            sb += (bf_lo(bq.x) + bf_hi(bq.x)) + (bf_lo(bq.y) + bf_hi(bq.y)) + (bf_lo(bq.z) + bf_hi(bq.z)) + (bf_lo(bq.w) + bf_hi(bq.w));
        }
        dn[(size_t)slot_f * 128 + tid] = sf; dn[(size_t)slot_b * 128 + tid] = sb;
    }
    const int r = lane & 31, hh = lane >> 5;
#pragma unroll 1
    for (int dir = 0; dir < 2; ++dir) {
        const u16* Bt = dir ? KTb : KTf;
        u16* dst = CT + (size_t)(dir ? slot_b : slot_f) * 32768;
#pragma unroll 1
        for (int nh = 0; nh < 2; ++nh) {
            f32x16 acc[2][2] = {};
#pragma unroll
            for (int kk = 0; kk < 4; ++kk) {
                bf16x8 a[2], bq[2];
#pragma unroll
                for (int mi = 0; mi < 2; ++mi) a[mi] = *(const bf16x8*)(VT + (wid * 64 + mi * 32 + r) * LDT + kk * 16 + hh * 8);
#pragma unroll
                for (int ni = 0; ni < 2; ++ni) bq[ni] = *(const bf16x8*)(Bt + (nh * 64 + ni * 32 + r) * LDT + kk * 16 + hh * 8);
#pragma unroll
                for (int mi = 0; mi < 2; ++mi)
#pragma unroll
                    for (int ni = 0; ni < 2; ++ni) acc[mi][ni] = mfma32(bq[ni], a[mi], acc[mi][ni]);
            }
#pragma unroll
            for (int mi = 0; mi < 2; ++mi)
#pragma unroll
                for (int ni = 0; ni < 2; ++ni) {
                    u16* drow = dst + (wid * 64 + mi * 32 + r) * 128 + nh * 64 + ni * 32 + 4 * hh;
#pragma unroll
                    for (int g = 0; g < 4; ++g) {
                        u32x2 w; w.x = pk2(acc[mi][ni][4 * g], acc[mi][ni][4 * g + 1]); w.y = pk2(acc[mi][ni][4 * g + 2], acc[mi][ni][4 * g + 3]);
                        *(u32x2*)(drow + 8 * g) = w;
                    }
                }
        }
    }
    __syncthreads();
}

__device__ __forceinline__ void na_item(const Params& p, unsigned char* smem, const int it) {
    const int tid = opaque_tid(), lane = tid & 63, wid = tid >> 6;
    const int row = it & 255, h = (it >> 8) & 7, b = it >> 11;
    const u16* P = (const u16*)(p.ws + OFF_P);
    u16* YNA = (u16*)(p.ws + OFF_YNA);
    float* rpb_s = (float*)(smem + 36864);
    const int l15 = lane & 15, l4 = lane >> 4;
    const int qc = wid * 16 + l15;
    const size_t qtok = (size_t)b * TSEQ + row * 64 + qc;
    const u16* qsrc = P + qtok * PV + V_NQ + h * 64 + l4 * 8;
    const bf16x8 qa0 = *(const bf16x8*)qsrc, qa1 = *(const bf16x8*)(qsrc + 32);
    const int rs = min(max(row - 4, 0), 248);
    const int cs = min(max(qc - 8, 0), 48);
    for (int j = tid; j < 465; j += 256) rpb_s[j] = p.na_rpb[h * 465 + j];
    f32x4 O[4] = {};
    float mrun = -INFINITY, lrun = 0.f;
    u32x4 kreg[2]; u32x2 vreg[8];
    const int cgp = (tid >> 3) & 15, tg = tid & 7;
    {
        const int kbase = b * TSEQ + rs * 64;
#pragma unroll
        for (int i = 0; i < 2; ++i) { const int id = tid + i * 256; kreg[i] = *(const u32x4*)(P + (size_t)(kbase + (id >> 3)) * PV + V_NK + h * 64 + (id & 7) * 8); }
        const u16* src = P + (size_t)(kbase + tg * 8) * PV + V_NV + h * 64 + cgp * 4;
#pragma unroll
        for (int i = 0; i < 8; ++i) vreg[i] = *(const u32x2*)(src + (size_t)i * PV);
    }
    for (int blk = 0; blk < 12; ++blk) {
        u16* Ks = (u16*)(smem + (blk & 1) * 18432); u16* VTs = Ks + 4608;
#pragma unroll
        for (int i = 0; i < 2; ++i) { const int id = tid + i * 256; *(u32x4*)(Ks + (id >> 3) * LDT + (id & 7) * 8) = kreg[i]; }
        if (tid < 128) {
#pragma unroll
            for (int cc = 0; cc < 4; ++cc) *(u32x4*)(VTs + (cgp * 4 + cc) * LDT + tg * 8) = tr8(vreg, cc);
        }
        __syncthreads();
        if (blk + 1 < 12) {
            const int nb = blk + 1;
            const int kbase = nb < 8 ? b * TSEQ + (rs + nb) * 64 : NTOK + b * 256 + (nb - 8) * 64;
#pragma unroll
            for (int i = 0; i < 2; ++i) { const int id = tid + i * 256; kreg[i] = *(const u32x4*)(P + (size_t)(kbase + (id >> 3)) * PV + V_NK + h * 64 + (id & 7) * 8); }
            const u16* src = P + (size_t)(kbase + tg * 8) * PV + V_NV + h * 64 + cgp * 4;
#pragma unroll
            for (int i = 0; i < 8; ++i) vreg[i] = *(const u32x2*)(src + (size_t)i * PV);
        }
        f32x4 S[4] = {};
#pragma unroll
        for (int t = 0; t < 4; ++t) {
            const bf16x8 k0 = *(const bf16x8*)(Ks + (t * 16 + l15) * LDT + l4 * 8), k1 = *(const bf16x8*)(Ks + (t * 16 + l15) * LDT + 32 + l4 * 8);
            S[t] = mfma16(k0, qa0, S[t]); S[t] = mfma16(k1, qa1, S[t]);
        }
        if (blk < 8) {
            const float* rpb = rpb_s + (rs + blk - row + 7) * 31 + 15 - qc;
#pragma unroll
            for (int t = 0; t < 4; ++t)
#pragma unroll
                for (int reg = 0; reg < 4; ++reg) {
                    const int kc = t * 16 + l4 * 4 + reg;
                    const bool valid = kc >= cs && kc < cs + 16;
                    float bias = 0.f;
                    if (valid) bias = rpb[kc];
                    S[t][reg] = valid ? S[t][reg] + bias : -INFINITY;
                }
        }
        float mx = -INFINITY;
#pragma unroll
        for (int t = 0; t < 4; ++t) mx = fmaxf(mx, fmaxf(fmaxf(S[t][0], S[t][1]), fmaxf(S[t][2], S[t][3])));
        mx = fmaxf(mx, __shfl_xor(mx, 16)); mx = fmaxf(mx, __shfl_xor(mx, 32));
        const float mnew = fmaxf(mrun, mx);
        const float alpha = __expf(mrun - mnew);
        float ps = 0.f;
#pragma unroll
        for (int t = 0; t < 4; ++t)
#pragma unroll
            for (int reg = 0; reg < 4; ++reg) { const float pe = __expf(S[t][reg] - mnew); S[t][reg] = pe; ps += pe; }
        ps += __shfl_xor(ps, 16); ps += __shfl_xor(ps, 32);
        lrun = lrun * alpha + ps; mrun = mnew;
#pragma unroll
        for (int t = 0; t < 4; ++t) { O[t][0] *= alpha; O[t][1] *= alpha; O[t][2] *= alpha; O[t][3] *= alpha; }
#pragma unroll
        for (int s = 0; s < 2; ++s) {
            u32x4 pb; pb.x = pk2(S[2 * s][0], S[2 * s][1]); pb.y = pk2(S[2 * s][2], S[2 * s][3]); pb.z = pk2(S[2 * s + 1][0], S[2 * s + 1][1]); pb.w = pk2(S[2 * s + 1][2], S[2 * s + 1][3]);
            const bf16x8 pfrag = __builtin_bit_cast(bf16x8, pb);
#pragma unroll
            for (int t = 0; t < 4; ++t) {
                const u16* vrow = VTs + (t * 16 + l15) * LDT + s * 32 + l4 * 4;
                const u32x2 v0 = *(const u32x2*)vrow, v1 = *(const u32x2*)(vrow + 16);
                u32x4 va; va.x = v0.x; va.y = v0.y; va.z = v1.x; va.w = v1.y;
                O[t] = mfma16(__builtin_bit_cast(bf16x8, va), pfrag, O[t]);
            }
        }
    }
    {
        const float il = 1.f / lrun;
#pragma unroll
        for (int t = 0; t < 4; ++t) {
            u32x2 w; w.x = pk2(O[t][0] * il, O[t][1] * il); w.y = pk2(O[t][2] * il, O[t][3] * il);
            *(u32x2*)(YNA + qtok * 512 + h * 64 + t * 16 + l4 * 4) = w;
        }
    }
    __syncthreads();
}

__device__ __forceinline__ int scan_cidx(int i, int dir) { return dir == 0 ? i : (i < 4 ? 3 - i : 263 - i); }
__device__ __forceinline__ void phase_scan(const Params& p, unsigned char* smem) {
    const int tid = opaque_tid(), lane = tid & 63, wid = tid >> 6;
    float* al = (float*)smem; float* be = al + 260;
    const float* gsum = (const float*)(p.ws + OFF_GS); const float* mloc = (const float*)(p.ws + OFF_ML);
    float* mprev = (float*)(p.ws + OFF_MP); float* dn = (float*)(p.ws + OFF_DN);
    for (int it = blockIdx.x; it < 512; it += gridDim.x) {
        const int bhd = it >> 5, eb = it & 31, dir = bhd & 1, slot0 = bhd * 260;
        if (wid == 0) {
            float g[5], ml[5]; int cc[5];
            float a = 0.f, b = -INFINITY;
#pragma unroll
            for (int j = 0; j < 5; ++j) {
                const int i = lane * 5 + j; const bool ok = i < 260;
                cc[j] = ok ? scan_cidx(i, dir) : 0;
                g[j] = ok ? gsum[slot0 + cc[j]] : 0.f; ml[j] = ok ? mloc[slot0 + cc[j]] : -INFINITY;
                b = fmaxf(b + g[j], ml[j]); a += g[j];
            }
#pragma unroll
            for (int o = 1; o < 64; o <<= 1) {
                const float pa = __shfl_up(a, o), pb = __shfl_up(b, o);
                if (lane >= o) { b = fmaxf(pb + a, b); a = pa + a; }
            }
            float ea = __shfl_up(a, 1), eb2 = __shfl_up(b, 1);
            if (lane == 0) { ea = 0.f; eb2 = -INFINITY; }
            float m = fmaxf(0.f + ea, eb2);
#pragma unroll
            for (int j = 0; j < 5; ++j) {
                const int i = lane * 5 + j;
                if (i < 260) {
                    const float mn = fmaxf(g[j] + m, ml[j]);
                    al[i] = __expf(g[j] + m - mn); be[i] = __expf(ml[j] - mn);
                    if (eb == 0) mprev[slot0 + cc[j]] = m;
                    m = mn;
                }
            }
        }
        __syncthreads();
        u32x2* basep = (u32x2*)(p.ws + OFF_CT) + (size_t)slot0 * 8192 + eb * 256 + tid;
        float C0 = 0.f, C1 = 0.f, C2 = 0.f, C3 = 0.f;
        for (int i = 0; i < 260; i += 13) {
            u32x2 v[13];
#pragma unroll
            for (int j = 0; j < 13; ++j) v[j] = basep[(size_t)scan_cidx(i + j, dir) * 8192];
#pragma unroll
            for (int j = 0; j < 13; ++j) {
                u32x2 o; o.x = pk2(C0, C1); o.y = pk2(C2, C3);
                basep[(size_t)scan_cidx(i + j, dir) * 8192] = o;
                const float a = al[i + j], bt = be[i + j];
                C0 = fmaf(a, C0, bt * bf_lo(v[j].x)); C1 = fmaf(a, C1, bt * bf_hi(v[j].x)); C2 = fmaf(a, C2, bt * bf_lo(v[j].y)); C3 = fmaf(a, C3, bt * bf_hi(v[j].y));
            }
        }
        if (eb == 0 && tid < 128) {
            float n = 0.f;
            for (int i = 0; i < 260; ++i) {
                float* q = dn + (size_t)(slot0 + scan_cidx(i, dir)) * 128 + tid;
                const float v = *q; *q = n; n = al[i] * n + be[i] * v;
            }
        }
        __syncthreads();
    }
}

__device__ __forceinline__ void mlstm_passC(const Params& p, unsigned char* smem, const int it) {
    const int tid = opaque_tid(), lane = tid & 63, wid = tid >> 6;
    const int cl = it & 255, bh = it >> 8, b = bh >> 2, h = bh & 3, c = cl + 4;
    const int base = b * TSEQ + cl * 64;
    const int slot_f = bh * 2 * 260 + c, slot_b = slot_f + 260;
    const u16* P = (const u16*)(p.ws + OFF_P); const float* G = (const float*)(p.ws + OFF_G);
    const float* mprev = (const float*)(p.ws + OFF_MP); const float* dn = (const float*)(p.ws + OFF_DN);
    const u16* CT = (const u16*)(p.ws + OFF_CT);
    u16* YM = (u16*)(p.ws + OFF_YM);
    u16* Ks = (u16*)smem;
    u16* CTf = (u16*)smem; u16* CTb = (u16*)(smem + 17408);
    u16* VTs = (u16*)(smem + 34816);
    float* ga = (float*)(smem + 44032);
    float *uf_s = ga, *Mf_s = ga + 64, *ub_s = ga + 128, *Mb_s = ga + 192, *clf = ga + 256, *clb = ga + 320, *wif = ga + 384, *wib = ga + 448;
    const int l15 = lane & 15, l4 = lane >> 4;
    if (wid == 0) {
        const float* g = G + (size_t)(base + lane) * 16;
        const float igf = g[h], ff = g[4 + h], igb = g[8 + h], fb = g[12 + h];
        const float lff = log_sigmoid_(ff), lfb = log_sigmoid_(fb);
        const float bfc = wave_incl_sum(lff, lane);
        const float uf = igf - bfc;
        const float pb = wave_incl_sum(lfb, lane), gb = __shfl(pb, 63);
        const float bb = gb - pb + lfb, ub = igb - bb;
        const float mpf = mprev[slot_f], mpb = mprev[slot_b];
        const float Mf = fmaxf(mpf, wave_prefix_max(uf, lane)), Mb = fmaxf(mpb, wave_suffix_max(ub, lane));
        uf_s[lane] = uf; Mf_s[lane] = Mf; clf[lane] = __expf(-(bfc + Mf)); wif[lane] = __expf(mpf - Mf);
        ub_s[lane] = ub; Mb_s[lane] = Mb; clb[lane] = __expf(-(bb + Mb)); wib[lane] = __expf(mpb - Mb);
    }
    const int t = wid * 16 + l15;
    const size_t tok = (size_t)base + t;
    bf16x8 qa[4];
    {
        const u16* qsrc = P + tok * PV + V_MQ + h * 128 + l4 * 8;
#pragma unroll
        for (int kk = 0; kk < 4; ++kk) qa[kk] = *(const bf16x8*)(qsrc + kk * 32);
    }
#pragma unroll
    for (int i = 0; i < 4; ++i) {
        const int id = tid + i * 256, kr = id >> 4, ch = id & 15;
        *(u32x4*)(Ks + kr * LDQ + ch * 8) = *(const u32x4*)(P + (size_t)(base + kr) * PV + V_MK + h * 128 + ch * 8);
    }
    __syncthreads();
    f32x4 S[4] = {};
#pragma unroll
    for (int st = 0; st < 4; ++st)
#pragma unroll
        for (int kk = 0; kk < 4; ++kk) {
            const bf16x8 kf = *(const bf16x8*)(Ks + (st * 16 + l15) * LDQ + kk * 32 + l4 * 8);
            S[st] = mfma16(kf, qa[kk], S[st]);
        }
    float qnf = 0.f, qnb = 0.f;
    {
        const float* nf = dn + (size_t)slot_f * 128; const float* nb = dn + (size_t)slot_b * 128;
#pragma unroll
        for (int kk = 0; kk < 4; ++kk)
#pragma unroll
            for (int j = 0; j < 8; ++j) {
                const int d = kk * 32 + l4 * 8 + j;
                const float qv = bf2f((u16)qa[kk][j]);
                qnf += qv * nf[d]; qnb += qv * nb[d];
            }
        qnf += __shfl_xor(qnf, 16); qnf += __shfl_xor(qnf, 32);
        qnb += __shfl_xor(qnb, 16); qnb += __shfl_xor(qnb, 32);
    }
    const float Mft = Mf_s[t], Mbt = Mb_s[t];
    float rsf = 0.f, rsb = 0.f;
    f32x4 PF[4], PB[4];
#pragma unroll
    for (int st = 0; st < 4; ++st) {
        const f32x4 uf4 = *(const f32x4*)(uf_s + st * 16 + l4 * 4), ub4 = *(const f32x4*)(ub_s + st * 16 + l4 * 4);
#pragma unroll
        for (int reg = 0; reg < 4; ++reg) {
            const int s = st * 16 + l4 * 4 + reg;
            const float sv = S[st][reg];
            const float pf = (s <= t) ? sv * __expf(uf4[reg] - Mft) : 0.f;
            const float pbv = (s >= t) ? sv * __expf(ub4[reg] - Mbt) : 0.f;
            rsf += pf; rsb += pbv; PF[st][reg] = pf; PB[st][reg] = pbv;
        }
    }
    rsf += __shfl_xor(rsf, 16); rsf += __shfl_xor(rsf, 32);
    rsb += __shfl_xor(rsb, 16); rsb += __shfl_xor(rsb, 32);
    const float wft = wif[t], wbt = wib[t];
    const float idf = 1.f / fmaxf(fabsf(rsf + wft * qnf), clf[t]), idb = 1.f / fmaxf(fabsf(rsb + wbt * qnb), clb[t]);
    bf16x8 pfr[2], qwf[4], qwb[4];
#pragma unroll
    for (int ss = 0; ss < 2; ++ss) {
        u32x4 pw;
        pw.x = pk2(PF[2 * ss][0] * idf + PB[2 * ss][0] * idb, PF[2 * ss][1] * idf + PB[2 * ss][1] * idb);
        pw.y = pk2(PF[2 * ss][2] * idf + PB[2 * ss][2] * idb, PF[2 * ss][3] * idf + PB[2 * ss][3] * idb);
        pw.z = pk2(PF[2 * ss + 1][0] * idf + PB[2 * ss + 1][0] * idb, PF[2 * ss + 1][1] * idf + PB[2 * ss + 1][1] * idb);
        pw.w = pk2(PF[2 * ss + 1][2] * idf + PB[2 * ss + 1][2] * idb, PF[2 * ss + 1][3] * idf + PB[2 * ss + 1][3] * idb);
        pfr[ss] = __builtin_bit_cast(bf16x8, pw);
    }
    {
        const float sf = wft * idf, sb = wbt * idb;
#pragma unroll
        for (int kk = 0; kk < 4; ++kk) {
            u32x4 of, ob;
            const float q0 = bf2f((u16)qa[kk][0]), q1 = bf2f((u16)qa[kk][1]), q2 = bf2f((u16)qa[kk][2]), q3 = bf2f((u16)qa[kk][3]);
            const float q4 = bf2f((u16)qa[kk][4]), q5 = bf2f((u16)qa[kk][5]), q6 = bf2f((u16)qa[kk][6]), q7 = bf2f((u16)qa[kk][7]);
            of.x = pk2(q0 * sf, q1 * sf); of.y = pk2(q2 * sf, q3 * sf); of.z = pk2(q4 * sf, q5 * sf); of.w = pk2(q6 * sf, q7 * sf);
            ob.x = pk2(q0 * sb, q1 * sb); ob.y = pk2(q2 * sb, q3 * sb); ob.z = pk2(q4 * sb, q5 * sb); ob.w = pk2(q6 * sb, q7 * sb);
            qwf[kk] = __builtin_bit_cast(bf16x8, of); qwb[kk] = __builtin_bit_cast(bf16x8, ob);
        }
    }
    __syncthreads();
    f32x4 hm[4][4];
#pragma unroll
    for (int vb = 0; vb < 4; ++vb) {
        if (tid < 128) {
            const int cgp = tid >> 3, tg = tid & 7;
            const u16* src = P + (size_t)(base + tg * 8) * PV + V_MV + h * 256 + vb * 64 + cgp * 4;
            u32x2 vv[8];
#pragma unroll
            for (int i = 0; i < 8; ++i) vv[i] = *(const u32x2*)(src + (size_t)i * PV);
#pragma unroll
            for (int cc = 0; cc < 4; ++cc) *(u32x4*)(VTs + (cgp * 4 + cc) * LDT + tg * 8) = tr8(vv, cc);
        }
#pragma unroll
        for (int i = 0; i < 4; ++i) {
            const int id = tid + i * 256, vr = id >> 4, ch = id & 15;
            *(u32x4*)(CTf + vr * LDQ + ch * 8) = *(const u32x4*)(CT + (size_t)slot_f * 32768 + (vb * 64 + vr) * 128 + ch * 8);
            *(u32x4*)(CTb + vr * LDQ + ch * 8) = *(const u32x4*)(CT + (size_t)slot_b * 32768 + (vb * 64 + vr) * 128 + ch * 8);
        }
        __syncthreads();
#pragma unroll
        for (int tv = 0; tv < 4; ++tv) {
            f32x4 a = {0.f, 0.f, 0.f, 0.f};
#pragma unroll
            for (int ss = 0; ss < 2; ++ss) {
                const u16* vrow = VTs + (tv * 16 + l15) * LDT + ss * 32 + l4 * 4;
                const u32x2 v0 = *(const u32x2*)vrow, v1 = *(const u32x2*)(vrow + 16);
                u32x4 va; va.x = v0.x; va.y = v0.y; va.z = v1.x; va.w = v1.y;
                a = mfma16(__builtin_bit_cast(bf16x8, va), pfr[ss], a);
            }
#pragma unroll
            for (int kk = 0; kk < 4; ++kk) {
                const bf16x8 cf = *(const bf16x8*)(CTf + (tv * 16 + l15) * LDQ + kk * 32 + l4 * 8);
                const bf16x8 cb = *(const bf16x8*)(CTb + (tv * 16 + l15) * LDQ + kk * 32 + l4 * 8);
                a = mfma16(cf, qwf[kk], a); a = mfma16(cb, qwb[kk], a);
            }
            hm[vb][tv] = a;
        }
        __syncthreads();
    }
    float ssq = 0.f;
#pragma unroll
    for (int vb = 0; vb < 4; ++vb)
#pragma unroll
        for (int tv = 0; tv < 4; ++tv) ssq += (hm[vb][tv][0] * hm[vb][tv][0] + hm[vb][tv][1] * hm[vb][tv][1]) + (hm[vb][tv][2] * hm[vb][tv][2] + hm[vb][tv][3] * hm[vb][tv][3]);
    ssq += __shfl_xor(ssq, 16); ssq += __shfl_xor(ssq, 32);
    const float rstd = rsqrtf(ssq * (1.f / 256.f) + 1e-6f);
#pragma unroll
    for (int vb = 0; vb < 4; ++vb)
#pragma unroll
        for (int tv = 0; tv < 4; ++tv) {
            const int v = h * 256 + vb * 64 + tv * 16 + l4 * 4;
            const u32x2 ov = *(const u32x2*)(P + tok * PV + V_MO + v);
            const f32x4 w = *(const f32x4*)(p.m_norm_w + v);
            u32x2 y;
            y.x = pk2(hm[vb][tv][0] * rstd * w.x * sigmoid_(bf_lo(ov.x)), hm[vb][tv][1] * rstd * w.y * sigmoid_(bf_hi(ov.x)));
            y.y = pk2(hm[vb][tv][2] * rstd * w.z * sigmoid_(bf_lo(ov.y)), hm[vb][tv][3] * rstd * w.w * sigmoid_(bf_hi(ov.y)));
            *(u32x2*)(YM + tok * 1024 + v) = y;
        }
}

__device__ __forceinline__ void phase_merge(const Params& p, unsigned char* smem, const bool second) {
    const u16* P = (const u16*)(p.ws + OFF_P);
    const u16* YM = (const u16*)(p.ws + OFF_YM); const u16* YNA = (const u16*)(p.ws + OFF_YNA);
    u16* MRG = (u16*)(p.ws + OFF_MRG);
    const int tid = opaque_tid(), lane = tid & 63, wid = tid >> 6, wr = wid >> 1, wc = wid & 1;
    const u16* abase = second ? YNA : YM; const int lda = second ? 512 : 1024;
    const u16* wt = (const u16*)(p.ws + (second ? OFF_BRNT : OFF_BRMT));
    const int gcol = second ? V_GN : V_GM;
    const int sw = ((tid & 3) ^ ((tid >> 4) & 3)) * 8;
    for (int ti = 0;; ++ti) {
        int mt, nt;
        if (!sched_tile(ti, 256, 4, 4, mt, nt)) break;
        f32x16 acc[2][4] = {};
        gemm_core3(acc, abase + (size_t)(mt * 128 + (tid >> 2)) * lda + sw, (size_t)64 * lda, wt + (size_t)(nt * 256 + (tid >> 2)) * lda + sw, (size_t)64 * lda, second ? 16 : 32, smem, tid, lane, wr, wc);
        u16* Ct = (u16*)smem;
        RAW_BARRIER();
        ct_write3(Ct, acc, wr, wc, lane);
        __syncthreads();
#pragma unroll 4
        for (int i = 0; i < 16; ++i) {
            const int idx = tid + i * 256, row = idx >> 5, ch = idx & 31;
            const size_t m = (size_t)mt * 128 + row;
            const u32x4 cv = *(const u32x4*)(Ct + row * CT3_LD + ch * 8);
            const u32x4 gv = *(const u32x4*)(P + m * PV + gcol + nt * 256 + ch * 8);
            u16* q = MRG + m * 1024 + nt * 256 + ch * 8;
            float o[8];
            o[0] = bf_lo(cv.x) * bf_lo(gv.x); o[1] = bf_hi(cv.x) * bf_hi(gv.x); o[2] = bf_lo(cv.y) * bf_lo(gv.y); o[3] = bf_hi(cv.y) * bf_hi(gv.y);
            o[4] = bf_lo(cv.z) * bf_lo(gv.z); o[5] = bf_hi(cv.z) * bf_hi(gv.z); o[6] = bf_lo(cv.w) * bf_lo(gv.w); o[7] = bf_hi(cv.w) * bf_hi(gv.w);
            if (second) {
                const u32x4 pv = *(const u32x4*)q;
                o[0] += bf_lo(pv.x); o[1] += bf_hi(pv.x); o[2] += bf_lo(pv.y); o[3] += bf_hi(pv.y); o[4] += bf_lo(pv.z); o[5] += bf_hi(pv.z); o[6] += bf_lo(pv.w); o[7] += bf_hi(pv.w);
            }
            u32x4 w; w.x = pk2(o[0], o[1]); w.y = pk2(o[2], o[3]); w.z = pk2(o[4], o[5]); w.w = pk2(o[6], o[7]);
            *(u32x4*)q = w;
        }
        __syncthreads();
    }
}

__device__ __forceinline__ void phase_outproj(const Params& p, unsigned char* smem) {
    const u16* MRG = (const u16*)(p.ws + OFF_MRG);
    const int tid = opaque_tid(), lane = tid & 63, wid = tid >> 6, wr = wid >> 1, wc = wid & 1;
    const u16* wt = (const u16*)(p.ws + OFF_OUTT);
    const int sw = ((tid & 3) ^ ((tid >> 4) & 3)) * 8;
    for (int ti = 0;; ++ti) {
        int mt, nt;
        if (!sched_tile(ti, 256, 4, 4, mt, nt)) break;
        f32x16 acc[2][4] = {};
        gemm_core3(acc, MRG + (size_t)(mt * 128 + (tid >> 2)) * 1024 + sw, 64 * 1024, wt + (size_t)(nt * 256 + (tid >> 2)) * 1024 + sw, 64 * 1024, 32, smem, tid, lane, wr, wc);
        u16* Ct = (u16*)smem;
        RAW_BARRIER();
        ct_write3(Ct, acc, wr, wc, lane);
        __syncthreads();
        {
            const int bvec = mt >> 7, ch = tid & 31;
            float g1[8];
#pragma unroll
            for (int j = 0; j < 8; ++j) g1[j] = mod_val(p, bvec, 2048 + nt * 256 + ch * 8 + j);
#pragma unroll 4
            for (int i = 0; i < 16; ++i) {
                const int row = (tid >> 5) + i * 8;
                const size_t off = ((size_t)mt * 128 + row) * 1024 + nt * 256 + ch * 8;
                const u32x4 cv = *(const u32x4*)(Ct + row * CT3_LD + ch * 8);
                const f32x4 x0 = *(const f32x4*)(p.x + off), x1 = *(const f32x4*)(p.x + off + 4);
                f32x4 o0, o1;
                o0.x = x0.x + g1[0] * bf_lo(cv.x); o0.y = x0.y + g1[1] * bf_hi(cv.x); o0.z = x0.z + g1[2] * bf_lo(cv.y); o0.w = x0.w + g1[3] * bf_hi(cv.y);
                o1.x = x1.x + g1[4] * bf_lo(cv.z); o1.y = x1.y + g1[5] * bf_hi(cv.z); o1.z = x1.z + g1[6] * bf_lo(cv.w); o1.w = x1.w + g1[7] * bf_hi(cv.w);
                *(f32x4*)(p.out + off) = o0; *(f32x4*)(p.out + off + 4) = o1;
            }
        }
        __syncthreads();
    }
}

__device__ __forceinline__ void phase_router(const Params& p, unsigned char* smem) {
    const u16* H = (const u16*)(p.ws + OFF_H);
    float* SC = (float*)(p.ws + OFF_SC);
    const int tid = opaque_tid(), lane = tid & 63, wid = tid >> 6, wr = wid >> 1, wc = wid & 1;
    const int r = lane & 31, hh = lane >> 5;
    const u16* wt = (const u16*)(p.ws + OFF_RTT);
    const int sw = ((tid & 7) ^ ((tid >> 3) & 7)) * 8;
    for (int ti = 0;; ++ti) {
        int mt, nt;
        if (!sched_tile(ti, 256, 2, 2, mt, nt)) break;
        f32x16 acc[2][2] = {};
        gemm_core2(acc, H + (size_t)(mt * 128 + (tid >> 3)) * 1024 + sw, 32 * 1024, wt + (size_t)(nt * 128 + (tid >> 3)) * 1024 + sw, 32 * 1024, 16, smem, tid, lane, wr, wc);
#pragma unroll
        for (int mi = 0; mi < 2; ++mi)
#pragma unroll
            for (int ni = 0; ni < 2; ++ni) {
                float* srow = SC + ((size_t)mt * 128 + wr * 64 + mi * 32 + r) * 256 + nt * 128 + wc * 64 + ni * 32 + 4 * hh;
#pragma unroll
                for (int g = 0; g < 4; ++g) {
                    f32x4 o; o.x = sigmoid_(acc[mi][ni][4 * g]); o.y = sigmoid_(acc[mi][ni][4 * g + 1]); o.z = sigmoid_(acc[mi][ni][4 * g + 2]); o.w = sigmoid_(acc[mi][ni][4 * g + 3]);
                    *(f32x4*)(srow + 8 * g) = o;
                }
            }
        __syncthreads();
    }
}

__device__ __forceinline__ void phase_route(const Params& p, unsigned char* smem) {
    const int tid = opaque_tid(), lane = tid & 63, wid = tid >> 6;
    const float* SC = (const float*)(p.ws + OFF_SC);
    int* tope = (int*)(p.ws + OFF_TOPE); float* topw = (float*)(p.ws + OFF_TOPW);
    int* lh = (int*)smem;
    lh[tid] = 0;
    __syncthreads();
    const f32x4 rb = *(const f32x4*)(p.router_bias + lane * 4);
    for (int tok = blockIdx.x * 4 + wid; tok < NTOK; tok += gridDim.x * 4) {
        const f32x4 sc = *(const f32x4*)(SC + (size_t)tok * 256 + lane * 4);
        float s0 = sc.x + rb.x, s1 = sc.y + rb.y, s2 = sc.z + rb.z, s3 = sc.w + rb.w;
        float a1 = fmaxf(s0, s1), a2 = fminf(s0, s1);
        { const float b1 = fmaxf(s2, s3), b2 = fminf(s2, s3); const float n1 = fmaxf(a1, b1), n2 = fmaxf(fminf(a1, b1), fmaxf(a2, b2)); a1 = n1; a2 = n2; }
#pragma unroll
        for (int o = 1; o < 8; o <<= 1) {
            const float b1 = __shfl_xor(a1, o), b2 = __shfl_xor(a2, o);
            const float n1 = fmaxf(a1, b1), n2 = fmaxf(fminf(a1, b1), fmaxf(a2, b2)); a1 = n1; a2 = n2;
        }
        const float gs = a1 + a2; const int mygrp = lane >> 3;
        int gcnt = 0;
#pragma unroll
        for (int g = 0; g < 8; ++g) { const float og = __shfl(gs, g * 8); gcnt += (og > gs || (og == gs && g < mygrp)) ? 1 : 0; }
        if (gcnt >= 4) { s0 = -INFINITY; s1 = -INFINITY; s2 = -INFINITY; s3 = -INFINITY; }
        int my_e = 0; float my_s = 0.f, wsum = 0.f;
#pragma unroll
        for (int k = 0; k < 8; ++k) {
            float bv = s0; int bi = lane * 4;
            if (s1 > bv) { bv = s1; bi = lane * 4 + 1; }
            if (s2 > bv) { bv = s2; bi = lane * 4 + 2; }
            if (s3 > bv) { bv = s3; bi = lane * 4 + 3; }
#pragma unroll
            for (int o = 1; o < 64; o <<= 1) {
                const float ov = __shfl_xor(bv, o); const int oi = __shfl_xor(bi, o);
                if (ov > bv || (ov == bv && oi < bi)) { bv = ov; bi = oi; }
            }
            const int own = bi >> 2, sub = bi & 3;
            const float mine = sub == 0 ? sc.x : sub == 1 ? sc.y : sub == 2 ? sc.z : sc.w;
            const float sel_sc = __shfl(mine, own);
            if (lane == own) { if (sub == 0) s0 = -INFINITY; else if (sub == 1) s1 = -INFINITY; else if (sub == 2) s2 = -INFINITY; else s3 = -INFINITY; }
            wsum += sel_sc;
            if (lane == k) { my_e = bi; my_s = sel_sc; }
        }
        if (lane < 8) {
            atomicAdd(lh + my_e, 1);
            tope[tok * 8 + lane] = my_e; topw[tok * 8 + lane] = my_s / wsum * 2.5f;
        }
    }
    __syncthreads();
    ((int*)(p.ws + OFF_HIST))[blockIdx.x * 256 + tid] = lh[tid];
}
__device__ __forceinline__ void phase_assign(const Params& p, unsigned char* smem) {
    const int tid = opaque_tid(), lane = tid & 63, wid = tid >> 6;
    int* offs = (int*)smem; int* lc = offs + 256;
    const int* hist = (const int*)(p.ws + OFF_HIST);
    int* slot_tok = (int*)(p.ws + OFF_SLOT);
    const int* tope = (const int*)(p.ws + OFF_TOPE); int* rnk = (int*)(p.ws + OFF_RANK);
    {
        int run = 0, mine = 0;
        const int nb = gridDim.x, me = blockIdx.x;
        for (int b0 = 0; b0 < nb; b0 += 8) {
            int v[8];
#pragma unroll
            for (int j = 0; j < 8; ++j) v[j] = (b0 + j < nb) ? hist[(b0 + j) * 256 + tid] : 0;
#pragma unroll
            for (int j = 0; j < 8; ++j) { if (b0 + j == me) mine = run; run += v[j]; }
        }
        offs[tid] = mine; lc[tid] = 0;
        if (me == 0) ((int*)(p.ws + OFF_CNT))[tid] = run;
    }
    __syncthreads();
    for (int tok = blockIdx.x * 4 + wid; tok < NTOK; tok += gridDim.x * 4) {
        if (lane < 8) {
            const int e = tope[tok * 8 + lane];
            const int rk = offs[e] + atomicAdd(lc + e, 1);
            rnk[tok * 8 + lane] = rk; slot_tok[(size_t)e * NTOK + rk] = tok;
        }
    }
}

__device__ __forceinline__ int* build_tile_table(const Params& p, unsigned char* smem) {
    int* tstart = (int*)(smem + 73728); int* cn = tstart + 260; int* pstart = cn + 256;
    const int tid = opaque_tid();
    cn[tid] = ((const int*)(p.ws + OFF_CNT))[tid];
    __syncthreads();
    if (tid == 0) {
        int s = 0, q = 0;
        for (int e = 0; e < 256; ++e) { const int t = (cn[e] + 127) >> 7; tstart[e] = s; pstart[e] = q; s += t; q += (t + 1) >> 1; }
        tstart[256] = s; pstart[256] = q;
    }
    __syncthreads();
    return tstart;
}
__device__ __forceinline__ int find_pair_expert(const int* pstart, int mp) {
    int lo = 0, hi = 256;
    while (hi - lo > 1) { const int mid = (lo + hi) >> 1; if (pstart[mid] <= mp) lo = mid; else hi = mid; }
    return lo;
}

__device__ __forceinline__ void gemm_core_m256(f32x16 (&acc)[4][2], const u16* abase, const int (&roff)[8], const float* bsrc, const size_t ldb, const int nk,
                                               unsigned char* smem, const int tid, const int lane, const int wr, const int wc) {
    typedef __attribute__((address_space(3))) unsigned lds_u32;
    u16* Bs = (u16*)(smem + 32768);
    f32x4 br[8];
#pragma unroll
    for (int i = 0; i < 8; ++i) br[i] = *(const f32x4*)(bsrc + (size_t)i * ldb);
    const int arow = tid >> 3, ach = tid & 7;
    const int r = lane & 31, hh = lane >> 5;
    for (int kt = 0; kt < nk; ++kt) {
        __syncthreads();
        {
            unsigned char* sa = smem + tid * 16;
#pragma unroll
            for (int i = 0; i < 8; ++i) __builtin_amdgcn_global_load_lds((const unsigned*)(abase + roff[i] + kt * 64), (lds_u32*)(sa + i * 4096), 16, 0, 0);
        }
#pragma unroll
        for (int cc = 0; cc < 4; ++cc) {
            u32x4 w; w.x = pk2(br[0][cc], br[1][cc]); w.y = pk2(br[2][cc], br[3][cc]); w.z = pk2(br[4][cc], br[5][cc]); w.w = pk2(br[6][cc], br[7][cc]);
            *(u32x4*)(Bs + (arow * 4 + cc) * LDT + ach * 8) = w;
        }
        __syncthreads();
        if (kt + 1 < nk) {
            const float* bp = bsrc + (size_t)(kt + 1) * 64 * ldb;
#pragma unroll
            for (int i = 0; i < 8; ++i) br[i] = *(const f32x4*)(bp + (size_t)i * ldb);
        }
#pragma unroll 1
        for (int kk = 0; kk < 4; ++kk) {
            bf16x8 a[4], b[2];
            const int ch = ((kk * 2 + hh) ^ (r & 7)) * 16;
#pragma unroll
            for (int mi = 0; mi < 4; ++mi) a[mi] = *(const bf16x8*)(smem + (wr * 128 + mi * 32 + r) * 128 + ch);
#pragma unroll
            for (int ni = 0; ni < 2; ++ni) b[ni] = *(const bf16x8*)(Bs + (wc * 64 + ni * 32 + r) * LDT + kk * 16 + hh * 8);
#pragma unroll
            for (int mi = 0; mi < 4; ++mi)
#pragma unroll
                for (int ni = 0; ni < 2; ++ni) acc[mi][ni] = mfma32(b[ni], a[mi], acc[mi][ni]);
        }
    }
    __syncthreads();
}

__device__ __forceinline__ void phase_moe1(const Params& p, unsigned char* smem) {
    const int* tstart = build_tile_table(p, smem); const int* cn = tstart + 260; const int* pstart = cn + 256;
    const u16* H2 = (const u16*)(p.ws + OFF_H);
    const int* slot_tok = (const int*)(p.ws + OFF_SLOT);
    u16* HID = (u16*)(p.ws + OFF_HID);
    const int tid = opaque_tid(), lane = tid & 63, wid = tid >> 6, wr = wid >> 1, wc = wid & 1;
    const int r = lane & 31, hh = lane >> 5;
    const int totalp = pstart[256];
    const int nitems = totalp * 4 + 512;
    const int sw = ((tid & 7) ^ ((tid >> 3) & 7)) * 8;
    for (int ii = 0;; ++ii) {
        const int it = ((blockIdx.x & 7) + 8 * ii) * (gridDim.x >> 3) + (blockIdx.x >> 3);
        if (it >= nitems) break;
        const bool shared = it >= totalp * 4;
        const int idx = shared ? it - totalp * 4 : it;
        const int mp = idx >> 2, nq = idx & 3;
        int e = 0, jp = 0, cnt_e = 0, vrows = 256;
        size_t hrow0;
        if (!shared) {
            e = find_pair_expert(pstart, mp); jp = mp - pstart[e]; cnt_e = cn[e];
            const int te = (cnt_e + 127) >> 7;
            vrows = (2 * jp + 1 < te) ? 256 : 128;
            hrow0 = (size_t)tstart[e] * 128 + jp * 256;
        } else hrow0 = (size_t)SH_BASE + mp * 256;
        int roff[8];
#pragma unroll
        for (int i = 0; i < 8; ++i) {
            const int ri = (tid >> 3) + 32 * i;
            int tok;
            if (shared) tok = mp * 256 + ri;
            else { const int pos = jp * 256 + ri; tok = pos < cnt_e ? slot_tok[(size_t)e * NTOK + pos] : 0; }
            roff[i] = tok * 1024 + sw;
        }
        const int R0 = (tid >> 3) * 4, bwc = R0 >> 6, bni = (R0 >> 5) & 1, bj = R0 & 31;
        const float* wsel = shared ? (bni ? p.w_sh_up : p.w_sh_gate) : ((bni ? p.w_exp_up : p.w_exp_gate) + (size_t)e * 1024 * 256);
        const float* bsrc = wsel + (size_t)((tid & 7) * 8) * 256 + nq * 64 + bwc * 32 + bj;
        f32x16 acc[4][2] = {};
        gemm_core_m256(acc, H2, roff, bsrc, 256, 16, smem, tid, lane, wr, wc);
        u16* Ct = (u16*)smem;
#pragma unroll
        for (int mi = 0; mi < 4; ++mi) {
            u16* base = Ct + (wr * 128 + mi * 32 + r) * LDT + wc * 32 + 4 * hh;
#pragma unroll
            for (int g = 0; g < 4; ++g) {
                float hv[4];
#pragma unroll
                for (int j = 0; j < 4; ++j) { const float gt = acc[mi][0][4 * g + j], u = acc[mi][1][4 * g + j]; hv[j] = gt * sigmoid_(gt) * u; }
                u32x2 w; w.x = pk2(hv[0], hv[1]); w.y = pk2(hv[2], hv[3]);
                *(u32x2*)(base + 8 * g) = w;
            }
        }
        __syncthreads();
#pragma unroll
        for (int i = 0; i < 8; ++i) {
            const int id2 = tid + i * 256, row = id2 >> 3, ch = id2 & 7;
            if (row < vrows) *(u32x4*)(HID + (hrow0 + row) * 256 + nq * 64 + ch * 8) = *(const u32x4*)(Ct + row * LDT + ch * 8);
        }
        __syncthreads();
    }
}

__device__ __forceinline__ void phase_moe2(const Params& p, unsigned char* smem) {
    const int* tstart = build_tile_table(p, smem); const int* cn = tstart + 260; const int* pstart = cn + 256;
    const u16* HID = (const u16*)(p.ws + OFF_HID);
    u16* Y = (u16*)(p.ws + OFF_Y);
    const int tid = opaque_tid(), lane = tid & 63, wid = tid >> 6, wr = wid >> 1, wc = wid & 1;
    const int r = lane & 31, hh = lane >> 5;
    const int totalp = pstart[256];
    const int nitems = totalp * 8 + 1024;
    const int sw = ((tid & 7) ^ ((tid >> 3) & 7)) * 8;
    for (int ii = 0;; ++ii) {
        const int it = ((blockIdx.x & 7) + 8 * ii) * (gridDim.x >> 3) + (blockIdx.x >> 3);
        if (it >= nitems) break;
        const bool shared = it >= totalp * 8;
        const int idx = shared ? it - totalp * 8 : it;
        const int mp = idx >> 3, nt = idx & 7;
        int e = 0, vrows = 256;
        size_t hrow0;
        if (!shared) {
            e = find_pair_expert(pstart, mp); const int jp = mp - pstart[e];
            const int te = (cn[e] + 127) >> 7;
            vrows = (2 * jp + 1 < te) ? 256 : 128;
            hrow0 = (size_t)tstart[e] * 128 + jp * 256;
        } else hrow0 = (size_t)SH_BASE + mp * 256;
        int roff[8];
#pragma unroll
        for (int i = 0; i < 8; ++i) {
            const int ri = (tid >> 3) + 32 * i;
            roff[i] = (int)(hrow0 + (ri < vrows ? ri : ri - 128)) * 256 + sw;
        }
        const float* wsel = shared ? p.w_sh_down : p.w_exp_down + (size_t)e * 256 * 1024;
        const float* bsrc = wsel + (size_t)((tid & 7) * 8) * 1024 + nt * 128 + (tid >> 3) * 4;
        f32x16 acc[4][2] = {};
        gemm_core_m256(acc, HID, roff, bsrc, 1024, 4, smem, tid, lane, wr, wc);
        u16* Ct = (u16*)smem;
#pragma unroll
        for (int mi = 0; mi < 4; ++mi)
#pragma unroll
            for (int ni = 0; ni < 2; ++ni) {
                u16* base = Ct + (wr * 128 + mi * 32 + r) * CT_LD + wc * 64 + ni * 32 + 4 * hh;
#pragma unroll
                for (int g = 0; g < 4; ++g) {
                    u32x2 w; w.x = pk2(acc[mi][ni][4 * g], acc[mi][ni][4 * g + 1]); w.y = pk2(acc[mi][ni][4 * g + 2], acc[mi][ni][4 * g + 3]);
                    *(u32x2*)(base + 8 * g) = w;
                }
            }
        __syncthreads();
#pragma unroll 4
        for (int i = 0; i < 16; ++i) {
            const int id2 = tid + i * 256, row = id2 >> 4, ch = id2 & 15;
            if (row < vrows) *(u32x4*)(Y + (hrow0 + row) * 1024 + nt * 128 + ch * 8) = *(const u32x4*)(Ct + row * CT_LD + ch * 8);
        }
        __syncthreads();
    }
}

__device__ __forceinline__ void phase_combine(const Params& p, unsigned char* smem) {
    const int* tstart = build_tile_table(p, smem);
    float* g2t = (float*)smem;
    const int tid = opaque_tid(), lane = tid & 63, wid = tid >> 6;
    for (int j = tid; j < 2048; j += 256) g2t[j] = mod_val(p, j >> 10, 5120 + (j & 1023));
    __syncthreads();
    const u16* Y = (const u16*)(p.ws + OFF_Y);
    const int* tope = (const int*)(p.ws + OFF_TOPE); const int* rnk = (const int*)(p.ws + OFF_RANK); const float* topw = (const float*)(p.ws + OFF_TOPW);
    for (int tok = blockIdx.x * 4 + wid; tok < NTOK; tok += gridDim.x * 4) {
        int myrow = 0; float myw = 0.f;
        if (lane < 8) { const int e = tope[tok * 8 + lane]; myrow = tstart[e] * 128 + rnk[tok * 8 + lane]; myw = topw[tok * 8 + lane]; }
        if (lane == 8) { myrow = SH_BASE + tok; myw = 1.f; }
        const float* g2 = g2t + (tok >> 14) * 1024;
        f32x4 a[4];
#pragma unroll
        for (int j = 0; j < 4; ++j) a[j] = (f32x4){0.f, 0.f, 0.f, 0.f};
#pragma unroll
        for (int k = 0; k < 9; ++k) {
            const int row = __shfl(myrow, k); const float w = __shfl(myw, k);
            const u16* yr = Y + (size_t)row * 1024 + lane * 4;
#pragma unroll
            for (int j = 0; j < 4; ++j) {
                const u32x2 v = *(const u32x2*)(yr + j * 256);
                a[j].x += w * bf_lo(v.x); a[j].y += w * bf_hi(v.x); a[j].z += w * bf_lo(v.y); a[j].w += w * bf_hi(v.y);
            }
        }
#pragma unroll
        for (int j = 0; j < 4; ++j) {
            const int col = j * 256 + lane * 4;
            float* op = p.out + (size_t)tok * 1024 + col;
            const f32x4 x1 = *(const f32x4*)op, g = *(const f32x4*)(g2 + col);
            f32x4 o; o.x = x1.x + g.x * a[j].x; o.y = x1.y + g.y * a[j].y; o.z = x1.z + g.z * a[j].z; o.w = x1.w + g.w * a[j].w;
            *(f32x4*)op = o;
        }
    }
}

#define XB_TMO      128
#define XB_XCNT(j)  (256  + 64 * (j))
#define XB_XSUB(j)  (1280 + 64 * (j))
#define XB_XGEN(j)  (2304 + 64 * (j))
#define XB_TOP      3328
#define XB_TOPGEN   3392
#define XCD_BAR_WORDS 3456
#define XB_SPIN_CAP (1u << 24)
#define LAS __attribute__((address_space(3)))
__device__ __forceinline__ unsigned xb_ld(unsigned* p)              { return __hip_atomic_load(p, __ATOMIC_RELAXED, __HIP_MEMORY_SCOPE_AGENT); }
__device__ __forceinline__ unsigned xb_add(unsigned* p, unsigned v) { return __hip_atomic_fetch_add(p, v, __ATOMIC_RELAXED, __HIP_MEMORY_SCOPE_AGENT); }
__device__ __forceinline__ unsigned xb_xcc_id() { return (unsigned)__builtin_amdgcn_s_getreg((3 << 11) | 20) & 0xFu; }
#define XB_SPIN(cond, bar) do { unsigned _sp = 0; while (cond) { __builtin_amdgcn_s_sleep(1); \
    if ((++_sp & 255u) == 0u) { if (xb_ld(&(bar)[XB_TMO])) break; if (_sp > XB_SPIN_CAP) { atomicAdd(&(bar)[XB_TMO], 1u); break; } } } } while (0)
struct XcdBarrier { unsigned* bar; unsigned x; volatile LAS unsigned* st; };
__device__ __forceinline__ XcdBarrier xcd_barrier_post(unsigned* bar, volatile LAS unsigned* st) {
    XcdBarrier b; b.bar = bar; b.x = xb_xcc_id(); b.st = st;
    if (threadIdx.x == 0) (void)xb_add(&bar[XB_XCNT(b.x)], 1u);
    return b;
}
__device__ __forceinline__ void xcd_barrier_complete(unsigned* bar, unsigned x, unsigned& nloc, unsigned& nx) {
    const unsigned G = gridDim.x * gridDim.y * gridDim.z;
    unsigned sum, cnt, mine, sp = 0u;
    for (;;) {
        sum = 0u; cnt = 0u; mine = 0u;
#pragma unroll
        for (unsigned j = 0; j < 16; ++j) { const unsigned c = xb_ld(&bar[XB_XCNT(j)]); sum += c; cnt += (c > 0u) ? 1u : 0u; mine = (j == x) ? c : mine; }
        if (sum == G) break;
        __builtin_amdgcn_s_sleep(1);
        if ((++sp & 255u) == 0u) { if (xb_ld(&bar[XB_TMO])) break; if (sp > XB_SPIN_CAP) { atomicAdd(&bar[XB_TMO], 1u); break; } }
    }
    nloc = mine > 0u ? mine : 1u; nx = cnt > 0u ? cnt : 1u;
}
__device__ __forceinline__ void xcd_barrier(const XcdBarrier& b) {
    asm volatile("s_waitcnt vmcnt(0)" ::: "memory");
    __syncthreads();
    if (threadIdx.x == 0) {
        unsigned* bar = b.bar;
        __builtin_amdgcn_s_waitcnt(0);
        unsigned nloc = b.st[0], nx = b.st[1];
        if (nloc == 0u) { xcd_barrier_complete(bar, b.x, nloc, nx); b.st[0] = nloc; b.st[1] = nx; }
        const unsigned old = xb_add(&bar[XB_XSUB(b.x)], 1u);
        const unsigned gen = old / nloc;
        if (old + 1u == (gen + 1u) * nloc) {
            __builtin_amdgcn_fence(__ATOMIC_RELEASE, "agent");
            asm volatile("s_waitcnt vmcnt(0)" ::: "memory");
            const unsigned og = xb_add(&bar[XB_TOP], 1u);
            const unsigned tg = og / nx;
            if (og + 1u == (tg + 1u) * nx) xb_add(&bar[XB_TOPGEN], 1u);
            else XB_SPIN(xb_ld(&bar[XB_TOPGEN]) == tg, bar);
            __builtin_amdgcn_fence(__ATOMIC_ACQUIRE, "agent");
            xb_add(&bar[XB_XGEN(b.x)], 1u);
            asm volatile("s_waitcnt vmcnt(0)" ::: "memory");
        } else {
            XB_SPIN(xb_ld(&bar[XB_XGEN(b.x)]) == gen, bar);
            __builtin_amdgcn_fence(__ATOMIC_ACQUIRE, "agent");
            asm volatile("s_waitcnt vmcnt(0)" ::: "memory");
        }
    }
    __syncthreads();
}

__global__ void __launch_bounds__(256, 2) mega(Params p) {
    extern __shared__ __attribute__((aligned(16))) unsigned char smem[];
    cg::grid_group grid = cg::this_grid();
    if (p.ph_lo < 0) grid.sync();
    volatile LAS unsigned* xst = (volatile LAS unsigned*)(smem + 77808);
    if (threadIdx.x == 0) { xst[0] = 0u; xst[1] = 0u; }
    __syncthreads();
    const XcdBarrier xb = xcd_barrier_post((unsigned*)(p.ws + OFF_BAR), xst);
#define GSYNC() xcd_barrier(xb)
#define PHASE_BEGIN(k) if (p.ph_lo <= (k) && (k) < p.ph_hi) {
#define PHASE_END(k) if ((k) + 1 < p.ph_hi) GSYNC(); }
    PHASE_BEGIN(0) phase_ada(p, smem); if (DUP_PHASE == 0) { GSYNC(); phase_ada(p, smem); } PHASE_END(0)
    PHASE_BEGIN(1) phase_norm(p, smem, false); if (DUP_PHASE == 1) { GSYNC(); phase_norm(p, smem, false); } PHASE_END(1)
    PHASE_BEGIN(2) phase_inproj(p, smem); if (DUP_PHASE == 2) { GSYNC(); phase_inproj(p, smem); } PHASE_END(2)
    PHASE_BEGIN(3)
        for (int it = blockIdx.x; it < 2080 + 4096; it += gridDim.x) { if (it < 2080) mlstm_passA(p, smem, it); else na_item(p, smem, it - 2080); }
        if (DUP_PHASE == 3) { GSYNC(); for (int it = blockIdx.x; it < 2080; it += gridDim.x) mlstm_passA(p, smem, it); }
        if (DUP_PHASE == 30) { GSYNC(); for (int it = blockIdx.x; it < 4096; it += gridDim.x) na_item(p, smem, it); }
    PHASE_END(3)
    PHASE_BEGIN(4) phase_scan(p, smem); if (DUP_PHASE == 34) { GSYNC(); for (int it = blockIdx.x; it < 2080; it += gridDim.x) mlstm_passA(p, smem, it); GSYNC(); phase_scan(p, smem); } PHASE_END(4)
    PHASE_BEGIN(5) for (int it = blockIdx.x; it < 2048; it += gridDim.x) mlstm_passC(p, smem, it); if (DUP_PHASE == 5) { GSYNC(); for (int it = blockIdx.x; it < 2048; it += gridDim.x) mlstm_passC(p, smem, it); } PHASE_END(5)
    PHASE_BEGIN(6) phase_merge(p, smem, false); phase_merge(p, smem, true); if (DUP_PHASE == 6) { GSYNC(); phase_merge(p, smem, false); phase_merge(p, smem, true); } PHASE_END(6)
    PHASE_BEGIN(7) phase_outproj(p, smem); if (DUP_PHASE == 7) { GSYNC(); phase_outproj(p, smem); } PHASE_END(7)
    PHASE_BEGIN(8) phase_norm(p, smem, true); if (DUP_PHASE == 8) { GSYNC(); phase_norm(p, smem, true); } PHASE_END(8)
    PHASE_BEGIN(9) phase_router(p, smem); if (DUP_PHASE == 9) { GSYNC(); phase_router(p, smem); } PHASE_END(9)
    PHASE_BEGIN(10) phase_route(p, smem); PHASE_END(10)
    PHASE_BEGIN(11) phase_assign(p, smem); PHASE_END(11)
    PHASE_BEGIN(12) phase_moe1(p, smem); if (DUP_PHASE == 12) { GSYNC(); phase_moe1(p, smem); } PHASE_END(12)
    PHASE_BEGIN(13) phase_moe2(p, smem); if (DUP_PHASE == 13) { GSYNC(); phase_moe2(p, smem); } PHASE_END(13)
    PHASE_BEGIN(14) phase_combine(p, smem);
        if (DUP_PHASE == 200) { for (int q = 0; q < 20; ++q) GSYNC(); }
        if (DUP_PHASE == 100) { GSYNC(); phase_route(p, smem); GSYNC(); phase_assign(p, smem); }
    PHASE_END(14)
#if RUN_PHASES < 8
    if (!MULTI_LAUNCH) GSYNC();
    if (p.ph_lo == 100 || !MULTI_LAUNCH) {
        const size_t NOUT = (size_t)NTOK * 1024;
        for (size_t i = (size_t)blockIdx.x * 256 + threadIdx.x; i < NOUT; i += (size_t)gridDim.x * 256) {
            float s = 0.f;
#define TAPB(off, n) { const u16* bb_ = (const u16*)(p.ws + (off)); for (size_t j = i; j < (size_t)(n); j += NOUT) s += bf2f(bb_[j]); }
#define TAPF(off, n) { const float* bb_ = (const float*)(p.ws + (off)); for (size_t j = i; j < (size_t)(n); j += NOUT) s += bb_[j]; }
#if RUN_PHASES == 1
            TAPF(OFF_MODP, 8 * 3 * 6144)
#elif RUN_PHASES == 2
            TAPB(OFF_H, (size_t)MTOT * 1024)
#elif RUN_PHASES == 3
            { const u16* bb_ = (const u16*)(p.ws + OFF_P); for (size_t j = i; j < (size_t)MTOT * 1024; j += NOUT) s += bf2f(bb_[(j / 1024) * PV + TAPC0 + (j % 1024)]); }
#elif RUN_PHASES == 4
            TAPB(OFF_YNA, (size_t)NTOK * 512) TAPB(OFF_CT, (size_t)NSLOT * 32768) TAPF(OFF_DN, NSLOT * 128) TAPF(OFF_GS, NSLOT) TAPF(OFF_ML, NSLOT)
#elif RUN_PHASES == 5
            TAPB(OFF_CT, (size_t)NSLOT * 32768) TAPF(OFF_DN, NSLOT * 128) TAPF(OFF_MP, NSLOT)
#elif RUN_PHASES == 6
            TAPB(OFF_YM, (size_t)NTOK * 1024)
#elif RUN_PHASES == 7
            TAPB(OFF_MRG, (size_t)NTOK * 1024)
#endif
            p.out[i] = p.x[i] + s;
        }
    }
#endif
}

extern "C" void kernel_launch(void* const* d_in, const int* in_sizes, int n_in, void* d_out, int out_size, void* d_ws, size_t ws_size, hipStream_t stream) {
    static int grid_blocks = 0;
    if (!grid_blocks) {
        int dev = 0, cus = 0, per_cu = 0;
        (void)hipGetDevice(&dev);
        (void)hipDeviceGetAttribute(&cus, hipDeviceAttributeMultiprocessorCount, dev);
        (void)hipFuncSetAttribute((const void*)mega, hipFuncAttributeMaxDynamicSharedMemorySize, LDS_BYTES);
        (void)hipOccupancyMaxActiveBlocksPerMultiprocessor(&per_cu, mega, 256, LDS_BYTES);
        if (per_cu > 2) per_cu = 2;
        if (per_cu < 1) per_cu = 1;
        grid_blocks = cus * per_cu;
        if (ws_size < WS_END) fprintf(stderr, "kernel_launch: workspace too small: %zu < %zu\n", ws_size, (size_t)WS_END);
    }
    (void)hipMemsetAsync((char*)d_ws + OFF_BAR, 0, XCD_BAR_WORDS * 4, stream);
    Params p{};
    const float** pp = (const float**)&p;
    for (int i = 0; i < 23; ++i) pp[i] = (const float*)d_in[i];
    p.out = (float*)d_out; p.ws = (unsigned char*)d_ws;
#if MULTI_LAUNCH
    for (int ph = 0; ph < (RUN_PHASES < 1 ? 1 : (RUN_PHASES < NPH ? RUN_PHASES : NPH)); ++ph) {
        p.ph_lo = ph; p.ph_hi = ph + 1;
        void* args[] = {&p};
        hipError_t e = hipLaunchCooperativeKernel((void*)mega, dim3(grid_blocks), dim3(256), args, LDS_BYTES, stream);
        if (e != hipSuccess) fprintf(stderr, "cooperative launch failed: %s (grid %d)\n", hipGetErrorString(e), grid_blocks);
    }
#if RUN_PHASES < 8
    { p.ph_lo = 100; p.ph_hi = 100; void* args[] = {&p};
      (void)hipLaunchCooperativeKernel((void*)mega, dim3(grid_blocks), dim3(256), args, LDS_BYTES, stream); }
#endif
#else
    p.ph_lo = 0; p.ph_hi = RUN_PHASES < NPH ? RUN_PHASES : NPH;
    void* args[] = {&p};
    hipError_t e = hipLaunchCooperativeKernel((void*)mega, dim3(grid_blocks), dim3(256), args, LDS_BYTES, stream);
    if (e != hipSuccess) fprintf(stderr, "cooperative launch failed: %s (grid %d)\n", hipGetErrorString(e), grid_blocks);
#endif
}
```

```cpp
#include <hip/hip_runtime.h>
#include <hip/hip_cooperative_groups.h>
#include <cstdio>
#include <cstdint>
namespace cg = cooperative_groups;

#ifndef MULTI_LAUNCH
#define MULTI_LAUNCH 0
#endif
#ifndef DUP_PHASE
#define DUP_PHASE -1
#endif

typedef unsigned short u16;
typedef unsigned int u32;
typedef short bf16x8 __attribute__((ext_vector_type(8)));
typedef float f32x16 __attribute__((ext_vector_type(16)));
typedef float f32x4 __attribute__((ext_vector_type(4)));
typedef u32 u32x4 __attribute__((ext_vector_type(4)));
typedef u32 u32x2 __attribute__((ext_vector_type(2)));

constexpr int DM = 1024;
constexpr int NTOK = 32768;
constexpr int TSEQ = 16384;
constexpr int MTOT = 33280;
constexpr int INC = 6672;
constexpr int PV = 6784;
constexpr int V_MQ = 0, V_MK = 512, V_MV = 1024, V_MO = 2048, V_NQ = 3072, V_NK = 3584, V_NV = 4096, V_GM = 4608, V_GN = 5632;
constexpr int NSLOT = 4160;
constexpr int SH_BASE = 294912;
constexpr int NPH = 15;
constexpr int LDS_BYTES = 76 * 1024;
constexpr int LDT = 72;
constexpr int LDQ = 136;

constexpr size_t AL(size_t x) { return (x + 255) & ~(size_t)255; }
constexpr size_t OFF_MODP = 0;
constexpr size_t OFF_CNT  = AL(OFF_MODP + (size_t)8 * 3 * 6144 * 4);
constexpr size_t OFF_G    = AL(OFF_CNT + 1024);
constexpr size_t OFF_GS   = AL(OFF_G + (size_t)MTOT * 16 * 4);
constexpr size_t OFF_ML   = AL(OFF_GS + NSLOT * 4);
constexpr size_t OFF_MP   = AL(OFF_ML + NSLOT * 4);
constexpr size_t OFF_DN   = AL(OFF_MP + NSLOT * 4);
constexpr size_t OFF_TOPE = AL(OFF_DN + (size_t)NSLOT * 128 * 4);
constexpr size_t OFF_RANK = OFF_TOPE + (size_t)NTOK * 8 * 4;
constexpr size_t OFF_TOPW = OFF_RANK + (size_t)NTOK * 8 * 4;
constexpr size_t OFF_H    = AL(OFF_TOPW + (size_t)NTOK * 8 * 4);
constexpr size_t OFF_SLOT = AL(OFF_H + (size_t)MTOT * 1024 * 2);
constexpr size_t OFF_R4   = AL(OFF_SLOT + (size_t)256 * 32768 * 4);
constexpr size_t OFF_YNA  = OFF_R4;
constexpr size_t OFF_YM   = OFF_R4 + (size_t)NTOK * 512 * 2;
constexpr size_t OFF_MRG  = OFF_YM + (size_t)NTOK * 1024 * 2;
constexpr size_t OFF_SC   = OFF_R4;
constexpr size_t OFF_HID  = OFF_R4;
constexpr size_t OFF_P    = AL(OFF_R4 + (size_t)327680 * 256 * 2);
constexpr size_t OFF_CT   = AL(OFF_P + (size_t)MTOT * PV * 2);
constexpr size_t OFF_Y    = OFF_P;
constexpr size_t OFF_WINT = AL(OFF_CT + (size_t)NSLOT * 65536);
constexpr size_t OFF_BRMT = AL(OFF_WINT + (size_t)6912 * 1024 * 2);
constexpr size_t OFF_BRNT = AL(OFF_BRMT + (size_t)1024 * 1024 * 2);
constexpr size_t OFF_OUTT = AL(OFF_BRNT + (size_t)1024 * 512 * 2);
constexpr size_t OFF_RTT  = AL(OFF_OUTT + (size_t)1024 * 1024 * 2);
constexpr size_t OFF_HIST = AL(OFF_RTT + (size_t)256 * 1024 * 2);
constexpr size_t OFF_BAR  = AL(OFF_HIST + (size_t)1024 * 256 * 4);
constexpr size_t WS_END   = OFF_BAR + 16384;
static_assert(OFF_Y + (size_t)327680 * 1024 * 2 <= OFF_WINT, "Y must fit over P+CT");
static_assert(WS_END <= (size_t)1073741824, "workspace budget");

struct Params {
    const float *x, *c, *ctx, *c_ctx, *w_ada, *b_ada, *w_in, *b_mgate, *m_norm_w, *na_qn_w, *na_kn_w, *na_rpb,
                *w_br_m, *w_br_na, *w_out, *w_router, *router_bias, *w_exp_gate, *w_exp_up, *w_exp_down,
                *w_sh_gate, *w_sh_up, *w_sh_down;
    float* out;
    unsigned char* ws;
    int ph_lo, ph_hi;
};

typedef __bf16 bf16x2_t __attribute__((ext_vector_type(2)));
__device__ __forceinline__ u32 pk2(float lo, float hi) { bf16x2_t v = {(__bf16)lo, (__bf16)hi}; return __builtin_bit_cast(u32, v); }
__device__ __forceinline__ u16 f2bf(float f) { return (u16)(pk2(f, 0.f) & 0xffffu); }
__device__ __forceinline__ float bf2f(u16 h) { return __uint_as_float(((u32)h) << 16); }
__device__ __forceinline__ float bf_lo(u32 w) { return __uint_as_float(w << 16); }
__device__ __forceinline__ float bf_hi(u32 w) { return __uint_as_float(w & 0xffff0000u); }
__device__ __forceinline__ float sigmoid_(float x) { return 1.f / (1.f + __expf(-x)); }
__device__ __forceinline__ float log_sigmoid_(float x) { return fminf(x, 0.f) - __logf(1.f + __expf(-fabsf(x))); }
__device__ __forceinline__ f32x4 mfma16(bf16x8 a, bf16x8 b, f32x4 c) { return __builtin_amdgcn_mfma_f32_16x16x32_bf16(a, b, c, 0, 0, 0); }
__device__ __forceinline__ f32x16 mfma32(bf16x8 a, bf16x8 b, f32x16 c) { return __builtin_amdgcn_mfma_f32_32x32x16_bf16(a, b, c, 0, 0, 0); }

__device__ __forceinline__ void sincos_rev(float rev, float& sn, float& cs) {
    rev -= rintf(rev);
    const float kq = rintf(rev * 4.f);
    const float th = (rev - kq * 0.25f) * 6.283185307179586f;
    const float t2 = th * th;
    const float s = th * (1.f + t2 * (-1.f / 6.f + t2 * (1.f / 120.f + t2 * (-1.f / 5040.f + t2 * (1.f / 362880.f)))));
    const float c = 1.f + t2 * (-0.5f + t2 * (1.f / 24.f + t2 * (-1.f / 720.f + t2 * (1.f / 40320.f))));
    const int k = ((int)kq) & 3;
    sn = (k == 0) ? s : (k == 1) ? c : (k == 2) ? -s : -c;
    cs = (k == 0) ? c : (k == 1) ? -s : (k == 2) ? -c : s;
}
__device__ __forceinline__ int opaque_tid() { int t = threadIdx.x; asm volatile("" : "+v"(t)); return t; }
__device__ __forceinline__ float wave_sum(float v) {
#pragma unroll
    for (int o = 1; o < 64; o <<= 1) v += __shfl_xor(v, o);
    return v;
}
__device__ __forceinline__ float wave_max(float v) {
#pragma unroll
    for (int o = 1; o < 64; o <<= 1) v = fmaxf(v, __shfl_xor(v, o));
    return v;
}
__device__ __forceinline__ float wave_incl_sum(float v, int lane) {
#pragma unroll
    for (int o = 1; o < 64; o <<= 1) { float t = __shfl_up(v, o); if (lane >= o) v += t; }
    return v;
}
__device__ __forceinline__ float wave_prefix_max(float v, int lane) {
#pragma unroll
    for (int o = 1; o < 64; o <<= 1) { float t = __shfl_up(v, o); if (lane >= o) v = fmaxf(v, t); }
    return v;
}
__device__ __forceinline__ float wave_suffix_max(float v, int lane) {
#pragma unroll
    for (int o = 1; o < 64; o <<= 1) { float t = __shfl_down(v, o); if (lane + o < 64) v = fmaxf(v, t); }
    return v;
}
__device__ __forceinline__ float mod_val(const Params& p, int vec, int j) {
    const float* mp = (const float*)(p.ws + OFF_MODP);
    float s = p.b_ada[j];
#pragma unroll
    for (int ks = 0; ks < 8; ++ks) s += mp[(ks * 3 + vec) * 6144 + j];
    return s;
}
__device__ __forceinline__ u32x4 tr8(const u32x2 (&v)[8], int cc) {
    u32x4 o;
    if (cc == 0)      { o.x = (v[0].x & 0xffffu) | (v[1].x << 16); o.y = (v[2].x & 0xffffu) | (v[3].x << 16); o.z = (v[4].x & 0xffffu) | (v[5].x << 16); o.w = (v[6].x & 0xffffu) | (v[7].x << 16); }
    else if (cc == 1) { o.x = (v[0].x >> 16) | (v[1].x & 0xffff0000u); o.y = (v[2].x >> 16) | (v[3].x & 0xffff0000u); o.z = (v[4].x >> 16) | (v[5].x & 0xffff0000u); o.w = (v[6].x >> 16) | (v[7].x & 0xffff0000u); }
    else if (cc == 2) { o.x = (v[0].y & 0xffffu) | (v[1].y << 16); o.y = (v[2].y & 0xffffu) | (v[3].y << 16); o.z = (v[4].y & 0xffffu) | (v[5].y << 16); o.w = (v[6].y & 0xffffu) | (v[7].y << 16); }
    else              { o.x = (v[0].y >> 16) | (v[1].y & 0xffff0000u); o.y = (v[2].y >> 16) | (v[3].y & 0xffff0000u); o.z = (v[4].y >> 16) | (v[5].y & 0xffff0000u); o.w = (v[6].y >> 16) | (v[7].y & 0xffff0000u); }
    return o;
}
__device__ __forceinline__ float bfsel(const u32x2& v, int cc) { return cc == 0 ? bf_lo(v.x) : cc == 1 ? bf_hi(v.x) : cc == 2 ? bf_lo(v.y) : bf_hi(v.y); }

__device__ __forceinline__ void gemm_core2(f32x16 (&acc)[2][2], const u16* a0, const size_t a32, const u16* b0, const size_t b32, const int nk,
                                           unsigned char* smem, const int tid, const int lane, const int wr, const int wc) {
    typedef __attribute__((address_space(3))) unsigned lds_u32;
    const int r = lane & 31, hh = lane >> 5;
    {
        unsigned char* sa = smem + tid * 16;
#pragma unroll
        for (int i = 0; i < 4; ++i) {
            __builtin_amdgcn_global_load_lds((const unsigned*)(a0 + i * a32), (lds_u32*)(sa + i * 4096), 16, 0, 0);
            __builtin_amdgcn_global_load_lds((const unsigned*)(b0 + i * b32), (lds_u32*)(sa + 16384 + i * 4096), 16, 0, 0);
        }
    }
    for (int kt = 0; kt < nk; ++kt) {
        __syncthreads();
        if (kt + 1 < nk) {
            unsigned char* sa = smem + ((kt + 1) & 1) * 32768 + tid * 16;
            const u16* ap = a0 + (kt + 1) * 64; const u16* bp = b0 + (kt + 1) * 64;
#pragma unroll
            for (int i = 0; i < 4; ++i) {
                __builtin_amdgcn_global_load_lds((const unsigned*)(ap + i * a32), (lds_u32*)(sa + i * 4096), 16, 0, 0);
                __builtin_amdgcn_global_load_lds((const unsigned*)(bp + i * b32), (lds_u32*)(sa + 16384 + i * 4096), 16, 0, 0);
            }
        }
        const unsigned char* sa = smem + (kt & 1) * 32768; const unsigned char* sb = sa + 16384;
        __builtin_amdgcn_s_setprio(1);
#pragma unroll
        for (int kk = 0; kk < 4; ++kk) {
            bf16x8 a[2], b[2];
            const int ch = ((kk * 2 + hh) ^ ((r >> 1) & 7)) * 16;
#pragma unroll
            for (int mi = 0; mi < 2; ++mi) a[mi] = *(const bf16x8*)(sa + (wr * 64 + mi * 32 + r) * 128 + ch);
#pragma unroll
            for (int ni = 0; ni < 2; ++ni) b[ni] = *(const bf16x8*)(sb + (wc * 64 + ni * 32 + r) * 128 + ch);
#pragma unroll
            for (int mi = 0; mi < 2; ++mi)
#pragma unroll
                for (int ni = 0; ni < 2; ++ni) acc[mi][ni] = mfma32(b[ni], a[mi], acc[mi][ni]);
        }
        __builtin_amdgcn_s_setprio(0);
    }
}
#define RAW_BARRIER() do { asm volatile("s_waitcnt lgkmcnt(0)" ::: "memory"); __builtin_amdgcn_s_barrier(); } while (0)
__device__ __forceinline__ void gemm_core3(f32x16 (&acc)[2][4], const u16* a0, const size_t a64, const u16* b0, const size_t b64, const int nk,
                                           unsigned char* smem, const int tid, const int lane, const int wr, const int wc) {
    typedef __attribute__((address_space(3))) unsigned lds_u32;
    const int r = lane & 31, hh = lane >> 5;
#pragma unroll
    for (int s = 0; s < 2; ++s) {
        unsigned char* sa = smem + s * 24576 + tid * 16;
#pragma unroll
        for (int i = 0; i < 2; ++i) __builtin_amdgcn_global_load_lds((const unsigned*)(a0 + s * 32 + i * a64), (lds_u32*)(sa + i * 4096), 16, 0, 0);
#pragma unroll
        for (int i = 0; i < 4; ++i) __builtin_amdgcn_global_load_lds((const unsigned*)(b0 + s * 32 + i * b64), (lds_u32*)(sa + 8192 + i * 4096), 16, 0, 0);
    }
    int cur = 0;
    for (int kt = 0; kt < nk; ++kt) {
        if (kt + 1 < nk) asm volatile("s_waitcnt vmcnt(6)" ::: "memory"); else asm volatile("s_waitcnt vmcnt(0)" ::: "memory");
        RAW_BARRIER();
        if (kt + 2 < nk) {
            const int nx = cur == 0 ? 2 : cur - 1;
            unsigned char* sa = smem + nx * 24576 + tid * 16;
            const u16* ap = a0 + (kt + 2) * 32; const u16* bp = b0 + (kt + 2) * 32;
#pragma unroll
            for (int i = 0; i < 2; ++i) __builtin_amdgcn_global_load_lds((const unsigned*)(ap + i * a64), (lds_u32*)(sa + i * 4096), 16, 0, 0);
#pragma unroll
            for (int i = 0; i < 4; ++i) __builtin_amdgcn_global_load_lds((const unsigned*)(bp + i * b64), (lds_u32*)(sa + 8192 + i * 4096), 16, 0, 0);
        }
        const unsigned char* sa = smem + cur * 24576; const unsigned char* sb = sa + 8192;
        __builtin_amdgcn_s_setprio(1);
#pragma unroll
        for (int kk = 0; kk < 2; ++kk) {
            bf16x8 a[2], b[4];
            const int ch = ((kk * 2 + hh) ^ ((r >> 2) & 3)) * 16;
#pragma unroll
            for (int mi = 0; mi < 2; ++mi) a[mi] = *(const bf16x8*)(sa + (wr * 64 + mi * 32 + r) * 64 + ch);
#pragma unroll
            for (int ni = 0; ni < 4; ++ni) b[ni] = *(const bf16x8*)(sb + (wc * 128 + ni * 32 + r) * 64 + ch);
#pragma unroll
            for (int mi = 0; mi < 2; ++mi)
#pragma unroll
                for (int ni = 0; ni < 4; ++ni) acc[mi][ni] = mfma32(b[ni], a[mi], acc[mi][ni]);
        }
        __builtin_amdgcn_s_setprio(0);
        cur = cur == 2 ? 0 : cur + 1;
    }
}
constexpr int CT3_LD = 264;
__device__ __forceinline__ void ct_write3(u16* Ct, const f32x16 (&v)[2][4], const int wr, const int wc, const int lane) {
    const int r = lane & 31, hh = lane >> 5;
#pragma unroll
    for (int mi = 0; mi < 2; ++mi)
#pragma unroll
        for (int ni = 0; ni < 4; ++ni) {
            u16* base = Ct + (wr * 64 + mi * 32 + r) * CT3_LD + wc * 128 + ni * 32 + 4 * hh;
#pragma unroll
            for (int g = 0; g < 4; ++g) {
                u32x2 w; w.x = pk2(v[mi][ni][4 * g], v[mi][ni][4 * g + 1]); w.y = pk2(v[mi][ni][4 * g + 2], v[mi][ni][4 * g + 3]);
                *(u32x2*)(base + 8 * g) = w;
            }
        }
}
__device__ __forceinline__ bool sched_tile(const int i, const int ntm, const int ntn, const int W, int& mt, int& nt) {
    const int nx = gridDim.x >> 3;
    const int o = ((blockIdx.x & 7) + 8 * i) * nx + (blockIdx.x >> 3);
    if (o >= ntm * ntn) return false;
    const int full = ntn / W, fo = full * W * ntm;
    if (o < fo) { const int G = o / (W * ntm), rem = o - G * (W * ntm); mt = rem / W; nt = G * W + (rem - mt * W); }
    else { const int W2 = ntn - full * W, rem = o - fo; mt = rem / W2; nt = full * W + (rem - mt * W2); }
    return true;
}
__device__ __forceinline__ void conv_item(const float* W, const int ldw, const int k0, const int nreal0, u16* WT, const int K, const int nvirt0, float* T, const int tid) {
    const int kr = tid >> 4, c4 = tid & 15;
#pragma unroll
    for (int ps = 0; ps < 4; ++ps) {
        const int k = ps * 16 + kr;
        const f32x4 v = *(const f32x4*)(W + (size_t)(k0 + k) * ldw + nreal0 + c4 * 4);
        T[k * 65 + c4 * 4 + 0] = v.x; T[k * 65 + c4 * 4 + 1] = v.y; T[k * 65 + c4 * 4 + 2] = v.z; T[k * 65 + c4 * 4 + 3] = v.w;
    }
    __syncthreads();
    const int n = tid >> 2, kq = tid & 3;
    u32x4 o0, o1;
    const float* t = T + (kq * 16) * 65 + n;
    o0.x = pk2(t[0 * 65], t[1 * 65]); o0.y = pk2(t[2 * 65], t[3 * 65]); o0.z = pk2(t[4 * 65], t[5 * 65]); o0.w = pk2(t[6 * 65], t[7 * 65]);
    o1.x = pk2(t[8 * 65], t[9 * 65]); o1.y = pk2(t[10 * 65], t[11 * 65]); o1.z = pk2(t[12 * 65], t[13 * 65]); o1.w = pk2(t[14 * 65], t[15 * 65]);
    u16* dst = WT + (size_t)(nvirt0 + n) * K + k0 + kq * 16;
    *(u32x4*)dst = o0; *(u32x4*)(dst + 8) = o1;
    __syncthreads();
}
#define ACC_COL(reg) (((reg) & 3) + 8 * ((reg) >> 2))
#define ACC_ROW(mi, reg) ((mi) * 32 + ((reg) & 3) + 8 * ((reg) >> 2))
constexpr int CT_LD = 136;
__device__ __forceinline__ void ct_write(u16* Ct, const f32x16 (&v)[2][2], const int wr, const int wc, const int lane) {
    const int r = lane & 31, hh = lane >> 5;
#pragma unroll
    for (int mi = 0; mi < 2; ++mi)
#pragma unroll
        for (int ni = 0; ni < 2; ++ni) {
            u16* base = Ct + (wr * 64 + mi * 32 + r) * CT_LD + wc * 64 + ni * 32 + 4 * hh;
#pragma unroll
            for (int g = 0; g < 4; ++g) {
                u32x2 w; w.x = pk2(v[mi][ni][4 * g], v[mi][ni][4 * g + 1]); w.y = pk2(v[mi][ni][4 * g + 2], v[mi][ni][4 * g + 3]);
                *(u32x2*)(base + 8 * g) = w;
            }
        }
}
__device__ __forceinline__ void ct_store(const u16* Ct, u16* dst, const size_t ldd, const int tid) {
#pragma unroll
    for (int i = 0; i < 8; ++i) {
        const int idx = tid + i * 256, row = idx >> 4, ch = idx & 15;
        *(u32x4*)(dst + (size_t)row * ldd + ch * 8) = *(const u32x4*)(Ct + row * CT_LD + ch * 8);
    }
}

__device__ __forceinline__ void phase_ada(const Params& p, unsigned char* smem) {
    const int tid = opaque_tid();
    float* red = (float*)smem;
    float* mp = (float*)(p.ws + OFF_MODP);
    for (int it = blockIdx.x; it < 192; it += gridDim.x) {
        const int cb = it % 24, ks = it / 24, cq = tid & 63, kq = tid >> 6;
        float a0[4] = {0, 0, 0, 0}, a1[4] = {0, 0, 0, 0}, a2[4] = {0, 0, 0, 0};
        for (int kk = 0; kk < 32; ++kk) {
            const int k = ks * 128 + kq * 32 + kk;
            const f32x4 w = *(const f32x4*)(p.w_ada + (size_t)k * 6144 + cb * 256 + cq * 4);
            float c0 = p.c[k], c1 = p.c[1024 + k], c2 = p.c_ctx[k];
            c0 *= sigmoid_(c0); c1 *= sigmoid_(c1); c2 *= sigmoid_(c2);
#pragma unroll
            for (int j = 0; j < 4; ++j) { a0[j] += c0 * w[j]; a1[j] += c1 * w[j]; a2[j] += c2 * w[j]; }
        }
#pragma unroll
        for (int j = 0; j < 4; ++j) { red[(kq * 3 + 0) * 256 + cq * 4 + j] = a0[j]; red[(kq * 3 + 1) * 256 + cq * 4 + j] = a1[j]; red[(kq * 3 + 2) * 256 + cq * 4 + j] = a2[j]; }
        __syncthreads();
#pragma unroll
        for (int v = 0; v < 3; ++v) {
            const float s = (red[(0 * 3 + v) * 256 + tid] + red[(1 * 3 + v) * 256 + tid]) + (red[(2 * 3 + v) * 256 + tid] + red[(3 * 3 + v) * 256 + tid]);
            mp[(ks * 3 + v) * 6144 + cb * 256 + tid] = s;
        }
        __syncthreads();
    }
    for (int it = blockIdx.x; it < 2400; it += gridDim.x) {
        if (it < 1696) {
            const int nb = it >> 4, kb = it & 15, nv = nb * 64;
            const int nr = nv < 3072 ? nv : (nv < 6656 ? nv + 16 : 3072 + (nv - 6656));
            conv_item(p.w_in, INC, kb * 64, nr, (u16*)(p.ws + OFF_WINT), 1024, nv, red, tid);
        } else if (it < 1952) { const int q = it - 1696; conv_item(p.w_br_m, 1024, (q & 15) * 64, (q >> 4) * 64, (u16*)(p.ws + OFF_BRMT), 1024, (q >> 4) * 64, red, tid); }
        else if (it < 2080) { const int q = it - 1952; conv_item(p.w_br_na, 1024, (q & 7) * 64, (q >> 3) * 64, (u16*)(p.ws + OFF_BRNT), 512, (q >> 3) * 64, red, tid); }
        else if (it < 2336) { const int q = it - 2080; conv_item(p.w_out, 1024, (q & 15) * 64, (q >> 4) * 64, (u16*)(p.ws + OFF_OUTT), 1024, (q >> 4) * 64, red, tid); }
        else { const int q = it - 2336; conv_item(p.w_router, 256, (q & 15) * 64, (q >> 4) * 64, (u16*)(p.ws + OFF_RTT), 1024, (q >> 4) * 64, red, tid); }
    }
}

__device__ __forceinline__ void phase_norm(const Params& p, unsigned char* smem, const bool second) {
    const int tid = opaque_tid(), lane = tid & 63, wid = tid >> 6;
    float* tsh = (float*)smem; float* tsc = tsh + 1024;
    u16* H = (u16*)(p.ws + OFF_H);
    const int nrows = second ? NTOK : MTOT;
    const int rpb = (nrows + gridDim.x - 1) / gridDim.x;
    const int r0 = blockIdx.x * rpb, r1 = min(r0 + rpb, nrows);
    const int sh_off = second ? 3072 : 0, sc_off = second ? 4096 : 1024;
    for (int vec = 0; vec < 3; ++vec) {
        const int vlo = vec == 0 ? 0 : (vec == 1 ? TSEQ : NTOK), vhi = vec == 0 ? TSEQ : (vec == 1 ? NTOK : MTOT);
        const int lo = max(r0, vlo), hi = min(r1, vhi);
        if (lo >= hi) continue;
        for (int j = tid; j < 1024; j += 256) { tsh[j] = mod_val(p, vec, sh_off + j); tsc[j] = 1.f + mod_val(p, vec, sc_off + j); }
        __syncthreads();
        for (int row = lo + wid; row < hi; row += 4) {
            const float* src = second ? (p.out + (size_t)row * 1024) : (row < NTOK ? p.x + (size_t)row * 1024 : p.ctx + (size_t)(row - NTOK) * 1024);
            f32x4 v[4]; float ss = 0.f;
#pragma unroll
            for (int j = 0; j < 4; ++j) { v[j] = *(const f32x4*)(src + j * 256 + lane * 4); ss += (v[j].x * v[j].x + v[j].y * v[j].y) + (v[j].z * v[j].z + v[j].w * v[j].w); }
            ss = wave_sum(ss);
            const float rstd = rsqrtf(ss * (1.f / 1024.f) + 1e-6f);
#pragma unroll
            for (int j = 0; j < 4; ++j) {
                const int k = j * 256 + lane * 4;
                const f32x4 sc = *(const f32x4*)(tsc + k), sh = *(const f32x4*)(tsh + k);
                u32x2 o; o.x = pk2(v[j].x * rstd * sc.x + sh.x, v[j].y * rstd * sc.y + sh.y); o.y = pk2(v[j].z * rstd * sc.z + sh.z, v[j].w * rstd * sc.w + sh.w);
                *(u32x2*)(H + (size_t)row * 1024 + k) = o;
            }
        }
        __syncthreads();
    }
}

__device__ __forceinline__ void phase_inproj(const Params& p, unsigned char* smem) {
    const u16* H = (const u16*)(p.ws + OFF_H);
    u16* P = (u16*)(p.ws + OFF_P); float* G = (float*)(p.ws + OFF_G);
    const int tid = opaque_tid(), lane = tid & 63, wid = tid >> 6, wr = wid >> 1, wc = wid & 1;
    const int r = lane & 31, hh = lane >> 5;
    const u16* WT = (const u16*)(p.ws + OFF_WINT);
    const int sw = ((tid & 7) ^ ((tid >> 4) & 7)) * 8;
    for (int ti = 0;; ++ti) {
        int mt, nt;
        if (!sched_tile(ti, 260, 53, 8, mt, nt)) break;
        f32x16 acc[2][2] = {};
        gemm_core2(acc, H + (size_t)(mt * 128 + (tid >> 3)) * 1024 + sw, 32 * 1024, WT + (size_t)(nt * 128 + (tid >> 3)) * 1024 + sw, 32 * 1024, 16, smem, tid, lane, wr, wc);
        if (nt < 8) {
            const float scale = nt < 4 ? 0.08838834764831845f : 1.f;
            const bool latent = mt < 256;
#pragma unroll
            for (int mi = 0; mi < 2; ++mi) {
                const int t = (mt * 128 + wr * 64 + mi * 32 + r) & (TSEQ - 1);
                const float posr = (float)(wc == 0 ? (t >> 6) : (t & 63)) * 0.15915494309189535f;
#pragma unroll
                for (int reg = 0; reg < 16; ++reg) {
                    float x1 = acc[mi][0][reg] * scale, x2 = acc[mi][1][reg] * scale;
                    if (latent) {
                        const float inv = exp2f(-(float)(ACC_COL(reg) + 4 * hh) * (13.287712379549449f / 32.f));
                        float sn, cs; sincos_rev(posr * inv, sn, cs);
                        float a = x1 * cs; asm volatile("" : "+v"(a), "+v"(x1), "+v"(x2));
                        float o1 = fmaf(-x2, sn, a); asm volatile("" : "+v"(o1), "+v"(x1), "+v"(x2));
                        float bq = x1 * sn; asm volatile("" : "+v"(bq), "+v"(x2));
                        float o2 = fmaf(x2, cs, bq); asm volatile("" : "+v"(o2));
                        x1 = o1; x2 = o2;
                    }
                    acc[mi][0][reg] = x1; acc[mi][1][reg] = x2;
                }
            }
        } else if (nt >= 24 && nt < 32) {
            const float* nw = nt < 28 ? p.na_qn_w : p.na_kn_w;
            const float sc = nt < 28 ? 0.125f : 1.f;
#pragma unroll
            for (int mi = 0; mi < 2; ++mi) {
                float s = 0.f;
#pragma unroll
                for (int ni = 0; ni < 2; ++ni)
#pragma unroll
                    for (int reg = 0; reg < 16; ++reg) s += acc[mi][ni][reg] * acc[mi][ni][reg];
                s += __shfl_xor(s, 32);
                const float rstd = rsqrtf(s * (1.f / 64.f) + 1e-6f) * sc;
#pragma unroll
                for (int ni = 0; ni < 2; ++ni)
#pragma unroll
                    for (int reg = 0; reg < 16; ++reg) acc[mi][ni][reg] *= rstd * nw[ni * 32 + ACC_COL(reg) + 4 * hh];
            }
        } else if (nt >= 36 && nt < 52) {
#pragma unroll
            for (int mi = 0; mi < 2; ++mi)
#pragma unroll
                for (int ni = 0; ni < 2; ++ni)
#pragma unroll
                    for (int reg = 0; reg < 16; ++reg) acc[mi][ni][reg] = sigmoid_(acc[mi][ni][reg]);
        }
        if (nt == 52) {
            if (wc == 0) {
                const f32x4 b0 = *(const f32x4*)(p.b_mgate + 4 * hh), b1 = *(const f32x4*)(p.b_mgate + 8 + 4 * hh);
#pragma unroll
                for (int mi = 0; mi < 2; ++mi) {
                    float* g = G + (size_t)(mt * 128 + wr * 64 + mi * 32 + r) * 16 + 4 * hh;
                    f32x4 o0, o1;
                    o0.x = acc[mi][0][0] + b0.x; o0.y = acc[mi][0][1] + b0.y; o0.z = acc[mi][0][2] + b0.z; o0.w = acc[mi][0][3] + b0.w;
                    o1.x = acc[mi][0][4] + b1.x; o1.y = acc[mi][0][5] + b1.y; o1.z = acc[mi][0][6] + b1.z; o1.w = acc[mi][0][7] + b1.w;
                    *(f32x4*)g = o0; *(f32x4*)(g + 8) = o1;
                }
            }
        } else {
            u16* Ct = (u16*)smem;
            __syncthreads();
            ct_write(Ct, acc, wr, wc, lane);
            __syncthreads();
            ct_store(Ct, P + (size_t)(mt * 128) * PV + nt * 128, PV, tid);
        }
        __syncthreads();
    }
}

__device__ __forceinline__ void mlstm_passA(const Params& p, unsigned char* smem, const int it) {
    const int tid = opaque_tid(), lane = tid & 63, wid = tid >> 6;
    const int c = it % 260, bh = it / 260, b = bh >> 2, h = bh & 3;
    const int base = c < 4 ? NTOK + b * 256 + c * 64 : b * TSEQ + (c - 4) * 64;
    const u16* P = (const u16*)(p.ws + OFF_P); const float* G = (const float*)(p.ws + OFF_G);
    float* gsum = (float*)(p.ws + OFF_GS); float* mloc = (float*)(p.ws + OFF_ML); float* dn = (float*)(p.ws + OFF_DN);
    u16* CT = (u16*)(p.ws + OFF_CT);
    u16* KTf = (u16*)smem; u16* KTb = (u16*)(smem + 18432); u16* VT = (u16*)(smem + 36864);
    float* wf = (float*)(smem + 73728); float* wb = wf + 64;
    const int slot_f = bh * 2 * 260 + c, slot_b = slot_f + 260;
    if (wid == 0) {
        const float* g = G + (size_t)(base + lane) * 16;
        const float igf = g[h], ff = g[4 + h], igb = g[8 + h], fb = g[12 + h];
        const float lff = log_sigmoid_(ff), lfb = log_sigmoid_(fb);
        const float bfc = wave_incl_sum(lff, lane), gf = __shfl(bfc, 63);
        const float uf = igf - bfc, umf = wave_max(uf);
        wf[lane] = __expf(uf - umf);
        const float pb = wave_incl_sum(lfb, lane), gb = __shfl(pb, 63);
        const float bb = gb - pb + lfb, ub = igb - bb, umb = wave_max(ub);
        wb[lane] = __expf(ub - umb);
        if (lane == 0) { gsum[slot_f] = gf; mloc[slot_f] = gf + umf; gsum[slot_b] = gb; mloc[slot_b] = gb + umb; }
    }
    __syncthreads();
    const int cgp = tid >> 3, tg = tid & 7;
    {
        const u16* src = P + (size_t)(base + tg * 8) * PV + V_MK + h * 128 + cgp * 4;
        u32x2 kv[8];
#pragma unroll
        for (int i = 0; i < 8; ++i) kv[i] = *(const u32x2*)(src + (size_t)i * PV);
        float wfi[8], wbi[8];
#pragma unroll
        for (int i = 0; i < 8; ++i) { wfi[i] = wf[tg * 8 + i]; wbi[i] = wb[tg * 8 + i]; }
#pragma unroll
        for (int cc = 0; cc < 4; ++cc) {
            float e[8];
#pragma unroll
            for (int i = 0; i < 8; ++i) e[i] = bfsel(kv[i], cc);
            u32x4 of, ob;
            of.x = pk2(e[0] * wfi[0], e[1] * wfi[1]); of.y = pk2(e[2] * wfi[2], e[3] * wfi[3]); of.z = pk2(e[4] * wfi[4], e[5] * wfi[5]); of.w = pk2(e[6] * wfi[6], e[7] * wfi[7]);
            ob.x = pk2(e[0] * wbi[0], e[1] * wbi[1]); ob.y = pk2(e[2] * wbi[2], e[3] * wbi[3]); ob.z = pk2(e[4] * wbi[4], e[5] * wbi[5]); ob.w = pk2(e[6] * wbi[6], e[7] * wbi[7]);
            *(u32x4*)(KTf + (cgp * 4 + cc) * LDT + tg * 8) = of;
            *(u32x4*)(KTb + (cgp * 4 + cc) * LDT + tg * 8) = ob;
        }
    }
#pragma unroll
    for (int vp = 0; vp < 2; ++vp) {
        const u16* src = P + (size_t)(base + tg * 8) * PV + V_MV + h * 256 + vp * 128 + cgp * 4;
        u32x2 vv[8];
#pragma unroll
        for (int i = 0; i < 8; ++i) vv[i] = *(const u32x2*)(src + (size_t)i * PV);
#pragma unroll
        for (int cc = 0; cc < 4; ++cc) *(u32x4*)(VT + (vp * 128 + cgp * 4 + cc) * LDT + tg * 8) = tr8(vv, cc);
    }
    __syncthreads();
    if (tid < 128) {
        float sf = 0.f, sb = 0.f;
#pragma unroll
        for (int j = 0; j < 8; ++j) {
            const u32x4 a = *(const u32x4*)(KTf + tid * LDT + j * 8), bq = *(const u32x4*)(KTb + tid * LDT + j * 8);
            sf += (bf_lo(a.x) + bf_hi(a.x)) + (bf_lo(a.y) + bf_hi(a.y)) + (bf_lo(a.z) + bf_hi(a.z)) + (bf_lo(a.w) + bf_hi(a.w));
            sb += (bf_lo(bq.x) + bf_hi(bq.x)) + (bf_lo(bq.y) + bf_hi(bq.y)) + (bf_lo(bq.z) + bf_hi(bq.z)) + (bf_lo(bq.w) + bf_hi(bq.w));
        }
        dn[(size_t)slot_f * 128 + tid] = sf; dn[(size_t)slot_b * 128 + tid] = sb;
    }
    const int r = lane & 31, hh = lane >> 5;
#pragma unroll 1
    for (int dir = 0; dir < 2; ++dir) {
        const u16* Bt = dir ? KTb : KTf;
        u16* dst = CT + (size_t)(dir ? slot_b : slot_f) * 32768;
#pragma unroll 1
        for (int nh = 0; nh < 2; ++nh) {
            f32x16 acc[2][2] = {};
#pragma unroll
            for (int kk = 0; kk < 4; ++kk) {
                bf16x8 a[2], bq[2];
#pragma unroll
                for (int mi = 0; mi < 2; ++mi) a[mi] = *(const bf16x8*)(VT + (wid * 64 + mi * 32 + r) * LDT + kk * 16 + hh * 8);
#pragma unroll
                for (int ni = 0; ni < 2; ++ni) bq[ni] = *(const bf16x8*)(Bt + (nh * 64 + ni * 32 + r) * LDT + kk * 16 + hh * 8);
#pragma unroll
                for (int mi = 0; mi < 2; ++mi)
#pragma unroll
                    for (int ni = 0; ni < 2; ++ni) acc[mi][ni] = mfma32(bq[ni], a[mi], acc[mi][ni]);
            }
#pragma unroll
            for (int mi = 0; mi < 2; ++mi)
#pragma unroll
                for (int ni = 0; ni < 2; ++ni) {
                    u16* drow = dst + (wid * 64 + mi * 32 + r) * 128 + nh * 64 + ni * 32 + 4 * hh;
#pragma unroll
                    for (int g = 0; g < 4; ++g) {
                        u32x2 w; w.x = pk2(acc[mi][ni][4 * g], acc[mi][ni][4 * g + 1]); w.y = pk2(acc[mi][ni][4 * g + 2], acc[mi][ni][4 * g + 3]);
                        *(u32x2*)(drow + 8 * g) = w;
                    }
                }
        }
    }
    __syncthreads();
}

__device__ __forceinline__ void na_item(const Params& p, unsigned char* smem, const int it) {
    const int tid = opaque_tid(), lane = tid & 63, wid = tid >> 6;
    const int row = it & 255, h = (it >> 8) & 7, b = it >> 11;
    const u16* P = (const u16*)(p.ws + OFF_P);
    u16* YNA = (u16*)(p.ws + OFF_YNA);
    float* rpb_s = (float*)(smem + 36864);
    const int l15 = lane & 15, l4 = lane >> 4;
    const int qc = wid * 16 + l15;
    const size_t qtok = (size_t)b * TSEQ + row * 64 + qc;
    const u16* qsrc = P + qtok * PV + V_NQ + h * 64 + l4 * 8;
    const bf16x8 qa0 = *(const bf16x8*)qsrc, qa1 = *(const bf16x8*)(qsrc + 32);
    const int rs = min(max(row - 4, 0), 248);
    const int cs = min(max(qc - 8, 0), 48);
    for (int j = tid; j < 465; j += 256) rpb_s[j] = p.na_rpb[h * 465 + j];
    f32x4 O[4] = {};
    float mrun = -INFINITY, lrun = 0.f;
    u32x4 kreg[2]; u32x2 vreg[8];
    const int cgp = (tid >> 3) & 15, tg = tid & 7;
    {
        const int kbase = b * TSEQ + rs * 64;
#pragma unroll
        for (int i = 0; i < 2; ++i) { const int id = tid + i * 256; kreg[i] = *(const u32x4*)(P + (size_t)(kbase + (id >> 3)) * PV + V_NK + h * 64 + (id & 7) * 8); }
        const u16* src = P + (size_t)(kbase + tg * 8) * PV + V_NV + h * 64 + cgp * 4;
#pragma unroll
        for (int i = 0; i < 8; ++i) vreg[i] = *(const u32x2*)(src + (size_t)i * PV);
    }
    for (int blk = 0; blk < 12; ++blk) {
        u16* Ks = (u16*)(smem + (blk & 1) * 18432); u16* VTs = Ks + 4608;
#pragma unroll
        for (int i = 0; i < 2; ++i) { const int id = tid + i * 256; *(u32x4*)(Ks + (id >> 3) * LDT + (id & 7) * 8) = kreg[i]; }
        if (tid < 128) {
#pragma unroll
            for (int cc = 0; cc < 4; ++cc) *(u32x4*)(VTs + (cgp * 4 + cc) * LDT + tg * 8) = tr8(vreg, cc);
        }
        __syncthreads();
        if (blk + 1 < 12) {
            const int nb = blk + 1;
            const int kbase = nb < 8 ? b * TSEQ + (rs + nb) * 64 : NTOK + b * 256 + (nb - 8) * 64;
#pragma unroll
            for (int i = 0; i < 2; ++i) { const int id = tid + i * 256; kreg[i] = *(const u32x4*)(P + (size_t)(kbase + (id >> 3)) * PV + V_NK + h * 64 + (id & 7) * 8); }
            const u16* src = P + (size_t)(kbase + tg * 8) * PV + V_NV + h * 64 + cgp * 4;
#pragma unroll
            for (int i = 0; i < 8; ++i) vreg[i] = *(const u32x2*)(src + (size_t)i * PV);
        }
        f32x4 S[4] = {};
#pragma unroll
        for (int t = 0; t < 4; ++t) {
            const bf16x8 k0 = *(const bf16x8*)(Ks + (t * 16 + l15) * LDT + l4 * 8), k1 = *(const bf16x8*)(Ks + (t * 16 + l15) * LDT + 32 + l4 * 8);
            S[t] = mfma16(k0, qa0, S[t]); S[t] = mfma16(k1, qa1, S[t]);
        }
        if (blk < 8) {
            const float* rpb = rpb_s + (rs + blk - row + 7) * 31 + 15 - qc;
#pragma unroll
            for (int t = 0; t < 4; ++t)
#pragma unroll
                for (int reg = 0; reg < 4; ++reg) {
                    const int kc = t * 16 + l4 * 4 + reg;
                    const bool valid = kc >= cs && kc < cs + 16;
                    float bias = 0.f;
                    if (valid) bias = rpb[kc];
                    S[t][reg] = valid ? S[t][reg] + bias : -INFINITY;
                }
        }
        float mx = -INFINITY;
#pragma unroll
        for (int t = 0; t < 4; ++t) mx = fmaxf(mx, fmaxf(fmaxf(S[t][0], S[t][1]), fmaxf(S[t][2], S[t][3])));
        mx = fmaxf(mx, __shfl_xor(mx, 16)); mx = fmaxf(mx, __shfl_xor(mx, 32));
        const float mnew = fmaxf(mrun, mx);
        const float alpha = __expf(mrun - mnew);
        float ps = 0.f;
#pragma unroll
        for (int t = 0; t < 4; ++t)
#pragma unroll
            for (int reg = 0; reg < 4; ++reg) { const float pe = __expf(S[t][reg] - mnew); S[t][reg] = pe; ps += pe; }
        ps += __shfl_xor(ps, 16); ps += __shfl_xor(ps, 32);
        lrun = lrun * alpha + ps; mrun = mnew;
#pragma unroll
        for (int t = 0; t < 4; ++t) { O[t][0] *= alpha; O[t][1] *= alpha; O[t][2] *= alpha; O[t][3] *= alpha; }
#pragma unroll
        for (int s = 0; s < 2; ++s) {
            u32x4 pb; pb.x = pk2(S[2 * s][0], S[2 * s][1]); pb.y = pk2(S[2 * s][2], S[2 * s][3]); pb.z = pk2(S[2 * s + 1][0], S[2 * s + 1][1]); pb.w = pk2(S[2 * s + 1][2], S[2 * s + 1][3]);
            const bf16x8 pfrag = __builtin_bit_cast(bf16x8, pb);
#pragma unroll
            for (int t = 0; t < 4; ++t) {
                const u16* vrow = VTs + (t * 16 + l15) * LDT + s * 32 + l4 * 4;
                const u32x2 v0 = *(const u32x2*)vrow, v1 = *(const u32x2*)(vrow + 16);
                u32x4 va; va.x = v0.x; va.y = v0.y; va.z = v1.x; va.w = v1.y;
                O[t] = mfma16(__builtin_bit_cast(bf16x8, va), pfrag, O[t]);
            }
        }
    }
    {
        const float il = 1.f / lrun;
#pragma unroll
        for (int t = 0; t < 4; ++t) {
            u32x2 w; w.x = pk2(O[t][0] * il, O[t][1] * il); w.y = pk2(O[t][2] * il, O[t][3] * il);
            *(u32x2*)(YNA + qtok * 512 + h * 64 + t * 16 + l4 * 4) = w;
        }
    }
    __syncthreads();
}

__device__ __forceinline__ int scan_cidx(int i, int dir) { return dir == 0 ? i : (i < 4 ? 3 - i : 263 - i); }
__device__ __forceinline__ void phase_scan(const Params& p, unsigned char* smem) {
    const int tid = opaque_tid(), lane = tid & 63, wid = tid >> 6;
    float* al = (float*)smem; float* be = al + 260;
    const float* gsum = (const float*)(p.ws + OFF_GS); const float* mloc = (const float*)(p.ws + OFF_ML);
    float* mprev = (float*)(p.ws + OFF_MP); float* dn = (float*)(p.ws + OFF_DN);
    for (int it = blockIdx.x; it < 512; it += gridDim.x) {
        const int bhd = it >> 5, eb = it & 31, dir = bhd & 1, slot0 = bhd * 260;
        if (wid == 0) {
            float g[5], ml[5]; int cc[5];
            float a = 0.f, b = -INFINITY;
#pragma unroll
            for (int j = 0; j < 5; ++j) {
                const int i = lane * 5 + j; const bool ok = i < 260;
                cc[j] = ok ? scan_cidx(i, dir) : 0;
                g[j] = ok ? gsum[slot0 + cc[j]] : 0.f; ml[j] = ok ? mloc[slot0 + cc[j]] : -INFINITY;
                b = fmaxf(b + g[j], ml[j]); a += g[j];
            }
#pragma unroll
            for (int o = 1; o < 64; o <<= 1) {
                const float pa = __shfl_up(a, o), pb = __shfl_up(b, o);
                if (lane >= o) { b = fmaxf(pb + a, b); a = pa + a; }
            }
            float ea = __shfl_up(a, 1), eb2 = __shfl_up(b, 1);
            if (lane == 0) { ea = 0.f; eb2 = -INFINITY; }
            float m = fmaxf(0.f + ea, eb2);
#pragma unroll
            for (int j = 0; j < 5; ++j) {
                const int i = lane * 5 + j;
                if (i < 260) {
                    const float mn = fmaxf(g[j] + m, ml[j]);
                    al[i] = __expf(g[j] + m - mn); be[i] = __expf(ml[j] - mn);
                    if (eb == 0) mprev[slot0 + cc[j]] = m;
                    m = mn;
                }
            }
        }
        __syncthreads();
        u32x2* basep = (u32x2*)(p.ws + OFF_CT) + (size_t)slot0 * 8192 + eb * 256 + tid;
        float C0 = 0.f, C1 = 0.f, C2 = 0.f, C3 = 0.f;
        for (int i = 0; i < 260; i += 13) {
            u32x2 v[13];
#pragma unroll
            for (int j = 0; j < 13; ++j) v[j] = basep[(size_t)scan_cidx(i + j, dir) * 8192];
#pragma unroll
            for (int j = 0; j < 13; ++j) {
                u32x2 o; o.x = pk2(C0, C1); o.y = pk2(C2, C3);
                basep[(size_t)scan_cidx(i + j, dir) * 8192] = o;
                const float a = al[i + j], bt = be[i + j];
                C0 = fmaf(a, C0, bt * bf_lo(v[j].x)); C1 = fmaf(a, C1, bt * bf_hi(v[j].x)); C2 = fmaf(a, C2, bt * bf_lo(v[j].y)); C3 = fmaf(a, C3, bt * bf_hi(v[j].y));
            }
        }
        if (eb == 0 && tid < 128) {
            float n = 0.f;
            for (int i = 0; i < 260; ++i) {
                float* q = dn + (size_t)(slot0 + scan_cidx(i, dir)) * 128 + tid;
                const float v = *q; *q = n; n = al[i] * n + be[i] * v;
            }
        }
        __syncthreads();
    }
}

__device__ __forceinline__ void mlstm_passC(const Params& p, unsigned char* smem, const int it) {
    const int tid = opaque_tid(), lane = tid & 63, wid = tid >> 6;
    const int cl = it & 255, bh = it >> 8, b = bh >> 2, h = bh & 3, c = cl + 4;
    const int base = b * TSEQ + cl * 64;
    const int slot_f = bh * 2 * 260 + c, slot_b = slot_f + 260;
    const u16* P = (const u16*)(p.ws + OFF_P); const float* G = (const float*)(p.ws + OFF_G);
    const float* mprev = (const float*)(p.ws + OFF_MP); const float* dn = (const float*)(p.ws + OFF_DN);
    const u16* CT = (const u16*)(p.ws + OFF_CT);
    u16* YM = (u16*)(p.ws + OFF_YM);
    u16* Ks = (u16*)smem;
    u16* CTf = (u16*)smem; u16* CTb = (u16*)(smem + 17408);
    u16* VTs = (u16*)(smem + 34816);
    float* ga = (float*)(smem + 44032);
    float *uf_s = ga, *Mf_s = ga + 64, *ub_s = ga + 128, *Mb_s = ga + 192, *clf = ga + 256, *clb = ga + 320, *wif = ga + 384, *wib = ga + 448;
    const int l15 = lane & 15, l4 = lane >> 4;
    if (wid == 0) {
        const float* g = G + (size_t)(base + lane) * 16;
        const float igf = g[h], ff = g[4 + h], igb = g[8 + h], fb = g[12 + h];
        const float lff = log_sigmoid_(ff), lfb = log_sigmoid_(fb);
        const float bfc = wave_incl_sum(lff, lane);
        const float uf = igf - bfc;
        const float pb = wave_incl_sum(lfb, lane), gb = __shfl(pb, 63);
        const float bb = gb - pb + lfb, ub = igb - bb;
        const float mpf = mprev[slot_f], mpb = mprev[slot_b];
        const float Mf = fmaxf(mpf, wave_prefix_max(uf, lane)), Mb = fmaxf(mpb, wave_suffix_max(ub, lane));
        uf_s[lane] = uf; Mf_s[lane] = Mf; clf[lane] = __expf(-(bfc + Mf)); wif[lane] = __expf(mpf - Mf);
        ub_s[lane] = ub; Mb_s[lane] = Mb; clb[lane] = __expf(-(bb + Mb)); wib[lane] = __expf(mpb - Mb);
    }
    const int t = wid * 16 + l15;
    const size_t tok = (size_t)base + t;
    bf16x8 qa[4];
    {
        const u16* qsrc = P + tok * PV + V_MQ + h * 128 + l4 * 8;
#pragma unroll
        for (int kk = 0; kk < 4; ++kk) qa[kk] = *(const bf16x8*)(qsrc + kk * 32);
    }
#pragma unroll
    for (int i = 0; i < 4; ++i) {
        const int id = tid + i * 256, kr = id >> 4, ch = id & 15;
        *(u32x4*)(Ks + kr * LDQ + ch * 8) = *(const u32x4*)(P + (size_t)(base + kr) * PV + V_MK + h * 128 + ch * 8);
    }
    __syncthreads();
    f32x4 S[4] = {};
#pragma unroll
    for (int st = 0; st < 4; ++st)
#pragma unroll
        for (int kk = 0; kk < 4; ++kk) {
            const bf16x8 kf = *(const bf16x8*)(Ks + (st * 16 + l15) * LDQ + kk * 32 + l4 * 8);
            S[st] = mfma16(kf, qa[kk], S[st]);
        }
    float qnf = 0.f, qnb = 0.f;
    {
        const float* nf = dn + (size_t)slot_f * 128; const float* nb = dn + (size_t)slot_b * 128;
#pragma unroll
        for (int kk = 0; kk < 4; ++kk)
#pragma unroll
            for (int j = 0; j < 8; ++j) {
                const int d = kk * 32 + l4 * 8 + j;
                const float qv = bf2f((u16)qa[kk][j]);
                qnf += qv * nf[d]; qnb += qv * nb[d];
            }
        qnf += __shfl_xor(qnf, 16); qnf += __shfl_xor(qnf, 32);
        qnb += __shfl_xor(qnb, 16); qnb += __shfl_xor(qnb, 32);
    }
    const float Mft = Mf_s[t], Mbt = Mb_s[t];
    float rsf = 0.f, rsb = 0.f;
    f32x4 PF[4], PB[4];
#pragma unroll
    for (int st = 0; st < 4; ++st) {
        const f32x4 uf4 = *(const f32x4*)(uf_s + st * 16 + l4 * 4), ub4 = *(const f32x4*)(ub_s + st * 16 + l4 * 4);
#pragma unroll
        for (int reg = 0; reg < 4; ++reg) {
            const int s = st * 16 + l4 * 4 + reg;
            const float sv = S[st][reg];
            const float pf = (s <= t) ? sv * __expf(uf4[reg] - Mft) : 0.f;
            const float pbv = (s >= t) ? sv * __expf(ub4[reg] - Mbt) : 0.f;
            rsf += pf; rsb += pbv; PF[st][reg] = pf; PB[st][reg] = pbv;
        }
    }
    rsf += __shfl_xor(rsf, 16); rsf += __shfl_xor(rsf, 32);
    rsb += __shfl_xor(rsb, 16); rsb += __shfl_xor(rsb, 32);
    const float wft = wif[t], wbt = wib[t];
    const float idf = 1.f / fmaxf(fabsf(rsf + wft * qnf), clf[t]), idb = 1.f / fmaxf(fabsf(rsb + wbt * qnb), clb[t]);
    bf16x8 pfr[2], qwf[4], qwb[4];
#pragma unroll
    for (int ss = 0; ss < 2; ++ss) {
        u32x4 pw;
        pw.x = pk2(PF[2 * ss][0] * idf + PB[2 * ss][0] * idb, PF[2 * ss][1] * idf + PB[2 * ss][1] * idb);
        pw.y = pk2(PF[2 * ss][2] * idf + PB[2 * ss][2] * idb, PF[2 * ss][3] * idf + PB[2 * ss][3] * idb);
        pw.z = pk2(PF[2 * ss + 1][0] * idf + PB[2 * ss + 1][0] * idb, PF[2 * ss + 1][1] * idf + PB[2 * ss + 1][1] * idb);
        pw.w = pk2(PF[2 * ss + 1][2] * idf + PB[2 * ss + 1][2] * idb, PF[2 * ss + 1][3] * idf + PB[2 * ss + 1][3] * idb);
        pfr[ss] = __builtin_bit_cast(bf16x8, pw);
    }
    {
        const float sf = wft * idf, sb = wbt * idb;
#pragma unroll
        for (int kk = 0; kk < 4; ++kk) {
            u32x4 of, ob;
            const float q0 = bf2f((u16)qa[kk][0]), q1 = bf2f((u16)qa[kk][1]), q2 = bf2f((u16)qa[kk][2]), q3 = bf2f((u16)qa[kk][3]);
            const float q4 = bf2f((u16)qa[kk][4]), q5 = bf2f((u16)qa[kk][5]), q6 = bf2f((u16)qa[kk][6]), q7 = bf2f((u16)qa[kk][7]);
            of.x = pk2(q0 * sf, q1 * sf); of.y = pk2(q2 * sf, q3 * sf); of.z = pk2(q4 * sf, q5 * sf); of.w = pk2(q6 * sf, q7 * sf);
            ob.x = pk2(q0 * sb, q1 * sb); ob.y = pk2(q2 * sb, q3 * sb); ob.z = pk2(q4 * sb, q5 * sb); ob.w = pk2(q6 * sb, q7 * sb);
            qwf[kk] = __builtin_bit_cast(bf16x8, of); qwb[kk] = __builtin_bit_cast(bf16x8, ob);
        }
    }
    __syncthreads();
    f32x4 hm[4][4];
#pragma unroll
    for (int vb = 0; vb < 4; ++vb) {
        if (tid < 128) {
            const int cgp = tid >> 3, tg = tid & 7;
            const u16* src = P + (size_t)(base + tg * 8) * PV + V_MV + h * 256 + vb * 64 + cgp * 4;
            u32x2 vv[8];
#pragma unroll
            for (int i = 0; i < 8; ++i) vv[i] = *(const u32x2*)(src + (size_t)i * PV);
#pragma unroll
            for (int cc = 0; cc < 4; ++cc) *(u32x4*)(VTs + (cgp * 4 + cc) * LDT + tg * 8) = tr8(vv, cc);
        }
#pragma unroll
        for (int i = 0; i < 4; ++i) {
            const int id = tid + i * 256, vr = id >> 4, ch = id & 15;
            *(u32x4*)(CTf + vr * LDQ + ch * 8) = *(const u32x4*)(CT + (size_t)slot_f * 32768 + (vb * 64 + vr) * 128 + ch * 8);
            *(u32x4*)(CTb + vr * LDQ + ch * 8) = *(const u32x4*)(CT + (size_t)slot_b * 32768 + (vb * 64 + vr) * 128 + ch * 8);
        }
        __syncthreads();
#pragma unroll
        for (int tv = 0; tv < 4; ++tv) {
            f32x4 a = {0.f, 0.f, 0.f, 0.f};
#pragma unroll
            for (int ss = 0; ss < 2; ++ss) {
                const u16* vrow = VTs + (tv * 16 + l15) * LDT + ss * 32 + l4 * 4;
                const u32x2 v0 = *(const u32x2*)vrow, v1 = *(const u32x2*)(vrow + 16);
                u32x4 va; va.x = v0.x; va.y = v0.y; va.z = v1.x; va.w = v1.y;
                a = mfma16(__builtin_bit_cast(bf16x8, va), pfr[ss], a);
            }
#pragma unroll
            for (int kk = 0; kk < 4; ++kk) {
                const bf16x8 cf = *(const bf16x8*)(CTf + (tv * 16 + l15) * LDQ + kk * 32 + l4 * 8);
                const bf16x8 cb = *(const bf16x8*)(CTb + (tv * 16 + l15) * LDQ + kk * 32 + l4 * 8);
                a = mfma16(cf, qwf[kk], a); a = mfma16(cb, qwb[kk], a);
            }
            hm[vb][tv] = a;
        }
        __syncthreads();
    }
    float ssq = 0.f;
#pragma unroll
    for (int vb = 0; vb < 4; ++vb)
#pragma unroll
        for (int tv = 0; tv < 4; ++tv) ssq += (hm[vb][tv][0] * hm[vb][tv][0] + hm[vb][tv][1] * hm[vb][tv][1]) + (hm[vb][tv][2] * hm[vb][tv][2] + hm[vb][tv][3] * hm[vb][tv][3]);
    ssq += __shfl_xor(ssq, 16); ssq += __shfl_xor(ssq, 32);
    const float rstd = rsqrtf(ssq * (1.f / 256.f) + 1e-6f);
#pragma unroll
    for (int vb = 0; vb < 4; ++vb)
#pragma unroll
        for (int tv = 0; tv < 4; ++tv) {
            const int v = h * 256 + vb * 64 + tv * 16 + l4 * 4;
            const u32x2 ov = *(const u32x2*)(P + tok * PV + V_MO + v);
            const f32x4 w = *(const f32x4*)(p.m_norm_w + v);
            u32x2 y;
            y.x = pk2(hm[vb][tv][0] * rstd * w.x * sigmoid_(bf_lo(ov.x)), hm[vb][tv][1] * rstd * w.y * sigmoid_(bf_hi(ov.x)));
            y.y = pk2(hm[vb][tv][2] * rstd * w.z * sigmoid_(bf_lo(ov.y)), hm[vb][tv][3] * rstd * w.w * sigmoid_(bf_hi(ov.y)));
            *(u32x2*)(YM + tok * 1024 + v) = y;
        }
}

__device__ __forceinline__ void phase_merge(const Params& p, unsigned char* smem, const bool second) {
    const u16* P = (const u16*)(p.ws + OFF_P);
    const u16* YM = (const u16*)(p.ws + OFF_YM); const u16* YNA = (const u16*)(p.ws + OFF_YNA);
    u16* MRG = (u16*)(p.ws + OFF_MRG);
    const int tid = opaque_tid(), lane = tid & 63, wid = tid >> 6, wr = wid >> 1, wc = wid & 1;
    const u16* abase = second ? YNA : YM; const int lda = second ? 512 : 1024;
    const u16* wt = (const u16*)(p.ws + (second ? OFF_BRNT : OFF_BRMT));
    const int gcol = second ? V_GN : V_GM;
    const int sw = ((tid & 3) ^ ((tid >> 4) & 3)) * 8;
    for (int ti = 0;; ++ti) {
        int mt, nt;
        if (!sched_tile(ti, 256, 4, 4, mt, nt)) break;
        f32x16 acc[2][4] = {};
        gemm_core3(acc, abase + (size_t)(mt * 128 + (tid >> 2)) * lda + sw, (size_t)64 * lda, wt + (size_t)(nt * 256 + (tid >> 2)) * lda + sw, (size_t)64 * lda, second ? 16 : 32, smem, tid, lane, wr, wc);
        u16* Ct = (u16*)smem;
        RAW_BARRIER();
        ct_write3(Ct, acc, wr, wc, lane);
        __syncthreads();
#pragma unroll 4
        for (int i = 0; i < 16; ++i) {
            const int idx = tid + i * 256, row = idx >> 5, ch = idx & 31;
            const size_t m = (size_t)mt * 128 + row;
            const u32x4 cv = *(const u32x4*)(Ct + row * CT3_LD + ch * 8);
            const u32x4 gv = *(const u32x4*)(P + m * PV + gcol + nt * 256 + ch * 8);
            u16* q = MRG + m * 1024 + nt * 256 + ch * 8;
            float o[8];
            o[0] = bf_lo(cv.x) * bf_lo(gv.x); o[1] = bf_hi(cv.x) * bf_hi(gv.x); o[2] = bf_lo(cv.y) * bf_lo(gv.y); o[3] = bf_hi(cv.y) * bf_hi(gv.y);
            o[4] = bf_lo(cv.z) * bf_lo(gv.z); o[5] = bf_hi(cv.z) * bf_hi(gv.z); o[6] = bf_lo(cv.w) * bf_lo(gv.w); o[7] = bf_hi(cv.w) * bf_hi(gv.w);
            if (second) {
                const u32x4 pv = *(const u32x4*)q;
                o[0] += bf_lo(pv.x); o[1] += bf_hi(pv.x); o[2] += bf_lo(pv.y); o[3] += bf_hi(pv.y); o[4] += bf_lo(pv.z); o[5] += bf_hi(pv.z); o[6] += bf_lo(pv.w); o[7] += bf_hi(pv.w);
            }
            u32x4 w; w.x = pk2(o[0], o[1]); w.y = pk2(o[2], o[3]); w.z = pk2(o[4], o[5]); w.w = pk2(o[6], o[7]);
            *(u32x4*)q = w;
        }
        __syncthreads();
    }
}

__device__ __forceinline__ void phase_outproj(const Params& p, unsigned char* smem) {
    const u16* MRG = (const u16*)(p.ws + OFF_MRG);
    const int tid = opaque_tid(), lane = tid & 63, wid = tid >> 6, wr = wid >> 1, wc = wid & 1;
    const u16* wt = (const u16*)(p.ws + OFF_OUTT);
    const int sw = ((tid & 3) ^ ((tid >> 4) & 3)) * 8;
    for (int ti = 0;; ++ti) {
        int mt, nt;
        if (!sched_tile(ti, 256, 4, 4, mt, nt)) break;
        f32x16 acc[2][4] = {};
        gemm_core3(acc, MRG + (size_t)(mt * 128 + (tid >> 2)) * 1024 + sw, 64 * 1024, wt + (size_t)(nt * 256 + (tid >> 2)) * 1024 + sw, 64 * 1024, 32, smem, tid, lane, wr, wc);
        u16* Ct = (u16*)smem;
        RAW_BARRIER();
        ct_write3(Ct, acc, wr, wc, lane);
        __syncthreads();
        {
            const int bvec = mt >> 7, ch = tid & 31;
            float g1[8];
#pragma unroll
            for (int j = 0; j < 8; ++j) g1[j] = mod_val(p, bvec, 2048 + nt * 256 + ch * 8 + j);
#pragma unroll 4
            for (int i = 0; i < 16; ++i) {
                const int row = (tid >> 5) + i * 8;
                const size_t off = ((size_t)mt * 128 + row) * 1024 + nt * 256 + ch * 8;
                const u32x4 cv = *(const u32x4*)(Ct + row * CT3_LD + ch * 8);
                const f32x4 x0 = *(const f32x4*)(p.x + off), x1 = *(const f32x4*)(p.x + off + 4);
                f32x4 o0, o1;
                o0.x = x0.x + g1[0] * bf_lo(cv.x); o0.y = x0.y + g1[1] * bf_hi(cv.x); o0.z = x0.z + g1[2] * bf_lo(cv.y); o0.w = x0.w + g1[3] * bf_hi(cv.y);
                o1.x = x1.x + g1[4] * bf_lo(cv.z); o1.y = x1.y + g1[5] * bf_hi(cv.z); o1.z = x1.z + g1[6] * bf_lo(cv.w); o1.w = x1.w + g1[7] * bf_hi(cv.w);
                *(f32x4*)(p.out + off) = o0; *(f32x4*)(p.out + off + 4) = o1;
            }
        }
        __syncthreads();
    }
}

__device__ __forceinline__ void phase_router(const Params& p, unsigned char* smem) {
    const u16* H = (const u16*)(p.ws + OFF_H);
    float* SC = (float*)(p.ws + OFF_SC);
    const int tid = opaque_tid(), lane = tid & 63, wid = tid >> 6, wr = wid >> 1, wc = wid & 1;
    const int r = lane & 31, hh = lane >> 5;
    const u16* wt = (const u16*)(p.ws + OFF_RTT);
    const int sw = ((tid & 7) ^ ((tid >> 4) & 7)) * 8;
    for (int ti = 0;; ++ti) {
        int mt, nt;
        if (!sched_tile(ti, 256, 2, 2, mt, nt)) break;
        f32x16 acc[2][2] = {};
        gemm_core2(acc, H + (size_t)(mt * 128 + (tid >> 3)) * 1024 + sw, 32 * 1024, wt + (size_t)(nt * 128 + (tid >> 3)) * 1024 + sw, 32 * 1024, 16, smem, tid, lane, wr, wc);
#pragma unroll
        for (int mi = 0; mi < 2; ++mi)
#pragma unroll
            for (int ni = 0; ni < 2; ++ni) {
                float* srow = SC + ((size_t)mt * 128 + wr * 64 + mi * 32 + r) * 256 + nt * 128 + wc * 64 + ni * 32 + 4 * hh;
#pragma unroll
                for (int g = 0; g < 4; ++g) {
                    f32x4 o; o.x = sigmoid_(acc[mi][ni][4 * g]); o.y = sigmoid_(acc[mi][ni][4 * g + 1]); o.z = sigmoid_(acc[mi][ni][4 * g + 2]); o.w = sigmoid_(acc[mi][ni][4 * g + 3]);
                    *(f32x4*)(srow + 8 * g) = o;
                }
            }
        __syncthreads();
    }
}

__device__ __forceinline__ void phase_route(const Params& p, unsigned char* smem) {
    const int tid = opaque_tid(), lane = tid & 63, wid = tid >> 6;
    const float* SC = (const float*)(p.ws + OFF_SC);
    int* tope = (int*)(p.ws + OFF_TOPE); float* topw = (float*)(p.ws + OFF_TOPW);
    int* lh = (int*)smem;
    lh[tid] = 0;
    __syncthreads();
    const f32x4 rb = *(const f32x4*)(p.router_bias + lane * 4);
    for (int tok = blockIdx.x * 4 + wid; tok < NTOK; tok += gridDim.x * 4) {
        const f32x4 sc = *(const f32x4*)(SC + (size_t)tok * 256 + lane * 4);
        float s0 = sc.x + rb.x, s1 = sc.y + rb.y, s2 = sc.z + rb.z, s3 = sc.w + rb.w;
        float a1 = fmaxf(s0, s1), a2 = fminf(s0, s1);
        { const float b1 = fmaxf(s2, s3), b2 = fminf(s2, s3); const float n1 = fmaxf(a1, b1), n2 = fmaxf(fminf(a1, b1), fmaxf(a2, b2)); a1 = n1; a2 = n2; }
#pragma unroll
        for (int o = 1; o < 8; o <<= 1) {
            const float b1 = __shfl_xor(a1, o), b2 = __shfl_xor(a2, o);
            const float n1 = fmaxf(a1, b1), n2 = fmaxf(fminf(a1, b1), fmaxf(a2, b2)); a1 = n1; a2 = n2;
        }
        const float gs = a1 + a2; const int mygrp = lane >> 3;
        int gcnt = 0;
#pragma unroll
        for (int g = 0; g < 8; ++g) { const float og = __shfl(gs, g * 8); gcnt += (og > gs || (og == gs && g < mygrp)) ? 1 : 0; }
        if (gcnt >= 4) { s0 = -INFINITY; s1 = -INFINITY; s2 = -INFINITY; s3 = -INFINITY; }
        int my_e = 0; float my_s = 0.f, wsum = 0.f;
#pragma unroll
        for (int k = 0; k < 8; ++k) {
            float bv = s0; int bi = lane * 4;
            if (s1 > bv) { bv = s1; bi = lane * 4 + 1; }
            if (s2 > bv) { bv = s2; bi = lane * 4 + 2; }
            if (s3 > bv) { bv = s3; bi = lane * 4 + 3; }
#pragma unroll
            for (int o = 1; o < 64; o <<= 1) {
                const float ov = __shfl_xor(bv, o); const int oi = __shfl_xor(bi, o);
                if (ov > bv || (ov == bv && oi < bi)) { bv = ov; bi = oi; }
            }
            const int own = bi >> 2, sub = bi & 3;
            const float mine = sub == 0 ? sc.x : sub == 1 ? sc.y : sub == 2 ? sc.z : sc.w;
            const float sel_sc = __shfl(mine, own);
            if (lane == own) { if (sub == 0) s0 = -INFINITY; else if (sub == 1) s1 = -INFINITY; else if (sub == 2) s2 = -INFINITY; else s3 = -INFINITY; }
            wsum += sel_sc;
            if (lane == k) { my_e = bi; my_s = sel_sc; }
        }
        if (lane < 8) {
            atomicAdd(lh + my_e, 1);
            tope[tok * 8 + lane] = my_e; topw[tok * 8 + lane] = my_s / wsum * 2.5f;
        }
    }
    __syncthreads();
    ((int*)(p.ws + OFF_HIST))[blockIdx.x * 256 + tid] = lh[tid];
}
__device__ __forceinline__ void phase_assign(const Params& p, unsigned char* smem) {
    const int tid = opaque_tid(), lane = tid & 63, wid = tid >> 6;
    int* offs = (int*)smem; int* lc = offs + 256;
    const int* hist = (const int*)(p.ws + OFF_HIST);
    int* slot_tok = (int*)(p.ws + OFF_SLOT);
    const int* tope = (const int*)(p.ws + OFF_TOPE); int* rnk = (int*)(p.ws + OFF_RANK);
    {
        int run = 0, mine = 0;
        const int nb = gridDim.x, me = blockIdx.x;
        for (int b0 = 0; b0 < nb; b0 += 8) {
            int v[8];
#pragma unroll
            for (int j = 0; j < 8; ++j) v[j] = (b0 + j < nb) ? hist[(b0 + j) * 256 + tid] : 0;
#pragma unroll
            for (int j = 0; j < 8; ++j) { if (b0 + j == me) mine = run; run += v[j]; }
        }
        offs[tid] = mine; lc[tid] = 0;
        if (me == 0) ((int*)(p.ws + OFF_CNT))[tid] = run;
    }
    __syncthreads();
    for (int tok = blockIdx.x * 4 + wid; tok < NTOK; tok += gridDim.x * 4) {
        if (lane < 8) {
            const int e = tope[tok * 8 + lane];
            const int rk = offs[e] + atomicAdd(lc + e, 1);
            rnk[tok * 8 + lane] = rk; slot_tok[(size_t)e * NTOK + rk] = tok;
        }
    }
}

__device__ __forceinline__ int* build_tile_table(const Params& p, unsigned char* smem) {
    int* tstart = (int*)(smem + 73728); int* cn = tstart + 260; int* pstart = cn + 256;
    const int tid = opaque_tid();
    cn[tid] = ((const int*)(p.ws + OFF_CNT))[tid];
    __syncthreads();
    if (tid == 0) {
        int s = 0, q = 0;
        for (int e = 0; e < 256; ++e) { const int t = (cn[e] + 127) >> 7; tstart[e] = s; pstart[e] = q; s += t; q += (t + 1) >> 1; }
        tstart[256] = s; pstart[256] = q;
    }
    __syncthreads();
    return tstart;
}
__device__ __forceinline__ int find_pair_expert(const int* pstart, int mp) {
    int lo = 0, hi = 256;
    while (hi - lo > 1) { const int mid = (lo + hi) >> 1; if (pstart[mid] <= mp) lo = mid; else hi = mid; }
    return lo;
}

__device__ __forceinline__ void gemm_core_m256(f32x16 (&acc)[4][2], const u16* abase, const int (&roff)[8], const float* bsrc, const size_t ldb, const int nk,
                                               unsigned char* smem, const int tid, const int lane, const int wr, const int wc) {
    typedef __attribute__((address_space(3))) unsigned lds_u32;
    u16* Bs = (u16*)(smem + 32768);
    f32x4 br[8];
#pragma unroll
    for (int i = 0; i < 8; ++i) br[i] = *(const f32x4*)(bsrc + (size_t)i * ldb);
    const int arow = tid >> 3, ach = tid & 7;
    const int r = lane & 31, hh = lane >> 5;
    for (int kt = 0; kt < nk; ++kt) {
        __syncthreads();
        {
            unsigned char* sa = smem + tid * 16;
#pragma unroll
            for (int i = 0; i < 8; ++i) __builtin_amdgcn_global_load_lds((const unsigned*)(abase + roff[i] + kt * 64), (lds_u32*)(sa + i * 4096), 16, 0, 0);
        }
#pragma unroll
        for (int cc = 0; cc < 4; ++cc) {
            u32x4 w; w.x = pk2(br[0][cc], br[1][cc]); w.y = pk2(br[2][cc], br[3][cc]); w.z = pk2(br[4][cc], br[5][cc]); w.w = pk2(br[6][cc], br[7][cc]);
            *(u32x4*)(Bs + (arow * 4 + cc) * LDT + ach * 8) = w;
        }
        __syncthreads();
        if (kt + 1 < nk) {
            const float* bp = bsrc + (size_t)(kt + 1) * 64 * ldb;
#pragma unroll
            for (int i = 0; i < 8; ++i) br[i] = *(const f32x4*)(bp + (size_t)i * ldb);
        }
        __builtin_amdgcn_s_setprio(1);
#pragma unroll 1
        for (int kk = 0; kk < 4; ++kk) {
            bf16x8 a[4], b[2];
            const int ch = ((kk * 2 + hh) ^ ((r >> 1) & 7)) * 16;
#pragma unroll
            for (int mi = 0; mi < 4; ++mi) a[mi] = *(const bf16x8*)(smem + (wr * 128 + mi * 32 + r) * 128 + ch);
#pragma unroll
            for (int ni = 0; ni < 2; ++ni) b[ni] = *(const bf16x8*)(Bs + (wc * 64 + ni * 32 + r) * LDT + kk * 16 + hh * 8);
#pragma unroll
            for (int mi = 0; mi < 4; ++mi)
#pragma unroll
                for (int ni = 0; ni < 2; ++ni) acc[mi][ni] = mfma32(b[ni], a[mi], acc[mi][ni]);
        }
        __builtin_amdgcn_s_setprio(0);
    }
    __syncthreads();
}

__device__ __forceinline__ void phase_moe1(const Params& p, unsigned char* smem) {
    const int* tstart = build_tile_table(p, smem); const int* cn = tstart + 260; const int* pstart = cn + 256;
    const u16* H2 = (const u16*)(p.ws + OFF_H);
    const int* slot_tok = (const int*)(p.ws + OFF_SLOT);
    u16* HID = (u16*)(p.ws + OFF_HID);
    const int tid = opaque_tid(), lane = tid & 63, wid = tid >> 6, wr = wid >> 1, wc = wid & 1;
    const int r = lane & 31, hh = lane >> 5;
    const int totalp = pstart[256];
    const int nitems = totalp * 4 + 512;
    const int sw = ((tid & 7) ^ ((tid >> 4) & 7)) * 8;
    for (int ii = 0;; ++ii) {
        const int it = ((blockIdx.x & 7) + 8 * ii) * (gridDim.x >> 3) + (blockIdx.x >> 3);
        if (it >= nitems) break;
        const bool shared = it >= totalp * 4;
        const int idx = shared ? it - totalp * 4 : it;
        const int mp = idx >> 2, nq = idx & 3;
        int e = 0, jp = 0, cnt_e = 0, vrows = 256;
        size_t hrow0;
        if (!shared) {
            e = find_pair_expert(pstart, mp); jp = mp - pstart[e]; cnt_e = cn[e];
            const int te = (cnt_e + 127) >> 7;
            vrows = (2 * jp + 1 < te) ? 256 : 128;
            hrow0 = (size_t)tstart[e] * 128 + jp * 256;
        } else hrow0 = (size_t)SH_BASE + mp * 256;
        int roff[8];
#pragma unroll
        for (int i = 0; i < 8; ++i) {
            const int ri = (tid >> 3) + 32 * i;
            int tok;
            if (shared) tok = mp * 256 + ri;
            else { const int pos = jp * 256 + ri; tok = pos < cnt_e ? slot_tok[(size_t)e * NTOK + pos] : 0; }
            roff[i] = tok * 1024 + sw;
        }
        const int R0 = (tid >> 3) * 4, bwc = R0 >> 6, bni = (R0 >> 5) & 1, bj = R0 & 31;
        const float* wsel = shared ? (bni ? p.w_sh_up : p.w_sh_gate) : ((bni ? p.w_exp_up : p.w_exp_gate) + (size_t)e * 1024 * 256);
        const float* bsrc = wsel + (size_t)((tid & 7) * 8) * 256 + nq * 64 + bwc * 32 + bj;
        f32x16 acc[4][2] = {};
        gemm_core_m256(acc, H2, roff, bsrc, 256, 16, smem, tid, lane, wr, wc);
        u16* Ct = (u16*)smem;
#pragma unroll
        for (int mi = 0; mi < 4; ++mi) {
            u16* base = Ct + (wr * 128 + mi * 32 + r) * LDT + wc * 32 + 4 * hh;
#pragma unroll
            for (int g = 0; g < 4; ++g) {
                float hv[4];
#pragma unroll
                for (int j = 0; j < 4; ++j) { const float gt = acc[mi][0][4 * g + j], u = acc[mi][1][4 * g + j]; hv[j] = gt * sigmoid_(gt) * u; }
                u32x2 w; w.x = pk2(hv[0], hv[1]); w.y = pk2(hv[2], hv[3]);
                *(u32x2*)(base + 8 * g) = w;
            }
        }
        __syncthreads();
#pragma unroll
        for (int i = 0; i < 8; ++i) {
            const int id2 = tid + i * 256, row = id2 >> 3, ch = id2 & 7;
            if (row < vrows) *(u32x4*)(HID + (hrow0 + row) * 256 + nq * 64 + ch * 8) = *(const u32x4*)(Ct + row * LDT + ch * 8);
        }
        __syncthreads();
    }
}

__device__ __forceinline__ void phase_moe2(const Params& p, unsigned char* smem) {
    const int* tstart = build_tile_table(p, smem); const int* cn = tstart + 260; const int* pstart = cn + 256;
    const u16* HID = (const u16*)(p.ws + OFF_HID);
    u16* Y = (u16*)(p.ws + OFF_Y);
    const int tid = opaque_tid(), lane = tid & 63, wid = tid >> 6, wr = wid >> 1, wc = wid & 1;
    const int r = lane & 31, hh = lane >> 5;
    const int totalp = pstart[256];
    const int nitems = totalp * 8 + 1024;
    const int sw = ((tid & 7) ^ ((tid >> 4) & 7)) * 8;
    for (int ii = 0;; ++ii) {
        const int it = ((blockIdx.x & 7) + 8 * ii) * (gridDim.x >> 3) + (blockIdx.x >> 3);
        if (it >= nitems) break;
        const bool shared = it >= totalp * 8;
        const int idx = shared ? it - totalp * 8 : it;
        const int mp = idx >> 3, nt = idx & 7;
        int e = 0, vrows = 256;
        size_t hrow0;
        if (!shared) {
            e = find_pair_expert(pstart, mp); const int jp = mp - pstart[e];
            const int te = (cn[e] + 127) >> 7;
            vrows = (2 * jp + 1 < te) ? 256 : 128;
            hrow0 = (size_t)tstart[e] * 128 + jp * 256;
        } else hrow0 = (size_t)SH_BASE + mp * 256;
        int roff[8];
#pragma unroll
        for (int i = 0; i < 8; ++i) {
            const int ri = (tid >> 3) + 32 * i;
            roff[i] = (int)(hrow0 + (ri < vrows ? ri : ri - 128)) * 256 + sw;
        }
        const float* wsel = shared ? p.w_sh_down : p.w_exp_down + (size_t)e * 256 * 1024;
        const float* bsrc = wsel + (size_t)((tid & 7) * 8) * 1024 + nt * 128 + (tid >> 3) * 4;
        f32x16 acc[4][2] = {};
        gemm_core_m256(acc, HID, roff, bsrc, 1024, 4, smem, tid, lane, wr, wc);
        u16* Ct = (u16*)smem;
#pragma unroll
        for (int mi = 0; mi < 4; ++mi)
#pragma unroll
            for (int ni = 0; ni < 2; ++ni) {
                u16* base = Ct + (wr * 128 + mi * 32 + r) * CT_LD + wc * 64 + ni * 32 + 4 * hh;
#pragma unroll
                for (int g = 0; g < 4; ++g) {
                    u32x2 w; w.x = pk2(acc[mi][ni][4 * g], acc[mi][ni][4 * g + 1]); w.y = pk2(acc[mi][ni][4 * g + 2], acc[mi][ni][4 * g + 3]);
                    *(u32x2*)(base + 8 * g) = w;
                }
            }
        __syncthreads();
#pragma unroll 4
        for (int i = 0; i < 16; ++i) {
            const int id2 = tid + i * 256, row = id2 >> 4, ch = id2 & 15;
            if (row < vrows) *(u32x4*)(Y + (hrow0 + row) * 1024 + nt * 128 + ch * 8) = *(const u32x4*)(Ct + row * CT_LD + ch * 8);
        }
        __syncthreads();
    }
}

__device__ __forceinline__ void phase_combine(const Params& p, unsigned char* smem) {
    const int* tstart = build_tile_table(p, smem);
    float* g2t = (float*)smem;
    const int tid = opaque_tid(), lane = tid & 63, wid = tid >> 6;
    for (int j = tid; j < 2048; j += 256) g2t[j] = mod_val(p, j >> 10, 5120 + (j & 1023));
    __syncthreads();
    const u16* Y = (const u16*)(p.ws + OFF_Y);
    const int* tope = (const int*)(p.ws + OFF_TOPE); const int* rnk = (const int*)(p.ws + OFF_RANK); const float* topw = (const float*)(p.ws + OFF_TOPW);
    for (int tok = blockIdx.x * 4 + wid; tok < NTOK; tok += gridDim.x * 4) {
        int myrow = 0; float myw = 0.f;
        if (lane < 8) { const int e = tope[tok * 8 + lane]; myrow = tstart[e] * 128 + rnk[tok * 8 + lane]; myw = topw[tok * 8 + lane]; }
        if (lane == 8) { myrow = SH_BASE + tok; myw = 1.f; }
        const float* g2 = g2t + (tok >> 14) * 1024;
        f32x4 a[4];
#pragma unroll
        for (int j = 0; j < 4; ++j) a[j] = (f32x4){0.f, 0.f, 0.f, 0.f};
#pragma unroll
        for (int k = 0; k < 9; ++k) {
            const int row = __shfl(myrow, k); const float w = __shfl(myw, k);
            const u16* yr = Y + (size_t)row * 1024 + lane * 4;
#pragma unroll
            for (int j = 0; j < 4; ++j) {
                const u32x2 v = *(const u32x2*)(yr + j * 256);
                a[j].x += w * bf_lo(v.x); a[j].y += w * bf_hi(v.x); a[j].z += w * bf_lo(v.y); a[j].w += w * bf_hi(v.y);
            }
        }
#pragma unroll
        for (int j = 0; j < 4; ++j) {
            const int col = j * 256 + lane * 4;
            float* op = p.out + (size_t)tok * 1024 + col;
            const f32x4 x1 = *(const f32x4*)op, g = *(const f32x4*)(g2 + col);
            f32x4 o; o.x = x1.x + g.x * a[j].x; o.y = x1.y + g.y * a[j].y; o.z = x1.z + g.z * a[j].z; o.w = x1.w + g.w * a[j].w;
            *(f32x4*)op = o;
        }
    }
}

#define XB_TMO      128
#define XB_XCNT(j)  (256  + 64 * (j))
#define XB_XSUB(j)  (1280 + 64 * (j))
#define XB_XGEN(j)  (2304 + 64 * (j))
#define XB_TOP      3328
#define XB_TOPGEN   3392
#define XCD_BAR_WORDS 3456
#define XB_SPIN_CAP (1u << 24)
#define LAS __attribute__((address_space(3)))
__device__ __forceinline__ unsigned xb_ld(unsigned* p)              { return __hip_atomic_load(p, __ATOMIC_RELAXED, __HIP_MEMORY_SCOPE_AGENT); }
__device__ __forceinline__ unsigned xb_add(unsigned* p, unsigned v) { return __hip_atomic_fetch_add(p, v, __ATOMIC_RELAXED, __HIP_MEMORY_SCOPE_AGENT); }
__device__ __forceinline__ unsigned xb_xcc_id() { return (unsigned)__builtin_amdgcn_s_getreg((3 << 11) | 20) & 0xFu; }
#define XB_SPIN(cond, bar) do { unsigned _sp = 0; while (cond) { __builtin_amdgcn_s_sleep(1); \
    if ((++_sp & 255u) == 0u) { if (xb_ld(&(bar)[XB_TMO])) break; if (_sp > XB_SPIN_CAP) { atomicAdd(&(bar)[XB_TMO], 1u); break; } } } } while (0)
struct XcdBarrier { unsigned* bar; unsigned x; volatile LAS unsigned* st; };
__device__ __forceinline__ XcdBarrier xcd_barrier_post(unsigned* bar, volatile LAS unsigned* st) {
    XcdBarrier b; b.bar = bar; b.x = xb_xcc_id(); b.st = st;
    if (threadIdx.x == 0) (void)xb_add(&bar[XB_XCNT(b.x)], 1u);
    return b;
}
__device__ __forceinline__ void xcd_barrier_complete(unsigned* bar, unsigned x, unsigned& nloc, unsigned& nx) {
    const unsigned G = gridDim.x * gridDim.y * gridDim.z;
    unsigned sum, cnt, mine, sp = 0u;
    for (;;) {
        sum = 0u; cnt = 0u; mine = 0u;
#pragma unroll
        for (unsigned j = 0; j < 16; ++j) { const unsigned c = xb_ld(&bar[XB_XCNT(j)]); sum += c; cnt += (c > 0u) ? 1u : 0u; mine = (j == x) ? c : mine; }
        if (sum == G) break;
        __builtin_amdgcn_s_sleep(1);
        if ((++sp & 255u) == 0u) { if (xb_ld(&bar[XB_TMO])) break; if (sp > XB_SPIN_CAP) { atomicAdd(&bar[XB_TMO], 1u); break; } }
    }
    nloc = mine > 0u ? mine : 1u; nx = cnt > 0u ? cnt : 1u;
}
__device__ __forceinline__ void xcd_barrier(const XcdBarrier& b) {
    asm volatile("s_waitcnt vmcnt(0)" ::: "memory");
    __syncthreads();
    if (threadIdx.x == 0) {
        unsigned* bar = b.bar;
        __builtin_amdgcn_s_waitcnt(0);
        unsigned nloc = b.st[0], nx = b.st[1];
        if (nloc == 0u) { xcd_barrier_complete(bar, b.x, nloc, nx); b.st[0] = nloc; b.st[1] = nx; }
        const unsigned old = xb_add(&bar[XB_XSUB(b.x)], 1u);
        const unsigned gen = old / nloc;
        if (old + 1u == (gen + 1u) * nloc) {
            __builtin_amdgcn_fence(__ATOMIC_RELEASE, "agent");
            asm volatile("s_waitcnt vmcnt(0)" ::: "memory");
            const unsigned og = xb_add(&bar[XB_TOP], 1u);
            const unsigned tg = og / nx;
            if (og + 1u == (tg + 1u) * nx) xb_add(&bar[XB_TOPGEN], 1u);
            else XB_SPIN(xb_ld(&bar[XB_TOPGEN]) == tg, bar);
            __builtin_amdgcn_fence(__ATOMIC_ACQUIRE, "agent");
            xb_add(&bar[XB_XGEN(b.x)], 1u);
            asm volatile("s_waitcnt vmcnt(0)" ::: "memory");
        } else {
            XB_SPIN(xb_ld(&bar[XB_XGEN(b.x)]) == gen, bar);
            __builtin_amdgcn_fence(__ATOMIC_ACQUIRE, "agent");
            asm volatile("s_waitcnt vmcnt(0)" ::: "memory");
        }
    }
    __syncthreads();
}

__global__ void __launch_bounds__(256, 2) mega(Params p) {
    extern __shared__ __attribute__((aligned(16))) unsigned char smem[];
    cg::grid_group grid = cg::this_grid();
    if (p.ph_lo < 0) grid.sync();
    volatile LAS unsigned* xst = (volatile LAS unsigned*)(smem + 77808);
    if (threadIdx.x == 0) { xst[0] = 0u; xst[1] = 0u; }
    __syncthreads();
    const XcdBarrier xb = xcd_barrier_post((unsigned*)(p.ws + OFF_BAR), xst);
#define GSYNC() xcd_barrier(xb)
#define PHASE_BEGIN(k) if (p.ph_lo <= (k) && (k) < p.ph_hi) {
#define PHASE_END(k) if ((k) + 1 < p.ph_hi) GSYNC(); }
    PHASE_BEGIN(0) phase_ada(p, smem); if (DUP_PHASE == 0) { GSYNC(); phase_ada(p, smem); } PHASE_END(0)
    PHASE_BEGIN(1) phase_norm(p, smem, false); if (DUP_PHASE == 1) { GSYNC(); phase_norm(p, smem, false); } PHASE_END(1)
    PHASE_BEGIN(2) phase_inproj(p, smem); if (DUP_PHASE == 2) { GSYNC(); phase_inproj(p, smem); } PHASE_END(2)
    PHASE_BEGIN(3)
        for (int it = blockIdx.x; it < 2080; it += gridDim.x) mlstm_passA(p, smem, it);
        if (DUP_PHASE == 3) { GSYNC(); for (int it = blockIdx.x; it < 2080; it += gridDim.x) mlstm_passA(p, smem, it); }
        if (DUP_PHASE == 30) { GSYNC(); for (int it = blockIdx.x; it < 4096; it += gridDim.x) na_item(p, smem, it); }
    PHASE_END(3)
    PHASE_BEGIN(4)
        if (blockIdx.x * 2 < gridDim.x) { phase_scan(p, smem); for (int it = blockIdx.x; it < 4096; it += gridDim.x) na_item(p, smem, it); }
        else { for (int it = blockIdx.x; it < 4096; it += gridDim.x) na_item(p, smem, it); phase_scan(p, smem); }
 if (DUP_PHASE == 34) { GSYNC(); for (int it = blockIdx.x; it < 2080; it += gridDim.x) mlstm_passA(p, smem, it); GSYNC(); phase_scan(p, smem); } PHASE_END(4)
    PHASE_BEGIN(5) for (int it = blockIdx.x; it < 2048; it += gridDim.x) mlstm_passC(p, smem, it); if (DUP_PHASE == 5) { GSYNC(); for (int it = blockIdx.x; it < 2048; it += gridDim.x) mlstm_passC(p, smem, it); } PHASE_END(5)
    PHASE_BEGIN(6) phase_merge(p, smem, false); phase_merge(p, smem, true); if (DUP_PHASE == 6) { GSYNC(); phase_merge(p, smem, false); phase_merge(p, smem, true); } PHASE_END(6)
    PHASE_BEGIN(7) phase_outproj(p, smem); if (DUP_PHASE == 7) { GSYNC(); phase_outproj(p, smem); } PHASE_END(7)
    PHASE_BEGIN(8) phase_norm(p, smem, true); if (DUP_PHASE == 8) { GSYNC(); phase_norm(p, smem, true); } PHASE_END(8)
    PHASE_BEGIN(9) phase_router(p, smem); if (DUP_PHASE == 9) { GSYNC(); phase_router(p, smem); } PHASE_END(9)
    PHASE_BEGIN(10) phase_route(p, smem); PHASE_END(10)
    PHASE_BEGIN(11) phase_assign(p, smem); PHASE_END(11)
    PHASE_BEGIN(12) phase_moe1(p, smem); if (DUP_PHASE == 12) { GSYNC(); phase_moe1(p, smem); } PHASE_END(12)
    PHASE_BEGIN(13) phase_moe2(p, smem); if (DUP_PHASE == 13) { GSYNC(); phase_moe2(p, smem); } PHASE_END(13)
    PHASE_BEGIN(14) phase_combine(p, smem);
        if (DUP_PHASE == 200) { for (int q = 0; q < 20; ++q) GSYNC(); }
        if (DUP_PHASE == 100) { GSYNC(); phase_route(p, smem); GSYNC(); phase_assign(p, smem); }
    PHASE_END(14)
}

extern "C" void kernel_launch(void* const* d_in, const int* in_sizes, int n_in, void* d_out, int out_size, void* d_ws, size_t ws_size, hipStream_t stream) {
    static int grid_blocks = 0;
    if (!grid_blocks) {
        int dev = 0, cus = 0, per_cu = 0;
        (void)hipGetDevice(&dev);
        (void)hipDeviceGetAttribute(&cus, hipDeviceAttributeMultiprocessorCount, dev);
        (void)hipFuncSetAttribute((const void*)mega, hipFuncAttributeMaxDynamicSharedMemorySize, LDS_BYTES);
        (void)hipOccupancyMaxActiveBlocksPerMultiprocessor(&per_cu, mega, 256, LDS_BYTES);
        if (per_cu > 2) per_cu = 2;
        if (per_cu < 1) per_cu = 1;
        grid_blocks = cus * per_cu;
        if (ws_size < WS_END) fprintf(stderr, "kernel_launch: workspace too small: %zu < %zu\n", ws_size, (size_t)WS_END);
    }
    (void)hipMemsetAsync((char*)d_ws + OFF_BAR, 0, XCD_BAR_WORDS * 4, stream);
    Params p{};
    const float** pp = (const float**)&p;
    for (int i = 0; i < 23; ++i) pp[i] = (const float*)d_in[i];
    p.out = (float*)d_out; p.ws = (unsigned char*)d_ws;
#if MULTI_LAUNCH
    for (int ph = 0; ph < NPH; ++ph) {
        p.ph_lo = ph; p.ph_hi = ph + 1;
        void* args[] = {&p};
        hipError_t e = hipLaunchCooperativeKernel((void*)mega, dim3(grid_blocks), dim3(256), args, LDS_BYTES, stream);
        if (e != hipSuccess) fprintf(stderr, "cooperative launch failed: %s (grid %d)\n", hipGetErrorString(e), grid_blocks);
    }
#else
    p.ph_lo = 0; p.ph_hi = NPH;
    void* args[] = {&p};
    hipError_t e = hipLaunchCooperativeKernel((void*)mega, dim3(grid_blocks), dim3(256), args, LDS_BYTES, stream);
    if (e != hipSuccess) fprintf(stderr, "cooperative launch failed: %s (grid %d)\n", hipGetErrorString(e), grid_blocks);
#endif
}
```

```cpp
#include <hip/hip_runtime.h>
#include <hip/hip_cooperative_groups.h>
#include <cstdio>
#include <cstdint>
namespace cg = cooperative_groups;

#ifndef MULTI_LAUNCH
#define MULTI_LAUNCH 0
#endif
#ifndef DUP_PHASE
#define DUP_PHASE -1
#endif

typedef unsigned short u16;
typedef unsigned int u32;
typedef short bf16x8 __attribute__((ext_vector_type(8)));
typedef float f32x16 __attribute__((ext_vector_type(16)));
typedef float f32x4 __attribute__((ext_vector_type(4)));
typedef u32 u32x4 __attribute__((ext_vector_type(4)));
typedef u32 u32x2 __attribute__((ext_vector_type(2)));

constexpr int DM = 1024;
constexpr int NTOK = 32768;
constexpr int TSEQ = 16384;
constexpr int MTOT = 33280;
constexpr int INC = 6672;
constexpr int PV = 6784;
constexpr int V_MQ = 0, V_MK = 512, V_MV = 1024, V_MO = 2048, V_NQ = 3072, V_NK = 3584, V_NV = 4096, V_GM = 4608, V_GN = 5632;
constexpr int NSLOT = 4160;
constexpr int SH_BASE = 294912;
constexpr int NPH = 15;
constexpr int LDS_BYTES = 76 * 1024;
constexpr int LDT = 72;
constexpr int LDQ = 136;

constexpr size_t AL(size_t x) { return (x + 255) & ~(size_t)255; }
constexpr size_t OFF_MODP = 0;
constexpr size_t OFF_CNT  = AL(OFF_MODP + (size_t)8 * 3 * 6144 * 4);
constexpr size_t OFF_G    = AL(OFF_CNT + 1024);
constexpr size_t OFF_GS   = AL(OFF_G + (size_t)MTOT * 16 * 4);
constexpr size_t OFF_ML   = AL(OFF_GS + NSLOT * 4);
constexpr size_t OFF_MP   = AL(OFF_ML + NSLOT * 4);
constexpr size_t OFF_DN   = AL(OFF_MP + NSLOT * 4);
constexpr size_t OFF_TOPE = AL(OFF_DN + (size_t)NSLOT * 128 * 4);
constexpr size_t OFF_RANK = OFF_TOPE + (size_t)NTOK * 8 * 4;
constexpr size_t OFF_TOPW = OFF_RANK + (size_t)NTOK * 8 * 4;
constexpr size_t OFF_H    = AL(OFF_TOPW + (size_t)NTOK * 8 * 4);
constexpr size_t OFF_SLOT = AL(OFF_H + (size_t)MTOT * 1024 * 2);
constexpr size_t OFF_R4   = AL(OFF_SLOT + (size_t)256 * 32768 * 4);
constexpr size_t OFF_YNA  = OFF_R4;
constexpr size_t OFF_YM   = OFF_R4 + (size_t)NTOK * 512 * 2;
constexpr size_t OFF_MRG  = OFF_YM + (size_t)NTOK * 1024 * 2;
constexpr size_t OFF_SC   = OFF_R4;
constexpr size_t OFF_HID  = OFF_R4;
constexpr size_t OFF_P    = AL(OFF_R4 + (size_t)327680 * 256 * 2);
constexpr size_t OFF_CT   = AL(OFF_P + (size_t)MTOT * PV * 2);
constexpr size_t OFF_Y    = OFF_P;
constexpr size_t OFF_WINT = AL(OFF_CT + (size_t)NSLOT * 65536);
constexpr size_t OFF_BRMT = AL(OFF_WINT + (size_t)6912 * 1024 * 2);
constexpr size_t OFF_BRNT = AL(OFF_BRMT + (size_t)1024 * 1024 * 2);
constexpr size_t OFF_OUTT = AL(OFF_BRNT + (size_t)1024 * 512 * 2);
constexpr size_t OFF_RTT  = AL(OFF_OUTT + (size_t)1024 * 1024 * 2);
constexpr size_t OFF_HIST = AL(OFF_RTT + (size_t)256 * 1024 * 2);
constexpr size_t OFF_BAR  = AL(OFF_HIST + (size_t)1024 * 256 * 4);
constexpr size_t WS_END   = OFF_BAR + 16384;
static_assert(OFF_Y + (size_t)327680 * 1024 * 2 <= OFF_WINT, "Y must fit over P+CT");
static_assert(WS_END <= (size_t)1073741824, "workspace budget");

struct Params {
    const float *x, *c, *ctx, *c_ctx, *w_ada, *b_ada, *w_in, *b_mgate, *m_norm_w, *na_qn_w, *na_kn_w, *na_rpb,
                *w_br_m, *w_br_na, *w_out, *w_router, *router_bias, *w_exp_gate, *w_exp_up, *w_exp_down,
                *w_sh_gate, *w_sh_up, *w_sh_down;
    float* out;
    unsigned char* ws;
    int ph_lo, ph_hi;
};

typedef __bf16 bf16x2_t __attribute__((ext_vector_type(2)));
__device__ __forceinline__ u32 pk2(float lo, float hi) { bf16x2_t v = {(__bf16)lo, (__bf16)hi}; return __builtin_bit_cast(u32, v); }
__device__ __forceinline__ u16 f2bf(float f) { return (u16)(pk2(f, 0.f) & 0xffffu); }
__device__ __forceinline__ float bf2f(u16 h) { return __uint_as_float(((u32)h) << 16); }
__device__ __forceinline__ float bf_lo(u32 w) { return __uint_as_float(w << 16); }
__device__ __forceinline__ float bf_hi(u32 w) { return __uint_as_float(w & 0xffff0000u); }
__device__ __forceinline__ float sigmoid_(float x) { return 1.f / (1.f + __expf(-x)); }
__device__ __forceinline__ float log_sigmoid_(float x) { return fminf(x, 0.f) - __logf(1.f + __expf(-fabsf(x))); }
__device__ __forceinline__ f32x4 mfma16(bf16x8 a, bf16x8 b, f32x4 c) { return __builtin_amdgcn_mfma_f32_16x16x32_bf16(a, b, c, 0, 0, 0); }
__device__ __forceinline__ f32x16 mfma32(bf16x8 a, bf16x8 b, f32x16 c) { return __builtin_amdgcn_mfma_f32_32x32x16_bf16(a, b, c, 0, 0, 0); }

__device__ __forceinline__ void sincos_rev(float rev, float& sn, float& cs) {
    rev -= rintf(rev);
    const float kq = rintf(rev * 4.f);
    const float th = (rev - kq * 0.25f) * 6.283185307179586f;
    const float t2 = th * th;
    const float s = th * (1.f + t2 * (-1.f / 6.f + t2 * (1.f / 120.f + t2 * (-1.f / 5040.f + t2 * (1.f / 362880.f)))));
    const float c = 1.f + t2 * (-0.5f + t2 * (1.f / 24.f + t2 * (-1.f / 720.f + t2 * (1.f / 40320.f))));
    const int k = ((int)kq) & 3;
    sn = (k == 0) ? s : (k == 1) ? c : (k == 2) ? -s : -c;
    cs = (k == 0) ? c : (k == 1) ? -s : (k == 2) ? -c : s;
}
__device__ __forceinline__ int opaque_tid() { int t = threadIdx.x; asm volatile("" : "+v"(t)); return t; }
__device__ __forceinline__ float wave_sum(float v) {
#pragma unroll
    for (int o = 1; o < 64; o <<= 1) v += __shfl_xor(v, o);
    return v;
}
__device__ __forceinline__ float wave_max(float v) {
#pragma unroll
    for (int o = 1; o < 64; o <<= 1) v = fmaxf(v, __shfl_xor(v, o));
    return v;
}
__device__ __forceinline__ float wave_incl_sum(float v, int lane) {
#pragma unroll
    for (int o = 1; o < 64; o <<= 1) { float t = __shfl_up(v, o); if (lane >= o) v += t; }
    return v;
}
__device__ __forceinline__ float wave_prefix_max(float v, int lane) {
#pragma unroll
    for (int o = 1; o < 64; o <<= 1) { float t = __shfl_up(v, o); if (lane >= o) v = fmaxf(v, t); }
    return v;
}
__device__ __forceinline__ float wave_suffix_max(float v, int lane) {
#pragma unroll
    for (int o = 1; o < 64; o <<= 1) { float t = __shfl_down(v, o); if (lane + o < 64) v = fmaxf(v, t); }
    return v;
}
__device__ __forceinline__ float mod_val(const Params& p, int vec, int j) {
    const float* mp = (const float*)(p.ws + OFF_MODP);
    float s = p.b_ada[j];
#pragma unroll
    for (int ks = 0; ks < 8; ++ks) s += mp[(ks * 3 + vec) * 6144 + j];
    return s;
}
__device__ __forceinline__ u32x4 tr8(const u32x2 (&v)[8], int cc) {
    u32x4 o;
    if (cc == 0)      { o.x = (v[0].x & 0xffffu) | (v[1].x << 16); o.y = (v[2].x & 0xffffu) | (v[3].x << 16); o.z = (v[4].x & 0xffffu) | (v[5].x << 16); o.w = (v[6].x & 0xffffu) | (v[7].x << 16); }
    else if (cc == 1) { o.x = (v[0].x >> 16) | (v[1].x & 0xffff0000u); o.y = (v[2].x >> 16) | (v[3].x & 0xffff0000u); o.z = (v[4].x >> 16) | (v[5].x & 0xffff0000u); o.w = (v[6].x >> 16) | (v[7].x & 0xffff0000u); }
    else if (cc == 2) { o.x = (v[0].y & 0xffffu) | (v[1].y << 16); o.y = (v[2].y & 0xffffu) | (v[3].y << 16); o.z = (v[4].y & 0xffffu) | (v[5].y << 16); o.w = (v[6].y & 0xffffu) | (v[7].y << 16); }
    else              { o.x = (v[0].y >> 16) | (v[1].y & 0xffff0000u); o.y = (v[2].y >> 16) | (v[3].y & 0xffff0000u); o.z = (v[4].y >> 16) | (v[5].y & 0xffff0000u); o.w = (v[6].y >> 16) | (v[7].y & 0xffff0000u); }
    return o;
}
__device__ __forceinline__ float bfsel(const u32x2& v, int cc) { return cc == 0 ? bf_lo(v.x) : cc == 1 ? bf_hi(v.x) : cc == 2 ? bf_lo(v.y) : bf_hi(v.y); }

__device__ __forceinline__ void gemm_core2(f32x16 (&acc)[2][2], const u16* a0, const size_t a32, const u16* b0, const size_t b32, const int nk,
                                           unsigned char* smem, const int tid, const int lane, const int wr, const int wc) {
    typedef __attribute__((address_space(3))) unsigned lds_u32;
    const int r = lane & 31, hh = lane >> 5;
    {
        unsigned char* sa = smem + tid * 16;
#pragma unroll
        for (int i = 0; i < 4; ++i) {
            __builtin_amdgcn_global_load_lds((const unsigned*)(a0 + i * a32), (lds_u32*)(sa + i * 4096), 16, 0, 0);
            __builtin_amdgcn_global_load_lds((const unsigned*)(b0 + i * b32), (lds_u32*)(sa + 16384 + i * 4096), 16, 0, 0);
        }
    }
    for (int kt = 0; kt < nk; ++kt) {
        __syncthreads();
        if (kt + 1 < nk) {
            unsigned char* sa = smem + ((kt + 1) & 1) * 32768 + tid * 16;
            const u16* ap = a0 + (kt + 1) * 64; const u16* bp = b0 + (kt + 1) * 64;
#pragma unroll
            for (int i = 0; i < 4; ++i) {
                __builtin_amdgcn_global_load_lds((const unsigned*)(ap + i * a32), (lds_u32*)(sa + i * 4096), 16, 0, 0);
                __builtin_amdgcn_global_load_lds((const unsigned*)(bp + i * b32), (lds_u32*)(sa + 16384 + i * 4096), 16, 0, 0);
            }
        }
        const unsigned char* sa = smem + (kt & 1) * 32768; const unsigned char* sb = sa + 16384;
        __builtin_amdgcn_s_setprio(1);
#pragma unroll
        for (int kk = 0; kk < 4; ++kk) {
            bf16x8 a[2], b[2];
            const int ch = ((kk * 2 + hh) ^ ((r >> 1) & 7)) * 16;
#pragma unroll
            for (int mi = 0; mi < 2; ++mi) a[mi] = *(const bf16x8*)(sa + (wr * 64 + mi * 32 + r) * 128 + ch);
#pragma unroll
            for (int ni = 0; ni < 2; ++ni) b[ni] = *(const bf16x8*)(sb + (wc * 64 + ni * 32 + r) * 128 + ch);
#pragma unroll
            for (int mi = 0; mi < 2; ++mi)
#pragma unroll
                for (int ni = 0; ni < 2; ++ni) acc[mi][ni] = mfma32(b[ni], a[mi], acc[mi][ni]);
        }
        __builtin_amdgcn_s_setprio(0);
    }
}
#define RAW_BARRIER() do { asm volatile("s_waitcnt lgkmcnt(0)" ::: "memory"); __builtin_amdgcn_s_barrier(); } while (0)
__device__ __forceinline__ void gemm_core3(f32x16 (&acc)[2][4], const u16* a0, const size_t a64, const u16* b0, const size_t b64, const int nk,
                                           unsigned char* smem, const int tid, const int lane, const int wr, const int wc) {
    typedef __attribute__((address_space(3))) unsigned lds_u32;
    const int r = lane & 31, hh = lane >> 5;
#pragma unroll
    for (int s = 0; s < 2; ++s) {
        unsigned char* sa = smem + s * 24576 + tid * 16;
#pragma unroll
        for (int i = 0; i < 2; ++i) __builtin_amdgcn_global_load_lds((const unsigned*)(a0 + s * 32 + i * a64), (lds_u32*)(sa + i * 4096), 16, 0, 0);
#pragma unroll
        for (int i = 0; i < 4; ++i) __builtin_amdgcn_global_load_lds((const unsigned*)(b0 + s * 32 + i * b64), (lds_u32*)(sa + 8192 + i * 4096), 16, 0, 0);
    }
    int cur = 0;
    for (int kt = 0; kt < nk; ++kt) {
        if (kt + 1 < nk) asm volatile("s_waitcnt vmcnt(6)" ::: "memory"); else asm volatile("s_waitcnt vmcnt(0)" ::: "memory");
        RAW_BARRIER();
        if (kt + 2 < nk) {
            const int nx = cur == 0 ? 2 : cur - 1;
            unsigned char* sa = smem + nx * 24576 + tid * 16;
            const u16* ap = a0 + (kt + 2) * 32; const u16* bp = b0 + (kt + 2) * 32;
#pragma unroll
            for (int i = 0; i < 2; ++i) __builtin_amdgcn_global_load_lds((const unsigned*)(ap + i * a64), (lds_u32*)(sa + i * 4096), 16, 0, 0);
#pragma unroll
            for (int i = 0; i < 4; ++i) __builtin_amdgcn_global_load_lds((const unsigned*)(bp + i * b64), (lds_u32*)(sa + 8192 + i * 4096), 16, 0, 0);
        }
        const unsigned char* sa = smem + cur * 24576; const unsigned char* sb = sa + 8192;
        __builtin_amdgcn_s_setprio(1);
#pragma unroll
        for (int kk = 0; kk < 2; ++kk) {
            bf16x8 a[2], b[4];
            const int ch = ((kk * 2 + hh) ^ ((r >> 2) & 3)) * 16;
#pragma unroll
            for (int mi = 0; mi < 2; ++mi) a[mi] = *(const bf16x8*)(sa + (wr * 64 + mi * 32 + r) * 64 + ch);
#pragma unroll
            for (int ni = 0; ni < 4; ++ni) b[ni] = *(const bf16x8*)(sb + (wc * 128 + ni * 32 + r) * 64 + ch);
#pragma unroll
            for (int mi = 0; mi < 2; ++mi)
#pragma unroll
                for (int ni = 0; ni < 4; ++ni) acc[mi][ni] = mfma32(b[ni], a[mi], acc[mi][ni]);
        }
        __builtin_amdgcn_s_setprio(0);
        cur = cur == 2 ? 0 : cur + 1;
    }
}
constexpr int CT3_LD = 264;
__device__ __forceinline__ void ct_write3(u16* Ct, const f32x16 (&v)[2][4], const int wr, const int wc, const int lane) {
    const int r = lane & 31, hh = lane >> 5;
#pragma unroll
    for (int mi = 0; mi < 2; ++mi)
#pragma unroll
        for (int ni = 0; ni < 4; ++ni) {
            u16* base = Ct + (wr * 64 + mi * 32 + r) * CT3_LD + wc * 128 + ni * 32 + 4 * hh;
#pragma unroll
            for (int g = 0; g < 4; ++g) {
                u32x2 w; w.x = pk2(v[mi][ni][4 * g], v[mi][ni][4 * g + 1]); w.y = pk2(v[mi][ni][4 * g + 2], v[mi][ni][4 * g + 3]);
                *(u32x2*)(base + 8 * g) = w;
            }
        }
}
__device__ __forceinline__ bool sched_tile(const int i, const int ntm, const int ntn, const int W, int& mt, int& nt) {
    const int nx = gridDim.x >> 3;
    const int o = ((blockIdx.x & 7) + 8 * i) * nx + (blockIdx.x >> 3);
    if (o >= ntm * ntn) return false;
    const int full = ntn / W, fo = full * W * ntm;
    if (o < fo) { const int G = o / (W * ntm), rem = o - G * (W * ntm); mt = rem / W; nt = G * W + (rem - mt * W); }
    else { const int W2 = ntn - full * W, rem = o - fo; mt = rem / W2; nt = full * W + (rem - mt * W2); }
    return true;
}
__device__ __forceinline__ void conv_item(const float* W, const int ldw, const int k0, const int nreal0, u16* WT, const int K, const int nvirt0, float* T, const int tid) {
    const int kr = tid >> 4, c4 = tid & 15;
#pragma unroll
    for (int ps = 0; ps < 4; ++ps) {
        const int k = ps * 16 + kr;
        const f32x4 v = *(const f32x4*)(W + (size_t)(k0 + k) * ldw + nreal0 + c4 * 4);
        T[k * 65 + c4 * 4 + 0] = v.x; T[k * 65 + c4 * 4 + 1] = v.y; T[k * 65 + c4 * 4 + 2] = v.z; T[k * 65 + c4 * 4 + 3] = v.w;
    }
    __syncthreads();
    const int n = tid >> 2, kq = tid & 3;
    u32x4 o0, o1;
    const float* t = T + (kq * 16) * 65 + n;
    o0.x = pk2(t[0 * 65], t[1 * 65]); o0.y = pk2(t[2 * 65], t[3 * 65]); o0.z = pk2(t[4 * 65], t[5 * 65]); o0.w = pk2(t[6 * 65], t[7 * 65]);
    o1.x = pk2(t[8 * 65], t[9 * 65]); o1.y = pk2(t[10 * 65], t[11 * 65]); o1.z = pk2(t[12 * 65], t[13 * 65]); o1.w = pk2(t[14 * 65], t[15 * 65]);
    u16* dst = WT + (size_t)(nvirt0 + n) * K + k0 + kq * 16;
    *(u32x4*)dst = o0; *(u32x4*)(dst + 8) = o1;
    __syncthreads();
}
#define ACC_COL(reg) (((reg) & 3) + 8 * ((reg) >> 2))
#define ACC_ROW(mi, reg) ((mi) * 32 + ((reg) & 3) + 8 * ((reg) >> 2))
constexpr int CT_LD = 136;
__device__ __forceinline__ void ct_write(u16* Ct, const f32x16 (&v)[2][2], const int wr, const int wc, const int lane) {
    const int r = lane & 31, hh = lane >> 5;
#pragma unroll
    for (int mi = 0; mi < 2; ++mi)
#pragma unroll
        for (int ni = 0; ni < 2; ++ni) {
            u16* base = Ct + (wr * 64 + mi * 32 + r) * CT_LD + wc * 64 + ni * 32 + 4 * hh;
#pragma unroll
            for (int g = 0; g < 4; ++g) {
                u32x2 w; w.x = pk2(v[mi][ni][4 * g], v[mi][ni][4 * g + 1]); w.y = pk2(v[mi][ni][4 * g + 2], v[mi][ni][4 * g + 3]);
                *(u32x2*)(base + 8 * g) = w;
            }
        }
}
__device__ __forceinline__ void ct_store(const u16* Ct, u16* dst, const size_t ldd, const int tid) {
#pragma unroll
    for (int i = 0; i < 8; ++i) {
        const int idx = tid + i * 256, row = idx >> 4, ch = idx & 15;
        *(u32x4*)(dst + (size_t)row * ldd + ch * 8) = *(const u32x4*)(Ct + row * CT_LD + ch * 8);
    }
}

__device__ __forceinline__ void phase_ada(const Params& p, unsigned char* smem) {
    const int tid = opaque_tid();
    float* red = (float*)smem;
    float* mp = (float*)(p.ws + OFF_MODP);
    for (int it = blockIdx.x; it < 192; it += gridDim.x) {
        const int cb = it % 24, ks = it / 24, cq = tid & 63, kq = tid >> 6;
        float a0[4] = {0, 0, 0, 0}, a1[4] = {0, 0, 0, 0}, a2[4] = {0, 0, 0, 0};
        for (int kk = 0; kk < 32; ++kk) {
            const int k = ks * 128 + kq * 32 + kk;
            const f32x4 w = *(const f32x4*)(p.w_ada + (size_t)k * 6144 + cb * 256 + cq * 4);
            float c0 = p.c[k], c1 = p.c[1024 + k], c2 = p.c_ctx[k];
            c0 *= sigmoid_(c0); c1 *= sigmoid_(c1); c2 *= sigmoid_(c2);
#pragma unroll
            for (int j = 0; j < 4; ++j) { a0[j] += c0 * w[j]; a1[j] += c1 * w[j]; a2[j] += c2 * w[j]; }
        }
#pragma unroll
        for (int j = 0; j < 4; ++j) { red[(kq * 3 + 0) * 256 + cq * 4 + j] = a0[j]; red[(kq * 3 + 1) * 256 + cq * 4 + j] = a1[j]; red[(kq * 3 + 2) * 256 + cq * 4 + j] = a2[j]; }
        __syncthreads();
#pragma unroll
        for (int v = 0; v < 3; ++v) {
            const float s = (red[(0 * 3 + v) * 256 + tid] + red[(1 * 3 + v) * 256 + tid]) + (red[(2 * 3 + v) * 256 + tid] + red[(3 * 3 + v) * 256 + tid]);
            mp[(ks * 3 + v) * 6144 + cb * 256 + tid] = s;
        }
        __syncthreads();
    }
    for (int it = blockIdx.x; it < 2400; it += gridDim.x) {
        if (it < 1696) {
            const int nb = it >> 4, kb = it & 15, nv = nb * 64;
            const int nr = nv < 3072 ? nv : (nv < 6656 ? nv + 16 : 3072 + (nv - 6656));
            conv_item(p.w_in, INC, kb * 64, nr, (u16*)(p.ws + OFF_WINT), 1024, nv, red, tid);
        } else if (it < 1952) { const int q = it - 1696; conv_item(p.w_br_m, 1024, (q & 15) * 64, (q >> 4) * 64, (u16*)(p.ws + OFF_BRMT), 1024, (q >> 4) * 64, red, tid); }
        else if (it < 2080) { const int q = it - 1952; conv_item(p.w_br_na, 1024, (q & 7) * 64, (q >> 3) * 64, (u16*)(p.ws + OFF_BRNT), 512, (q >> 3) * 64, red, tid); }
        else if (it < 2336) { const int q = it - 2080; conv_item(p.w_out, 1024, (q & 15) * 64, (q >> 4) * 64, (u16*)(p.ws + OFF_OUTT), 1024, (q >> 4) * 64, red, tid); }
        else { const int q = it - 2336; conv_item(p.w_router, 256, (q & 15) * 64, (q >> 4) * 64, (u16*)(p.ws + OFF_RTT), 1024, (q >> 4) * 64, red, tid); }
    }
}

__device__ __forceinline__ void phase_norm(const Params& p, unsigned char* smem, const bool second) {
    const int tid = opaque_tid(), lane = tid & 63, wid = tid >> 6;
    float* tsh = (float*)smem; float* tsc = tsh + 1024;
    u16* H = (u16*)(p.ws + OFF_H);
    const int nrows = second ? NTOK : MTOT;
    const int rpb = (nrows + gridDim.x - 1) / gridDim.x;
    const int r0 = blockIdx.x * rpb, r1 = min(r0 + rpb, nrows);
    const int sh_off = second ? 3072 : 0, sc_off = second ? 4096 : 1024;
    for (int vec = 0; vec < 3; ++vec) {
        const int vlo = vec == 0 ? 0 : (vec == 1 ? TSEQ : NTOK), vhi = vec == 0 ? TSEQ : (vec == 1 ? NTOK : MTOT);
        const int lo = max(r0, vlo), hi = min(r1, vhi);
        if (lo >= hi) continue;
        for (int j = tid; j < 1024; j += 256) { tsh[j] = mod_val(p, vec, sh_off + j); tsc[j] = 1.f + mod_val(p, vec, sc_off + j); }
        __syncthreads();
        for (int row = lo + wid; row < hi; row += 4) {
            const float* src = second ? (p.out + (size_t)row * 1024) : (row < NTOK ? p.x + (size_t)row * 1024 : p.ctx + (size_t)(row - NTOK) * 1024);
            f32x4 v[4]; float ss = 0.f;
#pragma unroll
            for (int j = 0; j < 4; ++j) { v[j] = *(const f32x4*)(src + j * 256 + lane * 4); ss += (v[j].x * v[j].x + v[j].y * v[j].y) + (v[j].z * v[j].z + v[j].w * v[j].w); }
            ss = wave_sum(ss);
            const float rstd = rsqrtf(ss * (1.f / 1024.f) + 1e-6f);
#pragma unroll
            for (int j = 0; j < 4; ++j) {
                const int k = j * 256 + lane * 4;
                const f32x4 sc = *(const f32x4*)(tsc + k), sh = *(const f32x4*)(tsh + k);
                u32x2 o; o.x = pk2(v[j].x * rstd * sc.x + sh.x, v[j].y * rstd * sc.y + sh.y); o.y = pk2(v[j].z * rstd * sc.z + sh.z, v[j].w * rstd * sc.w + sh.w);
                *(u32x2*)(H + (size_t)row * 1024 + k) = o;
            }
        }
        __syncthreads();
    }
}

__device__ __forceinline__ void phase_inproj(const Params& p, unsigned char* smem) {
    const u16* H = (const u16*)(p.ws + OFF_H);
    u16* P = (u16*)(p.ws + OFF_P); float* G = (float*)(p.ws + OFF_G);
    const int tid = opaque_tid(), lane = tid & 63, wid = tid >> 6, wr = wid >> 1, wc = wid & 1;
    const int r = lane & 31, hh = lane >> 5;
    const u16* WT = (const u16*)(p.ws + OFF_WINT);
    const int sw = ((tid & 7) ^ ((tid >> 4) & 7)) * 8;
    for (int ti = 0;; ++ti) {
        int mt, nt;
        if (!sched_tile(ti, 260, 53, 8, mt, nt)) break;
        f32x16 acc[2][2] = {};
        gemm_core2(acc, H + (size_t)(mt * 128 + (tid >> 3)) * 1024 + sw, 32 * 1024, WT + (size_t)(nt * 128 + (tid >> 3)) * 1024 + sw, 32 * 1024, 16, smem, tid, lane, wr, wc);
        if (nt < 8) {
            const float scale = nt < 4 ? 0.08838834764831845f : 1.f;
            const bool latent = mt < 256;
#pragma unroll
            for (int mi = 0; mi < 2; ++mi) {
                const int t = (mt * 128 + wr * 64 + mi * 32 + r) & (TSEQ - 1);
                const float posr = (float)(wc == 0 ? (t >> 6) : (t & 63)) * 0.15915494309189535f;
#pragma unroll
                for (int reg = 0; reg < 16; ++reg) {
                    float x1 = acc[mi][0][reg] * scale, x2 = acc[mi][1][reg] * scale;
                    if (latent) {
                        const float inv = exp2f(-(float)(ACC_COL(reg) + 4 * hh) * (13.287712379549449f / 32.f));
                        float sn, cs; sincos_rev(posr * inv, sn, cs);
                        float a = x1 * cs; asm volatile("" : "+v"(a), "+v"(x1), "+v"(x2));
                        float o1 = fmaf(-x2, sn, a); asm volatile("" : "+v"(o1), "+v"(x1), "+v"(x2));
                        float bq = x1 * sn; asm volatile("" : "+v"(bq), "+v"(x2));
                        float o2 = fmaf(x2, cs, bq); asm volatile("" : "+v"(o2));
                        x1 = o1; x2 = o2;
                    }
                    acc[mi][0][reg] = x1; acc[mi][1][reg] = x2;
                }
            }
        } else if (nt >= 24 && nt < 32) {
            const float* nw = nt < 28 ? p.na_qn_w : p.na_kn_w;
            const float sc = nt < 28 ? 0.125f : 1.f;
#pragma unroll
            for (int mi = 0; mi < 2; ++mi) {
                float s = 0.f;
#pragma unroll
                for (int ni = 0; ni < 2; ++ni)
#pragma unroll
                    for (int reg = 0; reg < 16; ++reg) s += acc[mi][ni][reg] * acc[mi][ni][reg];
                s += __shfl_xor(s, 32);
                const float rstd = rsqrtf(s * (1.f / 64.f) + 1e-6f) * sc;
#pragma unroll
                for (int ni = 0; ni < 2; ++ni)
#pragma unroll
                    for (int reg = 0; reg < 16; ++reg) acc[mi][ni][reg] *= rstd * nw[ni * 32 + ACC_COL(reg) + 4 * hh];
            }
        } else if (nt >= 36 && nt < 52) {
#pragma unroll
            for (int mi = 0; mi < 2; ++mi)
#pragma unroll
                for (int ni = 0; ni < 2; ++ni)
#pragma unroll
                    for (int reg = 0; reg < 16; ++reg) acc[mi][ni][reg] = sigmoid_(acc[mi][ni][reg]);
        }
        if (nt == 52) {
            if (wc == 0) {
                const f32x4 b0 = *(const f32x4*)(p.b_mgate + 4 * hh), b1 = *(const f32x4*)(p.b_mgate + 8 + 4 * hh);
#pragma unroll
                for (int mi = 0; mi < 2; ++mi) {
                    float* g = G + (size_t)(mt * 128 + wr * 64 + mi * 32 + r) * 16 + 4 * hh;
                    f32x4 o0, o1;
                    o0.x = acc[mi][0][0] + b0.x; o0.y = acc[mi][0][1] + b0.y; o0.z = acc[mi][0][2] + b0.z; o0.w = acc[mi][0][3] + b0.w;
                    o1.x = acc[mi][0][4] + b1.x; o1.y = acc[mi][0][5] + b1.y; o1.z = acc[mi][0][6] + b1.z; o1.w = acc[mi][0][7] + b1.w;
                    *(f32x4*)g = o0; *(f32x4*)(g + 8) = o1;
                }
            }
        } else {
            u16* Ct = (u16*)smem;
            __syncthreads();
            ct_write(Ct, acc, wr, wc, lane);
            __syncthreads();
            ct_store(Ct, P + (size_t)(mt * 128) * PV + nt * 128, PV, tid);
        }
        __syncthreads();
    }
}

__device__ __forceinline__ void mlstm_passA(const Params& p, unsigned char* smem, const int it) {
    const int tid = opaque_tid(), lane = tid & 63, wid = tid >> 6;
    const int c = it % 260, bh = it / 260, b = bh >> 2, h = bh & 3;
    const int base = c < 4 ? NTOK + b * 256 + c * 64 : b * TSEQ + (c - 4) * 64;
    const u16* P = (const u16*)(p.ws + OFF_P); const float* G = (const float*)(p.ws + OFF_G);
    float* gsum = (float*)(p.ws + OFF_GS); float* mloc = (float*)(p.ws + OFF_ML); float* dn = (float*)(p.ws + OFF_DN);
    u16* CT = (u16*)(p.ws + OFF_CT);
    u16* KTf = (u16*)smem; u16* KTb = (u16*)(smem + 18432); u16* VT = (u16*)(smem + 36864);
    float* wf = (float*)(smem + 73728); float* wb = wf + 64;
    const int slot_f = bh * 2 * 260 + c, slot_b = slot_f + 260;
    if (wid == 0) {
        const float* g = G + (size_t)(base + lane) * 16;
        const float igf = g[h], ff = g[4 + h], igb = g[8 + h], fb = g[12 + h];
        const float lff = log_sigmoid_(ff), lfb = log_sigmoid_(fb);
        const float bfc = wave_incl_sum(lff, lane), gf = __shfl(bfc, 63);
        const float uf = igf - bfc, umf = wave_max(uf);
        wf[lane] = __expf(uf - umf);
        const float pb = wave_incl_sum(lfb, lane), gb = __shfl(pb, 63);
        const float bb = gb - pb + lfb, ub = igb - bb, umb = wave_max(ub);
        wb[lane] = __expf(ub - umb);
        if (lane == 0) { gsum[slot_f] = gf; mloc[slot_f] = gf + umf; gsum[slot_b] = gb; mloc[slot_b] = gb + umb; }
    }
    __syncthreads();
    const int cgp = tid >> 3, tg = tid & 7;
    {
        const u16* src = P + (size_t)(base + tg * 8) * PV + V_MK + h * 128 + cgp * 4;
        u32x2 kv[8];
#pragma unroll
        for (int i = 0; i < 8; ++i) kv[i] = *(const u32x2*)(src + (size_t)i * PV);
        float wfi[8], wbi[8];
#pragma unroll
        for (int i = 0; i < 8; ++i) { wfi[i] = wf[tg * 8 + i]; wbi[i] = wb[tg * 8 + i]; }
#pragma unroll
        for (int cc = 0; cc < 4; ++cc) {
            float e[8];
#pragma unroll
            for (int i = 0; i < 8; ++i) e[i] = bfsel(kv[i], cc);
            u32x4 of, ob;
            of.x = pk2(e[0] * wfi[0], e[1] * wfi[1]); of.y = pk2(e[2] * wfi[2], e[3] * wfi[3]); of.z = pk2(e[4] * wfi[4], e[5] * wfi[5]); of.w = pk2(e[6] * wfi[6], e[7] * wfi[7]);
            ob.x = pk2(e[0] * wbi[0], e[1] * wbi[1]); ob.y = pk2(e[2] * wbi[2], e[3] * wbi[3]); ob.z = pk2(e[4] * wbi[4], e[5] * wbi[5]); ob.w = pk2(e[6] * wbi[6], e[7] * wbi[7]);
            *(u32x4*)(KTf + (cgp * 4 + cc) * LDT + tg * 8) = of;
            *(u32x4*)(KTb + (cgp * 4 + cc) * LDT + tg * 8) = ob;
        }
    }
#pragma unroll
    for (int vp = 0; vp < 2; ++vp) {
        const u16* src = P + (size_t)(base + tg * 8) * PV + V_MV + h * 256 + vp * 128 + cgp * 4;
        u32x2 vv[8];
#pragma unroll
        for (int i = 0; i < 8; ++i) vv[i] = *(const u32x2*)(src + (size_t)i * PV);
#pragma unroll
        for (int cc = 0; cc < 4; ++cc) *(u32x4*)(VT + (vp * 128 + cgp * 4 + cc) * LDT + tg * 8) = tr8(vv, cc);
    }
    __syncthreads();
    if (tid < 128) {
        float sf = 0.f, sb = 0.f;
#pragma unroll
        for (int j = 0; j < 8; ++j) {
            const u32x4 a = *(const u32x4*)(KTf + tid * LDT + j * 8), bq = *(const u32x4*)(KTb + tid * LDT + j * 8);
            sf += (bf_lo(a.x) + bf_hi(a.x)) + (bf_lo(a.y) + bf_hi(a.y)) + (bf_lo(a.z) + bf_hi(a.z)) + (bf_lo(a.w) + bf_hi(a.w));
            sb += (bf_lo(bq.x) + bf_hi(bq.x)) + (bf_lo(bq.y) + bf_hi(bq.y)) + (bf_lo(bq.z) + bf_hi(bq.z)) + (bf_lo(bq.w) + bf_hi(bq.w));
        }
        dn[(size_t)slot_f * 128 + tid] = sf; dn[(size_t)slot_b * 128 + tid] = sb;
    }
    const int r = lane & 31, hh = lane >> 5;
#pragma unroll 1
    for (int dir = 0; dir < 2; ++dir) {
        const u16* Bt = dir ? KTb : KTf;
        u16* dst = CT + (size_t)(dir ? slot_b : slot_f) * 32768;
#pragma unroll 1
        for (int nh = 0; nh < 2; ++nh) {
            f32x16 acc[2][2] = {};
#pragma unroll
            for (int kk = 0; kk < 4; ++kk) {
                bf16x8 a[2], bq[2];
#pragma unroll
                for (int mi = 0; mi < 2; ++mi) a[mi] = *(const bf16x8*)(VT + (wid * 64 + mi * 32 + r) * LDT + kk * 16 + hh * 8);
#pragma unroll
                for (int ni = 0; ni < 2; ++ni) bq[ni] = *(const bf16x8*)(Bt + (nh * 64 + ni * 32 + r) * LDT + kk * 16 + hh * 8);
#pragma unroll
                for (int mi = 0; mi < 2; ++mi)
#pragma unroll
                    for (int ni = 0; ni < 2; ++ni) acc[mi][ni] = mfma32(bq[ni], a[mi], acc[mi][ni]);
            }
#pragma unroll
            for (int mi = 0; mi < 2; ++mi)
#pragma unroll
                for (int ni = 0; ni < 2; ++ni) {
                    u16* drow = dst + (wid * 64 + mi * 32 + r) * 128 + nh * 64 + ni * 32 + 4 * hh;
#pragma unroll
                    for (int g = 0; g < 4; ++g) {
                        u32x2 w; w.x = pk2(acc[mi][ni][4 * g], acc[mi][ni][4 * g + 1]); w.y = pk2(acc[mi][ni][4 * g + 2], acc[mi][ni][4 * g + 3]);
                        *(u32x2*)(drow + 8 * g) = w;
                    }
                }
        }
    }
    __syncthreads();
}

template <int NT, bool WIN>
__device__ __forceinline__ void na_block(const u16* Ks, const u16* VTs, const bf16x8 qa0, const bf16x8 qa1, const float* rpb  ,
                                         const int cs, const int k0, const int l15, const int l4, f32x4 (&O)[4], float& mrun, float& lrun) {
    f32x4 S[NT];
#pragma unroll
    for (int t = 0; t < NT; ++t) {
        S[t] = (f32x4){0.f, 0.f, 0.f, 0.f};
        const bf16x8 kf0 = *(const bf16x8*)(Ks + (k0 + t * 16 + l15) * LDT + l4 * 8), kf1 = *(const bf16x8*)(Ks + (k0 + t * 16 + l15) * LDT + 32 + l4 * 8);
        S[t] = mfma16(kf0, qa0, S[t]); S[t] = mfma16(kf1, qa1, S[t]);
    }
    if (WIN) {
#pragma unroll
        for (int t = 0; t < NT; ++t)
#pragma unroll
            for (int reg = 0; reg < 4; ++reg) {
                const int kc = k0 + t * 16 + l4 * 4 + reg;
                const bool valid = kc >= cs && kc < cs + 16;
                float bias = 0.f;
                if (valid) bias = rpb[kc];
                S[t][reg] = valid ? S[t][reg] + bias : -INFINITY;
            }
    }
    float mx = -INFINITY;
#pragma unroll
    for (int t = 0; t < NT; ++t) mx = fmaxf(mx, fmaxf(fmaxf(S[t][0], S[t][1]), fmaxf(S[t][2], S[t][3])));
    mx = fmaxf(mx, __shfl_xor(mx, 16)); mx = fmaxf(mx, __shfl_xor(mx, 32));
    const float mnew = fmaxf(mrun, mx);
    const float alpha = __expf(mrun - mnew);
    float ps = 0.f;
#pragma unroll
    for (int t = 0; t < NT; ++t)
#pragma unroll
        for (int reg = 0; reg < 4; ++reg) { const float pe = __expf(S[t][reg] - mnew); S[t][reg] = pe; ps += pe; }
    ps += __shfl_xor(ps, 16); ps += __shfl_xor(ps, 32);
    lrun = lrun * alpha + ps; mrun = mnew;
#pragma unroll
    for (int t = 0; t < 4; ++t) { O[t][0] *= alpha; O[t][1] *= alpha; O[t][2] *= alpha; O[t][3] *= alpha; }
#pragma unroll
    for (int s = 0; s < NT / 2; ++s) {
        u32x4 pb; pb.x = pk2(S[2 * s][0], S[2 * s][1]); pb.y = pk2(S[2 * s][2], S[2 * s][3]); pb.z = pk2(S[2 * s + 1][0], S[2 * s + 1][1]); pb.w = pk2(S[2 * s + 1][2], S[2 * s + 1][3]);
        const bf16x8 pfrag = __builtin_bit_cast(bf16x8, pb);
#pragma unroll
        for (int t = 0; t < 4; ++t) {
            const u16* vrow = VTs + (t * 16 + l15) * LDT + k0 + s * 32 + l4 * 4;
            const u32x2 v0 = *(const u32x2*)vrow, v1 = *(const u32x2*)(vrow + 16);
            u32x4 va; va.x = v0.x; va.y = v0.y; va.z = v1.x; va.w = v1.y;
            O[t] = mfma16(__builtin_bit_cast(bf16x8, va), pfrag, O[t]);
        }
    }
}
__device__ __forceinline__ void na_item(const Params& p, unsigned char* smem, const int it) {
    const int tid = opaque_tid(), lane = tid & 63, wid = tid >> 6;
    const int row = it & 255, h = (it >> 8) & 7, b = it >> 11;
    const u16* P = (const u16*)(p.ws + OFF_P);
    u16* YNA = (u16*)(p.ws + OFF_YNA);
    float* rpb_s = (float*)(smem + 36864);
    const int l15 = lane & 15, l4 = lane >> 4;
    const int qc = wid * 16 + l15;
    const size_t qtok = (size_t)b * TSEQ + row * 64 + qc;
    const u16* qsrc = P + qtok * PV + V_NQ + h * 64 + l4 * 8;
    const bf16x8 qa0 = *(const bf16x8*)qsrc, qa1 = *(const bf16x8*)(qsrc + 32);
    const int rs = min(max(row - 4, 0), 248);
    const int cs = min(max(qc - 8, 0), 48);
    const int kst = min(max((qc & ~15) - 8, 0), 32);
    for (int j = tid; j < 465; j += 256) rpb_s[j] = p.na_rpb[h * 465 + j];
    f32x4 O[4] = {};
    float mrun = -INFINITY, lrun = 0.f;
    u32x4 kreg[2]; u32x2 vreg[8];
    const int cgp = (tid >> 3) & 15, tg = tid & 7;
    {
        const int kbase = b * TSEQ + rs * 64;
#pragma unroll
        for (int i = 0; i < 2; ++i) { const int id = tid + i * 256; kreg[i] = *(const u32x4*)(P + (size_t)(kbase + (id >> 3)) * PV + V_NK + h * 64 + (id & 7) * 8); }
        const u16* src = P + (size_t)(kbase + tg * 8) * PV + V_NV + h * 64 + cgp * 4;
#pragma unroll
        for (int i = 0; i < 8; ++i) vreg[i] = *(const u32x2*)(src + (size_t)i * PV);
    }
    for (int blk = 0; blk < 12; ++blk) {
        u16* Ks = (u16*)(smem + (blk & 1) * 18432); u16* VTs = Ks + 4608;
#pragma unroll
        for (int i = 0; i < 2; ++i) { const int id = tid + i * 256; *(u32x4*)(Ks + (id >> 3) * LDT + (id & 7) * 8) = kreg[i]; }
        if (tid < 128) {
#pragma unroll
            for (int cc = 0; cc < 4; ++cc) *(u32x4*)(VTs + (cgp * 4 + cc) * LDT + tg * 8) = tr8(vreg, cc);
        }
        __syncthreads();
        if (blk + 1 < 12) {
            const int nb = blk + 1;
            const int kbase = nb < 8 ? b * TSEQ + (rs + nb) * 64 : NTOK + b * 256 + (nb - 8) * 64;
#pragma unroll
            for (int i = 0; i < 2; ++i) { const int id = tid + i * 256; kreg[i] = *(const u32x4*)(P + (size_t)(kbase + (id >> 3)) * PV + V_NK + h * 64 + (id & 7) * 8); }
            const u16* src = P + (size_t)(kbase + tg * 8) * PV + V_NV + h * 64 + cgp * 4;
#pragma unroll
            for (int i = 0; i < 8; ++i) vreg[i] = *(const u32x2*)(src + (size_t)i * PV);
        }
        if (blk < 8) na_block<2, true>(Ks, VTs, qa0, qa1, rpb_s + (rs + blk - row + 7) * 31 + 15 - qc, cs, kst, l15, l4, O, mrun, lrun);
        else         na_block<4, false>(Ks, VTs, qa0, qa1, rpb_s, cs, 0, l15, l4, O, mrun, lrun);
    }
    {
        const float il = 1.f / lrun;
#pragma unroll
        for (int t = 0; t < 4; ++t) {
            u32x2 w; w.x = pk2(O[t][0] * il, O[t][1] * il); w.y = pk2(O[t][2] * il, O[t][3] * il);
            *(u32x2*)(YNA + qtok * 512 + h * 64 + t * 16 + l4 * 4) = w;
        }
    }
    __syncthreads();
}

__device__ __forceinline__ int scan_cidx(int i, int dir) { return dir == 0 ? i : (i < 4 ? 3 - i : 263 - i); }
__device__ __forceinline__ void phase_scan(const Params& p, unsigned char* smem) {
    const int tid = opaque_tid(), lane = tid & 63, wid = tid >> 6;
    float* al = (float*)smem; float* be = al + 260;
    const float* gsum = (const float*)(p.ws + OFF_GS); const float* mloc = (const float*)(p.ws + OFF_ML);
    float* mprev = (float*)(p.ws + OFF_MP); float* dn = (float*)(p.ws + OFF_DN);
    for (int it = blockIdx.x; it < 512; it += gridDim.x) {
        const int bhd = it >> 5, eb = it & 31, dir = bhd & 1, slot0 = bhd * 260;
        if (wid == 0) {
            float g[5], ml[5]; int cc[5];
            float a = 0.f, b = -INFINITY;
#pragma unroll
            for (int j = 0; j < 5; ++j) {
                const int i = lane * 5 + j; const bool ok = i < 260;
                cc[j] = ok ? scan_cidx(i, dir) : 0;
                g[j] = ok ? gsum[slot0 + cc[j]] : 0.f; ml[j] = ok ? mloc[slot0 + cc[j]] : -INFINITY;
                b = fmaxf(b + g[j], ml[j]); a += g[j];
            }
#pragma unroll
            for (int o = 1; o < 64; o <<= 1) {
                const float pa = __shfl_up(a, o), pb = __shfl_up(b, o);
                if (lane >= o) { b = fmaxf(pb + a, b); a = pa + a; }
            }
            float ea = __shfl_up(a, 1), eb2 = __shfl_up(b, 1);
            if (lane == 0) { ea = 0.f; eb2 = -INFINITY; }
            float m = fmaxf(0.f + ea, eb2);
#pragma unroll
            for (int j = 0; j < 5; ++j) {
                const int i = lane * 5 + j;
                if (i < 260) {
                    const float mn = fmaxf(g[j] + m, ml[j]);
                    al[i] = __expf(g[j] + m - mn); be[i] = __expf(ml[j] - mn);
                    if (eb == 0) mprev[slot0 + cc[j]] = m;
                    m = mn;
                }
            }
        }
        __syncthreads();
        u32x2* basep = (u32x2*)(p.ws + OFF_CT) + (size_t)slot0 * 8192 + eb * 256 + tid;
        float C0 = 0.f, C1 = 0.f, C2 = 0.f, C3 = 0.f;
        for (int i = 0; i < 260; i += 13) {
            u32x2 v[13];
#pragma unroll
            for (int j = 0; j < 13; ++j) v[j] = basep[(size_t)scan_cidx(i + j, dir) * 8192];
#pragma unroll
            for (int j = 0; j < 13; ++j) {
                u32x2 o; o.x = pk2(C0, C1); o.y = pk2(C2, C3);
                basep[(size_t)scan_cidx(i + j, dir) * 8192] = o;
                const float a = al[i + j], bt = be[i + j];
                C0 = fmaf(a, C0, bt * bf_lo(v[j].x)); C1 = fmaf(a, C1, bt * bf_hi(v[j].x)); C2 = fmaf(a, C2, bt * bf_lo(v[j].y)); C3 = fmaf(a, C3, bt * bf_hi(v[j].y));
            }
        }
        if (eb == 0 && tid < 128) {
            float n = 0.f;
            for (int i = 0; i < 260; ++i) {
                float* q = dn + (size_t)(slot0 + scan_cidx(i, dir)) * 128 + tid;
                const float v = *q; *q = n; n = al[i] * n + be[i] * v;
            }
        }
        __syncthreads();
    }
}

__device__ __forceinline__ void mlstm_passC(const Params& p, unsigned char* smem, const int it) {
    const int tid = opaque_tid(), lane = tid & 63, wid = tid >> 6;
    const int cl = it & 255, bh = it >> 8, b = bh >> 2, h = bh & 3, c = cl + 4;
    const int base = b * TSEQ + cl * 64;
    const int slot_f = bh * 2 * 260 + c, slot_b = slot_f + 260;
    const u16* P = (const u16*)(p.ws + OFF_P); const float* G = (const float*)(p.ws + OFF_G);
    const float* mprev = (const float*)(p.ws + OFF_MP); const float* dn = (const float*)(p.ws + OFF_DN);
    const u16* CT = (const u16*)(p.ws + OFF_CT);
    u16* YM = (u16*)(p.ws + OFF_YM);
    u16* Ks = (u16*)smem;
    u16* CTf = (u16*)smem; u16* CTb = (u16*)(smem + 17408);
    u16* VTs = (u16*)(smem + 34816);
    float* ga = (float*)(smem + 44032);
    float *uf_s = ga, *Mf_s = ga + 64, *ub_s = ga + 128, *Mb_s = ga + 192, *clf = ga + 256, *clb = ga + 320, *wif = ga + 384, *wib = ga + 448;
    const int l15 = lane & 15, l4 = lane >> 4;
    if (wid == 0) {
        const float* g = G + (size_t)(base + lane) * 16;
        const float igf = g[h], ff = g[4 + h], igb = g[8 + h], fb = g[12 + h];
        const float lff = log_sigmoid_(ff), lfb = log_sigmoid_(fb);
        const float bfc = wave_incl_sum(lff, lane);
        const float uf = igf - bfc;
        const float pb = wave_incl_sum(lfb, lane), gb = __shfl(pb, 63);
        const float bb = gb - pb + lfb, ub = igb - bb;
        const float mpf = mprev[slot_f], mpb = mprev[slot_b];
        const float Mf = fmaxf(mpf, wave_prefix_max(uf, lane)), Mb = fmaxf(mpb, wave_suffix_max(ub, lane));
        uf_s[lane] = uf; Mf_s[lane] = Mf; clf[lane] = __expf(-(bfc + Mf)); wif[lane] = __expf(mpf - Mf);
        ub_s[lane] = ub; Mb_s[lane] = Mb; clb[lane] = __expf(-(bb + Mb)); wib[lane] = __expf(mpb - Mb);
    }
    const int t = wid * 16 + l15;
    const size_t tok = (size_t)base + t;
    bf16x8 qa[4];
    {
        const u16* qsrc = P + tok * PV + V_MQ + h * 128 + l4 * 8;
#pragma unroll
        for (int kk = 0; kk < 4; ++kk) qa[kk] = *(const bf16x8*)(qsrc + kk * 32);
    }
#pragma unroll
    for (int i = 0; i < 4; ++i) {
        const int id = tid + i * 256, kr = id >> 4, ch = id & 15;
        *(u32x4*)(Ks + kr * LDQ + ch * 8) = *(const u32x4*)(P + (size_t)(base + kr) * PV + V_MK + h * 128 + ch * 8);
    }
    __syncthreads();
    f32x4 S[4] = {};
#pragma unroll
    for (int st = 0; st < 4; ++st)
#pragma unroll
        for (int kk = 0; kk < 4; ++kk) {
            const bf16x8 kf = *(const bf16x8*)(Ks + (st * 16 + l15) * LDQ + kk * 32 + l4 * 8);
            S[st] = mfma16(kf, qa[kk], S[st]);
        }
    float qnf = 0.f, qnb = 0.f;
    {
        const float* nf = dn + (size_t)slot_f * 128; const float* nb = dn + (size_t)slot_b * 128;
#pragma unroll
        for (int kk = 0; kk < 4; ++kk)
#pragma unroll
            for (int j = 0; j < 8; ++j) {
                const int d = kk * 32 + l4 * 8 + j;
                const float qv = bf2f((u16)qa[kk][j]);
                qnf += qv * nf[d]; qnb += qv * nb[d];
            }
        qnf += __shfl_xor(qnf, 16); qnf += __shfl_xor(qnf, 32);
        qnb += __shfl_xor(qnb, 16); qnb += __shfl_xor(qnb, 32);
    }
    const float Mft = Mf_s[t], Mbt = Mb_s[t];
    float rsf = 0.f, rsb = 0.f;
    f32x4 PF[4], PB[4];
#pragma unroll
    for (int st = 0; st < 4; ++st) {
        const f32x4 uf4 = *(const f32x4*)(uf_s + st * 16 + l4 * 4), ub4 = *(const f32x4*)(ub_s + st * 16 + l4 * 4);
#pragma unroll
        for (int reg = 0; reg < 4; ++reg) {
            const int s = st * 16 + l4 * 4 + reg;
            const float sv = S[st][reg];
            const float pf = (s <= t) ? sv * __expf(uf4[reg] - Mft) : 0.f;
            const float pbv = (s >= t) ? sv * __expf(ub4[reg] - Mbt) : 0.f;
            rsf += pf; rsb += pbv; PF[st][reg] = pf; PB[st][reg] = pbv;
        }
    }
    rsf += __shfl_xor(rsf, 16); rsf += __shfl_xor(rsf, 32);
    rsb += __shfl_xor(rsb, 16); rsb += __shfl_xor(rsb, 32);
    const float wft = wif[t], wbt = wib[t];
    const float idf = 1.f / fmaxf(fabsf(rsf + wft * qnf), clf[t]), idb = 1.f / fmaxf(fabsf(rsb + wbt * qnb), clb[t]);
    bf16x8 pfr[2], qwf[4], qwb[4];
#pragma unroll
    for (int ss = 0; ss < 2; ++ss) {
        u32x4 pw;
        pw.x = pk2(PF[2 * ss][0] * idf + PB[2 * ss][0] * idb, PF[2 * ss][1] * idf + PB[2 * ss][1] * idb);
        pw.y = pk2(PF[2 * ss][2] * idf + PB[2 * ss][2] * idb, PF[2 * ss][3] * idf + PB[2 * ss][3] * idb);
        pw.z = pk2(PF[2 * ss + 1][0] * idf + PB[2 * ss + 1][0] * idb, PF[2 * ss + 1][1] * idf + PB[2 * ss + 1][1] * idb);
        pw.w = pk2(PF[2 * ss + 1][2] * idf + PB[2 * ss + 1][2] * idb, PF[2 * ss + 1][3] * idf + PB[2 * ss + 1][3] * idb);
        pfr[ss] = __builtin_bit_cast(bf16x8, pw);
    }
    {
        const float sf = wft * idf, sb = wbt * idb;
#pragma unroll
        for (int kk = 0; kk < 4; ++kk) {
            u32x4 of, ob;
            const float q0 = bf2f((u16)qa[kk][0]), q1 = bf2f((u16)qa[kk][1]), q2 = bf2f((u16)qa[kk][2]), q3 = bf2f((u16)qa[kk][3]);
            const float q4 = bf2f((u16)qa[kk][4]), q5 = bf2f((u16)qa[kk][5]), q6 = bf2f((u16)qa[kk][6]), q7 = bf2f((u16)qa[kk][7]);
            of.x = pk2(q0 * sf, q1 * sf); of.y = pk2(q2 * sf, q3 * sf); of.z = pk2(q4 * sf, q5 * sf); of.w = pk2(q6 * sf, q7 * sf);
            ob.x = pk2(q0 * sb, q1 * sb); ob.y = pk2(q2 * sb, q3 * sb); ob.z = pk2(q4 * sb, q5 * sb); ob.w = pk2(q6 * sb, q7 * sb);
            qwf[kk] = __builtin_bit_cast(bf16x8, of); qwb[kk] = __builtin_bit_cast(bf16x8, ob);
        }
    }
    __syncthreads();
    f32x4 hm[4][4];
#pragma unroll
    for (int vb = 0; vb < 4; ++vb) {
        if (tid < 128) {
            const int cgp = tid >> 3, tg = tid & 7;
            const u16* src = P + (size_t)(base + tg * 8) * PV + V_MV + h * 256 + vb * 64 + cgp * 4;
            u32x2 vv[8];
#pragma unroll
            for (int i = 0; i < 8; ++i) vv[i] = *(const u32x2*)(src + (size_t)i * PV);
#pragma unroll
            for (int cc = 0; cc < 4; ++cc) *(u32x4*)(VTs + (cgp * 4 + cc) * LDT + tg * 8) = tr8(vv, cc);
        }
#pragma unroll
        for (int i = 0; i < 4; ++i) {
            const int id = tid + i * 256, vr = id >> 4, ch = id & 15;
            *(u32x4*)(CTf + vr * LDQ + ch * 8) = *(const u32x4*)(CT + (size_t)slot_f * 32768 + (vb * 64 + vr) * 128 + ch * 8);
            *(u32x4*)(CTb + vr * LDQ + ch * 8) = *(const u32x4*)(CT + (size_t)slot_b * 32768 + (vb * 64 + vr) * 128 + ch * 8);
        }
        __syncthreads();
#pragma unroll
        for (int tv = 0; tv < 4; ++tv) {
            f32x4 a = {0.f, 0.f, 0.f, 0.f};
#pragma unroll
            for (int ss = 0; ss < 2; ++ss) {
                const u16* vrow = VTs + (tv * 16 + l15) * LDT + ss * 32 + l4 * 4;
                const u32x2 v0 = *(const u32x2*)vrow, v1 = *(const u32x2*)(vrow + 16);
                u32x4 va; va.x = v0.x; va.y = v0.y; va.z = v1.x; va.w = v1.y;
                a = mfma16(__builtin_bit_cast(bf16x8, va), pfr[ss], a);
            }
#pragma unroll
            for (int kk = 0; kk < 4; ++kk) {
                const bf16x8 cf = *(const bf16x8*)(CTf + (tv * 16 + l15) * LDQ + kk * 32 + l4 * 8);
                const bf16x8 cb = *(const bf16x8*)(CTb + (tv * 16 + l15) * LDQ + kk * 32 + l4 * 8);
                a = mfma16(cf, qwf[kk], a); a = mfma16(cb, qwb[kk], a);
            }
            hm[vb][tv] = a;
        }
        __syncthreads();
    }
    float ssq = 0.f;
#pragma unroll
    for (int vb = 0; vb < 4; ++vb)
#pragma unroll
        for (int tv = 0; tv < 4; ++tv) ssq += (hm[vb][tv][0] * hm[vb][tv][0] + hm[vb][tv][1] * hm[vb][tv][1]) + (hm[vb][tv][2] * hm[vb][tv][2] + hm[vb][tv][3] * hm[vb][tv][3]);
    ssq += __shfl_xor(ssq, 16); ssq += __shfl_xor(ssq, 32);
    const float rstd = rsqrtf(ssq * (1.f / 256.f) + 1e-6f);
#pragma unroll
    for (int vb = 0; vb < 4; ++vb)
#pragma unroll
        for (int tv = 0; tv < 4; ++tv) {
            const int v = h * 256 + vb * 64 + tv * 16 + l4 * 4;
            const u32x2 ov = *(const u32x2*)(P + tok * PV + V_MO + v);
            const f32x4 w = *(const f32x4*)(p.m_norm_w + v);
            u32x2 y;
            y.x = pk2(hm[vb][tv][0] * rstd * w.x * sigmoid_(bf_lo(ov.x)), hm[vb][tv][1] * rstd * w.y * sigmoid_(bf_hi(ov.x)));
            y.y = pk2(hm[vb][tv][2] * rstd * w.z * sigmoid_(bf_lo(ov.y)), hm[vb][tv][3] * rstd * w.w * sigmoid_(bf_hi(ov.y)));
            *(u32x2*)(YM + tok * 1024 + v) = y;
        }
}

__device__ __forceinline__ void phase_merge(const Params& p, unsigned char* smem, const bool second) {
    const u16* P = (const u16*)(p.ws + OFF_P);
    const u16* YM = (const u16*)(p.ws + OFF_YM); const u16* YNA = (const u16*)(p.ws + OFF_YNA);
    u16* MRG = (u16*)(p.ws + OFF_MRG);
    const int tid = opaque_tid(), lane = tid & 63, wid = tid >> 6, wr = wid >> 1, wc = wid & 1;
    const u16* abase = second ? YNA : YM; const int lda = second ? 512 : 1024;
    const u16* wt = (const u16*)(p.ws + (second ? OFF_BRNT : OFF_BRMT));
    const int gcol = second ? V_GN : V_GM;
    const int sw = ((tid & 3) ^ ((tid >> 4) & 3)) * 8;
    for (int ti = 0;; ++ti) {
        int mt, nt;
        if (!sched_tile(ti, 256, 4, 4, mt, nt)) break;
        f32x16 acc[2][4] = {};
        gemm_core3(acc, abase + (size_t)(mt * 128 + (tid >> 2)) * lda + sw, (size_t)64 * lda, wt + (size_t)(nt * 256 + (tid >> 2)) * lda + sw, (size_t)64 * lda, second ? 16 : 32, smem, tid, lane, wr, wc);
        u16* Ct = (u16*)smem;
        RAW_BARRIER();
        ct_write3(Ct, acc, wr, wc, lane);
        __syncthreads();
#pragma unroll 4
        for (int i = 0; i < 16; ++i) {
            const int idx = tid + i * 256, row = idx >> 5, ch = idx & 31;
            const size_t m = (size_t)mt * 128 + row;
            const u32x4 cv = *(const u32x4*)(Ct + row * CT3_LD + ch * 8);
            const u32x4 gv = *(const u32x4*)(P + m * PV + gcol + nt * 256 + ch * 8);
            u16* q = MRG + m * 1024 + nt * 256 + ch * 8;
            float o[8];
            o[0] = bf_lo(cv.x) * bf_lo(gv.x); o[1] = bf_hi(cv.x) * bf_hi(gv.x); o[2] = bf_lo(cv.y) * bf_lo(gv.y); o[3] = bf_hi(cv.y) * bf_hi(gv.y);
            o[4] = bf_lo(cv.z) * bf_lo(gv.z); o[5] = bf_hi(cv.z) * bf_hi(gv.z); o[6] = bf_lo(cv.w) * bf_lo(gv.w); o[7] = bf_hi(cv.w) * bf_hi(gv.w);
            if (second) {
                const u32x4 pv = *(const u32x4*)q;
                o[0] += bf_lo(pv.x); o[1] += bf_hi(pv.x); o[2] += bf_lo(pv.y); o[3] += bf_hi(pv.y); o[4] += bf_lo(pv.z); o[5] += bf_hi(pv.z); o[6] += bf_lo(pv.w); o[7] += bf_hi(pv.w);
            }
            u32x4 w; w.x = pk2(o[0], o[1]); w.y = pk2(o[2], o[3]); w.z = pk2(o[4], o[5]); w.w = pk2(o[6], o[7]);
            *(u32x4*)q = w;
        }
        __syncthreads();
    }
}

__device__ __forceinline__ void phase_outproj(const Params& p, unsigned char* smem) {
    const u16* MRG = (const u16*)(p.ws + OFF_MRG);
    const int tid = opaque_tid(), lane = tid & 63, wid = tid >> 6, wr = wid >> 1, wc = wid & 1;
    const u16* wt = (const u16*)(p.ws + OFF_OUTT);
    const int sw = ((tid & 3) ^ ((tid >> 4) & 3)) * 8;
    for (int ti = 0;; ++ti) {
        int mt, nt;
        if (!sched_tile(ti, 256, 4, 4, mt, nt)) break;
        f32x16 acc[2][4] = {};
        gemm_core3(acc, MRG + (size_t)(mt * 128 + (tid >> 2)) * 1024 + sw, 64 * 1024, wt + (size_t)(nt * 256 + (tid >> 2)) * 1024 + sw, 64 * 1024, 32, smem, tid, lane, wr, wc);
        u16* Ct = (u16*)smem;
        RAW_BARRIER();
        ct_write3(Ct, acc, wr, wc, lane);
        __syncthreads();
        {
            const int bvec = mt >> 7, ch = tid & 31;
            float g1[8];
#pragma unroll
            for (int j = 0; j < 8; ++j) g1[j] = mod_val(p, bvec, 2048 + nt * 256 + ch * 8 + j);
#pragma unroll 4
            for (int i = 0; i < 16; ++i) {
                const int row = (tid >> 5) + i * 8;
                const size_t off = ((size_t)mt * 128 + row) * 1024 + nt * 256 + ch * 8;
                const u32x4 cv = *(const u32x4*)(Ct + row * CT3_LD + ch * 8);
                const f32x4 x0 = *(const f32x4*)(p.x + off), x1 = *(const f32x4*)(p.x + off + 4);
                f32x4 o0, o1;
                o0.x = x0.x + g1[0] * bf_lo(cv.x); o0.y = x0.y + g1[1] * bf_hi(cv.x); o0.z = x0.z + g1[2] * bf_lo(cv.y); o0.w = x0.w + g1[3] * bf_hi(cv.y);
                o1.x = x1.x + g1[4] * bf_lo(cv.z); o1.y = x1.y + g1[5] * bf_hi(cv.z); o1.z = x1.z + g1[6] * bf_lo(cv.w); o1.w = x1.w + g1[7] * bf_hi(cv.w);
                *(f32x4*)(p.out + off) = o0; *(f32x4*)(p.out + off + 4) = o1;
            }
        }
        __syncthreads();
    }
}

__device__ __forceinline__ void phase_router(const Params& p, unsigned char* smem) {
    const u16* H = (const u16*)(p.ws + OFF_H);
    float* SC = (float*)(p.ws + OFF_SC);
    const int tid = opaque_tid(), lane = tid & 63, wid = tid >> 6, wr = wid >> 1, wc = wid & 1;
    const int r = lane & 31, hh = lane >> 5;
    const u16* wt = (const u16*)(p.ws + OFF_RTT);
    const int sw = ((tid & 7) ^ ((tid >> 4) & 7)) * 8;
    for (int ti = 0;; ++ti) {
        int mt, nt;
        if (!sched_tile(ti, 256, 2, 2, mt, nt)) break;
        f32x16 acc[2][2] = {};
        gemm_core2(acc, H + (size_t)(mt * 128 + (tid >> 3)) * 1024 + sw, 32 * 1024, wt + (size_t)(nt * 128 + (tid >> 3)) * 1024 + sw, 32 * 1024, 16, smem, tid, lane, wr, wc);
#pragma unroll
        for (int mi = 0; mi < 2; ++mi)
#pragma unroll
            for (int ni = 0; ni < 2; ++ni) {
                float* srow = SC + ((size_t)mt * 128 + wr * 64 + mi * 32 + r) * 256 + nt * 128 + wc * 64 + ni * 32 + 4 * hh;
#pragma unroll
                for (int g = 0; g < 4; ++g) {
                    f32x4 o; o.x = sigmoid_(acc[mi][ni][4 * g]); o.y = sigmoid_(acc[mi][ni][4 * g + 1]); o.z = sigmoid_(acc[mi][ni][4 * g + 2]); o.w = sigmoid_(acc[mi][ni][4 * g + 3]);
                    *(f32x4*)(srow + 8 * g) = o;
                }
            }
        __syncthreads();
    }
}

__device__ __forceinline__ void phase_route(const Params& p, unsigned char* smem) {
    const int tid = opaque_tid(), lane = tid & 63, wid = tid >> 6;
    const float* SC = (const float*)(p.ws + OFF_SC);
    int* tope = (int*)(p.ws + OFF_TOPE); float* topw = (float*)(p.ws + OFF_TOPW);
    int* lh = (int*)smem;
    lh[tid] = 0;
    __syncthreads();
    const f32x4 rb = *(const f32x4*)(p.router_bias + lane * 4);
    for (int tok = blockIdx.x * 4 + wid; tok < NTOK; tok += gridDim.x * 4) {
        const f32x4 sc = *(const f32x4*)(SC + (size_t)tok * 256 + lane * 4);
        float s0 = sc.x + rb.x, s1 = sc.y + rb.y, s2 = sc.z + rb.z, s3 = sc.w + rb.w;
        float a1 = fmaxf(s0, s1), a2 = fminf(s0, s1);
        { const float b1 = fmaxf(s2, s3), b2 = fminf(s2, s3); const float n1 = fmaxf(a1, b1), n2 = fmaxf(fminf(a1, b1), fmaxf(a2, b2)); a1 = n1; a2 = n2; }
#pragma unroll
        for (int o = 1; o < 8; o <<= 1) {
            const float b1 = __shfl_xor(a1, o), b2 = __shfl_xor(a2, o);
            const float n1 = fmaxf(a1, b1), n2 = fmaxf(fminf(a1, b1), fmaxf(a2, b2)); a1 = n1; a2 = n2;
        }
        const float gs = a1 + a2; const int mygrp = lane >> 3;
        int gcnt = 0;
#pragma unroll
        for (int g = 0; g < 8; ++g) { const float og = __shfl(gs, g * 8); gcnt += (og > gs || (og == gs && g < mygrp)) ? 1 : 0; }
        const bool gsel = gcnt < 4;
        unsigned k0, k1, k2, k3;
        {
            const unsigned u0 = __float_as_uint(s0), u1 = __float_as_uint(s1), u2 = __float_as_uint(s2), u3 = __float_as_uint(s3);
            k0 = gsel ? (u0 ^ ((u0 >> 31) ? 0xffffffffu : 0x80000000u)) : 0u; k1 = gsel ? (u1 ^ ((u1 >> 31) ? 0xffffffffu : 0x80000000u)) : 0u;
            k2 = gsel ? (u2 ^ ((u2 >> 31) ? 0xffffffffu : 0x80000000u)) : 0u; k3 = gsel ? (u3 ^ ((u3 >> 31) ? 0xffffffffu : 0x80000000u)) : 0u;
        }
        unsigned T = 0u;
#pragma unroll 1
        for (int bit = 31; bit >= 0; --bit) {
            const unsigned trial = T | (1u << bit);
            const int cnt = __popcll(__ballot(k0 >= trial)) + __popcll(__ballot(k1 >= trial)) + __popcll(__ballot(k2 >= trial)) + __popcll(__ballot(k3 >= trial));
            if (cnt >= 8) T = trial;
        }
        const unsigned long long g0 = __ballot(k0 > T), g1 = __ballot(k1 > T), g2 = __ballot(k2 > T), g3 = __ballot(k3 > T);
        const unsigned long long e0 = __ballot(k0 == T), e1 = __ballot(k1 == T), e2 = __ballot(k2 == T), e3 = __ballot(k3 == T);
        const int need = 8 - (__popcll(g0) + __popcll(g1) + __popcll(g2) + __popcll(g3));
        const unsigned long long below = (1ull << lane) - 1ull;
        const int eb = __popcll(e0 & below) + __popcll(e1 & below) + __popcll(e2 & below) + __popcll(e3 & below);
        const int b0 = (int)((e0 >> lane) & 1ull), b1 = (int)((e1 >> lane) & 1ull), b2 = (int)((e2 >> lane) & 1ull);
        const bool t0 = k0 > T || (k0 == T && eb < need);
        const bool t1 = k1 > T || (k1 == T && eb + b0 < need);
        const bool t2 = k2 > T || (k2 == T && eb + b0 + b1 < need);
        const bool t3 = k3 > T || (k3 == T && eb + b0 + b1 + b2 < need);
        const unsigned long long m0 = __ballot(t0), m1 = __ballot(t1), m2 = __ballot(t2), m3 = __ballot(t3);
        const int kb = __popcll(m0 & below) + __popcll(m1 & below) + __popcll(m2 & below) + __popcll(m3 & below);
        const float wsum = wave_sum((t0 ? sc.x : 0.f) + (t1 ? sc.y : 0.f) + (t2 ? sc.z : 0.f) + (t3 ? sc.w : 0.f));
        const float wn = 2.5f / wsum;
        const int i0 = lane * 4;
        int kk = kb;
        if (t0) { atomicAdd(lh + i0, 1);     tope[tok * 8 + kk] = i0;     topw[tok * 8 + kk] = sc.x * wn; ++kk; }
        if (t1) { atomicAdd(lh + i0 + 1, 1); tope[tok * 8 + kk] = i0 + 1; topw[tok * 8 + kk] = sc.y * wn; ++kk; }
        if (t2) { atomicAdd(lh + i0 + 2, 1); tope[tok * 8 + kk] = i0 + 2; topw[tok * 8 + kk] = sc.z * wn; ++kk; }
        if (t3) { atomicAdd(lh + i0 + 3, 1); tope[tok * 8 + kk] = i0 + 3; topw[tok * 8 + kk] = sc.w * wn; ++kk; }
    }
    __syncthreads();
    ((int*)(p.ws + OFF_HIST))[blockIdx.x * 256 + tid] = lh[tid];
}
__device__ __forceinline__ void phase_assign(const Params& p, unsigned char* smem) {
    const int tid = opaque_tid(), lane = tid & 63, wid = tid >> 6;
    int* offs = (int*)smem; int* lc = offs + 256;
    const int* hist = (const int*)(p.ws + OFF_HIST);
    int* slot_tok = (int*)(p.ws + OFF_SLOT);
    const int* tope = (const int*)(p.ws + OFF_TOPE); int* rnk = (int*)(p.ws + OFF_RANK);
    {
        int run = 0, mine = 0;
        const int nb = gridDim.x, me = blockIdx.x;
        for (int b0 = 0; b0 < nb; b0 += 8) {
            int v[8];
#pragma unroll
            for (int j = 0; j < 8; ++j) v[j] = (b0 + j < nb) ? hist[(b0 + j) * 256 + tid] : 0;
#pragma unroll
            for (int j = 0; j < 8; ++j) { if (b0 + j == me) mine = run; run += v[j]; }
        }
        offs[tid] = mine; lc[tid] = 0;
        if (me == 0) ((int*)(p.ws + OFF_CNT))[tid] = run;
    }
    __syncthreads();
    for (int tok = blockIdx.x * 4 + wid; tok < NTOK; tok += gridDim.x * 4) {
        if (lane < 8) {
            const int e = tope[tok * 8 + lane];
            const int rk = offs[e] + atomicAdd(lc + e, 1);
            rnk[tok * 8 + lane] = rk; slot_tok[(size_t)e * NTOK + rk] = tok;
        }
    }
}

__device__ __forceinline__ int* build_tile_table(const Params& p, unsigned char* smem) {
    int* tstart = (int*)(smem + 73728); int* cn = tstart + 260; int* pstart = cn + 256;
    const int tid = opaque_tid();
    cn[tid] = ((const int*)(p.ws + OFF_CNT))[tid];
    __syncthreads();
    if (tid == 0) {
        int s = 0, q = 0;
        for (int e = 0; e < 256; ++e) { const int t = (cn[e] + 127) >> 7; tstart[e] = s; pstart[e] = q; s += t; q += (t + 1) >> 1; }
        tstart[256] = s; pstart[256] = q;
    }
    __syncthreads();
    return tstart;
}
__device__ __forceinline__ int find_pair_expert(const int* pstart, int mp) {
    int lo = 0, hi = 256;
    while (hi - lo > 1) { const int mid = (lo + hi) >> 1; if (pstart[mid] <= mp) lo = mid; else hi = mid; }
    return lo;
}

__device__ __forceinline__ void gemm_core_m256(f32x16 (&acc)[4][2], const u16* abase, const int (&roff)[8], const float* bsrc, const size_t ldb, const int nk,
                                               unsigned char* smem, const int tid, const int lane, const int wr, const int wc) {
    typedef __attribute__((address_space(3))) unsigned lds_u32;
    u16* Bs = (u16*)(smem + 32768);
    f32x4 br[8];
#pragma unroll
    for (int i = 0; i < 8; ++i) br[i] = *(const f32x4*)(bsrc + (size_t)i * ldb);
    const int arow = tid >> 3, ach = tid & 7;
    const int r = lane & 31, hh = lane >> 5;
    for (int kt = 0; kt < nk; ++kt) {
        __syncthreads();
        {
            unsigned char* sa = smem + tid * 16;
#pragma unroll
            for (int i = 0; i < 8; ++i) __builtin_amdgcn_global_load_lds((const unsigned*)(abase + roff[i] + kt * 64), (lds_u32*)(sa + i * 4096), 16, 0, 0);
        }
#pragma unroll
        for (int cc = 0; cc < 4; ++cc) {
            u32x4 w; w.x = pk2(br[0][cc], br[1][cc]); w.y = pk2(br[2][cc], br[3][cc]); w.z = pk2(br[4][cc], br[5][cc]); w.w = pk2(br[6][cc], br[7][cc]);
            *(u32x4*)(Bs + (arow * 4 + cc) * LDT + ach * 8) = w;
        }
        __syncthreads();
        if (kt + 1 < nk) {
            const float* bp = bsrc + (size_t)(kt + 1) * 64 * ldb;
#pragma unroll
            for (int i = 0; i < 8; ++i) br[i] = *(const f32x4*)(bp + (size_t)i * ldb);
        }
        __builtin_amdgcn_s_setprio(1);
#pragma unroll 1
        for (int kk = 0; kk < 4; ++kk) {
            bf16x8 a[4], b[2];
            const int ch = ((kk * 2 + hh) ^ ((r >> 1) & 7)) * 16;
#pragma unroll
            for (int mi = 0; mi < 4; ++mi) a[mi] = *(const bf16x8*)(smem + (wr * 128 + mi * 32 + r) * 128 + ch);
#pragma unroll
            for (int ni = 0; ni < 2; ++ni) b[ni] = *(const bf16x8*)(Bs + (wc * 64 + ni * 32 + r) * LDT + kk * 16 + hh * 8);
#pragma unroll
            for (int mi = 0; mi < 4; ++mi)
#pragma unroll
                for (int ni = 0; ni < 2; ++ni) acc[mi][ni] = mfma32(b[ni], a[mi], acc[mi][ni]);
        }
        __builtin_amdgcn_s_setprio(0);
    }
    __syncthreads();
}

__device__ __forceinline__ void phase_moe1(const Params& p, unsigned char* smem) {
    const int* tstart = build_tile_table(p, smem); const int* cn = tstart + 260; const int* pstart = cn + 256;
    const u16* H2 = (const u16*)(p.ws + OFF_H);
    const int* slot_tok = (const int*)(p.ws + OFF_SLOT);
    u16* HID = (u16*)(p.ws + OFF_HID);
    const int tid = opaque_tid(), lane = tid & 63, wid = tid >> 6, wr = wid >> 1, wc = wid & 1;
    const int r = lane & 31, hh = lane >> 5;
    const int totalp = pstart[256];
    const int nitems = totalp * 4 + 512;
    const int sw = ((tid & 7) ^ ((tid >> 4) & 7)) * 8;
    for (int ii = 0;; ++ii) {
        const int it = ((blockIdx.x & 7) + 8 * ii) * (gridDim.x >> 3) + (blockIdx.x >> 3);
        if (it >= nitems) break;
        const bool shared = it >= totalp * 4;
        const int idx = shared ? it - totalp * 4 : it;
        const int mp = idx >> 2, nq = idx & 3;
        int e = 0, jp = 0, cnt_e = 0, vrows = 256;
        size_t hrow0;
        if (!shared) {
            e = find_pair_expert(pstart, mp); jp = mp - pstart[e]; cnt_e = cn[e];
            const int te = (cnt_e + 127) >> 7;
            vrows = (2 * jp + 1 < te) ? 256 : 128;
            hrow0 = (size_t)tstart[e] * 128 + jp * 256;
        } else hrow0 = (size_t)SH_BASE + mp * 256;
        int roff[8];
#pragma unroll
        for (int i = 0; i < 8; ++i) {
            const int ri = (tid >> 3) + 32 * i;
            int tok;
            if (shared) tok = mp * 256 + ri;
            else { const int pos = jp * 256 + ri; tok = pos < cnt_e ? slot_tok[(size_t)e * NTOK + pos] : 0; }
            roff[i] = tok * 1024 + sw;
        }
        const int R0 = (tid >> 3) * 4, bwc = R0 >> 6, bni = (R0 >> 5) & 1, bj = R0 & 31;
        const float* wsel = shared ? (bni ? p.w_sh_up : p.w_sh_gate) : ((bni ? p.w_exp_up : p.w_exp_gate) + (size_t)e * 1024 * 256);
        const float* bsrc = wsel + (size_t)((tid & 7) * 8) * 256 + nq * 64 + bwc * 32 + bj;
        f32x16 acc[4][2] = {};
        gemm_core_m256(acc, H2, roff, bsrc, 256, 16, smem, tid, lane, wr, wc);
        u16* Ct = (u16*)smem;
#pragma unroll
        for (int mi = 0; mi < 4; ++mi) {
            u16* base = Ct + (wr * 128 + mi * 32 + r) * LDT + wc * 32 + 4 * hh;
#pragma unroll
            for (int g = 0; g < 4; ++g) {
                float hv[4];
#pragma unroll
                for (int j = 0; j < 4; ++j) { const float gt = acc[mi][0][4 * g + j], u = acc[mi][1][4 * g + j]; hv[j] = gt * sigmoid_(gt) * u; }
                u32x2 w; w.x = pk2(hv[0], hv[1]); w.y = pk2(hv[2], hv[3]);
                *(u32x2*)(base + 8 * g) = w;
            }
        }
        __syncthreads();
#pragma unroll
        for (int i = 0; i < 8; ++i) {
            const int id2 = tid + i * 256, row = id2 >> 3, ch = id2 & 7;
            if (row < vrows) *(u32x4*)(HID + (hrow0 + row) * 256 + nq * 64 + ch * 8) = *(const u32x4*)(Ct + row * LDT + ch * 8);
        }
        __syncthreads();
    }
}

__device__ __forceinline__ void phase_moe2(const Params& p, unsigned char* smem) {
    const int* tstart = build_tile_table(p, smem); const int* cn = tstart + 260; const int* pstart = cn + 256;
    const u16* HID = (const u16*)(p.ws + OFF_HID);
    u16* Y = (u16*)(p.ws + OFF_Y);
    const int tid = opaque_tid(), lane = tid & 63, wid = tid >> 6, wr = wid >> 1, wc = wid & 1;
    const int r = lane & 31, hh = lane >> 5;
    const int totalp = pstart[256];
    const int nitems = totalp * 8 + 1024;
    const int sw = ((tid & 7) ^ ((tid >> 4) & 7)) * 8;
    for (int ii = 0;; ++ii) {
        const int it = ((blockIdx.x & 7) + 8 * ii) * (gridDim.x >> 3) + (blockIdx.x >> 3);
        if (it >= nitems) break;
        const bool shared = it >= totalp * 8;
        const int idx = shared ? it - totalp * 8 : it;
        const int mp = idx >> 3, nt = idx & 7;
        int e = 0, vrows = 256;
        size_t hrow0;
        if (!shared) {
            e = find_pair_expert(pstart, mp); const int jp = mp - pstart[e];
            const int te = (cn[e] + 127) >> 7;
            vrows = (2 * jp + 1 < te) ? 256 : 128;
            hrow0 = (size_t)tstart[e] * 128 + jp * 256;
        } else hrow0 = (size_t)SH_BASE + mp * 256;
        int roff[8];
#pragma unroll
        for (int i = 0; i < 8; ++i) {
            const int ri = (tid >> 3) + 32 * i;
            roff[i] = (int)(hrow0 + (ri < vrows ? ri : ri - 128)) * 256 + sw;
        }
        const float* wsel = shared ? p.w_sh_down : p.w_exp_down + (size_t)e * 256 * 1024;
        const float* bsrc = wsel + (size_t)((tid & 7) * 8) * 1024 + nt * 128 + (tid >> 3) * 4;
        f32x16 acc[4][2] = {};
        gemm_core_m256(acc, HID, roff, bsrc, 1024, 4, smem, tid, lane, wr, wc);
        u16* Ct = (u16*)smem;
#pragma unroll
        for (int mi = 0; mi < 4; ++mi)
#pragma unroll
            for (int ni = 0; ni < 2; ++ni) {
                u16* base = Ct + (wr * 128 + mi * 32 + r) * CT_LD + wc * 64 + ni * 32 + 4 * hh;
#pragma unroll
                for (int g = 0; g < 4; ++g) {
                    u32x2 w; w.x = pk2(acc[mi][ni][4 * g], acc[mi][ni][4 * g + 1]); w.y = pk2(acc[mi][ni][4 * g + 2], acc[mi][ni][4 * g + 3]);
                    *(u32x2*)(base + 8 * g) = w;
                }
            }
        __syncthreads();
#pragma unroll 4
        for (int i = 0; i < 16; ++i) {
            const int id2 = tid + i * 256, row = id2 >> 4, ch = id2 & 15;
            if (row < vrows) *(u32x4*)(Y + (hrow0 + row) * 1024 + nt * 128 + ch * 8) = *(const u32x4*)(Ct + row * CT_LD + ch * 8);
        }
        __syncthreads();
    }
}

__device__ __forceinline__ void phase_combine(const Params& p, unsigned char* smem) {
    const int* tstart = build_tile_table(p, smem);
    float* g2t = (float*)smem;
    const int tid = opaque_tid(), lane = tid & 63, wid = tid >> 6;
    for (int j = tid; j < 2048; j += 256) g2t[j] = mod_val(p, j >> 10, 5120 + (j & 1023));
    __syncthreads();
    const u16* Y = (const u16*)(p.ws + OFF_Y);
    const int* tope = (const int*)(p.ws + OFF_TOPE); const int* rnk = (const int*)(p.ws + OFF_RANK); const float* topw = (const float*)(p.ws + OFF_TOPW);
    for (int tok = blockIdx.x * 4 + wid; tok < NTOK; tok += gridDim.x * 4) {
        int myrow = 0; float myw = 0.f;
        if (lane < 8) { const int e = tope[tok * 8 + lane]; myrow = tstart[e] * 128 + rnk[tok * 8 + lane]; myw = topw[tok * 8 + lane]; }
        if (lane == 8) { myrow = SH_BASE + tok; myw = 1.f; }
        const float* g2 = g2t + (tok >> 14) * 1024;
        f32x4 a[4];
#pragma unroll
        for (int j = 0; j < 4; ++j) a[j] = (f32x4){0.f, 0.f, 0.f, 0.f};
#pragma unroll
        for (int k = 0; k < 9; ++k) {
            const int row = __shfl(myrow, k); const float w = __shfl(myw, k);
            const u16* yr = Y + (size_t)row * 1024 + lane * 4;
#pragma unroll
            for (int j = 0; j < 4; ++j) {
                const u32x2 v = *(const u32x2*)(yr + j * 256);
                a[j].x += w * bf_lo(v.x); a[j].y += w * bf_hi(v.x); a[j].z += w * bf_lo(v.y); a[j].w += w * bf_hi(v.y);
            }
        }
#pragma unroll
        for (int j = 0; j < 4; ++j) {
            const int col = j * 256 + lane * 4;
            float* op = p.out + (size_t)tok * 1024 + col;
            const f32x4 x1 = *(const f32x4*)op, g = *(const f32x4*)(g2 + col);
            f32x4 o; o.x = x1.x + g.x * a[j].x; o.y = x1.y + g.y * a[j].y; o.z = x1.z + g.z * a[j].z; o.w = x1.w + g.w * a[j].w;
            *(f32x4*)op = o;
        }
    }
}

#define XB_TMO      128
#define XB_XCNT(j)  (256  + 64 * (j))
#define XB_XSUB(j)  (1280 + 64 * (j))
#define XB_XGEN(j)  (2304 + 64 * (j))
#define XB_TOP      3328
#define XB_TOPGEN   3392
#define XCD_BAR_WORDS 3456
#define XB_SPIN_CAP (1u << 24)
#define LAS __attribute__((address_space(3)))
__device__ __forceinline__ unsigned xb_ld(unsigned* p)              { return __hip_atomic_load(p, __ATOMIC_RELAXED, __HIP_MEMORY_SCOPE_AGENT); }
__device__ __forceinline__ unsigned xb_add(unsigned* p, unsigned v) { return __hip_atomic_fetch_add(p, v, __ATOMIC_RELAXED, __HIP_MEMORY_SCOPE_AGENT); }
__device__ __forceinline__ unsigned xb_xcc_id() { return (unsigned)__builtin_amdgcn_s_getreg((3 << 11) | 20) & 0xFu; }
#define XB_SPIN(cond, bar) do { unsigned _sp = 0; while (cond) { __builtin_amdgcn_s_sleep(1); \
    if ((++_sp & 255u) == 0u) { if (xb_ld(&(bar)[XB_TMO])) break; if (_sp > XB_SPIN_CAP) { atomicAdd(&(bar)[XB_TMO], 1u); break; } } } } while (0)
struct XcdBarrier { unsigned* bar; unsigned x; volatile LAS unsigned* st; };
__device__ __forceinline__ XcdBarrier xcd_barrier_post(unsigned* bar, volatile LAS unsigned* st) {
    XcdBarrier b; b.bar = bar; b.x = xb_xcc_id(); b.st = st;
    if (threadIdx.x == 0) (void)xb_add(&bar[XB_XCNT(b.x)], 1u);
    return b;
}
__device__ __forceinline__ void xcd_barrier_complete(unsigned* bar, unsigned x, unsigned& nloc, unsigned& nx) {
    const unsigned G = gridDim.x * gridDim.y * gridDim.z;
    unsigned sum, cnt, mine, sp = 0u;
    for (;;) {
        sum = 0u; cnt = 0u; mine = 0u;
#pragma unroll
        for (unsigned j = 0; j < 16; ++j) { const unsigned c = xb_ld(&bar[XB_XCNT(j)]); sum += c; cnt += (c > 0u) ? 1u : 0u; mine = (j == x) ? c : mine; }
        if (sum == G) break;
        __builtin_amdgcn_s_sleep(1);
        if ((++sp & 255u) == 0u) { if (xb_ld(&bar[XB_TMO])) break; if (sp > XB_SPIN_CAP) { atomicAdd(&bar[XB_TMO], 1u); break; } }
    }
    nloc = mine > 0u ? mine : 1u; nx = cnt > 0u ? cnt : 1u;
}
__device__ __forceinline__ void xcd_barrier(const XcdBarrier& b) {
    asm volatile("s_waitcnt vmcnt(0)" ::: "memory");
    __syncthreads();
    if (threadIdx.x == 0) {
        unsigned* bar = b.bar;
        __builtin_amdgcn_s_waitcnt(0);
        unsigned nloc = b.st[0], nx = b.st[1];
        if (nloc == 0u) { xcd_barrier_complete(bar, b.x, nloc, nx); b.st[0] = nloc; b.st[1] = nx; }
        const unsigned old = xb_add(&bar[XB_XSUB(b.x)], 1u);
        const unsigned gen = old / nloc;
        if (old + 1u == (gen + 1u) * nloc) {
            __builtin_amdgcn_fence(__ATOMIC_RELEASE, "agent");
            asm volatile("s_waitcnt vmcnt(0)" ::: "memory");
            const unsigned og = xb_add(&bar[XB_TOP], 1u);
            const unsigned tg = og / nx;
            if (og + 1u == (tg + 1u) * nx) xb_add(&bar[XB_TOPGEN], 1u);
            else XB_SPIN(xb_ld(&bar[XB_TOPGEN]) == tg, bar);
            __builtin_amdgcn_fence(__ATOMIC_ACQUIRE, "agent");
            xb_add(&bar[XB_XGEN(b.x)], 1u);
            asm volatile("s_waitcnt vmcnt(0)" ::: "memory");
        } else {
            XB_SPIN(xb_ld(&bar[XB_XGEN(b.x)]) == gen, bar);
            __builtin_amdgcn_fence(__ATOMIC_ACQUIRE, "agent");
            asm volatile("s_waitcnt vmcnt(0)" ::: "memory");
        }
    }
    __syncthreads();
}

__global__ void __launch_bounds__(256, 2) mega(Params p) {
    extern __shared__ __attribute__((aligned(16))) unsigned char smem[];
    cg::grid_group grid = cg::this_grid();
    if (p.ph_lo < 0) grid.sync();
    volatile LAS unsigned* xst = (volatile LAS unsigned*)(smem + 77808);
    if (threadIdx.x == 0) { xst[0] = 0u; xst[1] = 0u; }
    __syncthreads();
    const XcdBarrier xb = xcd_barrier_post((unsigned*)(p.ws + OFF_BAR), xst);
#define GSYNC() xcd_barrier(xb)
#define PHASE_BEGIN(k) if (p.ph_lo <= (k) && (k) < p.ph_hi) {
#define PHASE_END(k) if ((k) + 1 < p.ph_hi) GSYNC(); }
    PHASE_BEGIN(0) phase_ada(p, smem); if (DUP_PHASE == 0) { GSYNC(); phase_ada(p, smem); } PHASE_END(0)
    PHASE_BEGIN(1) phase_norm(p, smem, false); if (DUP_PHASE == 1) { GSYNC(); phase_norm(p, smem, false); } PHASE_END(1)
    PHASE_BEGIN(2) phase_inproj(p, smem); if (DUP_PHASE == 2) { GSYNC(); phase_inproj(p, smem); } PHASE_END(2)
    PHASE_BEGIN(3)
        for (int it = blockIdx.x; it < 2080; it += gridDim.x) mlstm_passA(p, smem, it);
        if (DUP_PHASE == 3) { GSYNC(); for (int it = blockIdx.x; it < 2080; it += gridDim.x) mlstm_passA(p, smem, it); }
        if (DUP_PHASE == 30) { GSYNC(); for (int it = blockIdx.x; it < 4096; it += gridDim.x) na_item(p, smem, it); }
    PHASE_END(3)
    PHASE_BEGIN(4)
        if (blockIdx.x * 2 < gridDim.x) { phase_scan(p, smem); for (int it = blockIdx.x; it < 4096; it += gridDim.x) na_item(p, smem, it); }
        else { for (int it = blockIdx.x; it < 4096; it += gridDim.x) na_item(p, smem, it); phase_scan(p, smem); }
 if (DUP_PHASE == 34) { GSYNC(); for (int it = blockIdx.x; it < 2080; it += gridDim.x) mlstm_passA(p, smem, it); GSYNC(); phase_scan(p, smem); } PHASE_END(4)
    PHASE_BEGIN(5) for (int it = blockIdx.x; it < 2048; it += gridDim.x) mlstm_passC(p, smem, it); if (DUP_PHASE == 5) { GSYNC(); for (int it = blockIdx.x; it < 2048; it += gridDim.x) mlstm_passC(p, smem, it); } PHASE_END(5)
    PHASE_BEGIN(6) phase_merge(p, smem, false); phase_merge(p, smem, true); if (DUP_PHASE == 6) { GSYNC(); phase_merge(p, smem, false); phase_merge(p, smem, true); } PHASE_END(6)
    PHASE_BEGIN(7) phase_outproj(p, smem); if (DUP_PHASE == 7) { GSYNC(); phase_outproj(p, smem); } PHASE_END(7)
    PHASE_BEGIN(8) phase_norm(p, smem, true); if (DUP_PHASE == 8) { GSYNC(); phase_norm(p, smem, true); } PHASE_END(8)
    PHASE_BEGIN(9) phase_router(p, smem); if (DUP_PHASE == 9) { GSYNC(); phase_router(p, smem); } PHASE_END(9)
    PHASE_BEGIN(10) phase_route(p, smem); PHASE_END(10)
    PHASE_BEGIN(11) phase_assign(p, smem); PHASE_END(11)
    PHASE_BEGIN(12) phase_moe1(p, smem); if (DUP_PHASE == 12) { GSYNC(); phase_moe1(p, smem); } PHASE_END(12)
    PHASE_BEGIN(13) phase_moe2(p, smem); if (DUP_PHASE == 13) { GSYNC(); phase_moe2(p, smem); } PHASE_END(13)
    PHASE_BEGIN(14) phase_combine(p, smem);
        if (DUP_PHASE == 200) { for (int q = 0; q < 20; ++q) GSYNC(); }
        if (DUP_PHASE == 100) { GSYNC(); phase_route(p, smem); GSYNC(); phase_assign(p, smem); }
    PHASE_END(14)
}

extern "C" void kernel_launch(void* const* d_in, const int* in_sizes, int n_in, void* d_out, int out_size, void* d_ws, size_t ws_size, hipStream_t stream) {
    static int grid_blocks = 0;
    if (!grid_blocks) {
        int dev = 0, cus = 0, per_cu = 0;
        (void)hipGetDevice(&dev);
        (void)hipDeviceGetAttribute(&cus, hipDeviceAttributeMultiprocessorCount, dev);
        (void)hipFuncSetAttribute((const void*)mega, hipFuncAttributeMaxDynamicSharedMemorySize, LDS_BYTES);
        (void)hipOccupancyMaxActiveBlocksPerMultiprocessor(&per_cu, mega, 256, LDS_BYTES);
        if (per_cu > 2) per_cu = 2;
        if (per_cu < 1) per_cu = 1;
        grid_blocks = cus * per_cu;
        if (ws_size < WS_END) fprintf(stderr, "kernel_launch: workspace too small: %zu < %zu\n", ws_size, (size_t)WS_END);
    }
    (void)hipMemsetAsync((char*)d_ws + OFF_BAR, 0, XCD_BAR_WORDS * 4, stream);
    Params p{};
    const float** pp = (const float**)&p;
    for (int i = 0; i < 23; ++i) pp[i] = (const float*)d_in[i];
    p.out = (float*)d_out; p.ws = (unsigned char*)d_ws;
#if MULTI_LAUNCH
    for (int ph = 0; ph < NPH; ++ph) {
        p.ph_lo = ph; p.ph_hi = ph + 1;
        void* args[] = {&p};
        hipError_t e = hipLaunchCooperativeKernel((void*)mega, dim3(grid_blocks), dim3(256), args, LDS_BYTES, stream);
        if (e != hipSuccess) fprintf(stderr, "cooperative launch failed: %s (grid %d)\n", hipGetErrorString(e), grid_blocks);
    }
#else
    p.ph_lo = 0; p.ph_hi = NPH;
    void* args[] = {&p};
    hipError_t e = hipLaunchCooperativeKernel((void*)mega, dim3(grid_blocks), dim3(256), args, LDS_BYTES, stream);
    if (e != hipSuccess) fprintf(stderr, "cooperative launch failed: %s (grid %d)\n", hipGetErrorString(e), grid_blocks);
#endif
}
```

```cpp
#include <hip/hip_runtime.h>
#include <hip/hip_cooperative_groups.h>
#include <cstdio>
#include <cstdint>
namespace cg = cooperative_groups;

#ifndef MULTI_LAUNCH
#define MULTI_LAUNCH 0
#endif
#ifndef DUP_PHASE
#define DUP_PHASE -1
#endif

typedef unsigned short u16;
typedef unsigned int u32;
typedef short bf16x8 __attribute__((ext_vector_type(8)));
typedef float f32x16 __attribute__((ext_vector_type(16)));
typedef float f32x4 __attribute__((ext_vector_type(4)));
typedef u32 u32x4 __attribute__((ext_vector_type(4)));
typedef u32 u32x2 __attribute__((ext_vector_type(2)));

constexpr int DM = 1024;
constexpr int NTOK = 32768;
constexpr int TSEQ = 16384;
constexpr int MTOT = 33280;
constexpr int INC = 6672;
constexpr int PV = 6784;
constexpr int V_MQ = 0, V_MK = 512, V_MV = 1024, V_MO = 2048, V_NQ = 3072, V_NK = 3584, V_NV = 4096, V_GM = 4608, V_GN = 5632;
constexpr int NSLOT = 4160;
constexpr int SH_BASE = 294912;
constexpr int NPH = 15;
constexpr int LDS_BYTES = 80 * 1024;
constexpr int LDT = 72;
constexpr int LDQ = 136;

constexpr size_t AL(size_t x) { return (x + 255) & ~(size_t)255; }
constexpr size_t OFF_MODP = 0;
constexpr size_t OFF_CNT  = AL(OFF_MODP + (size_t)8 * 3 * 6144 * 4);
constexpr size_t OFF_G    = AL(OFF_CNT + 1024);
constexpr size_t OFF_GS   = AL(OFF_G + (size_t)MTOT * 16 * 4);
constexpr size_t OFF_ML   = AL(OFF_GS + NSLOT * 4);
constexpr size_t OFF_MP   = AL(OFF_ML + NSLOT * 4);
constexpr size_t OFF_DN   = AL(OFF_MP + NSLOT * 4);
constexpr size_t OFF_TOPE = AL(OFF_DN + (size_t)NSLOT * 128 * 4);
constexpr size_t OFF_RANK = OFF_TOPE + (size_t)NTOK * 8 * 4;
constexpr size_t OFF_TOPW = OFF_RANK + (size_t)NTOK * 8 * 4;
constexpr size_t OFF_H    = AL(OFF_TOPW + (size_t)NTOK * 8 * 4);
constexpr size_t OFF_SLOT = AL(OFF_H + (size_t)MTOT * 1024 * 2);
constexpr size_t OFF_R4   = AL(OFF_SLOT + (size_t)256 * 32768 * 4);
constexpr size_t OFF_YNA  = OFF_R4;
constexpr size_t OFF_YM   = OFF_R4 + (size_t)NTOK * 512 * 2;
constexpr size_t OFF_MRG  = OFF_YM + (size_t)NTOK * 1024 * 2;
constexpr size_t OFF_SC   = OFF_R4;
constexpr size_t OFF_HID  = OFF_R4;
constexpr size_t OFF_P    = AL(OFF_R4 + (size_t)327680 * 256 * 2);
constexpr size_t OFF_CT   = AL(OFF_P + (size_t)MTOT * PV * 2);
constexpr size_t OFF_Y    = OFF_P;
constexpr size_t OFF_WINT = AL(OFF_CT + (size_t)NSLOT * 65536);
constexpr size_t OFF_BRMT = AL(OFF_WINT + (size_t)6912 * 1024 * 2);
constexpr size_t OFF_BRNT = AL(OFF_BRMT + (size_t)1024 * 1024 * 2);
constexpr size_t OFF_OUTT = AL(OFF_BRNT + (size_t)1024 * 512 * 2);
constexpr size_t OFF_RTT  = AL(OFF_OUTT + (size_t)1024 * 1024 * 2);
constexpr size_t OFF_HIST = AL(OFF_RTT + (size_t)256 * 1024 * 2);
constexpr size_t OFF_TAB  = AL(OFF_HIST + (size_t)1024 * 256 * 4);
constexpr size_t OFF_BAR  = AL(OFF_TAB + 4096);
constexpr size_t WS_END   = OFF_BAR + 32768;
static_assert(OFF_Y + (size_t)327680 * 1024 * 2 <= OFF_WINT, "Y must fit over P+CT");
static_assert(WS_END <= (size_t)1073741824, "workspace budget");

struct Params {
    const float *x, *c, *ctx, *c_ctx, *w_ada, *b_ada, *w_in, *b_mgate, *m_norm_w, *na_qn_w, *na_kn_w, *na_rpb,
                *w_br_m, *w_br_na, *w_out, *w_router, *router_bias, *w_exp_gate, *w_exp_up, *w_exp_down,
                *w_sh_gate, *w_sh_up, *w_sh_down;
    float* out;
    unsigned char* ws;
    int ph_lo, ph_hi;
};

typedef __bf16 bf16x2_t __attribute__((ext_vector_type(2)));
__device__ __forceinline__ u32 pk2(float lo, float hi) { bf16x2_t v = {(__bf16)lo, (__bf16)hi}; return __builtin_bit_cast(u32, v); }
__device__ __forceinline__ u16 f2bf(float f) { return (u16)(pk2(f, 0.f) & 0xffffu); }
__device__ __forceinline__ float bf2f(u16 h) { return __uint_as_float(((u32)h) << 16); }
__device__ __forceinline__ float bf_lo(u32 w) { return __uint_as_float(w << 16); }
__device__ __forceinline__ float bf_hi(u32 w) { return __uint_as_float(w & 0xffff0000u); }
__device__ __forceinline__ float sigmoid_(float x) { return 1.f / (1.f + __expf(-x)); }
__device__ __forceinline__ float log_sigmoid_(float x) { return fminf(x, 0.f) - __logf(1.f + __expf(-fabsf(x))); }
__device__ __forceinline__ f32x4 mfma16(bf16x8 a, bf16x8 b, f32x4 c) { return __builtin_amdgcn_mfma_f32_16x16x32_bf16(a, b, c, 0, 0, 0); }
__device__ __forceinline__ f32x16 mfma32(bf16x8 a, bf16x8 b, f32x16 c) { return __builtin_amdgcn_mfma_f32_32x32x16_bf16(a, b, c, 0, 0, 0); }

__device__ __forceinline__ void sincos_rev(float rev, float& sn, float& cs) {
    rev -= rintf(rev);
    const float kq = rintf(rev * 4.f);
    const float th = (rev - kq * 0.25f) * 6.283185307179586f;
    const float t2 = th * th;
    const float s = th * (1.f + t2 * (-1.f / 6.f + t2 * (1.f / 120.f + t2 * (-1.f / 5040.f + t2 * (1.f / 362880.f)))));
    const float c = 1.f + t2 * (-0.5f + t2 * (1.f / 24.f + t2 * (-1.f / 720.f + t2 * (1.f / 40320.f))));
    const int k = ((int)kq) & 3;
    sn = (k == 0) ? s : (k == 1) ? c : (k == 2) ? -s : -c;
    cs = (k == 0) ? c : (k == 1) ? -s : (k == 2) ? -c : s;
}
__device__ __forceinline__ int opaque_tid() { int t = threadIdx.x; asm volatile("" : "+v"(t)); return t; }
__device__ __forceinline__ float wave_sum(float v) {
#pragma unroll
    for (int o = 1; o < 64; o <<= 1) v += __shfl_xor(v, o);
    return v;
}
__device__ __forceinline__ float wave_max(float v) {
#pragma unroll
    for (int o = 1; o < 64; o <<= 1) v = fmaxf(v, __shfl_xor(v, o));
    return v;
}
__device__ __forceinline__ float wave_incl_sum(float v, int lane) {
#pragma unroll
    for (int o = 1; o < 64; o <<= 1) { float t = __shfl_up(v, o); if (lane >= o) v += t; }
    return v;
}
__device__ __forceinline__ float wave_prefix_max(float v, int lane) {
#pragma unroll
    for (int o = 1; o < 64; o <<= 1) { float t = __shfl_up(v, o); if (lane >= o) v = fmaxf(v, t); }
    return v;
}
__device__ __forceinline__ float wave_suffix_max(float v, int lane) {
#pragma unroll
    for (int o = 1; o < 64; o <<= 1) { float t = __shfl_down(v, o); if (lane + o < 64) v = fmaxf(v, t); }
    return v;
}
__device__ __forceinline__ float mod_val(const Params& p, int vec, int j) {
    const float* mp = (const float*)(p.ws + OFF_MODP);
    float s = p.b_ada[j];
#pragma unroll
    for (int ks = 0; ks < 8; ++ks) s += mp[(ks * 3 + vec) * 6144 + j];
    return s;
}
__device__ __forceinline__ u32x4 tr8(const u32x2 (&v)[8], int cc) {
    u32x4 o;
    if (cc == 0)      { o.x = (v[0].x & 0xffffu) | (v[1].x << 16); o.y = (v[2].x & 0xffffu) | (v[3].x << 16); o.z = (v[4].x & 0xffffu) | (v[5].x << 16); o.w = (v[6].x & 0xffffu) | (v[7].x << 16); }
    else if (cc == 1) { o.x = (v[0].x >> 16) | (v[1].x & 0xffff0000u); o.y = (v[2].x >> 16) | (v[3].x & 0xffff0000u); o.z = (v[4].x >> 16) | (v[5].x & 0xffff0000u); o.w = (v[6].x >> 16) | (v[7].x & 0xffff0000u); }
    else if (cc == 2) { o.x = (v[0].y & 0xffffu) | (v[1].y << 16); o.y = (v[2].y & 0xffffu) | (v[3].y << 16); o.z = (v[4].y & 0xffffu) | (v[5].y << 16); o.w = (v[6].y & 0xffffu) | (v[7].y << 16); }
    else              { o.x = (v[0].y >> 16) | (v[1].y & 0xffff0000u); o.y = (v[2].y >> 16) | (v[3].y & 0xffff0000u); o.z = (v[4].y >> 16) | (v[5].y & 0xffff0000u); o.w = (v[6].y >> 16) | (v[7].y & 0xffff0000u); }
    return o;
}
__device__ __forceinline__ float bfsel(const u32x2& v, int cc) { return cc == 0 ? bf_lo(v.x) : cc == 1 ? bf_hi(v.x) : cc == 2 ? bf_lo(v.y) : bf_hi(v.y); }

__device__ __forceinline__ void gemm_core2(f32x16 (&acc)[2][2], const u16* a0, const size_t a32, const u16* b0, const size_t b32, const int nk,
                                           unsigned char* smem, const int tid, const int lane, const int wr, const int wc) {
    typedef __attribute__((address_space(3))) unsigned lds_u32;
    const int r = lane & 31, hh = lane >> 5;
    {
        unsigned char* sa = smem + tid * 16;
#pragma unroll
        for (int i = 0; i < 4; ++i) {
            __builtin_amdgcn_global_load_lds((const unsigned*)(a0 + i * a32), (lds_u32*)(sa + i * 4096), 16, 0, 0);
            __builtin_amdgcn_global_load_lds((const unsigned*)(b0 + i * b32), (lds_u32*)(sa + 16384 + i * 4096), 16, 0, 0);
        }
    }
    for (int kt = 0; kt < nk; ++kt) {
        __syncthreads();
        if (kt + 1 < nk) {
            unsigned char* sa = smem + ((kt + 1) & 1) * 32768 + tid * 16;
            const u16* ap = a0 + (kt + 1) * 64; const u16* bp = b0 + (kt + 1) * 64;
#pragma unroll
            for (int i = 0; i < 4; ++i) {
                __builtin_amdgcn_global_load_lds((const unsigned*)(ap + i * a32), (lds_u32*)(sa + i * 4096), 16, 0, 0);
                __builtin_amdgcn_global_load_lds((const unsigned*)(bp + i * b32), (lds_u32*)(sa + 16384 + i * 4096), 16, 0, 0);
            }
        }
        const unsigned char* sa = smem + (kt & 1) * 32768; const unsigned char* sb = sa + 16384;
        __builtin_amdgcn_s_setprio(1);
#pragma unroll
        for (int kk = 0; kk < 4; ++kk) {
            bf16x8 a[2], b[2];
            const int ch = ((kk * 2 + hh) ^ ((r >> 1) & 7)) * 16;
#pragma unroll
            for (int mi = 0; mi < 2; ++mi) a[mi] = *(const bf16x8*)(sa + (wr * 64 + mi * 32 + r) * 128 + ch);
#pragma unroll
            for (int ni = 0; ni < 2; ++ni) b[ni] = *(const bf16x8*)(sb + (wc * 64 + ni * 32 + r) * 128 + ch);
#pragma unroll
            for (int mi = 0; mi < 2; ++mi)
#pragma unroll
                for (int ni = 0; ni < 2; ++ni) acc[mi][ni] = mfma32(b[ni], a[mi], acc[mi][ni]);
        }
        __builtin_amdgcn_s_setprio(0);
    }
}
#define RAW_BARRIER() do { asm volatile("s_waitcnt lgkmcnt(0)" ::: "memory"); __builtin_amdgcn_s_barrier(); } while (0)
__device__ __forceinline__ void gemm_core3(f32x16 (&acc)[2][4], const u16* a0, const size_t a64, const u16* b0, const size_t b64, const int nk,
                                           unsigned char* smem, const int tid, const int lane, const int wr, const int wc) {
    typedef __attribute__((address_space(3))) unsigned lds_u32;
    const int r = lane & 31, hh = lane >> 5;
#pragma unroll
    for (int s = 0; s < 2; ++s) {
        unsigned char* sa = smem + s * 24576 + tid * 16;
#pragma unroll
        for (int i = 0; i < 2; ++i) __builtin_amdgcn_global_load_lds((const unsigned*)(a0 + s * 32 + i * a64), (lds_u32*)(sa + i * 4096), 16, 0, 0);
#pragma unroll
        for (int i = 0; i < 4; ++i) __builtin_amdgcn_global_load_lds((const unsigned*)(b0 + s * 32 + i * b64), (lds_u32*)(sa + 8192 + i * 4096), 16, 0, 0);
    }
    int cur = 0;
    for (int kt = 0; kt < nk; ++kt) {
        if (kt + 1 < nk) asm volatile("s_waitcnt vmcnt(6)" ::: "memory"); else asm volatile("s_waitcnt vmcnt(0)" ::: "memory");
        RAW_BARRIER();
        if (kt + 2 < nk) {
            const int nx = cur == 0 ? 2 : cur - 1;
            unsigned char* sa = smem + nx * 24576 + tid * 16;
            const u16* ap = a0 + (kt + 2) * 32; const u16* bp = b0 + (kt + 2) * 32;
#pragma unroll
            for (int i = 0; i < 2; ++i) __builtin_amdgcn_global_load_lds((const unsigned*)(ap + i * a64), (lds_u32*)(sa + i * 4096), 16, 0, 0);
#pragma unroll
            for (int i = 0; i < 4; ++i) __builtin_amdgcn_global_load_lds((const unsigned*)(bp + i * b64), (lds_u32*)(sa + 8192 + i * 4096), 16, 0, 0);
        }
        const unsigned char* sa = smem + cur * 24576; const unsigned char* sb = sa + 8192;
        __builtin_amdgcn_s_setprio(1);
#pragma unroll
        for (int kk = 0; kk < 2; ++kk) {
            bf16x8 a[2], b[4];
            const int ch = ((kk * 2 + hh) ^ ((r >> 2) & 3)) * 16;
#pragma unroll
            for (int mi = 0; mi < 2; ++mi) a[mi] = *(const bf16x8*)(sa + (wr * 64 + mi * 32 + r) * 64 + ch);
#pragma unroll
            for (int ni = 0; ni < 4; ++ni) b[ni] = *(const bf16x8*)(sb + (wc * 128 + ni * 32 + r) * 64 + ch);
#pragma unroll
            for (int mi = 0; mi < 2; ++mi)
#pragma unroll
                for (int ni = 0; ni < 4; ++ni) acc[mi][ni] = mfma32(b[ni], a[mi], acc[mi][ni]);
        }
        __builtin_amdgcn_s_setprio(0);
        cur = cur == 2 ? 0 : cur + 1;
    }
}
constexpr int CT3_LD = 264;
__device__ __forceinline__ void ct_write3(u16* Ct, const f32x16 (&v)[2][4], const int wr, const int wc, const int lane) {
    const int r = lane & 31, hh = lane >> 5;
#pragma unroll
    for (int mi = 0; mi < 2; ++mi)
#pragma unroll
        for (int ni = 0; ni < 4; ++ni) {
            u16* base = Ct + (wr * 64 + mi * 32 + r) * CT3_LD + wc * 128 + ni * 32 + 4 * hh;
#pragma unroll
            for (int g = 0; g < 4; ++g) {
                u32x2 w; w.x = pk2(v[mi][ni][4 * g], v[mi][ni][4 * g + 1]); w.y = pk2(v[mi][ni][4 * g + 2], v[mi][ni][4 * g + 3]);
                *(u32x2*)(base + 8 * g) = w;
            }
        }
}
__device__ __forceinline__ bool sched_tile(const int i, const int ntm, const int ntn, const int W, int& mt, int& nt) {
    const int nx = gridDim.x >> 3;
    const int o = ((blockIdx.x & 7) + 8 * i) * nx + (blockIdx.x >> 3);
    if (o >= ntm * ntn) return false;
    const int full = ntn / W, fo = full * W * ntm;
    if (o < fo) { const int G = o / (W * ntm), rem = o - G * (W * ntm); mt = rem / W; nt = G * W + (rem - mt * W); }
    else { const int W2 = ntn - full * W, rem = o - fo; mt = rem / W2; nt = full * W + (rem - mt * W2); }
    return true;
}
__device__ __forceinline__ void conv_item(const float* W, const int ldw, const int k0, const int nreal0, u16* WT, const int K, const int nvirt0, float* T, const int tid) {
    const int kr = tid >> 4, c4 = tid & 15;
#pragma unroll
    for (int ps = 0; ps < 4; ++ps) {
        const int k = ps * 16 + kr;
        const f32x4 v = *(const f32x4*)(W + (size_t)(k0 + k) * ldw + nreal0 + c4 * 4);
        T[k * 65 + c4 * 4 + 0] = v.x; T[k * 65 + c4 * 4 + 1] = v.y; T[k * 65 + c4 * 4 + 2] = v.z; T[k * 65 + c4 * 4 + 3] = v.w;
    }
    __syncthreads();
    const int n = tid >> 2, kq = tid & 3;
    u32x4 o0, o1;
    const float* t = T + (kq * 16) * 65 + n;
    o0.x = pk2(t[0 * 65], t[1 * 65]); o0.y = pk2(t[2 * 65], t[3 * 65]); o0.z = pk2(t[4 * 65], t[5 * 65]); o0.w = pk2(t[6 * 65], t[7 * 65]);
    o1.x = pk2(t[8 * 65], t[9 * 65]); o1.y = pk2(t[10 * 65], t[11 * 65]); o1.z = pk2(t[12 * 65], t[13 * 65]); o1.w = pk2(t[14 * 65], t[15 * 65]);
    u16* dst = WT + (size_t)(nvirt0 + n) * K + k0 + kq * 16;
    *(u32x4*)dst = o0; *(u32x4*)(dst + 8) = o1;
    __syncthreads();
}
#define ACC_COL(reg) (((reg) & 3) + 8 * ((reg) >> 2))
#define ACC_ROW(mi, reg) ((mi) * 32 + ((reg) & 3) + 8 * ((reg) >> 2))
constexpr int CT_LD = 136;
__device__ __forceinline__ void ct_write(u16* Ct, const f32x16 (&v)[2][2], const int wr, const int wc, const int lane) {
    const int r = lane & 31, hh = lane >> 5;
#pragma unroll
    for (int mi = 0; mi < 2; ++mi)
#pragma unroll
        for (int ni = 0; ni < 2; ++ni) {
            u16* base = Ct + (wr * 64 + mi * 32 + r) * CT_LD + wc * 64 + ni * 32 + 4 * hh;
#pragma unroll
            for (int g = 0; g < 4; ++g) {
                u32x2 w; w.x = pk2(v[mi][ni][4 * g], v[mi][ni][4 * g + 1]); w.y = pk2(v[mi][ni][4 * g + 2], v[mi][ni][4 * g + 3]);
                *(u32x2*)(base + 8 * g) = w;
            }
        }
}
__device__ __forceinline__ void ct_store(const u16* Ct, u16* dst, const size_t ldd, const int tid) {
#pragma unroll
    for (int i = 0; i < 8; ++i) {
        const int idx = tid + i * 256, row = idx >> 4, ch = idx & 15;
        *(u32x4*)(dst + (size_t)row * ldd + ch * 8) = *(const u32x4*)(Ct + row * CT_LD + ch * 8);
    }
}

__device__ __forceinline__ void phase_ada(const Params& p, unsigned char* smem) {
    const int tid = opaque_tid();
    float* red = (float*)smem;
    float* mp = (float*)(p.ws + OFF_MODP);
    for (int it = blockIdx.x; it < 192; it += gridDim.x) {
        const int cb = it % 24, ks = it / 24, cq = tid & 63, kq = tid >> 6;
        float a0[4] = {0, 0, 0, 0}, a1[4] = {0, 0, 0, 0}, a2[4] = {0, 0, 0, 0};
        for (int kk = 0; kk < 32; ++kk) {
            const int k = ks * 128 + kq * 32 + kk;
            const f32x4 w = *(const f32x4*)(p.w_ada + (size_t)k * 6144 + cb * 256 + cq * 4);
            float c0 = p.c[k], c1 = p.c[1024 + k], c2 = p.c_ctx[k];
            c0 *= sigmoid_(c0); c1 *= sigmoid_(c1); c2 *= sigmoid_(c2);
#pragma unroll
            for (int j = 0; j < 4; ++j) { a0[j] += c0 * w[j]; a1[j] += c1 * w[j]; a2[j] += c2 * w[j]; }
        }
#pragma unroll
        for (int j = 0; j < 4; ++j) { red[(kq * 3 + 0) * 256 + cq * 4 + j] = a0[j]; red[(kq * 3 + 1) * 256 + cq * 4 + j] = a1[j]; red[(kq * 3 + 2) * 256 + cq * 4 + j] = a2[j]; }
        __syncthreads();
#pragma unroll
        for (int v = 0; v < 3; ++v) {
            const float s = (red[(0 * 3 + v) * 256 + tid] + red[(1 * 3 + v) * 256 + tid]) + (red[(2 * 3 + v) * 256 + tid] + red[(3 * 3 + v) * 256 + tid]);
            mp[(ks * 3 + v) * 6144 + cb * 256 + tid] = s;
        }
        __syncthreads();
    }
    for (int it = blockIdx.x; it < 2400; it += gridDim.x) {
        if (it < 1696) {
            const int nb = it >> 4, kb = it & 15, nv = nb * 64;
            const int nr = nv < 3072 ? nv : (nv < 6656 ? nv + 16 : 3072 + (nv - 6656));
            conv_item(p.w_in, INC, kb * 64, nr, (u16*)(p.ws + OFF_WINT), 1024, nv, red, tid);
        } else if (it < 1952) { const int q = it - 1696; conv_item(p.w_br_m, 1024, (q & 15) * 64, (q >> 4) * 64, (u16*)(p.ws + OFF_BRMT), 1024, (q >> 4) * 64, red, tid); }
        else if (it < 2080) { const int q = it - 1952; conv_item(p.w_br_na, 1024, (q & 7) * 64, (q >> 3) * 64, (u16*)(p.ws + OFF_BRNT), 512, (q >> 3) * 64, red, tid); }
        else if (it < 2336) { const int q = it - 2080; conv_item(p.w_out, 1024, (q & 15) * 64, (q >> 4) * 64, (u16*)(p.ws + OFF_OUTT), 1024, (q >> 4) * 64, red, tid); }
        else { const int q = it - 2336; conv_item(p.w_router, 256, (q & 15) * 64, (q >> 4) * 64, (u16*)(p.ws + OFF_RTT), 1024, (q >> 4) * 64, red, tid); }
    }
}

__device__ __forceinline__ void phase_norm(const Params& p, unsigned char* smem, const bool second) {
    const int tid = opaque_tid(), lane = tid & 63, wid = tid >> 6;
    float* tsh = (float*)smem; float* tsc = tsh + 1024;
    u16* H = (u16*)(p.ws + OFF_H);
    const int nrows = second ? NTOK : MTOT;
    const int rpb = (nrows + gridDim.x - 1) / gridDim.x;
    const int r0 = blockIdx.x * rpb, r1 = min(r0 + rpb, nrows);
    const int sh_off = second ? 3072 : 0, sc_off = second ? 4096 : 1024;
    for (int vec = 0; vec < 3; ++vec) {
        const int vlo = vec == 0 ? 0 : (vec == 1 ? TSEQ : NTOK), vhi = vec == 0 ? TSEQ : (vec == 1 ? NTOK : MTOT);
        const int lo = max(r0, vlo), hi = min(r1, vhi);
        if (lo >= hi) continue;
        for (int j = tid; j < 1024; j += 256) { tsh[j] = mod_val(p, vec, sh_off + j); tsc[j] = 1.f + mod_val(p, vec, sc_off + j); }
        __syncthreads();
        for (int row = lo + wid; row < hi; row += 4) {
            const float* src = second ? (p.out + (size_t)row * 1024) : (row < NTOK ? p.x + (size_t)row * 1024 : p.ctx + (size_t)(row - NTOK) * 1024);
            f32x4 v[4]; float ss = 0.f;
#pragma unroll
            for (int j = 0; j < 4; ++j) { v[j] = *(const f32x4*)(src + j * 256 + lane * 4); ss += (v[j].x * v[j].x + v[j].y * v[j].y) + (v[j].z * v[j].z + v[j].w * v[j].w); }
            ss = wave_sum(ss);
            const float rstd = rsqrtf(ss * (1.f / 1024.f) + 1e-6f);
#pragma unroll
            for (int j = 0; j < 4; ++j) {
                const int k = j * 256 + lane * 4;
                const f32x4 sc = *(const f32x4*)(tsc + k), sh = *(const f32x4*)(tsh + k);
                u32x2 o; o.x = pk2(v[j].x * rstd * sc.x + sh.x, v[j].y * rstd * sc.y + sh.y); o.y = pk2(v[j].z * rstd * sc.z + sh.z, v[j].w * rstd * sc.w + sh.w);
                *(u32x2*)(H + (size_t)row * 1024 + k) = o;
            }
        }
        __syncthreads();
    }
}

__device__ __forceinline__ void phase_inproj(const Params& p, unsigned char* smem) {
    const u16* H = (const u16*)(p.ws + OFF_H);
    u16* P = (u16*)(p.ws + OFF_P); float* G = (float*)(p.ws + OFF_G);
    const int tid = opaque_tid(), lane = tid & 63, wid = tid >> 6, wr = wid >> 1, wc = wid & 1;
    const int r = lane & 31, hh = lane >> 5;
    const u16* WT = (const u16*)(p.ws + OFF_WINT);
    const int sw = ((tid & 7) ^ ((tid >> 4) & 7)) * 8;
    for (int ti = 0;; ++ti) {
        int mt, nt;
        if (!sched_tile(ti, 260, 53, 8, mt, nt)) break;
        f32x16 acc[2][2] = {};
        gemm_core2(acc, H + (size_t)(mt * 128 + (tid >> 3)) * 1024 + sw, 32 * 1024, WT + (size_t)(nt * 128 + (tid >> 3)) * 1024 + sw, 32 * 1024, 16, smem, tid, lane, wr, wc);
        if (nt < 8) {
            const float scale = nt < 4 ? 0.08838834764831845f : 1.f;
            const bool latent = mt < 256;
#pragma unroll
            for (int mi = 0; mi < 2; ++mi) {
                const int t = (mt * 128 + wr * 64 + mi * 32 + r) & (TSEQ - 1);
                const float posr = (float)(wc == 0 ? (t >> 6) : (t & 63)) * 0.15915494309189535f;
#pragma unroll
                for (int reg = 0; reg < 16; ++reg) {
                    float x1 = acc[mi][0][reg] * scale, x2 = acc[mi][1][reg] * scale;
                    if (latent) {
                        const float inv = exp2f(-(float)(ACC_COL(reg) + 4 * hh) * (13.287712379549449f / 32.f));
                        float sn, cs; sincos_rev(posr * inv, sn, cs);
                        float a = x1 * cs; asm volatile("" : "+v"(a), "+v"(x1), "+v"(x2));
                        float o1 = fmaf(-x2, sn, a); asm volatile("" : "+v"(o1), "+v"(x1), "+v"(x2));
                        float bq = x1 * sn; asm volatile("" : "+v"(bq), "+v"(x2));
                        float o2 = fmaf(x2, cs, bq); asm volatile("" : "+v"(o2));
                        x1 = o1; x2 = o2;
                    }
                    acc[mi][0][reg] = x1; acc[mi][1][reg] = x2;
                }
            }
        } else if (nt >= 24 && nt < 32) {
            const float* nw = nt < 28 ? p.na_qn_w : p.na_kn_w;
            const float sc = nt < 28 ? 0.125f : 1.f;
#pragma unroll
            for (int mi = 0; mi < 2; ++mi) {
                float s = 0.f;
#pragma unroll
                for (int ni = 0; ni < 2; ++ni)
#pragma unroll
                    for (int reg = 0; reg < 16; ++reg) s += acc[mi][ni][reg] * acc[mi][ni][reg];
                s += __shfl_xor(s, 32);
                const float rstd = rsqrtf(s * (1.f / 64.f) + 1e-6f) * sc;
#pragma unroll
                for (int ni = 0; ni < 2; ++ni)
#pragma unroll
                    for (int reg = 0; reg < 16; ++reg) acc[mi][ni][reg] *= rstd * nw[ni * 32 + ACC_COL(reg) + 4 * hh];
            }
        } else if (nt >= 36 && nt < 52) {
#pragma unroll
            for (int mi = 0; mi < 2; ++mi)
#pragma unroll
                for (int ni = 0; ni < 2; ++ni)
#pragma unroll
                    for (int reg = 0; reg < 16; ++reg) acc[mi][ni][reg] = sigmoid_(acc[mi][ni][reg]);
        }
        if (nt == 52) {
            if (wc == 0) {
                const f32x4 b0 = *(const f32x4*)(p.b_mgate + 4 * hh), b1 = *(const f32x4*)(p.b_mgate + 8 + 4 * hh);
#pragma unroll
                for (int mi = 0; mi < 2; ++mi) {
                    float* g = G + (size_t)(mt * 128 + wr * 64 + mi * 32 + r) * 16 + 4 * hh;
                    f32x4 o0, o1;
                    o0.x = acc[mi][0][0] + b0.x; o0.y = acc[mi][0][1] + b0.y; o0.z = acc[mi][0][2] + b0.z; o0.w = acc[mi][0][3] + b0.w;
                    o1.x = acc[mi][0][4] + b1.x; o1.y = acc[mi][0][5] + b1.y; o1.z = acc[mi][0][6] + b1.z; o1.w = acc[mi][0][7] + b1.w;
                    *(f32x4*)g = o0; *(f32x4*)(g + 8) = o1;
                }
            }
        } else {
            u16* Ct = (u16*)smem;
            __syncthreads();
            ct_write(Ct, acc, wr, wc, lane);
            __syncthreads();
            ct_store(Ct, P + (size_t)(mt * 128) * PV + nt * 128, PV, tid);
        }
        __syncthreads();
    }
}

__device__ __forceinline__ void mlstm_passA(const Params& p, unsigned char* smem, const int it) {
    const int tid = opaque_tid(), lane = tid & 63, wid = tid >> 6;
    const int c = it % 260, bh = it / 260, b = bh >> 2, h = bh & 3;
    const int base = c < 4 ? NTOK + b * 256 + c * 64 : b * TSEQ + (c - 4) * 64;
    const u16* P = (const u16*)(p.ws + OFF_P); const float* G = (const float*)(p.ws + OFF_G);
    float* gsum = (float*)(p.ws + OFF_GS); float* mloc = (float*)(p.ws + OFF_ML); float* dn = (float*)(p.ws + OFF_DN);
    u16* CT = (u16*)(p.ws + OFF_CT);
    u16* KTf = (u16*)smem; u16* KTb = (u16*)(smem + 18432); u16* VT = (u16*)(smem + 36864);
    float* wf = (float*)(smem + 73728); float* wb = wf + 64;
    const int slot_f = bh * 2 * 260 + c, slot_b = slot_f + 260;
    if (wid == 0) {
        const float* g = G + (size_t)(base + lane) * 16;
        const float igf = g[h], ff = g[4 + h], igb = g[8 + h], fb = g[12 + h];
        const float lff = log_sigmoid_(ff), lfb = log_sigmoid_(fb);
        const float bfc = wave_incl_sum(lff, lane), gf = __shfl(bfc, 63);
        const float uf = igf - bfc, umf = wave_max(uf);
        wf[lane] = __expf(uf - umf);
        const float pb = wave_incl_sum(lfb, lane), gb = __shfl(pb, 63);
        const float bb = gb - pb + lfb, ub = igb - bb, umb = wave_max(ub);
        wb[lane] = __expf(ub - umb);
        if (lane == 0) { gsum[slot_f] = gf; mloc[slot_f] = gf + umf; gsum[slot_b] = gb; mloc[slot_b] = gb + umb; }
    }
    __syncthreads();
    const int cgp = tid >> 3, tg = tid & 7;
    {
        const u16* src = P + (size_t)(base + tg * 8) * PV + V_MK + h * 128 + cgp * 4;
        u32x2 kv[8];
#pragma unroll
        for (int i = 0; i < 8; ++i) kv[i] = *(const u32x2*)(src + (size_t)i * PV);
        float wfi[8], wbi[8];
#pragma unroll
        for (int i = 0; i < 8; ++i) { wfi[i] = wf[tg * 8 + i]; wbi[i] = wb[tg * 8 + i]; }
#pragma unroll
        for (int cc = 0; cc < 4; ++cc) {
            float e[8];
#pragma unroll
            for (int i = 0; i < 8; ++i) e[i] = bfsel(kv[i], cc);
            u32x4 of, ob;
            of.x = pk2(e[0] * wfi[0], e[1] * wfi[1]); of.y = pk2(e[2] * wfi[2], e[3] * wfi[3]); of.z = pk2(e[4] * wfi[4], e[5] * wfi[5]); of.w = pk2(e[6] * wfi[6], e[7] * wfi[7]);
            ob.x = pk2(e[0] * wbi[0], e[1] * wbi[1]); ob.y = pk2(e[2] * wbi[2], e[3] * wbi[3]); ob.z = pk2(e[4] * wbi[4], e[5] * wbi[5]); ob.w = pk2(e[6] * wbi[6], e[7] * wbi[7]);
            *(u32x4*)(KTf + (cgp * 4 + cc) * LDT + tg * 8) = of;
            *(u32x4*)(KTb + (cgp * 4 + cc) * LDT + tg * 8) = ob;
        }
    }
#pragma unroll
    for (int vp = 0; vp < 2; ++vp) {
        const u16* src = P + (size_t)(base + tg * 8) * PV + V_MV + h * 256 + vp * 128 + cgp * 4;
        u32x2 vv[8];
#pragma unroll
        for (int i = 0; i < 8; ++i) vv[i] = *(const u32x2*)(src + (size_t)i * PV);
#pragma unroll
        for (int cc = 0; cc < 4; ++cc) *(u32x4*)(VT + (vp * 128 + cgp * 4 + cc) * LDT + tg * 8) = tr8(vv, cc);
    }
    __syncthreads();
    if (tid < 128) {
        float sf = 0.f, sb = 0.f;
#pragma unroll
        for (int j = 0; j < 8; ++j) {
            const u32x4 a = *(const u32x4*)(KTf + tid * LDT + j * 8), bq = *(const u32x4*)(KTb + tid * LDT + j * 8);
            sf += (bf_lo(a.x) + bf_hi(a.x)) + (bf_lo(a.y) + bf_hi(a.y)) + (bf_lo(a.z) + bf_hi(a.z)) + (bf_lo(a.w) + bf_hi(a.w));
            sb += (bf_lo(bq.x) + bf_hi(bq.x)) + (bf_lo(bq.y) + bf_hi(bq.y)) + (bf_lo(bq.z) + bf_hi(bq.z)) + (bf_lo(bq.w) + bf_hi(bq.w));
        }
        dn[(size_t)slot_f * 128 + tid] = sf; dn[(size_t)slot_b * 128 + tid] = sb;
    }
    const int r = lane & 31, hh = lane >> 5;
#pragma unroll 1
    for (int dir = 0; dir < 2; ++dir) {
        const u16* Bt = dir ? KTb : KTf;
        u16* dst = CT + (size_t)(dir ? slot_b : slot_f) * 32768;
#pragma unroll 1
        for (int nh = 0; nh < 2; ++nh) {
            f32x16 acc[2][2] = {};
#pragma unroll
            for (int kk = 0; kk < 4; ++kk) {
                bf16x8 a[2], bq[2];
#pragma unroll
                for (int mi = 0; mi < 2; ++mi) a[mi] = *(const bf16x8*)(VT + (wid * 64 + mi * 32 + r) * LDT + kk * 16 + hh * 8);
#pragma unroll
                for (int ni = 0; ni < 2; ++ni) bq[ni] = *(const bf16x8*)(Bt + (nh * 64 + ni * 32 + r) * LDT + kk * 16 + hh * 8);
#pragma unroll
                for (int mi = 0; mi < 2; ++mi)
#pragma unroll
                    for (int ni = 0; ni < 2; ++ni) acc[mi][ni] = mfma32(bq[ni], a[mi], acc[mi][ni]);
            }
#pragma unroll
            for (int mi = 0; mi < 2; ++mi)
#pragma unroll
                for (int ni = 0; ni < 2; ++ni) {
                    u16* drow = dst + (wid * 64 + mi * 32 + r) * 128 + nh * 64 + ni * 32 + 4 * hh;
#pragma unroll
                    for (int g = 0; g < 4; ++g) {
                        u32x2 w; w.x = pk2(acc[mi][ni][4 * g], acc[mi][ni][4 * g + 1]); w.y = pk2(acc[mi][ni][4 * g + 2], acc[mi][ni][4 * g + 3]);
                        *(u32x2*)(drow + 8 * g) = w;
                    }
                }
        }
    }
    __syncthreads();
}

template <int NT, bool WIN>
__device__ __forceinline__ void na_block(const u16* Ks, const u16* VTs, const bf16x8 qa0, const bf16x8 qa1, const float* rpb  ,
                                         const int cs, const int k0, const int l15, const int l4, f32x4 (&O)[4], float& mrun, float& lrun) {
    f32x4 S[NT];
#pragma unroll
    for (int t = 0; t < NT; ++t) {
        S[t] = (f32x4){0.f, 0.f, 0.f, 0.f};
        const bf16x8 kf0 = *(const bf16x8*)(Ks + (k0 + t * 16 + l15) * LDT + l4 * 8), kf1 = *(const bf16x8*)(Ks + (k0 + t * 16 + l15) * LDT + 32 + l4 * 8);
        S[t] = mfma16(kf0, qa0, S[t]); S[t] = mfma16(kf1, qa1, S[t]);
    }
    if (WIN) {
#pragma unroll
        for (int t = 0; t < NT; ++t)
#pragma unroll
            for (int reg = 0; reg < 4; ++reg) {
                const int kc = k0 + t * 16 + l4 * 4 + reg;
                const bool valid = kc >= cs && kc < cs + 16;
                float bias = 0.f;
                if (valid) bias = rpb[kc];
                S[t][reg] = valid ? S[t][reg] + bias : -INFINITY;
            }
    }
    float mx = -INFINITY;
#pragma unroll
    for (int t = 0; t < NT; ++t) mx = fmaxf(mx, fmaxf(fmaxf(S[t][0], S[t][1]), fmaxf(S[t][2], S[t][3])));
    mx = fmaxf(mx, __shfl_xor(mx, 16)); mx = fmaxf(mx, __shfl_xor(mx, 32));
    const float mnew = fmaxf(mrun, mx);
    const float alpha = __expf(mrun - mnew);
    float ps = 0.f;
#pragma unroll
    for (int t = 0; t < NT; ++t)
#pragma unroll
        for (int reg = 0; reg < 4; ++reg) { const float pe = __expf(S[t][reg] - mnew); S[t][reg] = pe; ps += pe; }
    ps += __shfl_xor(ps, 16); ps += __shfl_xor(ps, 32);
    lrun = lrun * alpha + ps; mrun = mnew;
#pragma unroll
    for (int t = 0; t < 4; ++t) { O[t][0] *= alpha; O[t][1] *= alpha; O[t][2] *= alpha; O[t][3] *= alpha; }
#pragma unroll
    for (int s = 0; s < NT / 2; ++s) {
        u32x4 pb; pb.x = pk2(S[2 * s][0], S[2 * s][1]); pb.y = pk2(S[2 * s][2], S[2 * s][3]); pb.z = pk2(S[2 * s + 1][0], S[2 * s + 1][1]); pb.w = pk2(S[2 * s + 1][2], S[2 * s + 1][3]);
        const bf16x8 pfrag = __builtin_bit_cast(bf16x8, pb);
#pragma unroll
        for (int t = 0; t < 4; ++t) {
            const u16* vrow = VTs + (t * 16 + l15) * LDT + k0 + s * 32 + l4 * 4;
            const u32x2 v0 = *(const u32x2*)vrow, v1 = *(const u32x2*)(vrow + 16);
            u32x4 va; va.x = v0.x; va.y = v0.y; va.z = v1.x; va.w = v1.y;
            O[t] = mfma16(__builtin_bit_cast(bf16x8, va), pfrag, O[t]);
        }
    }
}
__device__ __forceinline__ void na_item(const Params& p, unsigned char* smem, const int it) {
    const int tid = opaque_tid(), lane = tid & 63, wid = tid >> 6;
    const int row = it & 255, h = (it >> 8) & 7, b = it >> 11;
    const u16* P = (const u16*)(p.ws + OFF_P);
    u16* YNA = (u16*)(p.ws + OFF_YNA);
    float* rpb_s = (float*)(smem + 36864);
    const int l15 = lane & 15, l4 = lane >> 4;
    const int qc = wid * 16 + l15;
    const size_t qtok = (size_t)b * TSEQ + row * 64 + qc;
    const u16* qsrc = P + qtok * PV + V_NQ + h * 64 + l4 * 8;
    const bf16x8 qa0 = *(const bf16x8*)qsrc, qa1 = *(const bf16x8*)(qsrc + 32);
    const int rs = min(max(row - 4, 0), 248);
    const int cs = min(max(qc - 8, 0), 48);
    const int kst = min(max((qc & ~15) - 8, 0), 32);
    for (int j = tid; j < 465; j += 256) rpb_s[j] = p.na_rpb[h * 465 + j];
    f32x4 O[4] = {};
    float mrun = -INFINITY, lrun = 0.f;
    u32x4 kreg[2]; u32x2 vreg[8];
    const int cgp = (tid >> 3) & 15, tg = tid & 7;
    {
        const int kbase = b * TSEQ + rs * 64;
#pragma unroll
        for (int i = 0; i < 2; ++i) { const int id = tid + i * 256; kreg[i] = *(const u32x4*)(P + (size_t)(kbase + (id >> 3)) * PV + V_NK + h * 64 + (id & 7) * 8); }
        const u16* src = P + (size_t)(kbase + tg * 8) * PV + V_NV + h * 64 + cgp * 4;
#pragma unroll
        for (int i = 0; i < 8; ++i) vreg[i] = *(const u32x2*)(src + (size_t)i * PV);
    }
    for (int blk = 0; blk < 12; ++blk) {
        u16* Ks = (u16*)(smem + (blk & 1) * 18432); u16* VTs = Ks + 4608;
#pragma unroll
        for (int i = 0; i < 2; ++i) { const int id = tid + i * 256; *(u32x4*)(Ks + (id >> 3) * LDT + (id & 7) * 8) = kreg[i]; }
        if (tid < 128) {
#pragma unroll
            for (int cc = 0; cc < 4; ++cc) *(u32x4*)(VTs + (cgp * 4 + cc) * LDT + tg * 8) = tr8(vreg, cc);
        }
        __syncthreads();
        if (blk + 1 < 12) {
            const int nb = blk + 1;
            const int kbase = nb < 8 ? b * TSEQ + (rs + nb) * 64 : NTOK + b * 256 + (nb - 8) * 64;
#pragma unroll
            for (int i = 0; i < 2; ++i) { const int id = tid + i * 256; kreg[i] = *(const u32x4*)(P + (size_t)(kbase + (id >> 3)) * PV + V_NK + h * 64 + (id & 7) * 8); }
            const u16* src = P + (size_t)(kbase + tg * 8) * PV + V_NV + h * 64 + cgp * 4;
#pragma unroll
            for (int i = 0; i < 8; ++i) vreg[i] = *(const u32x2*)(src + (size_t)i * PV);
        }
        if (blk < 8) na_block<2, true>(Ks, VTs, qa0, qa1, rpb_s + (rs + blk - row + 7) * 31 + 15 - qc, cs, kst, l15, l4, O, mrun, lrun);
        else         na_block<4, false>(Ks, VTs, qa0, qa1, rpb_s, cs, 0, l15, l4, O, mrun, lrun);
    }
    {
        const float il = 1.f / lrun;
#pragma unroll
        for (int t = 0; t < 4; ++t) {
            u32x2 w; w.x = pk2(O[t][0] * il, O[t][1] * il); w.y = pk2(O[t][2] * il, O[t][3] * il);
            *(u32x2*)(YNA + qtok * 512 + h * 64 + t * 16 + l4 * 4) = w;
        }
    }
    __syncthreads();
}

__device__ __forceinline__ int scan_cidx(int i, int dir) { return dir == 0 ? i : (i < 4 ? 3 - i : 263 - i); }
__device__ __forceinline__ void phase_scan(const Params& p, unsigned char* smem) {
    const int tid = opaque_tid(), lane = tid & 63, wid = tid >> 6;
    float* al = (float*)smem; float* be = al + 260;
    const float* gsum = (const float*)(p.ws + OFF_GS); const float* mloc = (const float*)(p.ws + OFF_ML);
    float* mprev = (float*)(p.ws + OFF_MP); float* dn = (float*)(p.ws + OFF_DN);
    for (int it = blockIdx.x; it < 512; it += gridDim.x) {
        const int bhd = it >> 5, eb = it & 31, dir = bhd & 1, slot0 = bhd * 260;
        if (wid == 0) {
            float g[5], ml[5]; int cc[5];
            float a = 0.f, b = -INFINITY;
#pragma unroll
            for (int j = 0; j < 5; ++j) {
                const int i = lane * 5 + j; const bool ok = i < 260;
                cc[j] = ok ? scan_cidx(i, dir) : 0;
                g[j] = ok ? gsum[slot0 + cc[j]] : 0.f; ml[j] = ok ? mloc[slot0 + cc[j]] : -INFINITY;
                b = fmaxf(b + g[j], ml[j]); a += g[j];
            }
#pragma unroll
            for (int o = 1; o < 64; o <<= 1) {
                const float pa = __shfl_up(a, o), pb = __shfl_up(b, o);
                if (lane >= o) { b = fmaxf(pb + a, b); a = pa + a; }
            }
            float ea = __shfl_up(a, 1), eb2 = __shfl_up(b, 1);
            if (lane == 0) { ea = 0.f; eb2 = -INFINITY; }
            float m = fmaxf(0.f + ea, eb2);
#pragma unroll
            for (int j = 0; j < 5; ++j) {
                const int i = lane * 5 + j;
                if (i < 260) {
                    const float mn = fmaxf(g[j] + m, ml[j]);
                    al[i] = __expf(g[j] + m - mn); be[i] = __expf(ml[j] - mn);
                    if (eb == 0) mprev[slot0 + cc[j]] = m;
                    m = mn;
                }
            }
        }
        __syncthreads();
        u32x2* basep = (u32x2*)(p.ws + OFF_CT) + (size_t)slot0 * 8192 + eb * 256 + tid;
        float C0 = 0.f, C1 = 0.f, C2 = 0.f, C3 = 0.f;
        for (int i = 0; i < 260; i += 13) {
            u32x2 v[13];
#pragma unroll
            for (int j = 0; j < 13; ++j) v[j] = basep[(size_t)scan_cidx(i + j, dir) * 8192];
#pragma unroll
            for (int j = 0; j < 13; ++j) {
                u32x2 o; o.x = pk2(C0, C1); o.y = pk2(C2, C3);
                basep[(size_t)scan_cidx(i + j, dir) * 8192] = o;
                const float a = al[i + j], bt = be[i + j];
                C0 = fmaf(a, C0, bt * bf_lo(v[j].x)); C1 = fmaf(a, C1, bt * bf_hi(v[j].x)); C2 = fmaf(a, C2, bt * bf_lo(v[j].y)); C3 = fmaf(a, C3, bt * bf_hi(v[j].y));
            }
        }
        if (eb == 0 && tid < 128) {
            float n = 0.f;
            for (int i = 0; i < 260; ++i) {
                float* q = dn + (size_t)(slot0 + scan_cidx(i, dir)) * 128 + tid;
                const float v = *q; *q = n; n = al[i] * n + be[i] * v;
            }
        }
        __syncthreads();
    }
}

__device__ __forceinline__ void mlstm_passC(const Params& p, unsigned char* smem, const int it) {
    const int tid = opaque_tid(), lane = tid & 63, wid = tid >> 6;
    const int cl = it & 255, bh = it >> 8, b = bh >> 2, h = bh & 3, c = cl + 4;
    const int base = b * TSEQ + cl * 64;
    const int slot_f = bh * 2 * 260 + c, slot_b = slot_f + 260;
    const u16* P = (const u16*)(p.ws + OFF_P); const float* G = (const float*)(p.ws + OFF_G);
    const float* mprev = (const float*)(p.ws + OFF_MP); const float* dn = (const float*)(p.ws + OFF_DN);
    const u16* CT = (const u16*)(p.ws + OFF_CT);
    u16* YM = (u16*)(p.ws + OFF_YM);
    u16* Ks = (u16*)smem;
    u16* CTf = (u16*)smem; u16* CTb = (u16*)(smem + 17408);
    u16* VTs = (u16*)(smem + 34816);
    float* ga = (float*)(smem + 44032);
    float *uf_s = ga, *Mf_s = ga + 64, *ub_s = ga + 128, *Mb_s = ga + 192, *clf = ga + 256, *clb = ga + 320, *wif = ga + 384, *wib = ga + 448;
    const int l15 = lane & 15, l4 = lane >> 4;
    if (wid == 0) {
        const float* g = G + (size_t)(base + lane) * 16;
        const float igf = g[h], ff = g[4 + h], igb = g[8 + h], fb = g[12 + h];
        const float lff = log_sigmoid_(ff), lfb = log_sigmoid_(fb);
        const float bfc = wave_incl_sum(lff, lane);
        const float uf = igf - bfc;
        const float pb = wave_incl_sum(lfb, lane), gb = __shfl(pb, 63);
        const float bb = gb - pb + lfb, ub = igb - bb;
        const float mpf = mprev[slot_f], mpb = mprev[slot_b];
        const float Mf = fmaxf(mpf, wave_prefix_max(uf, lane)), Mb = fmaxf(mpb, wave_suffix_max(ub, lane));
        uf_s[lane] = uf; Mf_s[lane] = Mf; clf[lane] = __expf(-(bfc + Mf)); wif[lane] = __expf(mpf - Mf);
        ub_s[lane] = ub; Mb_s[lane] = Mb; clb[lane] = __expf(-(bb + Mb)); wib[lane] = __expf(mpb - Mb);
    }
    const int t = wid * 16 + l15;
    const size_t tok = (size_t)base + t;
    bf16x8 qa[4];
    {
        const u16* qsrc = P + tok * PV + V_MQ + h * 128 + l4 * 8;
#pragma unroll
        for (int kk = 0; kk < 4; ++kk) qa[kk] = *(const bf16x8*)(qsrc + kk * 32);
    }
#pragma unroll
    for (int i = 0; i < 4; ++i) {
        const int id = tid + i * 256, kr = id >> 4, ch = id & 15;
        *(u32x4*)(Ks + kr * LDQ + ch * 8) = *(const u32x4*)(P + (size_t)(base + kr) * PV + V_MK + h * 128 + ch * 8);
    }
    __syncthreads();
    f32x4 S[4] = {};
#pragma unroll
    for (int st = 0; st < 4; ++st)
#pragma unroll
        for (int kk = 0; kk < 4; ++kk) {
            const bf16x8 kf = *(const bf16x8*)(Ks + (st * 16 + l15) * LDQ + kk * 32 + l4 * 8);
            S[st] = mfma16(kf, qa[kk], S[st]);
        }
    float qnf = 0.f, qnb = 0.f;
    {
        const float* nf = dn + (size_t)slot_f * 128; const float* nb = dn + (size_t)slot_b * 128;
#pragma unroll
        for (int kk = 0; kk < 4; ++kk)
#pragma unroll
            for (int j = 0; j < 8; ++j) {
                const int d = kk * 32 + l4 * 8 + j;
                const float qv = bf2f((u16)qa[kk][j]);
                qnf += qv * nf[d]; qnb += qv * nb[d];
            }
        qnf += __shfl_xor(qnf, 16); qnf += __shfl_xor(qnf, 32);
        qnb += __shfl_xor(qnb, 16); qnb += __shfl_xor(qnb, 32);
    }
    const float Mft = Mf_s[t], Mbt = Mb_s[t];
    float rsf = 0.f, rsb = 0.f;
    f32x4 PF[4], PB[4];
#pragma unroll
    for (int st = 0; st < 4; ++st) {
        const f32x4 uf4 = *(const f32x4*)(uf_s + st * 16 + l4 * 4), ub4 = *(const f32x4*)(ub_s + st * 16 + l4 * 4);
#pragma unroll
        for (int reg = 0; reg < 4; ++reg) {
            const int s = st * 16 + l4 * 4 + reg;
            const float sv = S[st][reg];
            const float pf = (s <= t) ? sv * __expf(uf4[reg] - Mft) : 0.f;
            const float pbv = (s >= t) ? sv * __expf(ub4[reg] - Mbt) : 0.f;
            rsf += pf; rsb += pbv; PF[st][reg] = pf; PB[st][reg] = pbv;
        }
    }
    rsf += __shfl_xor(rsf, 16); rsf += __shfl_xor(rsf, 32);
    rsb += __shfl_xor(rsb, 16); rsb += __shfl_xor(rsb, 32);
    const float wft = wif[t], wbt = wib[t];
    const float idf = 1.f / fmaxf(fabsf(rsf + wft * qnf), clf[t]), idb = 1.f / fmaxf(fabsf(rsb + wbt * qnb), clb[t]);
    bf16x8 pfr[2], qwf[4], qwb[4];
#pragma unroll
    for (int ss = 0; ss < 2; ++ss) {
        u32x4 pw;
        pw.x = pk2(PF[2 * ss][0] * idf + PB[2 * ss][0] * idb, PF[2 * ss][1] * idf + PB[2 * ss][1] * idb);
        pw.y = pk2(PF[2 * ss][2] * idf + PB[2 * ss][2] * idb, PF[2 * ss][3] * idf + PB[2 * ss][3] * idb);
        pw.z = pk2(PF[2 * ss + 1][0] * idf + PB[2 * ss + 1][0] * idb, PF[2 * ss + 1][1] * idf + PB[2 * ss + 1][1] * idb);
        pw.w = pk2(PF[2 * ss + 1][2] * idf + PB[2 * ss + 1][2] * idb, PF[2 * ss + 1][3] * idf + PB[2 * ss + 1][3] * idb);
        pfr[ss] = __builtin_bit_cast(bf16x8, pw);
    }
    {
        const float sf = wft * idf, sb = wbt * idb;
#pragma unroll
        for (int kk = 0; kk < 4; ++kk) {
            u32x4 of, ob;
            const float q0 = bf2f((u16)qa[kk][0]), q1 = bf2f((u16)qa[kk][1]), q2 = bf2f((u16)qa[kk][2]), q3 = bf2f((u16)qa[kk][3]);
            const float q4 = bf2f((u16)qa[kk][4]), q5 = bf2f((u16)qa[kk][5]), q6 = bf2f((u16)qa[kk][6]), q7 = bf2f((u16)qa[kk][7]);
            of.x = pk2(q0 * sf, q1 * sf); of.y = pk2(q2 * sf, q3 * sf); of.z = pk2(q4 * sf, q5 * sf); of.w = pk2(q6 * sf, q7 * sf);
            ob.x = pk2(q0 * sb, q1 * sb); ob.y = pk2(q2 * sb, q3 * sb); ob.z = pk2(q4 * sb, q5 * sb); ob.w = pk2(q6 * sb, q7 * sb);
            qwf[kk] = __builtin_bit_cast(bf16x8, of); qwb[kk] = __builtin_bit_cast(bf16x8, ob);
        }
    }
    __syncthreads();
    f32x4 hm[4][4];
#pragma unroll
    for (int vb = 0; vb < 4; ++vb) {
        if (tid < 128) {
            const int cgp = tid >> 3, tg = tid & 7;
            const u16* src = P + (size_t)(base + tg * 8) * PV + V_MV + h * 256 + vb * 64 + cgp * 4;
            u32x2 vv[8];
#pragma unroll
            for (int i = 0; i < 8; ++i) vv[i] = *(const u32x2*)(src + (size_t)i * PV);
#pragma unroll
            for (int cc = 0; cc < 4; ++cc) *(u32x4*)(VTs + (cgp * 4 + cc) * LDT + tg * 8) = tr8(vv, cc);
        }
#pragma unroll
        for (int i = 0; i < 4; ++i) {
            const int id = tid + i * 256, vr = id >> 4, ch = id & 15;
            *(u32x4*)(CTf + vr * LDQ + ch * 8) = *(const u32x4*)(CT + (size_t)slot_f * 32768 + (vb * 64 + vr) * 128 + ch * 8);
            *(u32x4*)(CTb + vr * LDQ + ch * 8) = *(const u32x4*)(CT + (size_t)slot_b * 32768 + (vb * 64 + vr) * 128 + ch * 8);
        }
        __syncthreads();
#pragma unroll
        for (int tv = 0; tv < 4; ++tv) {
            f32x4 a = {0.f, 0.f, 0.f, 0.f};
#pragma unroll
            for (int ss = 0; ss < 2; ++ss) {
                const u16* vrow = VTs + (tv * 16 + l15) * LDT + ss * 32 + l4 * 4;
                const u32x2 v0 = *(const u32x2*)vrow, v1 = *(const u32x2*)(vrow + 16);
                u32x4 va; va.x = v0.x; va.y = v0.y; va.z = v1.x; va.w = v1.y;
                a = mfma16(__builtin_bit_cast(bf16x8, va), pfr[ss], a);
            }
#pragma unroll
            for (int kk = 0; kk < 4; ++kk) {
                const bf16x8 cf = *(const bf16x8*)(CTf + (tv * 16 + l15) * LDQ + kk * 32 + l4 * 8);
                const bf16x8 cb = *(const bf16x8*)(CTb + (tv * 16 + l15) * LDQ + kk * 32 + l4 * 8);
                a = mfma16(cf, qwf[kk], a); a = mfma16(cb, qwb[kk], a);
            }
            hm[vb][tv] = a;
        }
        __syncthreads();
    }
    float ssq = 0.f;
#pragma unroll
    for (int vb = 0; vb < 4; ++vb)
#pragma unroll
        for (int tv = 0; tv < 4; ++tv) ssq += (hm[vb][tv][0] * hm[vb][tv][0] + hm[vb][tv][1] * hm[vb][tv][1]) + (hm[vb][tv][2] * hm[vb][tv][2] + hm[vb][tv][3] * hm[vb][tv][3]);
    ssq += __shfl_xor(ssq, 16); ssq += __shfl_xor(ssq, 32);
    const float rstd = rsqrtf(ssq * (1.f / 256.f) + 1e-6f);
#pragma unroll
    for (int vb = 0; vb < 4; ++vb)
#pragma unroll
        for (int tv = 0; tv < 4; ++tv) {
            const int v = h * 256 + vb * 64 + tv * 16 + l4 * 4;
            const u32x2 ov = *(const u32x2*)(P + tok * PV + V_MO + v);
            const f32x4 w = *(const f32x4*)(p.m_norm_w + v);
            u32x2 y;
            y.x = pk2(hm[vb][tv][0] * rstd * w.x * sigmoid_(bf_lo(ov.x)), hm[vb][tv][1] * rstd * w.y * sigmoid_(bf_hi(ov.x)));
            y.y = pk2(hm[vb][tv][2] * rstd * w.z * sigmoid_(bf_lo(ov.y)), hm[vb][tv][3] * rstd * w.w * sigmoid_(bf_hi(ov.y)));
            *(u32x2*)(YM + tok * 1024 + v) = y;
        }
}

__device__ __forceinline__ void phase_merge(const Params& p, unsigned char* smem) {
    const u16* P = (const u16*)(p.ws + OFF_P);
    const u16* YM = (const u16*)(p.ws + OFF_YM); const u16* YNA = (const u16*)(p.ws + OFF_YNA);
    u16* MRG = (u16*)(p.ws + OFF_MRG);
    const u16* wm = (const u16*)(p.ws + OFF_BRMT); const u16* wn = (const u16*)(p.ws + OFF_BRNT);
    const int tid = opaque_tid(), lane = tid & 63, wid = tid >> 6, wr = wid >> 1, wc = wid & 1;
    const int sw = ((tid & 7) ^ ((tid >> 4) & 7)) * 8;
    for (int ti = 0;; ++ti) {
        int mt, nt;
        if (!sched_tile(ti, 256, 8, 8, mt, nt)) break;
        f32x16 acc[2][2] = {};
        gemm_core2(acc, YM + (size_t)(mt * 128 + (tid >> 3)) * 1024 + sw, 32 * 1024, wm + (size_t)(nt * 128 + (tid >> 3)) * 1024 + sw, 32 * 1024, 16, smem, tid, lane, wr, wc);
        u32 part[2][2][8];
#pragma unroll
        for (int mi = 0; mi < 2; ++mi)
#pragma unroll
            for (int ni = 0; ni < 2; ++ni)
#pragma unroll
                for (int q = 0; q < 8; ++q) { part[mi][ni][q] = pk2(acc[mi][ni][2 * q], acc[mi][ni][2 * q + 1]); acc[mi][ni][2 * q] = 0.f; acc[mi][ni][2 * q + 1] = 0.f; }
        __syncthreads();
        gemm_core2(acc, YNA + (size_t)(mt * 128 + (tid >> 3)) * 512 + sw, 32 * 512, wn + (size_t)(nt * 128 + (tid >> 3)) * 512 + sw, 32 * 512, 8, smem, tid, lane, wr, wc);
        u16* C1 = (u16*)smem; u16* C2 = (u16*)(smem + 34816);
        __syncthreads();
        {
            const int r = lane & 31, hh = lane >> 5;
#pragma unroll
            for (int mi = 0; mi < 2; ++mi)
#pragma unroll
                for (int ni = 0; ni < 2; ++ni) {
                    u16* base = C1 + (wr * 64 + mi * 32 + r) * CT_LD + wc * 64 + ni * 32 + 4 * hh;
#pragma unroll
                    for (int g = 0; g < 4; ++g) { u32x2 w; w.x = part[mi][ni][2 * g]; w.y = part[mi][ni][2 * g + 1]; *(u32x2*)(base + 8 * g) = w; }
                }
        }
        ct_write(C2, acc, wr, wc, lane);
        __syncthreads();
#pragma unroll 2
        for (int i = 0; i < 8; ++i) {
            const int idx = tid + i * 256, row = idx >> 4, ch = idx & 15;
            const size_t m = (size_t)mt * 128 + row;
            const u32x4 c1 = *(const u32x4*)(C1 + row * CT_LD + ch * 8), c2 = *(const u32x4*)(C2 + row * CT_LD + ch * 8);
            const u32x4 g1 = *(const u32x4*)(P + m * PV + V_GM + nt * 128 + ch * 8), g2 = *(const u32x4*)(P + m * PV + V_GN + nt * 128 + ch * 8);
            u32x4 w;
            w.x = pk2(bf_lo(c1.x) * bf_lo(g1.x) + bf_lo(c2.x) * bf_lo(g2.x), bf_hi(c1.x) * bf_hi(g1.x) + bf_hi(c2.x) * bf_hi(g2.x));
            w.y = pk2(bf_lo(c1.y) * bf_lo(g1.y) + bf_lo(c2.y) * bf_lo(g2.y), bf_hi(c1.y) * bf_hi(g1.y) + bf_hi(c2.y) * bf_hi(g2.y));
            w.z = pk2(bf_lo(c1.z) * bf_lo(g1.z) + bf_lo(c2.z) * bf_lo(g2.z), bf_hi(c1.z) * bf_hi(g1.z) + bf_hi(c2.z) * bf_hi(g2.z));
            w.w = pk2(bf_lo(c1.w) * bf_lo(g1.w) + bf_lo(c2.w) * bf_lo(g2.w), bf_hi(c1.w) * bf_hi(g1.w) + bf_hi(c2.w) * bf_hi(g2.w));
            *(u32x4*)(MRG + m * 1024 + nt * 128 + ch * 8) = w;
        }
        __syncthreads();
    }
}

__device__ __forceinline__ void phase_outproj(const Params& p, unsigned char* smem) {
    const u16* MRG = (const u16*)(p.ws + OFF_MRG);
    const int tid = opaque_tid(), lane = tid & 63, wid = tid >> 6, wr = wid >> 1, wc = wid & 1;
    const u16* wt = (const u16*)(p.ws + OFF_OUTT);
    const int sw = ((tid & 3) ^ ((tid >> 4) & 3)) * 8;
    for (int ti = 0;; ++ti) {
        int mt, nt;
        if (!sched_tile(ti, 256, 4, 4, mt, nt)) break;
        f32x16 acc[2][4] = {};
        gemm_core3(acc, MRG + (size_t)(mt * 128 + (tid >> 2)) * 1024 + sw, 64 * 1024, wt + (size_t)(nt * 256 + (tid >> 2)) * 1024 + sw, 64 * 1024, 32, smem, tid, lane, wr, wc);
        u16* Ct = (u16*)smem;
        RAW_BARRIER();
        ct_write3(Ct, acc, wr, wc, lane);
        __syncthreads();
        {
            const int bvec = mt >> 7, ch = tid & 31;
            float g1[8];
#pragma unroll
            for (int j = 0; j < 8; ++j) g1[j] = mod_val(p, bvec, 2048 + nt * 256 + ch * 8 + j);
#pragma unroll 4
            for (int i = 0; i < 16; ++i) {
                const int row = (tid >> 5) + i * 8;
                const size_t off = ((size_t)mt * 128 + row) * 1024 + nt * 256 + ch * 8;
                const u32x4 cv = *(const u32x4*)(Ct + row * CT3_LD + ch * 8);
                const f32x4 x0 = *(const f32x4*)(p.x + off), x1 = *(const f32x4*)(p.x + off + 4);
                f32x4 o0, o1;
                o0.x = x0.x + g1[0] * bf_lo(cv.x); o0.y = x0.y + g1[1] * bf_hi(cv.x); o0.z = x0.z + g1[2] * bf_lo(cv.y); o0.w = x0.w + g1[3] * bf_hi(cv.y);
                o1.x = x1.x + g1[4] * bf_lo(cv.z); o1.y = x1.y + g1[5] * bf_hi(cv.z); o1.z = x1.z + g1[6] * bf_lo(cv.w); o1.w = x1.w + g1[7] * bf_hi(cv.w);
                *(f32x4*)(p.out + off) = o0; *(f32x4*)(p.out + off + 4) = o1;
            }
        }
        __syncthreads();
    }
}

__device__ __forceinline__ void phase_router(const Params& p, unsigned char* smem) {
    const u16* H = (const u16*)(p.ws + OFF_H);
    float* SC = (float*)(p.ws + OFF_SC);
    const int tid = opaque_tid(), lane = tid & 63, wid = tid >> 6, wr = wid >> 1, wc = wid & 1;
    const int r = lane & 31, hh = lane >> 5;
    const u16* wt = (const u16*)(p.ws + OFF_RTT);
    const int sw = ((tid & 7) ^ ((tid >> 4) & 7)) * 8;
    for (int ti = 0;; ++ti) {
        int mt, nt;
        if (!sched_tile(ti, 256, 2, 2, mt, nt)) break;
        f32x16 acc[2][2] = {};
        gemm_core2(acc, H + (size_t)(mt * 128 + (tid >> 3)) * 1024 + sw, 32 * 1024, wt + (size_t)(nt * 128 + (tid >> 3)) * 1024 + sw, 32 * 1024, 16, smem, tid, lane, wr, wc);
#pragma unroll
        for (int mi = 0; mi < 2; ++mi)
#pragma unroll
            for (int ni = 0; ni < 2; ++ni) {
                float* srow = SC + ((size_t)mt * 128 + wr * 64 + mi * 32 + r) * 256 + nt * 128 + wc * 64 + ni * 32 + 4 * hh;
#pragma unroll
                for (int g = 0; g < 4; ++g) {
                    f32x4 o; o.x = sigmoid_(acc[mi][ni][4 * g]); o.y = sigmoid_(acc[mi][ni][4 * g + 1]); o.z = sigmoid_(acc[mi][ni][4 * g + 2]); o.w = sigmoid_(acc[mi][ni][4 * g + 3]);
                    *(f32x4*)(srow + 8 * g) = o;
                }
            }
        __syncthreads();
    }
}

__device__ __forceinline__ void phase_route(const Params& p, unsigned char* smem) {
    const int tid = opaque_tid(), lane = tid & 63, wid = tid >> 6;
    const float* SC = (const float*)(p.ws + OFF_SC);
    int* tope = (int*)(p.ws + OFF_TOPE); float* topw = (float*)(p.ws + OFF_TOPW);
    int* lh = (int*)smem;
    lh[tid] = 0;
    __syncthreads();
    const f32x4 rb = *(const f32x4*)(p.router_bias + lane * 4);
    for (int tok = blockIdx.x * 4 + wid; tok < NTOK; tok += gridDim.x * 4) {
        const f32x4 sc = *(const f32x4*)(SC + (size_t)tok * 256 + lane * 4);
        float s0 = sc.x + rb.x, s1 = sc.y + rb.y, s2 = sc.z + rb.z, s3 = sc.w + rb.w;
        float a1 = fmaxf(s0, s1), a2 = fminf(s0, s1);
        { const float b1 = fmaxf(s2, s3), b2 = fminf(s2, s3); const float n1 = fmaxf(a1, b1), n2 = fmaxf(fminf(a1, b1), fmaxf(a2, b2)); a1 = n1; a2 = n2; }
#pragma unroll
        for (int o = 1; o < 8; o <<= 1) {
            const float b1 = __shfl_xor(a1, o), b2 = __shfl_xor(a2, o);
            const float n1 = fmaxf(a1, b1), n2 = fmaxf(fminf(a1, b1), fmaxf(a2, b2)); a1 = n1; a2 = n2;
        }
        const float gs = a1 + a2; const int mygrp = lane >> 3;
        int gcnt = 0;
#pragma unroll
        for (int g = 0; g < 8; ++g) { const float og = __shfl(gs, g * 8); gcnt += (og > gs || (og == gs && g < mygrp)) ? 1 : 0; }
        const bool gsel = gcnt < 4;
        unsigned k0, k1, k2, k3;
        {
            const unsigned u0 = __float_as_uint(s0), u1 = __float_as_uint(s1), u2 = __float_as_uint(s2), u3 = __float_as_uint(s3);
            k0 = gsel ? (u0 ^ ((u0 >> 31) ? 0xffffffffu : 0x80000000u)) : 0u; k1 = gsel ? (u1 ^ ((u1 >> 31) ? 0xffffffffu : 0x80000000u)) : 0u;
            k2 = gsel ? (u2 ^ ((u2 >> 31) ? 0xffffffffu : 0x80000000u)) : 0u; k3 = gsel ? (u3 ^ ((u3 >> 31) ? 0xffffffffu : 0x80000000u)) : 0u;
        }
        unsigned T = 0u;
#pragma unroll 1
        for (int bit = 31; bit >= 0; --bit) {
            const unsigned trial = T | (1u << bit);
            const int cnt = __popcll(__ballot(k0 >= trial)) + __popcll(__ballot(k1 >= trial)) + __popcll(__ballot(k2 >= trial)) + __popcll(__ballot(k3 >= trial));
            if (cnt >= 8) T = trial;
        }
        const unsigned long long g0 = __ballot(k0 > T), g1 = __ballot(k1 > T), g2 = __ballot(k2 > T), g3 = __ballot(k3 > T);
        const unsigned long long e0 = __ballot(k0 == T), e1 = __ballot(k1 == T), e2 = __ballot(k2 == T), e3 = __ballot(k3 == T);
        const int need = 8 - (__popcll(g0) + __popcll(g1) + __popcll(g2) + __popcll(g3));
        const unsigned long long below = (1ull << lane) - 1ull;
        const int eb = __popcll(e0 & below) + __popcll(e1 & below) + __popcll(e2 & below) + __popcll(e3 & below);
        const int b0 = (int)((e0 >> lane) & 1ull), b1 = (int)((e1 >> lane) & 1ull), b2 = (int)((e2 >> lane) & 1ull);
        const bool t0 = k0 > T || (k0 == T && eb < need);
        const bool t1 = k1 > T || (k1 == T && eb + b0 < need);
        const bool t2 = k2 > T || (k2 == T && eb + b0 + b1 < need);
        const bool t3 = k3 > T || (k3 == T && eb + b0 + b1 + b2 < need);
        const unsigned long long m0 = __ballot(t0), m1 = __ballot(t1), m2 = __ballot(t2), m3 = __ballot(t3);
        const int kb = __popcll(m0 & below) + __popcll(m1 & below) + __popcll(m2 & below) + __popcll(m3 & below);
        const float wsum = wave_sum((t0 ? sc.x : 0.f) + (t1 ? sc.y : 0.f) + (t2 ? sc.z : 0.f) + (t3 ? sc.w : 0.f));
        const float wn = 2.5f / wsum;
        const int i0 = lane * 4;
        int kk = kb;
        if (t0) { atomicAdd(lh + i0, 1);     tope[tok * 8 + kk] = i0;     topw[tok * 8 + kk] = sc.x * wn; ++kk; }
        if (t1) { atomicAdd(lh + i0 + 1, 1); tope[tok * 8 + kk] = i0 + 1; topw[tok * 8 + kk] = sc.y * wn; ++kk; }
        if (t2) { atomicAdd(lh + i0 + 2, 1); tope[tok * 8 + kk] = i0 + 2; topw[tok * 8 + kk] = sc.z * wn; ++kk; }
        if (t3) { atomicAdd(lh + i0 + 3, 1); tope[tok * 8 + kk] = i0 + 3; topw[tok * 8 + kk] = sc.w * wn; ++kk; }
    }
    __syncthreads();
    ((int*)(p.ws + OFF_HIST))[blockIdx.x * 256 + tid] = lh[tid];
}
__device__ __forceinline__ void phase_assign(const Params& p, unsigned char* smem) {
    const int tid = opaque_tid(), lane = tid & 63, wid = tid >> 6;
    int* offs = (int*)smem; int* lc = offs + 256;
    const int* hist = (const int*)(p.ws + OFF_HIST);
    int* slot_tok = (int*)(p.ws + OFF_SLOT);
    const int* tope = (const int*)(p.ws + OFF_TOPE); int* rnk = (int*)(p.ws + OFF_RANK);
    {
        int run = 0, mine = 0;
        const int nb = gridDim.x, me = blockIdx.x;
        for (int b0 = 0; b0 < nb; b0 += 8) {
            int v[8];
#pragma unroll
            for (int j = 0; j < 8; ++j) v[j] = (b0 + j < nb) ? hist[(b0 + j) * 256 + tid] : 0;
#pragma unroll
            for (int j = 0; j < 8; ++j) { if (b0 + j == me) mine = run; run += v[j]; }
        }
        offs[tid] = mine; lc[tid] = 0;
        if (me == 0) { ((int*)(p.ws + OFF_CNT))[tid] = run; lc[256 + tid] = run; }
    }
    __syncthreads();
    if (blockIdx.x == 0 && tid == 0) {
        int* tab = (int*)(p.ws + OFF_TAB);
        int s = 0, q = 0;
        for (int e = 0; e < 256; ++e) { const int t = (lc[256 + e] + 127) >> 7; tab[e] = s; tab[260 + e] = q; s += t; q += (t + 1) >> 1; }
        tab[256] = s; tab[260 + 256] = q;
    }
    for (int tok = blockIdx.x * 4 + wid; tok < NTOK; tok += gridDim.x * 4) {
        if (lane < 8) {
            const int e = tope[tok * 8 + lane];
            const int rk = offs[e] + atomicAdd(lc + e, 1);
            rnk[tok * 8 + lane] = rk; slot_tok[(size_t)e * NTOK + rk] = tok;
        }
    }
}

__device__ __forceinline__ int* build_tile_table(const Params& p, unsigned char* smem) {
    int* tstart = (int*)(smem + 73728); int* cn = tstart + 260; int* pstart = cn + 256;
    const int tid = opaque_tid();
    cn[tid] = ((const int*)(p.ws + OFF_CNT))[tid];
    __syncthreads();
    if (tid == 0) {
        int s = 0, q = 0;
        for (int e = 0; e < 256; ++e) { const int t = (cn[e] + 127) >> 7; tstart[e] = s; pstart[e] = q; s += t; q += (t + 1) >> 1; }
        tstart[256] = s; pstart[256] = q;
    }
    __syncthreads();
    return tstart;
}
__device__ __forceinline__ int find_pair_expert(const int* pstart, int mp) {
    int lo = 0, hi = 256;
    while (hi - lo > 1) { const int mid = (lo + hi) >> 1; if (pstart[mid] <= mp) lo = mid; else hi = mid; }
    return lo;
}

__device__ __forceinline__ void gemm_core_m256(f32x16 (&acc)[4][2], const u16* abase, const int (&roff)[8], const float* bsrc, const size_t ldb, const int nk,
                                               unsigned char* smem, const int tid, const int lane, const int wr, const int wc) {
    typedef __attribute__((address_space(3))) unsigned lds_u32;
    unsigned char* Bs = smem + 65536;
    f32x4 br[8];
#pragma unroll
    for (int i = 0; i < 8; ++i) br[i] = *(const f32x4*)(bsrc + (size_t)i * ldb);
    {
        unsigned char* sa = smem + tid * 16;
#pragma unroll
        for (int i = 0; i < 8; ++i) __builtin_amdgcn_global_load_lds((const unsigned*)(abase + roff[i]), (lds_u32*)(sa + i * 4096), 16, 0, 0);
    }
    const int arow = tid >> 3, ach = tid & 7;
    const int r = lane & 31, hh = lane >> 5;
    for (int kt = 0; kt < nk; ++kt) {
#pragma unroll
        for (int cc = 0; cc < 4; ++cc) {
            u32x4 w; w.x = pk2(br[0][cc], br[1][cc]); w.y = pk2(br[2][cc], br[3][cc]); w.z = pk2(br[4][cc], br[5][cc]); w.w = pk2(br[6][cc], br[7][cc]);
            const int row = arow * 4 + cc;
            *(u32x4*)(Bs + row * 128 + ((ach ^ ((row >> 1) & 7)) * 16)) = w;
        }
        __syncthreads();
        if (kt + 1 < nk) {
            unsigned char* sa = smem + ((kt + 1) & 1) * 32768 + tid * 16;
#pragma unroll
            for (int i = 0; i < 8; ++i) __builtin_amdgcn_global_load_lds((const unsigned*)(abase + roff[i] + (kt + 1) * 64), (lds_u32*)(sa + i * 4096), 16, 0, 0);
            const float* bp = bsrc + (size_t)(kt + 1) * 64 * ldb;
#pragma unroll
            for (int i = 0; i < 8; ++i) br[i] = *(const f32x4*)(bp + (size_t)i * ldb);
        }
        const unsigned char* sa = smem + (kt & 1) * 32768;
        __builtin_amdgcn_s_setprio(1);
#pragma unroll 1
        for (int kk = 0; kk < 4; ++kk) {
            bf16x8 a[4], b[2];
            const int ch = ((kk * 2 + hh) ^ ((r >> 1) & 7)) * 16;
#pragma unroll
            for (int mi = 0; mi < 4; ++mi) a[mi] = *(const bf16x8*)(sa + (wr * 128 + mi * 32 + r) * 128 + ch);
#pragma unroll
            for (int ni = 0; ni < 2; ++ni) b[ni] = *(const bf16x8*)(Bs + (wc * 64 + ni * 32 + r) * 128 + ch);
#pragma unroll
            for (int mi = 0; mi < 4; ++mi)
#pragma unroll
                for (int ni = 0; ni < 2; ++ni) acc[mi][ni] = mfma32(b[ni], a[mi], acc[mi][ni]);
        }
        __builtin_amdgcn_s_setprio(0);
        __syncthreads();
    }
}

__device__ __forceinline__ void phase_moe1(const Params& p, unsigned char* smem) {
    const int* tstart = (const int*)(p.ws + OFF_TAB); const int* pstart = tstart + 260; const int* cn = (const int*)(p.ws + OFF_CNT);
    const u16* H2 = (const u16*)(p.ws + OFF_H);
    const int* slot_tok = (const int*)(p.ws + OFF_SLOT);
    u16* HID = (u16*)(p.ws + OFF_HID);
    const int tid = opaque_tid(), lane = tid & 63, wid = tid >> 6, wr = wid >> 1, wc = wid & 1;
    const int r = lane & 31, hh = lane >> 5;
    const int totalp = pstart[256];
    const int nitems = totalp * 4 + 512;
    const int sw = ((tid & 7) ^ ((tid >> 4) & 7)) * 8;
    for (int ii = 0;; ++ii) {
        const int it = ((blockIdx.x & 7) + 8 * ii) * (gridDim.x >> 3) + (blockIdx.x >> 3);
        if (it >= nitems) break;
        const bool shared = it >= totalp * 4;
        const int idx = shared ? it - totalp * 4 : it;
        const int mp = idx >> 2, nq = idx & 3;
        int e = 0, jp = 0, cnt_e = 0, vrows = 256;
        size_t hrow0;
        if (!shared) {
            e = find_pair_expert(pstart, mp); jp = mp - pstart[e]; cnt_e = cn[e];
            const int te = (cnt_e + 127) >> 7;
            vrows = (2 * jp + 1 < te) ? 256 : 128;
            hrow0 = (size_t)tstart[e] * 128 + jp * 256;
        } else hrow0 = (size_t)SH_BASE + mp * 256;
        int roff[8];
#pragma unroll
        for (int i = 0; i < 8; ++i) {
            const int ri = (tid >> 3) + 32 * i;
            int tok;
            if (shared) tok = mp * 256 + ri;
            else { const int pos = jp * 256 + ri; tok = pos < cnt_e ? slot_tok[(size_t)e * NTOK + pos] : 0; }
            roff[i] = tok * 1024 + sw;
        }
        const int R0 = (tid >> 3) * 4, bwc = R0 >> 6, bni = (R0 >> 5) & 1, bj = R0 & 31;
        const float* wsel = shared ? (bni ? p.w_sh_up : p.w_sh_gate) : ((bni ? p.w_exp_up : p.w_exp_gate) + (size_t)e * 1024 * 256);
        const float* bsrc = wsel + (size_t)((tid & 7) * 8) * 256 + nq * 64 + bwc * 32 + bj;
        f32x16 acc[4][2] = {};
        gemm_core_m256(acc, H2, roff, bsrc, 256, 16, smem, tid, lane, wr, wc);
        u16* Ct = (u16*)smem;
#pragma unroll
        for (int mi = 0; mi < 4; ++mi) {
            u16* base = Ct + (wr * 128 + mi * 32 + r) * LDT + wc * 32 + 4 * hh;
#pragma unroll
            for (int g = 0; g < 4; ++g) {
                float hv[4];
#pragma unroll
                for (int j = 0; j < 4; ++j) { const float gt = acc[mi][0][4 * g + j], u = acc[mi][1][4 * g + j]; hv[j] = gt * sigmoid_(gt) * u; }
                u32x2 w; w.x = pk2(hv[0], hv[1]); w.y = pk2(hv[2], hv[3]);
                *(u32x2*)(base + 8 * g) = w;
            }
        }
        __syncthreads();
#pragma unroll
        for (int i = 0; i < 8; ++i) {
            const int id2 = tid + i * 256, row = id2 >> 3, ch = id2 & 7;
            if (row < vrows) *(u32x4*)(HID + (hrow0 + row) * 256 + nq * 64 + ch * 8) = *(const u32x4*)(Ct + row * LDT + ch * 8);
        }
        __syncthreads();
    }
}

__device__ __forceinline__ void phase_moe2(const Params& p, unsigned char* smem) {
    const int* tstart = (const int*)(p.ws + OFF_TAB); const int* pstart = tstart + 260; const int* cn = (const int*)(p.ws + OFF_CNT);
    const u16* HID = (const u16*)(p.ws + OFF_HID);
    u16* Y = (u16*)(p.ws + OFF_Y);
    const int tid = opaque_tid(), lane = tid & 63, wid = tid >> 6, wr = wid >> 1, wc = wid & 1;
    const int r = lane & 31, hh = lane >> 5;
    const int totalp = pstart[256];
    const int nitems = totalp * 8 + 1024;
    const int sw = ((tid & 7) ^ ((tid >> 4) & 7)) * 8;
    for (int ii = 0;; ++ii) {
        const int it = ((blockIdx.x & 7) + 8 * ii) * (gridDim.x >> 3) + (blockIdx.x >> 3);
        if (it >= nitems) break;
        const bool shared = it >= totalp * 8;
        const int idx = shared ? it - totalp * 8 : it;
        const int mp = idx >> 3, nt = idx & 7;
        int e = 0, vrows = 256;
        size_t hrow0;
        if (!shared) {
            e = find_pair_expert(pstart, mp); const int jp = mp - pstart[e];
            const int te = (cn[e] + 127) >> 7;
            vrows = (2 * jp + 1 < te) ? 256 : 128;
            hrow0 = (size_t)tstart[e] * 128 + jp * 256;
        } else hrow0 = (size_t)SH_BASE + mp * 256;
        int roff[8];
#pragma unroll
        for (int i = 0; i < 8; ++i) {
            const int ri = (tid >> 3) + 32 * i;
            roff[i] = (int)(hrow0 + (ri < vrows ? ri : ri - 128)) * 256 + sw;
        }
        const float* wsel = shared ? p.w_sh_down : p.w_exp_down + (size_t)e * 256 * 1024;
        const float* bsrc = wsel + (size_t)((tid & 7) * 8) * 1024 + nt * 128 + (tid >> 3) * 4;
        f32x16 acc[4][2] = {};
        gemm_core_m256(acc, HID, roff, bsrc, 1024, 4, smem, tid, lane, wr, wc);
        u16* Ct = (u16*)smem;
#pragma unroll
        for (int mi = 0; mi < 4; ++mi)
#pragma unroll
            for (int ni = 0; ni < 2; ++ni) {
                u16* base = Ct + (wr * 128 + mi * 32 + r) * CT_LD + wc * 64 + ni * 32 + 4 * hh;
#pragma unroll
                for (int g = 0; g < 4; ++g) {
                    u32x2 w; w.x = pk2(acc[mi][ni][4 * g], acc[mi][ni][4 * g + 1]); w.y = pk2(acc[mi][ni][4 * g + 2], acc[mi][ni][4 * g + 3]);
                    *(u32x2*)(base + 8 * g) = w;
                }
            }
        __syncthreads();
#pragma unroll 4
        for (int i = 0; i < 16; ++i) {
            const int id2 = tid + i * 256, row = id2 >> 4, ch = id2 & 15;
            if (row < vrows) *(u32x4*)(Y + (hrow0 + row) * 1024 + nt * 128 + ch * 8) = *(const u32x4*)(Ct + row * CT_LD + ch * 8);
        }
        __syncthreads();
    }
}

__device__ __forceinline__ void phase_combine(const Params& p, unsigned char* smem) {
    const int* tstart = build_tile_table(p, smem);
    float* g2t = (float*)smem;
    const int tid = opaque_tid(), lane = tid & 63, wid = tid >> 6;
    for (int j = tid; j < 2048; j += 256) g2t[j] = mod_val(p, j >> 10, 5120 + (j & 1023));
    __syncthreads();
    const u16* Y = (const u16*)(p.ws + OFF_Y);
    const int* tope = (const int*)(p.ws + OFF_TOPE); const int* rnk = (const int*)(p.ws + OFF_RANK); const float* topw = (const float*)(p.ws + OFF_TOPW);
    for (int tok = blockIdx.x * 4 + wid; tok < NTOK; tok += gridDim.x * 4) {
        int myrow = 0; float myw = 0.f;
        if (lane < 8) { const int e = tope[tok * 8 + lane]; myrow = tstart[e] * 128 + rnk[tok * 8 + lane]; myw = topw[tok * 8 + lane]; }
        if (lane == 8) { myrow = SH_BASE + tok; myw = 1.f; }
        const float* g2 = g2t + (tok >> 14) * 1024;
        f32x4 a[4];
#pragma unroll
        for (int j = 0; j < 4; ++j) a[j] = (f32x4){0.f, 0.f, 0.f, 0.f};
#pragma unroll
        for (int k = 0; k < 9; ++k) {
            const int row = __shfl(myrow, k); const float w = __shfl(myw, k);
            const u16* yr = Y + (size_t)row * 1024 + lane * 4;
#pragma unroll
            for (int j = 0; j < 4; ++j) {
                const u32x2 v = *(const u32x2*)(yr + j * 256);
                a[j].x += w * bf_lo(v.x); a[j].y += w * bf_hi(v.x); a[j].z += w * bf_lo(v.y); a[j].w += w * bf_hi(v.y);
            }
        }
#pragma unroll
        for (int j = 0; j < 4; ++j) {
            const int col = j * 256 + lane * 4;
            float* op = p.out + (size_t)tok * 1024 + col;
            const f32x4 x1 = *(const f32x4*)op, g = *(const f32x4*)(g2 + col);
            f32x4 o; o.x = x1.x + g.x * a[j].x; o.y = x1.y + g.y * a[j].y; o.z = x1.z + g.z * a[j].z; o.w = x1.w + g.w * a[j].w;
            *(f32x4*)op = o;
        }
    }
}

#define XB_TMO      128
#define XB_XCNT(j)  (256  + 64 * (j))
#define XB_XSUB(j)  (1280 + 64 * (j))
#define XB_XGEN(j)  (2304 + 64 * (j))
#define XB_TOP      3328
#define XB_TOPGEN   3392
#define XCD_BAR_WORDS 3456
#define XB_SPIN_CAP (1u << 24)
#define LAS __attribute__((address_space(3)))
__device__ __forceinline__ unsigned xb_ld(unsigned* p)              { return __hip_atomic_load(p, __ATOMIC_RELAXED, __HIP_MEMORY_SCOPE_AGENT); }
__device__ __forceinline__ unsigned xb_add(unsigned* p, unsigned v) { return __hip_atomic_fetch_add(p, v, __ATOMIC_RELAXED, __HIP_MEMORY_SCOPE_AGENT); }
__device__ __forceinline__ unsigned xb_xcc_id() { return (unsigned)__builtin_amdgcn_s_getreg((3 << 11) | 20) & 0xFu; }
#define XB_SPIN(cond, bar) do { unsigned _sp = 0; while (cond) { __builtin_amdgcn_s_sleep(1); \
    if ((++_sp & 255u) == 0u) { if (xb_ld(&(bar)[XB_TMO])) break; if (_sp > XB_SPIN_CAP) { atomicAdd(&(bar)[XB_TMO], 1u); break; } } } } while (0)
struct XcdBarrier { unsigned* bar; unsigned x; unsigned* st; };
__device__ __forceinline__ XcdBarrier xcd_barrier_post(unsigned* bar, unsigned* st) {
    XcdBarrier b; b.bar = bar; b.x = xb_xcc_id(); b.st = st;
    if (threadIdx.x == 0) (void)xb_add(&bar[XB_XCNT(b.x)], 1u);
    return b;
}
__device__ __forceinline__ void xcd_barrier_complete(unsigned* bar, unsigned x, unsigned& nloc, unsigned& nx) {
    const unsigned G = gridDim.x * gridDim.y * gridDim.z;
    unsigned sum, cnt, mine, sp = 0u;
    for (;;) {
        sum = 0u; cnt = 0u; mine = 0u;
#pragma unroll
        for (unsigned j = 0; j < 16; ++j) { const unsigned c = xb_ld(&bar[XB_XCNT(j)]); sum += c; cnt += (c > 0u) ? 1u : 0u; mine = (j == x) ? c : mine; }
        if (sum == G) break;
        __builtin_amdgcn_s_sleep(1);
        if ((++sp & 255u) == 0u) { if (xb_ld(&bar[XB_TMO])) break; if (sp > XB_SPIN_CAP) { atomicAdd(&bar[XB_TMO], 1u); break; } }
    }
    nloc = mine > 0u ? mine : 1u; nx = cnt > 0u ? cnt : 1u;
}
__device__ __forceinline__ void xcd_barrier(const XcdBarrier& b) {
    asm volatile("s_waitcnt vmcnt(0)" ::: "memory");
    __syncthreads();
    if (threadIdx.x == 0) {
        unsigned* bar = b.bar;
        __builtin_amdgcn_s_waitcnt(0);
        unsigned nloc = xb_ld(b.st), nx = xb_ld(b.st + 1);
        if (nloc == 0u) { xcd_barrier_complete(bar, b.x, nloc, nx); __hip_atomic_store(b.st, nloc, __ATOMIC_RELAXED, __HIP_MEMORY_SCOPE_AGENT); __hip_atomic_store(b.st + 1, nx, __ATOMIC_RELAXED, __HIP_MEMORY_SCOPE_AGENT); }
        const unsigned old = xb_add(&bar[XB_XSUB(b.x)], 1u);
        const unsigned gen = old / nloc;
        if (old + 1u == (gen + 1u) * nloc) {
            __builtin_amdgcn_fence(__ATOMIC_RELEASE, "agent");
            asm volatile("s_waitcnt vmcnt(0)" ::: "memory");
            const unsigned og = xb_add(&bar[XB_TOP], 1u);
            const unsigned tg = og / nx;
            if (og + 1u == (tg + 1u) * nx) xb_add(&bar[XB_TOPGEN], 1u);
            else XB_SPIN(xb_ld(&bar[XB_TOPGEN]) == tg, bar);
            __builtin_amdgcn_fence(__ATOMIC_ACQUIRE, "agent");
            xb_add(&bar[XB_XGEN(b.x)], 1u);
            asm volatile("s_waitcnt vmcnt(0)" ::: "memory");
        } else {
            XB_SPIN(xb_ld(&bar[XB_XGEN(b.x)]) == gen, bar);
            __builtin_amdgcn_fence(__ATOMIC_ACQUIRE, "agent");
            asm volatile("s_waitcnt vmcnt(0)" ::: "memory");
        }
    }
    __syncthreads();
}

__global__ void __launch_bounds__(256, 2) mega(Params p) {
    extern __shared__ __attribute__((aligned(16))) unsigned char smem[];
    cg::grid_group grid = cg::this_grid();
    if (p.ph_lo < 0) grid.sync();
    const XcdBarrier xb = xcd_barrier_post((unsigned*)(p.ws + OFF_BAR), (unsigned*)(p.ws + OFF_BAR + 16384) + blockIdx.x * 2);
#define GSYNC() xcd_barrier(xb)
#define PHASE_BEGIN(k) if (p.ph_lo <= (k) && (k) < p.ph_hi) {
#define PHASE_END(k) if ((k) + 1 < p.ph_hi) GSYNC(); }
    PHASE_BEGIN(0) phase_ada(p, smem); if (DUP_PHASE == 0) { GSYNC(); phase_ada(p, smem); } PHASE_END(0)
    PHASE_BEGIN(1) phase_norm(p, smem, false); if (DUP_PHASE == 1) { GSYNC(); phase_norm(p, smem, false); } PHASE_END(1)
    PHASE_BEGIN(2) phase_inproj(p, smem); if (DUP_PHASE == 2) { GSYNC(); phase_inproj(p, smem); } PHASE_END(2)
    PHASE_BEGIN(3)
        for (int it = blockIdx.x; it < 2080; it += gridDim.x) mlstm_passA(p, smem, it);
        if (DUP_PHASE == 3) { GSYNC(); for (int it = blockIdx.x; it < 2080; it += gridDim.x) mlstm_passA(p, smem, it); }
        if (DUP_PHASE == 30) { GSYNC(); for (int it = blockIdx.x; it < 4096; it += gridDim.x) na_item(p, smem, it); }
    PHASE_END(3)
    PHASE_BEGIN(4)
        if (blockIdx.x * 2 < gridDim.x) { phase_scan(p, smem); for (int it = blockIdx.x; it < 4096; it += gridDim.x) na_item(p, smem, it); }
        else { for (int it = blockIdx.x; it < 4096; it += gridDim.x) na_item(p, smem, it); phase_scan(p, smem); }
 if (DUP_PHASE == 34) { GSYNC(); for (int it = blockIdx.x; it < 2080; it += gridDim.x) mlstm_passA(p, smem, it); GSYNC(); phase_scan(p, smem); } PHASE_END(4)
    PHASE_BEGIN(5) for (int it = blockIdx.x; it < 2048; it += gridDim.x) mlstm_passC(p, smem, it); if (DUP_PHASE == 5) { GSYNC(); for (int it = blockIdx.x; it < 2048; it += gridDim.x) mlstm_passC(p, smem, it); } PHASE_END(5)
    PHASE_BEGIN(6) phase_merge(p, smem); if (DUP_PHASE == 6) { GSYNC(); phase_merge(p, smem); } PHASE_END(6)
    PHASE_BEGIN(7) phase_outproj(p, smem); if (DUP_PHASE == 7) { GSYNC(); phase_outproj(p, smem); } PHASE_END(7)
    PHASE_BEGIN(8) phase_norm(p, smem, true); if (DUP_PHASE == 8) { GSYNC(); phase_norm(p, smem, true); } PHASE_END(8)
    PHASE_BEGIN(9) phase_router(p, smem); if (DUP_PHASE == 9) { GSYNC(); phase_router(p, smem); } PHASE_END(9)
    PHASE_BEGIN(10) phase_route(p, smem); PHASE_END(10)
    PHASE_BEGIN(11) phase_assign(p, smem); PHASE_END(11)
    PHASE_BEGIN(12) phase_moe1(p, smem); if (DUP_PHASE == 12) { GSYNC(); phase_moe1(p, smem); } PHASE_END(12)
    PHASE_BEGIN(13) phase_moe2(p, smem); if (DUP_PHASE == 13) { GSYNC(); phase_moe2(p, smem); } PHASE_END(13)
    PHASE_BEGIN(14) phase_combine(p, smem);
        if (DUP_PHASE == 200) { for (int q = 0; q < 20; ++q) GSYNC(); }
        if (DUP_PHASE == 100) { GSYNC(); phase_route(p, smem); GSYNC(); phase_assign(p, smem); }
    PHASE_END(14)
}

extern "C" void kernel_launch(void* const* d_in, const int* in_sizes, int n_in, void* d_out, int out_size, void* d_ws, size_t ws_size, hipStream_t stream) {
    static int grid_blocks = 0;
    if (!grid_blocks) {
        int dev = 0, cus = 0, per_cu = 0;
        (void)hipGetDevice(&dev);
        (void)hipDeviceGetAttribute(&cus, hipDeviceAttributeMultiprocessorCount, dev);
        (void)hipFuncSetAttribute((const void*)mega, hipFuncAttributeMaxDynamicSharedMemorySize, LDS_BYTES);
        (void)hipOccupancyMaxActiveBlocksPerMultiprocessor(&per_cu, mega, 256, LDS_BYTES);
        if (per_cu > 2) per_cu = 2;
        if (per_cu < 1) per_cu = 1;
        grid_blocks = cus * per_cu;
        if (ws_size < WS_END) fprintf(stderr, "kernel_launch: workspace too small: %zu < %zu\n", ws_size, (size_t)WS_END);
    }
    (void)hipMemsetAsync((char*)d_ws + OFF_BAR, 0, 32768, stream);
    Params p{};
    const float** pp = (const float**)&p;
    for (int i = 0; i < 23; ++i) pp[i] = (const float*)d_in[i];
    p.out = (float*)d_out; p.ws = (unsigned char*)d_ws;
#if MULTI_LAUNCH
    for (int ph = 0; ph < NPH; ++ph) {
        p.ph_lo = ph; p.ph_hi = ph + 1;
        void* args[] = {&p};
        hipError_t e = hipLaunchCooperativeKernel((void*)mega, dim3(grid_blocks), dim3(256), args, LDS_BYTES, stream);
        if (e != hipSuccess) fprintf(stderr, "cooperative launch failed: %s (grid %d)\n", hipGetErrorString(e), grid_blocks);
    }
#else
    p.ph_lo = 0; p.ph_hi = NPH;
    void* args[] = {&p};
    hipError_t e = hipLaunchCooperativeKernel((void*)mega, dim3(grid_blocks), dim3(256), args, LDS_BYTES, stream);
    if (e != hipSuccess) fprintf(stderr, "cooperative launch failed: %s (grid %d)\n", hipGetErrorString(e), grid_blocks);
#endif
}
```

```cpp
#include <hip/hip_runtime.h>
#include <hip/hip_cooperative_groups.h>
#include <cstdio>
#include <cstdint>
namespace cg = cooperative_groups;

#ifndef MULTI_LAUNCH
#define MULTI_LAUNCH 0
#endif
#ifndef DUP_PHASE
#define DUP_PHASE -1
#endif

typedef unsigned short u16;
typedef unsigned int u32;
typedef short bf16x8 __attribute__((ext_vector_type(8)));
typedef float f32x16 __attribute__((ext_vector_type(16)));
typedef float f32x4 __attribute__((ext_vector_type(4)));
typedef u32 u32x4 __attribute__((ext_vector_type(4)));
typedef u32 u32x2 __attribute__((ext_vector_type(2)));

constexpr int DM = 1024;
constexpr int NTOK = 32768;
constexpr int TSEQ = 16384;
constexpr int MTOT = 33280;
constexpr int INC = 6672;
constexpr int PV = 6784;
constexpr int V_MQ = 0, V_MK = 512, V_MV = 1024, V_MO = 2048, V_NQ = 3072, V_NK = 3584, V_NV = 4096, V_GM = 4608, V_GN = 5632;
constexpr int NSLOT = 4160;
constexpr int SH_BASE = 294912;
constexpr int NPH = 15;
constexpr int HALF_LDS = 80 * 1024;
constexpr int LDS_BYTES = 2 * HALF_LDS;
constexpr int LDT = 72;
constexpr int LDQ = 136;

constexpr size_t AL(size_t x) { return (x + 255) & ~(size_t)255; }
constexpr size_t OFF_MODP = 0;
constexpr size_t OFF_CNT  = AL(OFF_MODP + (size_t)8 * 3 * 6144 * 4);
constexpr size_t OFF_G    = AL(OFF_CNT + 1024);
constexpr size_t OFF_GS   = AL(OFF_G + (size_t)MTOT * 16 * 4);
constexpr size_t OFF_ML   = AL(OFF_GS + NSLOT * 4);
constexpr size_t OFF_MP   = AL(OFF_ML + NSLOT * 4);
constexpr size_t OFF_DN   = AL(OFF_MP + NSLOT * 4);
constexpr size_t OFF_TOPE = AL(OFF_DN + (size_t)NSLOT * 128 * 4);
constexpr size_t OFF_RANK = OFF_TOPE + (size_t)NTOK * 8 * 4;
constexpr size_t OFF_TOPW = OFF_RANK + (size_t)NTOK * 8 * 4;
constexpr size_t OFF_H    = AL(OFF_TOPW + (size_t)NTOK * 8 * 4);
constexpr size_t OFF_SLOT = AL(OFF_H + (size_t)MTOT * 1024 * 2);
constexpr size_t OFF_R4   = AL(OFF_SLOT + (size_t)256 * 32768 * 4);
constexpr size_t OFF_YNA  = OFF_R4;
constexpr size_t OFF_YM   = OFF_R4 + (size_t)NTOK * 512 * 2;
constexpr size_t OFF_MRG  = OFF_YM + (size_t)NTOK * 1024 * 2;
constexpr size_t OFF_SC   = OFF_R4;
constexpr size_t OFF_HID  = OFF_R4;
constexpr size_t OFF_P    = AL(OFF_R4 + (size_t)327680 * 256 * 2);
constexpr size_t OFF_CT   = AL(OFF_P + (size_t)MTOT * PV * 2);
constexpr size_t OFF_Y    = OFF_P;
constexpr size_t OFF_WINT = AL(OFF_CT + (size_t)NSLOT * 65536);
constexpr size_t OFF_BRMT = AL(OFF_WINT + (size_t)6912 * 1024 * 2);
constexpr size_t OFF_BRNT = AL(OFF_BRMT + (size_t)1024 * 1024 * 2);
constexpr size_t OFF_OUTT = AL(OFF_BRNT + (size_t)1024 * 512 * 2);
constexpr size_t OFF_RTT  = AL(OFF_OUTT + (size_t)1024 * 1024 * 2);
constexpr size_t OFF_HIST = AL(OFF_RTT + (size_t)256 * 1024 * 2);
constexpr size_t OFF_TAB  = AL(OFF_HIST + (size_t)1024 * 256 * 4);
constexpr size_t OFF_BAR  = AL(OFF_TAB + 4096);
constexpr size_t WS_END   = OFF_BAR + 32768;
static_assert(OFF_Y + (size_t)327680 * 1024 * 2 <= OFF_WINT, "Y must fit over P+CT");
static_assert(WS_END <= (size_t)1073741824, "workspace budget");

struct Params {
    const float *x, *c, *ctx, *c_ctx, *w_ada, *b_ada, *w_in, *b_mgate, *m_norm_w, *na_qn_w, *na_kn_w, *na_rpb,
                *w_br_m, *w_br_na, *w_out, *w_router, *router_bias, *w_exp_gate, *w_exp_up, *w_exp_down,
                *w_sh_gate, *w_sh_up, *w_sh_down;
    float* out;
    unsigned char* ws;
    int ph_lo, ph_hi;
};

typedef __bf16 bf16x2_t __attribute__((ext_vector_type(2)));
__device__ __forceinline__ u32 pk2(float lo, float hi) { bf16x2_t v = {(__bf16)lo, (__bf16)hi}; return __builtin_bit_cast(u32, v); }
__device__ __forceinline__ u16 f2bf(float f) { return (u16)(pk2(f, 0.f) & 0xffffu); }
__device__ __forceinline__ float bf2f(u16 h) { return __uint_as_float(((u32)h) << 16); }
__device__ __forceinline__ float bf_lo(u32 w) { return __uint_as_float(w << 16); }
__device__ __forceinline__ float bf_hi(u32 w) { return __uint_as_float(w & 0xffff0000u); }
__device__ __forceinline__ float sigmoid_(float x) { return 1.f / (1.f + __expf(-x)); }
__device__ __forceinline__ float log_sigmoid_(float x) { return fminf(x, 0.f) - __logf(1.f + __expf(-fabsf(x))); }
__device__ __forceinline__ f32x4 mfma16(bf16x8 a, bf16x8 b, f32x4 c) { return __builtin_amdgcn_mfma_f32_16x16x32_bf16(a, b, c, 0, 0, 0); }
__device__ __forceinline__ f32x16 mfma32(bf16x8 a, bf16x8 b, f32x16 c) { return __builtin_amdgcn_mfma_f32_32x32x16_bf16(a, b, c, 0, 0, 0); }

__device__ __forceinline__ void sincos_rev(float rev, float& sn, float& cs) {
    rev -= rintf(rev);
    const float kq = rintf(rev * 4.f);
    const float th = (rev - kq * 0.25f) * 6.283185307179586f;
    const float t2 = th * th;
    const float s = th * (1.f + t2 * (-1.f / 6.f + t2 * (1.f / 120.f + t2 * (-1.f / 5040.f + t2 * (1.f / 362880.f)))));
    const float c = 1.f + t2 * (-0.5f + t2 * (1.f / 24.f + t2 * (-1.f / 720.f + t2 * (1.f / 40320.f))));
    const int k = ((int)kq) & 3;
    sn = (k == 0) ? s : (k == 1) ? c : (k == 2) ? -s : -c;
    cs = (k == 0) ? c : (k == 1) ? -s : (k == 2) ? -c : s;
}
#define VB  ((int)(blockIdx.x * 2 + __builtin_amdgcn_readfirstlane(threadIdx.x >> 8)))
#define NVB ((int)(gridDim.x * 2))
__device__ __forceinline__ int opaque_tid() { int t = threadIdx.x & 255; asm volatile("" : "+v"(t)); return t; }
#define LAS __attribute__((address_space(3)))
constexpr int HB_OFF = HALF_LDS - 64;
__device__ __forceinline__ void half_bar(unsigned char* smem, unsigned& tgt) {
    LAS unsigned* c = (LAS unsigned*)(smem + HB_OFF);
    __builtin_amdgcn_fence(__ATOMIC_RELEASE, "workgroup");
    tgt += 4;
    if ((threadIdx.x & 63) == 0) (void)__hip_atomic_fetch_add(c, 1u, __ATOMIC_RELAXED, __HIP_MEMORY_SCOPE_WORKGROUP);
    while ((unsigned)__builtin_amdgcn_readfirstlane((int)__hip_atomic_load(c, __ATOMIC_RELAXED, __HIP_MEMORY_SCOPE_WORKGROUP)) < tgt) __builtin_amdgcn_s_sleep(1);
    __builtin_amdgcn_fence(__ATOMIC_ACQUIRE, "workgroup");
}
__device__ __forceinline__ float wave_sum(float v) {
#pragma unroll
    for (int o = 1; o < 64; o <<= 1) v += __shfl_xor(v, o);
    return v;
}
__device__ __forceinline__ float wave_max(float v) {
#pragma unroll
    for (int o = 1; o < 64; o <<= 1) v = fmaxf(v, __shfl_xor(v, o));
    return v;
}
__device__ __forceinline__ float wave_incl_sum(float v, int lane) {
#pragma unroll
    for (int o = 1; o < 64; o <<= 1) { float t = __shfl_up(v, o); if (lane >= o) v += t; }
    return v;
}
__device__ __forceinline__ float wave_prefix_max(float v, int lane) {
#pragma unroll
    for (int o = 1; o < 64; o <<= 1) { float t = __shfl_up(v, o); if (lane >= o) v = fmaxf(v, t); }
    return v;
}
__device__ __forceinline__ float wave_suffix_max(float v, int lane) {
#pragma unroll
    for (int o = 1; o < 64; o <<= 1) { float t = __shfl_down(v, o); if (lane + o < 64) v = fmaxf(v, t); }
    return v;
}
__device__ __forceinline__ float mod_val(const Params& p, int vec, int j) {
    const float* mp = (const float*)(p.ws + OFF_MODP);
    float s = p.b_ada[j];
#pragma unroll
    for (int ks = 0; ks < 8; ++ks) s += mp[(ks * 3 + vec) * 6144 + j];
    return s;
}
__device__ __forceinline__ u32x4 tr8(const u32x2 (&v)[8], int cc) {
    u32x4 o;
    if (cc == 0)      { o.x = (v[0].x & 0xffffu) | (v[1].x << 16); o.y = (v[2].x & 0xffffu) | (v[3].x << 16); o.z = (v[4].x & 0xffffu) | (v[5].x << 16); o.w = (v[6].x & 0xffffu) | (v[7].x << 16); }
    else if (cc == 1) { o.x = (v[0].x >> 16) | (v[1].x & 0xffff0000u); o.y = (v[2].x >> 16) | (v[3].x & 0xffff0000u); o.z = (v[4].x >> 16) | (v[5].x & 0xffff0000u); o.w = (v[6].x >> 16) | (v[7].x & 0xffff0000u); }
    else if (cc == 2) { o.x = (v[0].y & 0xffffu) | (v[1].y << 16); o.y = (v[2].y & 0xffffu) | (v[3].y << 16); o.z = (v[4].y & 0xffffu) | (v[5].y << 16); o.w = (v[6].y & 0xffffu) | (v[7].y << 16); }
    else              { o.x = (v[0].y >> 16) | (v[1].y & 0xffff0000u); o.y = (v[2].y >> 16) | (v[3].y & 0xffff0000u); o.z = (v[4].y >> 16) | (v[5].y & 0xffff0000u); o.w = (v[6].y >> 16) | (v[7].y & 0xffff0000u); }
    return o;
}
__device__ __forceinline__ float bfsel(const u32x2& v, int cc) { return cc == 0 ? bf_lo(v.x) : cc == 1 ? bf_hi(v.x) : cc == 2 ? bf_lo(v.y) : bf_hi(v.y); }

__device__ __forceinline__ void gemm_core2(f32x16 (&acc)[2][2], const u16* a0, const size_t a32, const u16* b0, const size_t b32, const int nk,
                                           unsigned char* smem, const int tid, const int lane, const int wr, const int wc) {
    typedef __attribute__((address_space(3))) unsigned lds_u32;
    const int r = lane & 31, hh = lane >> 5;
    {
        unsigned char* sa = smem + tid * 16;
#pragma unroll
        for (int i = 0; i < 4; ++i) {
            __builtin_amdgcn_global_load_lds((const unsigned*)(a0 + i * a32), (lds_u32*)(sa + i * 4096), 16, 0, 0);
            __builtin_amdgcn_global_load_lds((const unsigned*)(b0 + i * b32), (lds_u32*)(sa + 16384 + i * 4096), 16, 0, 0);
        }
    }
    for (int kt = 0; kt < nk; ++kt) {
        __syncthreads();
        if (kt + 1 < nk) {
            unsigned char* sa = smem + ((kt + 1) & 1) * 32768 + tid * 16;
            const u16* ap = a0 + (kt + 1) * 64; const u16* bp = b0 + (kt + 1) * 64;
#pragma unroll
            for (int i = 0; i < 4; ++i) {
                __builtin_amdgcn_global_load_lds((const unsigned*)(ap + i * a32), (lds_u32*)(sa + i * 4096), 16, 0, 0);
                __builtin_amdgcn_global_load_lds((const unsigned*)(bp + i * b32), (lds_u32*)(sa + 16384 + i * 4096), 16, 0, 0);
            }
        }
        const unsigned char* sa = smem + (kt & 1) * 32768; const unsigned char* sb = sa + 16384;
        __builtin_amdgcn_s_setprio(1);
#pragma unroll
        for (int kk = 0; kk < 4; ++kk) {
            bf16x8 a[2], b[2];
            const int ch = ((kk * 2 + hh) ^ ((r >> 1) & 7)) * 16;
#pragma unroll
            for (int mi = 0; mi < 2; ++mi) a[mi] = *(const bf16x8*)(sa + (wr * 64 + mi * 32 + r) * 128 + ch);
#pragma unroll
            for (int ni = 0; ni < 2; ++ni) b[ni] = *(const bf16x8*)(sb + (wc * 64 + ni * 32 + r) * 128 + ch);
#pragma unroll
            for (int mi = 0; mi < 2; ++mi)
#pragma unroll
                for (int ni = 0; ni < 2; ++ni) acc[mi][ni] = mfma32(b[ni], a[mi], acc[mi][ni]);
        }
        __builtin_amdgcn_s_setprio(0);
    }
}
#define RAW_BARRIER() do { asm volatile("s_waitcnt lgkmcnt(0)" ::: "memory"); __builtin_amdgcn_s_barrier(); } while (0)
__device__ __forceinline__ void gemm_core3(f32x16 (&acc)[2][4], const u16* a0, const size_t a64, const u16* b0, const size_t b64, const int nk,
                                           unsigned char* smem, const int tid, const int lane, const int wr, const int wc) {
    typedef __attribute__((address_space(3))) unsigned lds_u32;
    const int r = lane & 31, hh = lane >> 5;
#pragma unroll
    for (int s = 0; s < 2; ++s) {
        unsigned char* sa = smem + s * 24576 + tid * 16;
#pragma unroll
        for (int i = 0; i < 2; ++i) __builtin_amdgcn_global_load_lds((const unsigned*)(a0 + s * 32 + i * a64), (lds_u32*)(sa + i * 4096), 16, 0, 0);
#pragma unroll
        for (int i = 0; i < 4; ++i) __builtin_amdgcn_global_load_lds((const unsigned*)(b0 + s * 32 + i * b64), (lds_u32*)(sa + 8192 + i * 4096), 16, 0, 0);
    }
    int cur = 0;
    for (int kt = 0; kt < nk; ++kt) {
        if (kt + 1 < nk) asm volatile("s_waitcnt vmcnt(6)" ::: "memory"); else asm volatile("s_waitcnt vmcnt(0)" ::: "memory");
        RAW_BARRIER();
        if (kt + 2 < nk) {
            const int nx = cur == 0 ? 2 : cur - 1;
            unsigned char* sa = smem + nx * 24576 + tid * 16;
            const u16* ap = a0 + (kt + 2) * 32; const u16* bp = b0 + (kt + 2) * 32;
#pragma unroll
            for (int i = 0; i < 2; ++i) __builtin_amdgcn_global_load_lds((const unsigned*)(ap + i * a64), (lds_u32*)(sa + i * 4096), 16, 0, 0);
#pragma unroll
            for (int i = 0; i < 4; ++i) __builtin_amdgcn_global_load_lds((const unsigned*)(bp + i * b64), (lds_u32*)(sa + 8192 + i * 4096), 16, 0, 0);
        }
        const unsigned char* sa = smem + cur * 24576; const unsigned char* sb = sa + 8192;
        __builtin_amdgcn_s_setprio(1);
#pragma unroll
        for (int kk = 0; kk < 2; ++kk) {
            bf16x8 a[2], b[4];
            const int ch = ((kk * 2 + hh) ^ ((r >> 2) & 3)) * 16;
#pragma unroll
            for (int mi = 0; mi < 2; ++mi) a[mi] = *(const bf16x8*)(sa + (wr * 64 + mi * 32 + r) * 64 + ch);
#pragma unroll
            for (int ni = 0; ni < 4; ++ni) b[ni] = *(const bf16x8*)(sb + (wc * 128 + ni * 32 + r) * 64 + ch);
#pragma unroll
            for (int mi = 0; mi < 2; ++mi)
#pragma unroll
                for (int ni = 0; ni < 4; ++ni) acc[mi][ni] = mfma32(b[ni], a[mi], acc[mi][ni]);
        }
        __builtin_amdgcn_s_setprio(0);
        cur = cur == 2 ? 0 : cur + 1;
    }
}
constexpr int CT3_LD = 264;
__device__ __forceinline__ void ct_write3(u16* Ct, const f32x16 (&v)[2][4], const int wr, const int wc, const int lane) {
    const int r = lane & 31, hh = lane >> 5;
#pragma unroll
    for (int mi = 0; mi < 2; ++mi)
#pragma unroll
        for (int ni = 0; ni < 4; ++ni) {
            u16* base = Ct + (wr * 64 + mi * 32 + r) * CT3_LD + wc * 128 + ni * 32 + 4 * hh;
#pragma unroll
            for (int g = 0; g < 4; ++g) {
                u32x2 w; w.x = pk2(v[mi][ni][4 * g], v[mi][ni][4 * g + 1]); w.y = pk2(v[mi][ni][4 * g + 2], v[mi][ni][4 * g + 3]);
                *(u32x2*)(base + 8 * g) = w;
            }
        }
}
__device__ __forceinline__ int xcd_index(const int i) {
    const int vb = VB, nx = NVB >> 3;
    const int g = (vb >> 1) & 7, jb = ((vb >> 4) << 1) | (vb & 1);
    return (g + 8 * i) * nx + jb;
}
__device__ __forceinline__ int sched_rounds(const int total) { return (total + NVB - 1) / NVB; }
__device__ __forceinline__ void sched_tile(const int i, const int ntm, const int ntn, const int W, int& mt, int& nt) {
    int o = xcd_index(i);
    o = min(o, ntm * ntn - 1);
    const int full = ntn / W, fo = full * W * ntm;
    if (o < fo) { const int G = o / (W * ntm), rem = o - G * (W * ntm); mt = rem / W; nt = G * W + (rem - mt * W); }
    else { const int W2 = ntn - full * W, rem = o - fo; mt = rem / W2; nt = full * W + (rem - mt * W2); }
}
__device__ __forceinline__ int inproj_wrow(const int s);
__device__ __forceinline__ void conv_item(const float* W, const int ldw, const int k0, const int nreal0, u16* WT, const int K, const int nvirt0, float* T, const int tid, const bool perm = false) {
    const int kr = tid >> 4, c4 = tid & 15;
#pragma unroll
    for (int ps = 0; ps < 4; ++ps) {
        const int k = ps * 16 + kr;
        const f32x4 v = *(const f32x4*)(W + (size_t)(k0 + k) * ldw + nreal0 + c4 * 4);
        T[k * 65 + c4 * 4 + 0] = v.x; T[k * 65 + c4 * 4 + 1] = v.y; T[k * 65 + c4 * 4 + 2] = v.z; T[k * 65 + c4 * 4 + 3] = v.w;
    }
    __syncthreads();
    const int n = tid >> 2, kq = tid & 3;
    u32x4 o0, o1;
    const float* t = T + (kq * 16) * 65 + n;
    o0.x = pk2(t[0 * 65], t[1 * 65]); o0.y = pk2(t[2 * 65], t[3 * 65]); o0.z = pk2(t[4 * 65], t[5 * 65]); o0.w = pk2(t[6 * 65], t[7 * 65]);
    o1.x = pk2(t[8 * 65], t[9 * 65]); o1.y = pk2(t[10 * 65], t[11 * 65]); o1.z = pk2(t[12 * 65], t[13 * 65]); o1.w = pk2(t[14 * 65], t[15 * 65]);
    u16* dst = WT + (size_t)(perm ? inproj_wrow(nvirt0 + n) : nvirt0 + n) * K + k0 + kq * 16;
    *(u32x4*)dst = o0; *(u32x4*)(dst + 8) = o1;
    __syncthreads();
}
#define ACC_COL(reg) (((reg) & 3) + 8 * ((reg) >> 2))
#define ACC_ROW(mi, reg) ((mi) * 32 + ((reg) & 3) + 8 * ((reg) >> 2))
constexpr int CT_LD = 136;
__device__ __forceinline__ void ct_write(u16* Ct, const f32x16 (&v)[2][2], const int wr, const int wc, const int lane) {
    const int r = lane & 31, hh = lane >> 5;
#pragma unroll
    for (int mi = 0; mi < 2; ++mi)
#pragma unroll
        for (int ni = 0; ni < 2; ++ni) {
            u16* base = Ct + (wr * 64 + mi * 32 + r) * CT_LD + wc * 64 + ni * 32 + 4 * hh;
#pragma unroll
            for (int g = 0; g < 4; ++g) {
                u32x2 w; w.x = pk2(v[mi][ni][4 * g], v[mi][ni][4 * g + 1]); w.y = pk2(v[mi][ni][4 * g + 2], v[mi][ni][4 * g + 3]);
                *(u32x2*)(base + 8 * g) = w;
            }
        }
}
__device__ __forceinline__ void ct_store(const u16* Ct, u16* dst, const size_t ldd, const int tid) {
#pragma unroll
    for (int i = 0; i < 8; ++i) {
        const int idx = tid + i * 256, row = idx >> 4, ch = idx & 15;
        *(u32x4*)(dst + (size_t)row * ldd + ch * 8) = *(const u32x4*)(Ct + row * CT_LD + ch * 8);
    }
}

__device__ __forceinline__ void phase_ada(const Params& p, unsigned char* smem) {
    const int tid = opaque_tid();
    float* red = (float*)smem;
    float* mp = (float*)(p.ws + OFF_MODP);
    for (int it = VB; it < 192; it += NVB) {
        const int cb = it % 24, ks = it / 24, cq = tid & 63, kq = tid >> 6;
        float a0[4] = {0, 0, 0, 0}, a1[4] = {0, 0, 0, 0}, a2[4] = {0, 0, 0, 0};
        for (int kk = 0; kk < 32; ++kk) {
            const int k = ks * 128 + kq * 32 + kk;
            const f32x4 w = *(const f32x4*)(p.w_ada + (size_t)k * 6144 + cb * 256 + cq * 4);
            float c0 = p.c[k], c1 = p.c[1024 + k], c2 = p.c_ctx[k];
            c0 *= sigmoid_(c0); c1 *= sigmoid_(c1); c2 *= sigmoid_(c2);
#pragma unroll
            for (int j = 0; j < 4; ++j) { a0[j] += c0 * w[j]; a1[j] += c1 * w[j]; a2[j] += c2 * w[j]; }
        }
#pragma unroll
        for (int j = 0; j < 4; ++j) { red[(kq * 3 + 0) * 256 + cq * 4 + j] = a0[j]; red[(kq * 3 + 1) * 256 + cq * 4 + j] = a1[j]; red[(kq * 3 + 2) * 256 + cq * 4 + j] = a2[j]; }
        __syncthreads();
#pragma unroll
        for (int v = 0; v < 3; ++v) {
            const float s = (red[(0 * 3 + v) * 256 + tid] + red[(1 * 3 + v) * 256 + tid]) + (red[(2 * 3 + v) * 256 + tid] + red[(3 * 3 + v) * 256 + tid]);
            mp[(ks * 3 + v) * 6144 + cb * 256 + tid] = s;
        }
        __syncthreads();
    }
    for (int it = VB; it < 2400; it += NVB) {
        if (it < 1696) {
            const int nb = it >> 4, kb = it & 15, nv = nb * 64;
            const int nr = nv < 3072 ? nv : (nv < 6656 ? nv + 16 : 3072 + (nv - 6656));
            conv_item(p.w_in, INC, kb * 64, nr, (u16*)(p.ws + OFF_WINT), 1024, nv, red, tid, true);
        } else if (it < 1952) { const int q = it - 1696; conv_item(p.w_br_m, 1024, (q & 15) * 64, (q >> 4) * 64, (u16*)(p.ws + OFF_BRMT), 1024, (q >> 4) * 64, red, tid); }
        else if (it < 2080) { const int q = it - 1952; conv_item(p.w_br_na, 1024, (q & 7) * 64, (q >> 3) * 64, (u16*)(p.ws + OFF_BRNT), 512, (q >> 3) * 64, red, tid); }
        else if (it < 2336) { const int q = it - 2080; conv_item(p.w_out, 1024, (q & 15) * 64, (q >> 4) * 64, (u16*)(p.ws + OFF_OUTT), 1024, (q >> 4) * 64, red, tid); }
        else { const int q = it - 2336; conv_item(p.w_router, 256, (q & 15) * 64, (q >> 4) * 64, (u16*)(p.ws + OFF_RTT), 1024, (q >> 4) * 64, red, tid); }
    }
}

__device__ __forceinline__ void phase_norm(const Params& p, unsigned char* smem, const bool second) {
    const int tid = opaque_tid(), lane = tid & 63, wid = tid >> 6;
    float* tsh = (float*)smem; float* tsc = tsh + 1024;
    u16* H = (u16*)(p.ws + OFF_H);
    const int nrows = second ? NTOK : MTOT;
    const int rpb = (nrows + NVB - 1) / NVB;
    const int r0 = VB * rpb, r1 = min(r0 + rpb, nrows);
    const int sh_off = second ? 3072 : 0, sc_off = second ? 4096 : 1024;
    for (int vec = 0; vec < 3; ++vec) {
        const int vlo = vec == 0 ? 0 : (vec == 1 ? TSEQ : NTOK), vhi = vec == 0 ? TSEQ : (vec == 1 ? NTOK : MTOT);
        const int lo = max(r0, vlo), hi = min(r1, vhi);
        if (lo < hi) for (int j = tid; j < 1024; j += 256) { tsh[j] = mod_val(p, vec, sh_off + j); tsc[j] = 1.f + mod_val(p, vec, sc_off + j); }
        __syncthreads();
        for (int row = lo + wid; row < hi; row += 4) {
            const float* src = second ? (p.out + (size_t)row * 1024) : (row < NTOK ? p.x + (size_t)row * 1024 : p.ctx + (size_t)(row - NTOK) * 1024);
            f32x4 v[4]; float ss = 0.f;
#pragma unroll
            for (int j = 0; j < 4; ++j) { v[j] = *(const f32x4*)(src + j * 256 + lane * 4); ss += (v[j].x * v[j].x + v[j].y * v[j].y) + (v[j].z * v[j].z + v[j].w * v[j].w); }
            ss = wave_sum(ss);
            const float rstd = rsqrtf(ss * (1.f / 1024.f) + 1e-6f);
#pragma unroll
            for (int j = 0; j < 4; ++j) {
                const int k = j * 256 + lane * 4;
                const f32x4 sc = *(const f32x4*)(tsc + k), sh = *(const f32x4*)(tsh + k);
                u32x2 o; o.x = pk2(v[j].x * rstd * sc.x + sh.x, v[j].y * rstd * sc.y + sh.y); o.y = pk2(v[j].z * rstd * sc.z + sh.z, v[j].w * rstd * sc.w + sh.w);
                *(u32x2*)(H + (size_t)row * 1024 + k) = o;
            }
        }
        __syncthreads();
    }
}

__device__ __forceinline__ void phase_inproj(const Params& p, unsigned char* smem) {
    const u16* H = (const u16*)(p.ws + OFF_H);
    u16* P = (u16*)(p.ws + OFF_P); float* G = (float*)(p.ws + OFF_G);
    const int tid = opaque_tid(), lane = tid & 63, wid = tid >> 6, wr = wid >> 1, wc = wid & 1;
    const int r = lane & 31, hh = lane >> 5;
    const u16* WT = (const u16*)(p.ws + OFF_WINT);
    const int sw = ((tid & 7) ^ ((tid >> 4) & 7)) * 8;
    for (int ti = 0, nti = sched_rounds(260 * 53); ti < nti; ++ti) {
        int mt, nt;
        sched_tile(ti, 260, 53, 8, mt, nt);
        f32x16 acc[2][2] = {};
        gemm_core2(acc, H + (size_t)(mt * 128 + (tid >> 3)) * 1024 + sw, 32 * 1024, WT + (size_t)(nt * 128 + (tid >> 3)) * 1024 + sw, 32 * 1024, 16, smem, tid, lane, wr, wc);
        if (nt < 8) {
            const float scale = nt < 4 ? 0.08838834764831845f : 1.f;
            const bool latent = mt < 256;
#pragma unroll
            for (int mi = 0; mi < 2; ++mi) {
                const int t = (mt * 128 + wr * 64 + mi * 32 + r) & (TSEQ - 1);
                const float posr = (float)(wc == 0 ? (t >> 6) : (t & 63)) * 0.15915494309189535f;
#pragma unroll
                for (int reg = 0; reg < 16; ++reg) {
                    float x1 = acc[mi][0][reg] * scale, x2 = acc[mi][1][reg] * scale;
                    if (latent) {
                        const float inv = exp2f(-(float)(ACC_COL(reg) + 4 * hh) * (13.287712379549449f / 32.f));
                        float sn, cs; sincos_rev(posr * inv, sn, cs);
                        float a = x1 * cs; asm volatile("" : "+v"(a), "+v"(x1), "+v"(x2));
                        float o1 = fmaf(-x2, sn, a); asm volatile("" : "+v"(o1), "+v"(x1), "+v"(x2));
                        float bq = x1 * sn; asm volatile("" : "+v"(bq), "+v"(x2));
                        float o2 = fmaf(x2, cs, bq); asm volatile("" : "+v"(o2));
                        x1 = o1; x2 = o2;
                    }
                    acc[mi][0][reg] = x1; acc[mi][1][reg] = x2;
                }
            }
        } else if (nt >= 24 && nt < 32) {
            const float* nw = nt < 28 ? p.na_qn_w : p.na_kn_w;
            const float sc = nt < 28 ? 0.125f : 1.f;
#pragma unroll
            for (int mi = 0; mi < 2; ++mi) {
                float s = 0.f;
#pragma unroll
                for (int ni = 0; ni < 2; ++ni)
#pragma unroll
                    for (int reg = 0; reg < 16; ++reg) s += acc[mi][ni][reg] * acc[mi][ni][reg];
                s += __shfl_xor(s, 32);
                const float rstd = rsqrtf(s * (1.f / 64.f) + 1e-6f) * sc;
#pragma unroll
                for (int ni = 0; ni < 2; ++ni)
#pragma unroll
                    for (int reg = 0; reg < 16; ++reg) acc[mi][ni][reg] *= rstd * nw[ni * 32 + ACC_COL(reg) + 4 * hh];
            }
        } else if (nt >= 36 && nt < 52) {
#pragma unroll
            for (int mi = 0; mi < 2; ++mi)
#pragma unroll
                for (int ni = 0; ni < 2; ++ni)
#pragma unroll
                    for (int reg = 0; reg < 16; ++reg) acc[mi][ni][reg] = sigmoid_(acc[mi][ni][reg]);
        }
        if (nt == 52) {
            if (wc == 0) {
                const f32x4 b0 = *(const f32x4*)(p.b_mgate + 4 * hh), b1 = *(const f32x4*)(p.b_mgate + 8 + 4 * hh);
#pragma unroll
                for (int mi = 0; mi < 2; ++mi) {
                    float* g = G + (size_t)(mt * 128 + wr * 64 + mi * 32 + r) * 16 + 4 * hh;
                    f32x4 o0, o1;
                    o0.x = acc[mi][0][0] + b0.x; o0.y = acc[mi][0][1] + b0.y; o0.z = acc[mi][0][2] + b0.z; o0.w = acc[mi][0][3] + b0.w;
                    o1.x = acc[mi][0][4] + b1.x; o1.y = acc[mi][0][5] + b1.y; o1.z = acc[mi][0][6] + b1.z; o1.w = acc[mi][0][7] + b1.w;
                    *(f32x4*)g = o0; *(f32x4*)(g + 8) = o1;
                }
            }
        }
        {
            u16* Ct = (u16*)smem;
            __syncthreads();
            if (nt != 52) ct_write(Ct, acc, wr, wc, lane);
            __syncthreads();
            if (nt != 52) ct_store(Ct, P + (size_t)(mt * 128) * PV + nt * 128, PV, tid);
        }
        __syncthreads();
    }
}

namespace pg8 {
#define PG8_LAS __attribute__((address_space(3)))
constexpr int BM = 256, BK = 64, HALF = 128, HTB = HALF * BK * 2, STAGE_BYTES = 8 * HTB, NXCD = 8, WGM = 8;
__device__ __forceinline__ int lds_byte(int r, int c) { const int st = (r >> 4) * 2 + (c >> 5), rr = r & 15, cc = c & 31, ob = rr * 64 + cc * 2; return st * 1024 + (ob ^ (((ob >> 9) & 1) << 5)); }
__device__ __forceinline__ void stage_rc(int b, int& R, int& C) { const int st = b / 1024, sb = b % 1024, swz = sb ^ (((sb >> 9) & 1) << 5); R = (st >> 1) * 16 + swz / 64; C = (st & 1) * 32 + (swz % 64) / 2; }
__device__ __forceinline__ int perm32(int rho) { const int n = rho >> 4, i = rho & 15; return 8 * (i >> 2) + 4 * n + (i & 3); }
struct Unit { int pm, pn; };
struct Gemm { const u16* A; const u16* Bt; int M, N, K; };
struct StaticOrder {
    int nM, nN, nwg, G, c;
    __device__ void init(int M, int N, int G_, int c_) { nM = M / BM; nN = N / BM; nwg = nM * nN; G = G_; c = c_; }
    __device__ bool next(int i, Unit& u) const {
        const long L = (long)i * G + c; if (L >= nwg) return false;
        int wgid = (int)L; { const int q = nwg / NXCD, r = nwg % NXCD, xcd = wgid % NXCD, off = wgid / NXCD; wgid = (xcd < r ? xcd * (q + 1) : r * (q + 1) + (xcd - r) * q) + off; }
        const int nig = WGM * nN, gid = wgid / nig, fm = gid * WGM, gsz = (nM - fm) < WGM ? (nM - fm) : WGM;
        u.pm = fm + ((wgid % nig) % gsz); u.pn = (wgid % nig) / gsz; return true;
    }
};
template <class Epi>
__device__ __forceinline__ void gemm_phase(PG8_LAS unsigned char* lds, const Gemm g, const StaticOrder& S, const Epi& E) {
    const int tid = threadIdx.x, wid = __builtin_amdgcn_readfirstlane(tid >> 6), lane = tid & 63, wr = wid >> 2, wc = wid & 3, fr = lane & 15, fq = lane >> 4;
    const int K = g.K, nt = K / BK;
    unsigned voffA[2], voffB[2];
#pragma unroll
    for (int i = 0; i < 2; ++i) { int R, C; stage_rc(tid * 16 + i * 8192, R, C); const int Rb = Epi::PERM ? ((R & ~31) + perm32(R & 31)) : R;
        voffA[i] = (unsigned)(R * K + C) * 2u; voffB[i] = (unsigned)(Rb * K + C) * 2u; }
    const size_t kstep = (size_t)(BK * 2);
    const size_t hstep = (size_t)HALF * K * 2;
    const size_t tstep = 2 * hstep;
    const unsigned ldsw = (unsigned)wid * 1024u;
    const int aoff = lds_byte(wr * 64 + fr, fq * 8), boff = lds_byte(wc * 32 + fr, fq * 8);
#define PG8_SA(b, h) (((b) * 2 + (h)) * HTB)
#define PG8_SB(b, h) ((4 + (b) * 2 + (h)) * HTB)
#define PG8_STAGE(bufoff, gbase, voff) do { _Pragma("unroll") for (int _i = 0; _i < 2; ++_i) \
        __builtin_amdgcn_global_load_lds((const unsigned*)((const char*)(gbase) + (voff)[_i]), (PG8_LAS unsigned*)(lds + (bufoff) + ldsw + _i * 8192), 16, 0, 0); } while (0)
#define PG8_LDA(dst, b, h) do { _Pragma("unroll") for (int m = 0; m < 4; ++m) _Pragma("unroll") for (int k = 0; k < 2; ++k) dst[m][k] = *(const PG8_LAS bf16x8*)(lds + PG8_SA(b, h) + aoff + m * 2048 + k * 1024); } while (0)
#define PG8_LDB(dst, b, h) do { _Pragma("unroll") for (int n = 0; n < 2; ++n) _Pragma("unroll") for (int k = 0; k < 2; ++k) dst[n][k] = *(const PG8_LAS bf16x8*)(lds + PG8_SB(b, h) + boff + n * 2048 + k * 1024); } while (0)
#define PG8_MMA(ai, bj, At, Bt) do { __builtin_amdgcn_s_setprio(1); _Pragma("unroll") for (int m = 0; m < 4; ++m) _Pragma("unroll") for (int n = 0; n < 2; ++n) _Pragma("unroll") for (int k = 0; k < 2; ++k) \
        acc[ai][bj][m][n] = __builtin_amdgcn_mfma_f32_16x16x32_bf16(Bt[n][k], At[m][k], acc[ai][bj][m][n], 0, 0, 0); __builtin_amdgcn_s_setprio(0); } while (0)
#define PG8_WAIT_V(n) asm volatile("s_waitcnt vmcnt(" #n ")" ::: "memory")
#define PG8_WAIT_L(n) asm volatile("s_waitcnt lgkmcnt(" #n ")" ::: "memory")
#define PG8_BAR __builtin_amdgcn_s_barrier()
#define PG8_SCHED __builtin_amdgcn_sched_barrier(0)
    Unit cur, nxt; int ui = 0;
    if (!S.next(0, cur)) return;
    f32x4 acc[2][2][4][2];
#pragma unroll
    for (int a = 0; a < 2; ++a)
#pragma unroll
        for (int b = 0; b < 2; ++b)
#pragma unroll
            for (int m = 0; m < 4; ++m)
#pragma unroll
                for (int n = 0; n < 2; ++n) acc[a][b][m][n] = (f32x4){0.f, 0.f, 0.f, 0.f};
    bf16x8 At[4][2], B0[2][2], B1[2][2];
    const char* cA = (const char*)g.A + (size_t)cur.pm * tstep; const char* cB = (const char*)g.Bt + (size_t)cur.pn * tstep;
    PG8_STAGE(PG8_SB(0, 0), cB, voffB); PG8_STAGE(PG8_SA(0, 0), cA, voffA); PG8_STAGE(PG8_SB(0, 1), cB + hstep, voffB); PG8_STAGE(PG8_SA(0, 1), cA + hstep, voffA);
    if (wr == 1) PG8_BAR;
    PG8_WAIT_V(4); PG8_BAR;
    PG8_STAGE(PG8_SB(1, 0), cB + kstep, voffB); PG8_STAGE(PG8_SA(1, 0), cA + kstep, voffA); PG8_STAGE(PG8_SB(1, 1), cB + hstep + kstep, voffB);
    PG8_WAIT_V(6); PG8_BAR;
    for (;;) {
        const bool has_next = S.next(ui + 1, nxt);
        const char* nA = has_next ? (const char*)g.A + (size_t)nxt.pm * tstep : cA; const char* nB = has_next ? (const char*)g.Bt + (size_t)nxt.pn * tstep : cB;
        for (int t = 0; t < nt; t += 2) {
            const bool last = (t == nt - 2);
            const char* a1 = cA + (size_t)(t + 1) * kstep;
            const char* a2 = last ? nA : cA + (size_t)(t + 2) * kstep; const char* b2 = last ? nB : cB + (size_t)(t + 2) * kstep;
            const char* a3 = a2 + kstep; const char* b3 = b2 + kstep;
            PG8_LDB(B0, 0, 0); PG8_SCHED; PG8_LDA(At, 0, 0); PG8_STAGE(PG8_SA(1, 1), a1 + hstep, voffA);
            PG8_WAIT_L(8); PG8_BAR; PG8_WAIT_L(0); PG8_MMA(0, 0, At, B0); PG8_BAR; PG8_SCHED;
            PG8_LDB(B1, 0, 1); PG8_STAGE(PG8_SB(0, 0), b2, voffB);
            PG8_BAR; PG8_WAIT_L(0); PG8_MMA(0, 1, At, B1); PG8_BAR;
            PG8_LDA(At, 0, 1); PG8_STAGE(PG8_SA(0, 0), a2, voffA);
            PG8_BAR; PG8_WAIT_L(0); PG8_MMA(1, 0, At, B0); PG8_BAR; PG8_SCHED;
            PG8_STAGE(PG8_SB(0, 1), b2 + hstep, voffB);
            PG8_WAIT_V(6); PG8_BAR; PG8_MMA(1, 1, At, B1); PG8_BAR;
            PG8_LDB(B0, 1, 0); PG8_SCHED; PG8_LDA(At, 1, 0); PG8_STAGE(PG8_SA(0, 1), a2 + hstep, voffA);
            PG8_WAIT_L(8); PG8_BAR; PG8_WAIT_L(0); PG8_MMA(0, 0, At, B0); PG8_BAR; PG8_SCHED;
            PG8_LDB(B1, 1, 1); PG8_STAGE(PG8_SB(1, 0), b3, voffB);
            PG8_BAR; PG8_WAIT_L(0); PG8_MMA(0, 1, At, B1); PG8_BAR;
            PG8_LDA(At, 1, 1); PG8_STAGE(PG8_SA(1, 0), a3, voffA);
            PG8_BAR; PG8_WAIT_L(0); PG8_MMA(1, 0, At, B0); PG8_BAR; PG8_SCHED;
            PG8_STAGE(PG8_SB(1, 1), b3 + hstep, voffB);
            PG8_WAIT_V(6); PG8_BAR; PG8_MMA(1, 1, At, B1); PG8_BAR;
        }
        E(acc, cur, wr, wc, fr, fq);
        if (!has_next) break;
#pragma unroll
        for (int a = 0; a < 2; ++a)
#pragma unroll
            for (int b = 0; b < 2; ++b)
#pragma unroll
                for (int m = 0; m < 4; ++m)
#pragma unroll
                    for (int n = 0; n < 2; ++n) acc[a][b][m][n] = (f32x4){0.f, 0.f, 0.f, 0.f};
        cur = nxt; cA = nA; cB = nB; ++ui;
    }
    PG8_WAIT_V(0);
    if (wr == 0) PG8_BAR;
    PG8_BAR;
#undef PG8_SA
#undef PG8_SB
#undef PG8_STAGE
#undef PG8_LDA
#undef PG8_LDB
#undef PG8_MMA
#undef PG8_WAIT_V
#undef PG8_WAIT_L
#undef PG8_BAR
#undef PG8_SCHED
}
}

__device__ __forceinline__ int inproj_wrow(const int s) {
    if (s < 1024) { const int sl = s & 127, n = (sl >> 5) & 1, pi = ((sl >> 6) << 5) | (sl & 31); return (s & ~127) + ((pi >> 4) << 5) + (((pi >> 2) & 3) << 3) + (n << 2) + (pi & 3); }
    if (s >= 3072 && s < 4096) { const int u = s & 255; return (s & ~255) + (((u >> 5) & 1) << 7) + ((u >> 6) << 5) + (u & 31); }
    return s;
}

struct EpiInproj {
    static constexpr bool PERM = true;
    u16* P; float* G; const float *b_mgate, *qn_w, *kn_w;
    __device__ __forceinline__ void operator()(const f32x4 (&acc)[2][2][4][2], const pg8::Unit& u, const int wr, const int wc, const int fr_, const int fq_) const {
        int fr = fr_, fq = fq_; asm volatile("" : "+v"(fr), "+v"(fq));
        const int pn = u.pn;
        const int row0 = u.pm * 256 + wr * 64 + fr;
        if (pn < 4) {
            const float scale = pn < 2 ? 0.08838834764831845f : 1.f;
            const bool latent = u.pm < 128;
            const int half = wc >> 1, i0 = 16 * (wc & 1) + 4 * fq;
            float inv[4];
#pragma unroll
            for (int j = 0; j < 4; ++j) inv[j] = exp2f(-(float)(i0 + j) * (13.287712379549449f / 32.f)) * 0.15915494309189535f;
#pragma unroll
            for (int ai = 0; ai < 2; ++ai)
#pragma unroll
                for (int m = 0; m < 4; ++m) {
                    const int row = row0 + ai * 128 + m * 16, t = row & (TSEQ - 1);
                    const float pos = (float)(half ? (t & 63) : (t >> 6));
                    float o1[2][4], o2[2][4];
#pragma unroll
                    for (int j = 0; j < 4; ++j) {
                        float sn = 0.f, cs = 1.f;
                        if (latent) sincos_rev(pos * inv[j], sn, cs);
#pragma unroll
                        for (int bj = 0; bj < 2; ++bj) {
                            float x1 = acc[ai][bj][m][0][j] * scale, x2 = acc[ai][bj][m][1][j] * scale;
                            float a = x1 * cs; asm volatile("" : "+v"(a), "+v"(x1), "+v"(x2));
                            float q1 = fmaf(-x2, sn, a); asm volatile("" : "+v"(q1), "+v"(x1), "+v"(x2));
                            float bq = x1 * sn; asm volatile("" : "+v"(bq), "+v"(x2));
                            float q2 = fmaf(x2, cs, bq); asm volatile("" : "+v"(q2));
                            o1[bj][j] = q1; o2[bj][j] = q2;
                        }
                    }
#pragma unroll
                    for (int bj = 0; bj < 2; ++bj) {
                        u16* dst = P + (size_t)row * PV + pn * 256 + bj * 128 + half * 64 + i0;
                        u32x2 w1, w2; w1.x = pk2(o1[bj][0], o1[bj][1]); w1.y = pk2(o1[bj][2], o1[bj][3]); w2.x = pk2(o2[bj][0], o2[bj][1]); w2.y = pk2(o2[bj][2], o2[bj][3]);
                        *(u32x2*)dst = w1; *(u32x2*)(dst + 32) = w2;
                    }
                }
        } else if (pn >= 12 && pn < 16) {
            const float* nw = pn < 14 ? qn_w : kn_w;
            const float sc = pn < 14 ? 0.125f : 1.f;
            f32x4 wv[2][2];
#pragma unroll
            for (int bj = 0; bj < 2; ++bj)
#pragma unroll
                for (int n = 0; n < 2; ++n) wv[bj][n] = *(const f32x4*)(nw + bj * 32 + fq * 8 + n * 4);
#pragma unroll
            for (int ai = 0; ai < 2; ++ai)
#pragma unroll
                for (int m = 0; m < 4; ++m) {
                    const int row = row0 + ai * 128 + m * 16;
                    float s = 0.f;
#pragma unroll
                    for (int bj = 0; bj < 2; ++bj)
#pragma unroll
                        for (int n = 0; n < 2; ++n) { const f32x4 v = acc[ai][bj][m][n]; s += (v[0] * v[0] + v[1] * v[1]) + (v[2] * v[2] + v[3] * v[3]); }
                    s += __shfl_xor(s, 16); s += __shfl_xor(s, 32);
                    const float rstd = rsqrtf(s * (1.f / 64.f) + 1e-6f) * sc;
#pragma unroll
                    for (int bj = 0; bj < 2; ++bj) {
                        const f32x4 v0 = acc[ai][bj][m][0] * rstd * wv[bj][0], v1 = acc[ai][bj][m][1] * rstd * wv[bj][1];
                        u32x4 w; w.x = pk2(v0[0], v0[1]); w.y = pk2(v0[2], v0[3]); w.z = pk2(v1[0], v1[1]); w.w = pk2(v1[2], v1[3]);
                        *(u32x4*)(P + (size_t)row * PV + pn * 256 + wc * 64 + bj * 32 + fq * 8) = w;
                    }
                }
        } else if (pn == 26) {
            if (wc == 0 && fq < 2) {
                const f32x4 b0 = *(const f32x4*)(b_mgate + 8 * fq), b1 = *(const f32x4*)(b_mgate + 8 * fq + 4);
#pragma unroll
                for (int ai = 0; ai < 2; ++ai)
#pragma unroll
                    for (int m = 0; m < 4; ++m) {
                        float* g = G + (size_t)(row0 + ai * 128 + m * 16) * 16 + 8 * fq;
                        *(f32x4*)g = acc[ai][0][m][0] + b0; *(f32x4*)(g + 4) = acc[ai][0][m][1] + b1;
                    }
            }
        } else {
            const bool sg = pn >= 18;
#pragma unroll
            for (int ai = 0; ai < 2; ++ai)
#pragma unroll
                for (int m = 0; m < 4; ++m) {
                    const int row = row0 + ai * 128 + m * 16;
#pragma unroll
                    for (int bj = 0; bj < 2; ++bj) {
                        f32x4 v0 = acc[ai][bj][m][0], v1 = acc[ai][bj][m][1];
                        if (sg) {
#pragma unroll
                            for (int j = 0; j < 4; ++j) { v0[j] = sigmoid_(v0[j]); v1[j] = sigmoid_(v1[j]); }
                        }
                        u32x4 w; w.x = pk2(v0[0], v0[1]); w.y = pk2(v0[2], v0[3]); w.z = pk2(v1[0], v1[1]); w.w = pk2(v1[2], v1[3]);
                        *(u32x4*)(P + (size_t)row * PV + pn * 256 + bj * 128 + wc * 32 + fq * 8) = w;
                    }
                }
        }
    }
};
__device__ __forceinline__ void phase_inproj8(const Params& p, unsigned char* smem_all) {
    pg8::Gemm g; g.A = (const u16*)(p.ws + OFF_H); g.Bt = (const u16*)(p.ws + OFF_WINT); g.M = MTOT; g.N = 6912; g.K = 1024;
    pg8::StaticOrder S; S.init(g.M, g.N, (int)gridDim.x, (int)blockIdx.x);
    EpiInproj E; E.P = (u16*)(p.ws + OFF_P); E.G = (float*)(p.ws + OFF_G); E.b_mgate = p.b_mgate; E.qn_w = p.na_qn_w; E.kn_w = p.na_kn_w;
    pg8::gemm_phase<EpiInproj>((PG8_LAS unsigned char*)smem_all, g, S, E);
}

__device__ __forceinline__ void mlstm_passA(const Params& p, unsigned char* smem, const int it) {
    const int tid = opaque_tid(), lane = tid & 63, wid = tid >> 6;
    const int c = it % 260, bh = it / 260, b = bh >> 2, h = bh & 3;
    const int base = c < 4 ? NTOK + b * 256 + c * 64 : b * TSEQ + (c - 4) * 64;
    const u16* P = (const u16*)(p.ws + OFF_P); const float* G = (const float*)(p.ws + OFF_G);
    float* gsum = (float*)(p.ws + OFF_GS); float* mloc = (float*)(p.ws + OFF_ML); float* dn = (float*)(p.ws + OFF_DN);
    u16* CT = (u16*)(p.ws + OFF_CT);
    u16* KTf = (u16*)smem; u16* KTb = (u16*)(smem + 18432); u16* VT = (u16*)(smem + 36864);
    float* wf = (float*)(smem + 73728); float* wb = wf + 64;
    const int slot_f = bh * 2 * 260 + c, slot_b = slot_f + 260;
    if (wid == 0) {
        const float* g = G + (size_t)(base + lane) * 16;
        const float igf = g[h], ff = g[4 + h], igb = g[8 + h], fb = g[12 + h];
        const float lff = log_sigmoid_(ff), lfb = log_sigmoid_(fb);
        const float bfc = wave_incl_sum(lff, lane), gf = __shfl(bfc, 63);
        const float uf = igf - bfc, umf = wave_max(uf);
        wf[lane] = __expf(uf - umf);
        const float pb = wave_incl_sum(lfb, lane), gb = __shfl(pb, 63);
        const float bb = gb - pb + lfb, ub = igb - bb, umb = wave_max(ub);
        wb[lane] = __expf(ub - umb);
        if (lane == 0) { gsum[slot_f] = gf; mloc[slot_f] = gf + umf; gsum[slot_b] = gb; mloc[slot_b] = gb + umb; }
    }
    __syncthreads();
    const int cgp = tid >> 3, tg = tid & 7;
    {
        const u16* src = P + (size_t)(base + tg * 8) * PV + V_MK + h * 128 + cgp * 4;
        u32x2 kv[8];
#pragma unroll
        for (int i = 0; i < 8; ++i) kv[i] = *(const u32x2*)(src + (size_t)i * PV);
        float wfi[8], wbi[8];
#pragma unroll
        for (int i = 0; i < 8; ++i) { wfi[i] = wf[tg * 8 + i]; wbi[i] = wb[tg * 8 + i]; }
#pragma unroll
        for (int cc = 0; cc < 4; ++cc) {
            float e[8];
#pragma unroll
            for (int i = 0; i < 8; ++i) e[i] = bfsel(kv[i], cc);
            u32x4 of, ob;
            of.x = pk2(e[0] * wfi[0], e[1] * wfi[1]); of.y = pk2(e[2] * wfi[2], e[3] * wfi[3]); of.z = pk2(e[4] * wfi[4], e[5] * wfi[5]); of.w = pk2(e[6] * wfi[6], e[7] * wfi[7]);
            ob.x = pk2(e[0] * wbi[0], e[1] * wbi[1]); ob.y = pk2(e[2] * wbi[2], e[3] * wbi[3]); ob.z = pk2(e[4] * wbi[4], e[5] * wbi[5]); ob.w = pk2(e[6] * wbi[6], e[7] * wbi[7]);
            *(u32x4*)(KTf + (cgp * 4 + cc) * LDT + tg * 8) = of;
            *(u32x4*)(KTb + (cgp * 4 + cc) * LDT + tg * 8) = ob;
        }
    }
#pragma unroll
    for (int vp = 0; vp < 2; ++vp) {
        const u16* src = P + (size_t)(base + tg * 8) * PV + V_MV + h * 256 + vp * 128 + cgp * 4;
        u32x2 vv[8];
#pragma unroll
        for (int i = 0; i < 8; ++i) vv[i] = *(const u32x2*)(src + (size_t)i * PV);
#pragma unroll
        for (int cc = 0; cc < 4; ++cc) *(u32x4*)(VT + (vp * 128 + cgp * 4 + cc) * LDT + tg * 8) = tr8(vv, cc);
    }
    __syncthreads();
    if (tid < 128) {
        float sf = 0.f, sb = 0.f;
#pragma unroll
        for (int j = 0; j < 8; ++j) {
            const u32x4 a = *(const u32x4*)(KTf + tid * LDT + j * 8), bq = *(const u32x4*)(KTb + tid * LDT + j * 8);
            sf += (bf_lo(a.x) + bf_hi(a.x)) + (bf_lo(a.y) + bf_hi(a.y)) + (bf_lo(a.z) + bf_hi(a.z)) + (bf_lo(a.w) + bf_hi(a.w));
            sb += (bf_lo(bq.x) + bf_hi(bq.x)) + (bf_lo(bq.y) + bf_hi(bq.y)) + (bf_lo(bq.z) + bf_hi(bq.z)) + (bf_lo(bq.w) + bf_hi(bq.w));
        }
        dn[(size_t)slot_f * 128 + tid] = sf; dn[(size_t)slot_b * 128 + tid] = sb;
    }
    const int r = lane & 31, hh = lane >> 5;
#pragma unroll 1
    for (int dir = 0; dir < 2; ++dir) {
        const u16* Bt = dir ? KTb : KTf;
        u16* dst = CT + (size_t)(dir ? slot_b : slot_f) * 32768;
#pragma unroll 1
        for (int nh = 0; nh < 2; ++nh) {
            f32x16 acc[2][2] = {};
#pragma unroll
            for (int kk = 0; kk < 4; ++kk) {
                bf16x8 a[2], bq[2];
#pragma unroll
                for (int mi = 0; mi < 2; ++mi) a[mi] = *(const bf16x8*)(VT + (wid * 64 + mi * 32 + r) * LDT + kk * 16 + hh * 8);
#pragma unroll
                for (int ni = 0; ni < 2; ++ni) bq[ni] = *(const bf16x8*)(Bt + (nh * 64 + ni * 32 + r) * LDT + kk * 16 + hh * 8);
#pragma unroll
                for (int mi = 0; mi < 2; ++mi)
#pragma unroll
                    for (int ni = 0; ni < 2; ++ni) acc[mi][ni] = mfma32(bq[ni], a[mi], acc[mi][ni]);
            }
#pragma unroll
            for (int mi = 0; mi < 2; ++mi)
#pragma unroll
                for (int ni = 0; ni < 2; ++ni) {
                    u16* drow = dst + (wid * 64 + mi * 32 + r) * 128 + nh * 64 + ni * 32 + 4 * hh;
#pragma unroll
                    for (int g = 0; g < 4; ++g) {
                        u32x2 w; w.x = pk2(acc[mi][ni][4 * g], acc[mi][ni][4 * g + 1]); w.y = pk2(acc[mi][ni][4 * g + 2], acc[mi][ni][4 * g + 3]);
                        *(u32x2*)(drow + 8 * g) = w;
                    }
                }
        }
    }
    __syncthreads();
}

template <int NT, bool WIN>
__device__ __forceinline__ void na_block(const u16* Ks, const u16* VTs, const bf16x8 qa0, const bf16x8 qa1, const float* rpb  ,
                                         const int cs, const int k0, const int l15, const int l4, f32x4 (&O)[4], float& mrun, float& lrun) {
    f32x4 S[NT];
#pragma unroll
    for (int t = 0; t < NT; ++t) {
        S[t] = (f32x4){0.f, 0.f, 0.f, 0.f};
        const bf16x8 kf0 = *(const bf16x8*)(Ks + (k0 + t * 16 + l15) * LDT + l4 * 8), kf1 = *(const bf16x8*)(Ks + (k0 + t * 16 + l15) * LDT + 32 + l4 * 8);
        S[t] = mfma16(kf0, qa0, S[t]); S[t] = mfma16(kf1, qa1, S[t]);
    }
    if (WIN) {
#pragma unroll
        for (int t = 0; t < NT; ++t)
#pragma unroll
            for (int reg = 0; reg < 4; ++reg) {
                const int kc = k0 + t * 16 + l4 * 4 + reg;
                const bool valid = kc >= cs && kc < cs + 16;
                float bias = 0.f;
                if (valid) bias = rpb[kc];
                S[t][reg] = valid ? S[t][reg] + bias : -INFINITY;
            }
    }
    float mx = -INFINITY;
#pragma unroll
    for (int t = 0; t < NT; ++t) mx = fmaxf(mx, fmaxf(fmaxf(S[t][0], S[t][1]), fmaxf(S[t][2], S[t][3])));
    mx = fmaxf(mx, __shfl_xor(mx, 16)); mx = fmaxf(mx, __shfl_xor(mx, 32));
    const float mnew = fmaxf(mrun, mx);
    const float alpha = __expf(mrun - mnew);
    float ps = 0.f;
#pragma unroll
    for (int t = 0; t < NT; ++t)
#pragma unroll
        for (int reg = 0; reg < 4; ++reg) { const float pe = __expf(S[t][reg] - mnew); S[t][reg] = pe; ps += pe; }
    ps += __shfl_xor(ps, 16); ps += __shfl_xor(ps, 32);
    lrun = lrun * alpha + ps; mrun = mnew;
#pragma unroll
    for (int t = 0; t < 4; ++t) { O[t][0] *= alpha; O[t][1] *= alpha; O[t][2] *= alpha; O[t][3] *= alpha; }
#pragma unroll
    for (int s = 0; s < NT / 2; ++s) {
        u32x4 pb; pb.x = pk2(S[2 * s][0], S[2 * s][1]); pb.y = pk2(S[2 * s][2], S[2 * s][3]); pb.z = pk2(S[2 * s + 1][0], S[2 * s + 1][1]); pb.w = pk2(S[2 * s + 1][2], S[2 * s + 1][3]);
        const bf16x8 pfrag = __builtin_bit_cast(bf16x8, pb);
#pragma unroll
        for (int t = 0; t < 4; ++t) {
            const u16* vrow = VTs + (t * 16 + l15) * LDT + k0 + s * 32 + l4 * 4;
            const u32x2 v0 = *(const u32x2*)vrow, v1 = *(const u32x2*)(vrow + 16);
            u32x4 va; va.x = v0.x; va.y = v0.y; va.z = v1.x; va.w = v1.y;
            O[t] = mfma16(__builtin_bit_cast(bf16x8, va), pfrag, O[t]);
        }
    }
}
__device__ __forceinline__ void na_item(const Params& p, unsigned char* smem, const int it, unsigned& hb) {
    const int tid = opaque_tid(), lane = tid & 63, wid = tid >> 6;
    const int row = it & 255, h = (it >> 8) & 7, b = it >> 11;
    const u16* P = (const u16*)(p.ws + OFF_P);
    u16* YNA = (u16*)(p.ws + OFF_YNA);
    float* rpb_s = (float*)(smem + 36864);
    const int l15 = lane & 15, l4 = lane >> 4;
    const int qc = wid * 16 + l15;
    const size_t qtok = (size_t)b * TSEQ + row * 64 + qc;
    const u16* qsrc = P + qtok * PV + V_NQ + h * 64 + l4 * 8;
    const bf16x8 qa0 = *(const bf16x8*)qsrc, qa1 = *(const bf16x8*)(qsrc + 32);
    const int rs = min(max(row - 4, 0), 248);
    const int cs = min(max(qc - 8, 0), 48);
    const int kst = min(max((qc & ~15) - 8, 0), 32);
    for (int j = tid; j < 465; j += 256) rpb_s[j] = p.na_rpb[h * 465 + j];
    f32x4 O[4] = {};
    float mrun = -INFINITY, lrun = 0.f;
    u32x4 kreg[2]; u32x2 vreg[8];
    const int cgp = (tid >> 3) & 15, tg = tid & 7;
    {
        const int kbase = b * TSEQ + rs * 64;
#pragma unroll
        for (int i = 0; i < 2; ++i) { const int id = tid + i * 256; kreg[i] = *(const u32x4*)(P + (size_t)(kbase + (id >> 3)) * PV + V_NK + h * 64 + (id & 7) * 8); }
        const u16* src = P + (size_t)(kbase + tg * 8) * PV + V_NV + h * 64 + cgp * 4;
#pragma unroll
        for (int i = 0; i < 8; ++i) vreg[i] = *(const u32x2*)(src + (size_t)i * PV);
    }
    for (int blk = 0; blk < 12; ++blk) {
        u16* Ks = (u16*)(smem + (blk & 1) * 18432); u16* VTs = Ks + 4608;
#pragma unroll
        for (int i = 0; i < 2; ++i) { const int id = tid + i * 256; *(u32x4*)(Ks + (id >> 3) * LDT + (id & 7) * 8) = kreg[i]; }
        if (tid < 128) {
#pragma unroll
            for (int cc = 0; cc < 4; ++cc) *(u32x4*)(VTs + (cgp * 4 + cc) * LDT + tg * 8) = tr8(vreg, cc);
        }
        half_bar(smem, hb);
        if (blk + 1 < 12) {
            const int nb = blk + 1;
            const int kbase = nb < 8 ? b * TSEQ + (rs + nb) * 64 : NTOK + b * 256 + (nb - 8) * 64;
#pragma unroll
            for (int i = 0; i < 2; ++i) { const int id = tid + i * 256; kreg[i] = *(const u32x4*)(P + (size_t)(kbase + (id >> 3)) * PV + V_NK + h * 64 + (id & 7) * 8); }
            const u16* src = P + (size_t)(kbase + tg * 8) * PV + V_NV + h * 64 + cgp * 4;
#pragma unroll
            for (int i = 0; i < 8; ++i) vreg[i] = *(const u32x2*)(src + (size_t)i * PV);
        }
        if (blk < 8) na_block<2, true>(Ks, VTs, qa0, qa1, rpb_s + (rs + blk - row + 7) * 31 + 15 - qc, cs, kst, l15, l4, O, mrun, lrun);
        else         na_block<4, false>(Ks, VTs, qa0, qa1, rpb_s, cs, 0, l15, l4, O, mrun, lrun);
    }
    {
        const float il = 1.f / lrun;
#pragma unroll
        for (int t = 0; t < 4; ++t) {
            u32x2 w; w.x = pk2(O[t][0] * il, O[t][1] * il); w.y = pk2(O[t][2] * il, O[t][3] * il);
            *(u32x2*)(YNA + qtok * 512 + h * 64 + t * 16 + l4 * 4) = w;
        }
    }
    half_bar(smem, hb);
}

__device__ __forceinline__ int scan_cidx(int i, int dir) { return dir == 0 ? i : (i < 4 ? 3 - i : 263 - i); }
__device__ __forceinline__ void phase_scan(const Params& p, unsigned char* smem, unsigned& hb) {
    const int tid = opaque_tid(), lane = tid & 63, wid = tid >> 6;
    float* al = (float*)smem; float* be = al + 260;
    const float* gsum = (const float*)(p.ws + OFF_GS); const float* mloc = (const float*)(p.ws + OFF_ML);
    float* mprev = (float*)(p.ws + OFF_MP); float* dn = (float*)(p.ws + OFF_DN);
    for (int it = VB; it < 512; it += NVB) {
        const int bhd = it >> 5, eb = it & 31, dir = bhd & 1, slot0 = bhd * 260;
        if (wid == 0) {
            float g[5], ml[5]; int cc[5];
            float a = 0.f, b = -INFINITY;
#pragma unroll
            for (int j = 0; j < 5; ++j) {
                const int i = lane * 5 + j; const bool ok = i < 260;
                cc[j] = ok ? scan_cidx(i, dir) : 0;
                g[j] = ok ? gsum[slot0 + cc[j]] : 0.f; ml[j] = ok ? mloc[slot0 + cc[j]] : -INFINITY;
                b = fmaxf(b + g[j], ml[j]); a += g[j];
            }
#pragma unroll
            for (int o = 1; o < 64; o <<= 1) {
                const float pa = __shfl_up(a, o), pb = __shfl_up(b, o);
                if (lane >= o) { b = fmaxf(pb + a, b); a = pa + a; }
            }
            float ea = __shfl_up(a, 1), eb2 = __shfl_up(b, 1);
            if (lane == 0) { ea = 0.f; eb2 = -INFINITY; }
            float m = fmaxf(0.f + ea, eb2);
#pragma unroll
            for (int j = 0; j < 5; ++j) {
                const int i = lane * 5 + j;
                if (i < 260) {
                    const float mn = fmaxf(g[j] + m, ml[j]);
                    al[i] = __expf(g[j] + m - mn); be[i] = __expf(ml[j] - mn);
                    if (eb == 0) mprev[slot0 + cc[j]] = m;
                    m = mn;
                }
            }
        }
        half_bar(smem, hb);
        u32x2* basep = (u32x2*)(p.ws + OFF_CT) + (size_t)slot0 * 8192 + eb * 256 + tid;
        float C0 = 0.f, C1 = 0.f, C2 = 0.f, C3 = 0.f;
        for (int i = 0; i < 260; i += 13) {
            u32x2 v[13];
#pragma unroll
            for (int j = 0; j < 13; ++j) v[j] = basep[(size_t)scan_cidx(i + j, dir) * 8192];
#pragma unroll
            for (int j = 0; j < 13; ++j) {
                u32x2 o; o.x = pk2(C0, C1); o.y = pk2(C2, C3);
                basep[(size_t)scan_cidx(i + j, dir) * 8192] = o;
                const float a = al[i + j], bt = be[i + j];
                C0 = fmaf(a, C0, bt * bf_lo(v[j].x)); C1 = fmaf(a, C1, bt * bf_hi(v[j].x)); C2 = fmaf(a, C2, bt * bf_lo(v[j].y)); C3 = fmaf(a, C3, bt * bf_hi(v[j].y));
            }
        }
        if (eb == 0 && tid < 128) {
            float n = 0.f;
            for (int i = 0; i < 260; ++i) {
                float* q = dn + (size_t)(slot0 + scan_cidx(i, dir)) * 128 + tid;
                const float v = *q; *q = n; n = al[i] * n + be[i] * v;
            }
        }
        half_bar(smem, hb);
    }
}

__device__ __forceinline__ void mlstm_passC(const Params& p, unsigned char* smem, const int it) {
    const int tid = opaque_tid(), lane = tid & 63, wid = tid >> 6;
    const int cl = it & 255, bh = it >> 8, b = bh >> 2, h = bh & 3, c = cl + 4;
    const int base = b * TSEQ + cl * 64;
    const int slot_f = bh * 2 * 260 + c, slot_b = slot_f + 260;
    const u16* P = (const u16*)(p.ws + OFF_P); const float* G = (const float*)(p.ws + OFF_G);
    const float* mprev = (const float*)(p.ws + OFF_MP); const float* dn = (const float*)(p.ws + OFF_DN);
    const u16* CT = (const u16*)(p.ws + OFF_CT);
    u16* YM = (u16*)(p.ws + OFF_YM);
    u16* Ks = (u16*)smem;
    u16* CTf = (u16*)smem; u16* CTb = (u16*)(smem + 17408);
    u16* VTs = (u16*)(smem + 34816);
    float* ga = (float*)(smem + 44032);
    float *uf_s = ga, *Mf_s = ga + 64, *ub_s = ga + 128, *Mb_s = ga + 192, *clf = ga + 256, *clb = ga + 320, *wif = ga + 384, *wib = ga + 448;
    const int l15 = lane & 15, l4 = lane >> 4;
    if (wid == 0) {
        const float* g = G + (size_t)(base + lane) * 16;
        const float igf = g[h], ff = g[4 + h], igb = g[8 + h], fb = g[12 + h];
        const float lff = log_sigmoid_(ff), lfb = log_sigmoid_(fb);
        const float bfc = wave_incl_sum(lff, lane);
        const float uf = igf - bfc;
        const float pb = wave_incl_sum(lfb, lane), gb = __shfl(pb, 63);
        const float bb = gb - pb + lfb, ub = igb - bb;
        const float mpf = mprev[slot_f], mpb = mprev[slot_b];
        const float Mf = fmaxf(mpf, wave_prefix_max(uf, lane)), Mb = fmaxf(mpb, wave_suffix_max(ub, lane));
        uf_s[lane] = uf; Mf_s[lane] = Mf; clf[lane] = __expf(-(bfc + Mf)); wif[lane] = __expf(mpf - Mf);
        ub_s[lane] = ub; Mb_s[lane] = Mb; clb[lane] = __expf(-(bb + Mb)); wib[lane] = __expf(mpb - Mb);
    }
    const int t = wid * 16 + l15;
    const size_t tok = (size_t)base + t;
    bf16x8 qa[4];
    {
        const u16* qsrc = P + tok * PV + V_MQ + h * 128 + l4 * 8;
#pragma unroll
        for (int kk = 0; kk < 4; ++kk) qa[kk] = *(const bf16x8*)(qsrc + kk * 32);
    }
#pragma unroll
    for (int i = 0; i < 4; ++i) {
        const int id = tid + i * 256, kr = id >> 4, ch = id & 15;
        *(u32x4*)(Ks + kr * LDQ + ch * 8) = *(const u32x4*)(P + (size_t)(base + kr) * PV + V_MK + h * 128 + ch * 8);
    }
    __syncthreads();
    f32x4 S[4] = {};
#pragma unroll
    for (int st = 0; st < 4; ++st)
#pragma unroll
        for (int kk = 0; kk < 4; ++kk) {
            const bf16x8 kf = *(const bf16x8*)(Ks + (st * 16 + l15) * LDQ + kk * 32 + l4 * 8);
            S[st] = mfma16(kf, qa[kk], S[st]);
        }
    float qnf = 0.f, qnb = 0.f;
    {
        const float* nf = dn + (size_t)slot_f * 128; const float* nb = dn + (size_t)slot_b * 128;
#pragma unroll
        for (int kk = 0; kk < 4; ++kk)
#pragma unroll
            for (int j = 0; j < 8; ++j) {
                const int d = kk * 32 + l4 * 8 + j;
                const float qv = bf2f((u16)qa[kk][j]);
                qnf += qv * nf[d]; qnb += qv * nb[d];
            }
        qnf += __shfl_xor(qnf, 16); qnf += __shfl_xor(qnf, 32);
        qnb += __shfl_xor(qnb, 16); qnb += __shfl_xor(qnb, 32);
    }
    const float Mft = Mf_s[t], Mbt = Mb_s[t];
    float rsf = 0.f, rsb = 0.f;
    f32x4 PF[4], PB[4];
#pragma unroll
    for (int st = 0; st < 4; ++st) {
        const f32x4 uf4 = *(const f32x4*)(uf_s + st * 16 + l4 * 4), ub4 = *(const f32x4*)(ub_s + st * 16 + l4 * 4);
#pragma unroll
        for (int reg = 0; reg < 4; ++reg) {
            const int s = st * 16 + l4 * 4 + reg;
            const float sv = S[st][reg];
            const float pf = (s <= t) ? sv * __expf(uf4[reg] - Mft) : 0.f;
            const float pbv = (s >= t) ? sv * __expf(ub4[reg] - Mbt) : 0.f;
            rsf += pf; rsb += pbv; PF[st][reg] = pf; PB[st][reg] = pbv;
        }
    }
    rsf += __shfl_xor(rsf, 16); rsf += __shfl_xor(rsf, 32);
    rsb += __shfl_xor(rsb, 16); rsb += __shfl_xor(rsb, 32);
    const float wft = wif[t], wbt = wib[t];
    const float idf = 1.f / fmaxf(fabsf(rsf + wft * qnf), clf[t]), idb = 1.f / fmaxf(fabsf(rsb + wbt * qnb), clb[t]);
    bf16x8 pfr[2], qwf[4], qwb[4];
#pragma unroll
    for (int ss = 0; ss < 2; ++ss) {
        u32x4 pw;
        pw.x = pk2(PF[2 * ss][0] * idf + PB[2 * ss][0] * idb, PF[2 * ss][1] * idf + PB[2 * ss][1] * idb);
        pw.y = pk2(PF[2 * ss][2] * idf + PB[2 * ss][2] * idb, PF[2 * ss][3] * idf + PB[2 * ss][3] * idb);
        pw.z = pk2(PF[2 * ss + 1][0] * idf + PB[2 * ss + 1][0] * idb, PF[2 * ss + 1][1] * idf + PB[2 * ss + 1][1] * idb);
        pw.w = pk2(PF[2 * ss + 1][2] * idf + PB[2 * ss + 1][2] * idb, PF[2 * ss + 1][3] * idf + PB[2 * ss + 1][3] * idb);
        pfr[ss] = __builtin_bit_cast(bf16x8, pw);
    }
    {
        const float sf = wft * idf, sb = wbt * idb;
#pragma unroll
        for (int kk = 0; kk < 4; ++kk) {
            u32x4 of, ob;
            const float q0 = bf2f((u16)qa[kk][0]), q1 = bf2f((u16)qa[kk][1]), q2 = bf2f((u16)qa[kk][2]), q3 = bf2f((u16)qa[kk][3]);
            const float q4 = bf2f((u16)qa[kk][4]), q5 = bf2f((u16)qa[kk][5]), q6 = bf2f((u16)qa[kk][6]), q7 = bf2f((u16)qa[kk][7]);
            of.x = pk2(q0 * sf, q1 * sf); of.y = pk2(q2 * sf, q3 * sf); of.z = pk2(q4 * sf, q5 * sf); of.w = pk2(q6 * sf, q7 * sf);
            ob.x = pk2(q0 * sb, q1 * sb); ob.y = pk2(q2 * sb, q3 * sb); ob.z = pk2(q4 * sb, q5 * sb); ob.w = pk2(q6 * sb, q7 * sb);
            qwf[kk] = __builtin_bit_cast(bf16x8, of); qwb[kk] = __builtin_bit_cast(bf16x8, ob);
        }
    }
    __syncthreads();
    f32x4 hm[4][4];
#pragma unroll
    for (int vb = 0; vb < 4; ++vb) {
        if (tid < 128) {
            const int cgp = tid >> 3, tg = tid & 7;
            const u16* src = P + (size_t)(base + tg * 8) * PV + V_MV + h * 256 + vb * 64 + cgp * 4;
            u32x2 vv[8];
#pragma unroll
            for (int i = 0; i < 8; ++i) vv[i] = *(const u32x2*)(src + (size_t)i * PV);
#pragma unroll
            for (int cc = 0; cc < 4; ++cc) *(u32x4*)(VTs + (cgp * 4 + cc) * LDT + tg * 8) = tr8(vv, cc);
        }
#pragma unroll
        for (int i = 0; i < 4; ++i) {
            const int id = tid + i * 256, vr = id >> 4, ch = id & 15;
            *(u32x4*)(CTf + vr * LDQ + ch * 8) = *(const u32x4*)(CT + (size_t)slot_f * 32768 + (vb * 64 + vr) * 128 + ch * 8);
            *(u32x4*)(CTb + vr * LDQ + ch * 8) = *(const u32x4*)(CT + (size_t)slot_b * 32768 + (vb * 64 + vr) * 128 + ch * 8);
        }
        __syncthreads();
#pragma unroll
        for (int tv = 0; tv < 4; ++tv) {
            f32x4 a = {0.f, 0.f, 0.f, 0.f};
#pragma unroll
            for (int ss = 0; ss < 2; ++ss) {
                const u16* vrow = VTs + (tv * 16 + l15) * LDT + ss * 32 + l4 * 4;
                const u32x2 v0 = *(const u32x2*)vrow, v1 = *(const u32x2*)(vrow + 16);
                u32x4 va; va.x = v0.x; va.y = v0.y; va.z = v1.x; va.w = v1.y;
                a = mfma16(__builtin_bit_cast(bf16x8, va), pfr[ss], a);
            }
#pragma unroll
            for (int kk = 0; kk < 4; ++kk) {
                const bf16x8 cf = *(const bf16x8*)(CTf + (tv * 16 + l15) * LDQ + kk * 32 + l4 * 8);
                const bf16x8 cb = *(const bf16x8*)(CTb + (tv * 16 + l15) * LDQ + kk * 32 + l4 * 8);
                a = mfma16(cf, qwf[kk], a); a = mfma16(cb, qwb[kk], a);
            }
            hm[vb][tv] = a;
        }
        __syncthreads();
    }
    float ssq = 0.f;
#pragma unroll
    for (int vb = 0; vb < 4; ++vb)
#pragma unroll
        for (int tv = 0; tv < 4; ++tv) ssq += (hm[vb][tv][0] * hm[vb][tv][0] + hm[vb][tv][1] * hm[vb][tv][1]) + (hm[vb][tv][2] * hm[vb][tv][2] + hm[vb][tv][3] * hm[vb][tv][3]);
    ssq += __shfl_xor(ssq, 16); ssq += __shfl_xor(ssq, 32);
    const float rstd = rsqrtf(ssq * (1.f / 256.f) + 1e-6f);
#pragma unroll
    for (int vb = 0; vb < 4; ++vb)
#pragma unroll
        for (int tv = 0; tv < 4; ++tv) {
            const int v = h * 256 + vb * 64 + tv * 16 + l4 * 4;
            const u32x2 ov = *(const u32x2*)(P + tok * PV + V_MO + v);
            const f32x4 w = *(const f32x4*)(p.m_norm_w + v);
            u32x2 y;
            y.x = pk2(hm[vb][tv][0] * rstd * w.x * sigmoid_(bf_lo(ov.x)), hm[vb][tv][1] * rstd * w.y * sigmoid_(bf_hi(ov.x)));
            y.y = pk2(hm[vb][tv][2] * rstd * w.z * sigmoid_(bf_lo(ov.y)), hm[vb][tv][3] * rstd * w.w * sigmoid_(bf_hi(ov.y)));
            *(u32x2*)(YM + tok * 1024 + v) = y;
        }
}

__device__ __forceinline__ void phase_merge(const Params& p, unsigned char* smem) {
    const u16* P = (const u16*)(p.ws + OFF_P);
    const u16* YM = (const u16*)(p.ws + OFF_YM); const u16* YNA = (const u16*)(p.ws + OFF_YNA);
    u16* MRG = (u16*)(p.ws + OFF_MRG);
    const u16* wm = (const u16*)(p.ws + OFF_BRMT); const u16* wn = (const u16*)(p.ws + OFF_BRNT);
    const int tid = opaque_tid(), lane = tid & 63, wid = tid >> 6, wr = wid >> 1, wc = wid & 1;
    const int sw = ((tid & 7) ^ ((tid >> 4) & 7)) * 8;
    for (int ti = 0, nti = sched_rounds(256 * 8); ti < nti; ++ti) {
        int mt, nt;
        sched_tile(ti, 256, 8, 8, mt, nt);
        f32x16 acc[2][2] = {};
        gemm_core2(acc, YM + (size_t)(mt * 128 + (tid >> 3)) * 1024 + sw, 32 * 1024, wm + (size_t)(nt * 128 + (tid >> 3)) * 1024 + sw, 32 * 1024, 16, smem, tid, lane, wr, wc);
        u32 part[2][2][8];
#pragma unroll
        for (int mi = 0; mi < 2; ++mi)
#pragma unroll
            for (int ni = 0; ni < 2; ++ni)
#pragma unroll
                for (int q = 0; q < 8; ++q) { part[mi][ni][q] = pk2(acc[mi][ni][2 * q], acc[mi][ni][2 * q + 1]); acc[mi][ni][2 * q] = 0.f; acc[mi][ni][2 * q + 1] = 0.f; }
        __syncthreads();
        gemm_core2(acc, YNA + (size_t)(mt * 128 + (tid >> 3)) * 512 + sw, 32 * 512, wn + (size_t)(nt * 128 + (tid >> 3)) * 512 + sw, 32 * 512, 8, smem, tid, lane, wr, wc);
        u16* C1 = (u16*)smem; u16* C2 = (u16*)(smem + 34816);
        __syncthreads();
        {
            const int r = lane & 31, hh = lane >> 5;
#pragma unroll
            for (int mi = 0; mi < 2; ++mi)
#pragma unroll
                for (int ni = 0; ni < 2; ++ni) {
                    u16* base = C1 + (wr * 64 + mi * 32 + r) * CT_LD + wc * 64 + ni * 32 + 4 * hh;
#pragma unroll
                    for (int g = 0; g < 4; ++g) { u32x2 w; w.x = part[mi][ni][2 * g]; w.y = part[mi][ni][2 * g + 1]; *(u32x2*)(base + 8 * g) = w; }
                }
        }
        ct_write(C2, acc, wr, wc, lane);
        __syncthreads();
#pragma unroll 2
        for (int i = 0; i < 8; ++i) {
            const int idx = tid + i * 256, row = idx >> 4, ch = idx & 15;
            const size_t m = (size_t)mt * 128 + row;
            const u32x4 c1 = *(const u32x4*)(C1 + row * CT_LD + ch * 8), c2 = *(const u32x4*)(C2 + row * CT_LD + ch * 8);
            const u32x4 g1 = *(const u32x4*)(P + m * PV + V_GM + nt * 128 + ch * 8), g2 = *(const u32x4*)(P + m * PV + V_GN + nt * 128 + ch * 8);
            u32x4 w;
            w.x = pk2(bf_lo(c1.x) * bf_lo(g1.x) + bf_lo(c2.x) * bf_lo(g2.x), bf_hi(c1.x) * bf_hi(g1.x) + bf_hi(c2.x) * bf_hi(g2.x));
            w.y = pk2(bf_lo(c1.y) * bf_lo(g1.y) + bf_lo(c2.y) * bf_lo(g2.y), bf_hi(c1.y) * bf_hi(g1.y) + bf_hi(c2.y) * bf_hi(g2.y));
            w.z = pk2(bf_lo(c1.z) * bf_lo(g1.z) + bf_lo(c2.z) * bf_lo(g2.z), bf_hi(c1.z) * bf_hi(g1.z) + bf_hi(c2.z) * bf_hi(g2.z));
            w.w = pk2(bf_lo(c1.w) * bf_lo(g1.w) + bf_lo(c2.w) * bf_lo(g2.w), bf_hi(c1.w) * bf_hi(g1.w) + bf_hi(c2.w) * bf_hi(g2.w));
            *(u32x4*)(MRG + m * 1024 + nt * 128 + ch * 8) = w;
        }
        __syncthreads();
    }
}

__device__ __forceinline__ void phase_outproj(const Params& p, unsigned char* smem) {
    const u16* MRG = (const u16*)(p.ws + OFF_MRG);
    const int tid = opaque_tid(), lane = tid & 63, wid = tid >> 6, wr = wid >> 1, wc = wid & 1;
    const u16* wt = (const u16*)(p.ws + OFF_OUTT);
    const int sw = ((tid & 3) ^ ((tid >> 4) & 3)) * 8;
    for (int ti = 0, nti = sched_rounds(256 * 4); ti < nti; ++ti) {
        int mt, nt;
        sched_tile(ti, 256, 4, 4, mt, nt);
        f32x16 acc[2][4] = {};
        gemm_core3(acc, MRG + (size_t)(mt * 128 + (tid >> 2)) * 1024 + sw, 64 * 1024, wt + (size_t)(nt * 256 + (tid >> 2)) * 1024 + sw, 64 * 1024, 32, smem, tid, lane, wr, wc);
        u16* Ct = (u16*)smem;
        RAW_BARRIER();
        ct_write3(Ct, acc, wr, wc, lane);
        __syncthreads();
        {
            const int bvec = mt >> 7, ch = tid & 31;
            float g1[8];
#pragma unroll
            for (int j = 0; j < 8; ++j) g1[j] = mod_val(p, bvec, 2048 + nt * 256 + ch * 8 + j);
#pragma unroll 4
            for (int i = 0; i < 16; ++i) {
                const int row = (tid >> 5) + i * 8;
                const size_t off = ((size_t)mt * 128 + row) * 1024 + nt * 256 + ch * 8;
                const u32x4 cv = *(const u32x4*)(Ct + row * CT3_LD + ch * 8);
                const f32x4 x0 = *(const f32x4*)(p.x + off), x1 = *(const f32x4*)(p.x + off + 4);
                f32x4 o0, o1;
                o0.x = x0.x + g1[0] * bf_lo(cv.x); o0.y = x0.y + g1[1] * bf_hi(cv.x); o0.z = x0.z + g1[2] * bf_lo(cv.y); o0.w = x0.w + g1[3] * bf_hi(cv.y);
                o1.x = x1.x + g1[4] * bf_lo(cv.z); o1.y = x1.y + g1[5] * bf_hi(cv.z); o1.z = x1.z + g1[6] * bf_lo(cv.w); o1.w = x1.w + g1[7] * bf_hi(cv.w);
                *(f32x4*)(p.out + off) = o0; *(f32x4*)(p.out + off + 4) = o1;
            }
        }
        __syncthreads();
    }
}

__device__ __forceinline__ void phase_router(const Params& p, unsigned char* smem) {
    const u16* H = (const u16*)(p.ws + OFF_H);
    float* SC = (float*)(p.ws + OFF_SC);
    const int tid = opaque_tid(), lane = tid & 63, wid = tid >> 6, wr = wid >> 1, wc = wid & 1;
    const int r = lane & 31, hh = lane >> 5;
    const u16* wt = (const u16*)(p.ws + OFF_RTT);
    const int sw = ((tid & 7) ^ ((tid >> 4) & 7)) * 8;
    for (int ti = 0, nti = sched_rounds(256 * 2); ti < nti; ++ti) {
        int mt, nt;
        sched_tile(ti, 256, 2, 2, mt, nt);
        f32x16 acc[2][2] = {};
        gemm_core2(acc, H + (size_t)(mt * 128 + (tid >> 3)) * 1024 + sw, 32 * 1024, wt + (size_t)(nt * 128 + (tid >> 3)) * 1024 + sw, 32 * 1024, 16, smem, tid, lane, wr, wc);
#pragma unroll
        for (int mi = 0; mi < 2; ++mi)
#pragma unroll
            for (int ni = 0; ni < 2; ++ni) {
                float* srow = SC + ((size_t)mt * 128 + wr * 64 + mi * 32 + r) * 256 + nt * 128 + wc * 64 + ni * 32 + 4 * hh;
#pragma unroll
                for (int g = 0; g < 4; ++g) {
                    f32x4 o; o.x = sigmoid_(acc[mi][ni][4 * g]); o.y = sigmoid_(acc[mi][ni][4 * g + 1]); o.z = sigmoid_(acc[mi][ni][4 * g + 2]); o.w = sigmoid_(acc[mi][ni][4 * g + 3]);
                    *(f32x4*)(srow + 8 * g) = o;
                }
            }
        __syncthreads();
    }
}

template <bool SECOND> struct EpiMerge {
    static constexpr bool PERM = true;
    const u16* P; u16* MRG;
    __device__ __forceinline__ void operator()(const f32x4 (&acc)[2][2][4][2], const pg8::Unit& u, const int wr, const int wc, const int fr_, const int fq_) const {
        int fr = fr_, fq = fq_; asm volatile("" : "+v"(fr), "+v"(fq));
        const int col0 = u.pn * 256 + wc * 32 + fq * 8;
#pragma unroll
        for (int ai = 0; ai < 2; ++ai)
#pragma unroll
            for (int m = 0; m < 4; ++m) {
                const size_t row = (size_t)(u.pm * 256 + ai * 128 + wr * 64 + m * 16 + fr);
#pragma unroll
                for (int bj = 0; bj < 2; ++bj) {
                    const u32x4 gv = *(const u32x4*)(P + row * PV + (SECOND ? V_GN : V_GM) + col0 + bj * 128);
                    u16* q = MRG + row * 1024 + col0 + bj * 128;
                    const f32x4 v0 = acc[ai][bj][m][0], v1 = acc[ai][bj][m][1];
                    float o[8];
                    o[0] = v0[0] * bf_lo(gv.x); o[1] = v0[1] * bf_hi(gv.x); o[2] = v0[2] * bf_lo(gv.y); o[3] = v0[3] * bf_hi(gv.y);
                    o[4] = v1[0] * bf_lo(gv.z); o[5] = v1[1] * bf_hi(gv.z); o[6] = v1[2] * bf_lo(gv.w); o[7] = v1[3] * bf_hi(gv.w);
                    if (SECOND) {
                        const u32x4 pv = *(const u32x4*)q;
                        o[0] += bf_lo(pv.x); o[1] += bf_hi(pv.x); o[2] += bf_lo(pv.y); o[3] += bf_hi(pv.y); o[4] += bf_lo(pv.z); o[5] += bf_hi(pv.z); o[6] += bf_lo(pv.w); o[7] += bf_hi(pv.w);
                    }
                    u32x4 w; w.x = pk2(o[0], o[1]); w.y = pk2(o[2], o[3]); w.z = pk2(o[4], o[5]); w.w = pk2(o[6], o[7]);
                    *(u32x4*)q = w;
                }
                asm volatile("" ::: "memory");
            }
    }
};
__device__ __forceinline__ void phase_merge8(const Params& p, unsigned char* smem_all) {
    pg8::StaticOrder S; S.init(NTOK, 1024, (int)gridDim.x, (int)blockIdx.x);
    {
        pg8::Gemm g; g.A = (const u16*)(p.ws + OFF_YM); g.Bt = (const u16*)(p.ws + OFF_BRMT); g.M = NTOK; g.N = 1024; g.K = 1024;
        EpiMerge<false> E; E.P = (const u16*)(p.ws + OFF_P); E.MRG = (u16*)(p.ws + OFF_MRG);
        pg8::gemm_phase<EpiMerge<false>>((PG8_LAS unsigned char*)smem_all, g, S, E);
    }
    {
        pg8::Gemm g; g.A = (const u16*)(p.ws + OFF_YNA); g.Bt = (const u16*)(p.ws + OFF_BRNT); g.M = NTOK; g.N = 1024; g.K = 512;
        EpiMerge<true> E; E.P = (const u16*)(p.ws + OFF_P); E.MRG = (u16*)(p.ws + OFF_MRG);
        pg8::gemm_phase<EpiMerge<true>>((PG8_LAS unsigned char*)smem_all, g, S, E);
    }
}

struct EpiOut {
    static constexpr bool PERM = false;
    const float *x, *b_ada, *modp; float* out;
    __device__ __forceinline__ void operator()(const f32x4 (&acc)[2][2][4][2], const pg8::Unit& u, const int wr, const int wc, const int fr_, const int fq_) const {
        int fr = fr_, fq = fq_; asm volatile("" : "+v"(fr), "+v"(fq));
        const int col0 = u.pn * 256 + wc * 32 + fq * 4, bvec = u.pm >> 6;
        f32x4 g1[2][2];
#pragma unroll
        for (int bj = 0; bj < 2; ++bj)
#pragma unroll
            for (int n = 0; n < 2; ++n) {
                const int j = 2048 + col0 + bj * 128 + n * 16;
                f32x4 s = *(const f32x4*)(b_ada + j);
#pragma unroll
                for (int ks = 0; ks < 8; ++ks) s += *(const f32x4*)(modp + (ks * 3 + bvec) * 6144 + j);
                g1[bj][n] = s;
            }
#pragma unroll
        for (int ai = 0; ai < 2; ++ai)
#pragma unroll
            for (int m = 0; m < 4; ++m) {
                const size_t off = (size_t)(u.pm * 256 + ai * 128 + wr * 64 + m * 16 + fr) * 1024 + col0;
#pragma unroll
                for (int bj = 0; bj < 2; ++bj)
#pragma unroll
                    for (int n = 0; n < 2; ++n) {
                        const f32x4 xv = *(const f32x4*)(x + off + bj * 128 + n * 16);
                        *(f32x4*)(out + off + bj * 128 + n * 16) = xv + g1[bj][n] * acc[ai][bj][m][n];
                    }
                asm volatile("" ::: "memory");
            }
    }
};
__device__ __forceinline__ void phase_outproj8(const Params& p, unsigned char* smem_all) {
    pg8::Gemm g; g.A = (const u16*)(p.ws + OFF_MRG); g.Bt = (const u16*)(p.ws + OFF_OUTT); g.M = NTOK; g.N = 1024; g.K = 1024;
    pg8::StaticOrder S; S.init(g.M, g.N, (int)gridDim.x, (int)blockIdx.x);
    EpiOut E; E.x = p.x; E.b_ada = p.b_ada; E.modp = (const float*)(p.ws + OFF_MODP); E.out = p.out;
    pg8::gemm_phase<EpiOut>((PG8_LAS unsigned char*)smem_all, g, S, E);
}

struct EpiRouter {
    static constexpr bool PERM = false;
    float* SC;
    __device__ __forceinline__ void operator()(const f32x4 (&acc)[2][2][4][2], const pg8::Unit& u, const int wr, const int wc, const int fr_, const int fq_) const {
        int fr = fr_, fq = fq_; asm volatile("" : "+v"(fr), "+v"(fq));
        const int col0 = wc * 32 + fq * 4;
#pragma unroll
        for (int ai = 0; ai < 2; ++ai)
#pragma unroll
            for (int m = 0; m < 4; ++m) {
                float* srow = SC + (size_t)(u.pm * 256 + ai * 128 + wr * 64 + m * 16 + fr) * 256 + col0;
#pragma unroll
                for (int bj = 0; bj < 2; ++bj)
#pragma unroll
                    for (int n = 0; n < 2; ++n) {
                        const f32x4 v = acc[ai][bj][m][n];
                        f32x4 o; o.x = sigmoid_(v[0]); o.y = sigmoid_(v[1]); o.z = sigmoid_(v[2]); o.w = sigmoid_(v[3]);
                        *(f32x4*)(srow + bj * 128 + n * 16) = o;
                    }
            }
    }
};
__device__ __forceinline__ void phase_router8(const Params& p, unsigned char* smem_all) {
    pg8::Gemm g; g.A = (const u16*)(p.ws + OFF_H); g.Bt = (const u16*)(p.ws + OFF_RTT); g.M = NTOK; g.N = 256; g.K = 1024;
    pg8::StaticOrder S; S.init(g.M, g.N, (int)gridDim.x, (int)blockIdx.x);
    EpiRouter E; E.SC = (float*)(p.ws + OFF_SC);
    pg8::gemm_phase<EpiRouter>((PG8_LAS unsigned char*)smem_all, g, S, E);
}

__device__ __forceinline__ void phase_route(const Params& p, unsigned char* smem) {
    const int tid = opaque_tid(), lane = tid & 63, wid = tid >> 6;
    const float* SC = (const float*)(p.ws + OFF_SC);
    int* tope = (int*)(p.ws + OFF_TOPE); float* topw = (float*)(p.ws + OFF_TOPW);
    int* lh = (int*)smem;
    lh[tid] = 0;
    __syncthreads();
    const f32x4 rb = *(const f32x4*)(p.router_bias + lane * 4);
    for (int tok = VB * 4 + wid; tok < NTOK; tok += NVB * 4) {
        const f32x4 sc = *(const f32x4*)(SC + (size_t)tok * 256 + lane * 4);
        float s0 = sc.x + rb.x, s1 = sc.y + rb.y, s2 = sc.z + rb.z, s3 = sc.w + rb.w;
        float a1 = fmaxf(s0, s1), a2 = fminf(s0, s1);
        { const float b1 = fmaxf(s2, s3), b2 = fminf(s2, s3); const float n1 = fmaxf(a1, b1), n2 = fmaxf(fminf(a1, b1), fmaxf(a2, b2)); a1 = n1; a2 = n2; }
#pragma unroll
        for (int o = 1; o < 8; o <<= 1) {
            const float b1 = __shfl_xor(a1, o), b2 = __shfl_xor(a2, o);
            const float n1 = fmaxf(a1, b1), n2 = fmaxf(fminf(a1, b1), fmaxf(a2, b2)); a1 = n1; a2 = n2;
        }
        const float gs = a1 + a2; const int mygrp = lane >> 3;
        int gcnt = 0;
#pragma unroll
        for (int g = 0; g < 8; ++g) { const float og = __shfl(gs, g * 8); gcnt += (og > gs || (og == gs && g < mygrp)) ? 1 : 0; }
        const bool gsel = gcnt < 4;
        unsigned k0, k1, k2, k3;
        {
            const unsigned u0 = __float_as_uint(s0), u1 = __float_as_uint(s1), u2 = __float_as_uint(s2), u3 = __float_as_uint(s3);
            k0 = gsel ? (u0 ^ ((u0 >> 31) ? 0xffffffffu : 0x80000000u)) : 0u; k1 = gsel ? (u1 ^ ((u1 >> 31) ? 0xffffffffu : 0x80000000u)) : 0u;
            k2 = gsel ? (u2 ^ ((u2 >> 31) ? 0xffffffffu : 0x80000000u)) : 0u; k3 = gsel ? (u3 ^ ((u3 >> 31) ? 0xffffffffu : 0x80000000u)) : 0u;
        }
        unsigned T = 0u;
#pragma unroll 1
        for (int bit = 31; bit >= 0; --bit) {
            const unsigned trial = T | (1u << bit);
            const int cnt = __popcll(__ballot(k0 >= trial)) + __popcll(__ballot(k1 >= trial)) + __popcll(__ballot(k2 >= trial)) + __popcll(__ballot(k3 >= trial));
            if (cnt >= 8) T = trial;
        }
        const unsigned long long g0 = __ballot(k0 > T), g1 = __ballot(k1 > T), g2 = __ballot(k2 > T), g3 = __ballot(k3 > T);
        const unsigned long long e0 = __ballot(k0 == T), e1 = __ballot(k1 == T), e2 = __ballot(k2 == T), e3 = __ballot(k3 == T);
        const int need = 8 - (__popcll(g0) + __popcll(g1) + __popcll(g2) + __popcll(g3));
        const unsigned long long below = (1ull << lane) - 1ull;
        const int eb = __popcll(e0 & below) + __popcll(e1 & below) + __popcll(e2 & below) + __popcll(e3 & below);
        const int b0 = (int)((e0 >> lane) & 1ull), b1 = (int)((e1 >> lane) & 1ull), b2 = (int)((e2 >> lane) & 1ull);
        const bool t0 = k0 > T || (k0 == T && eb < need);
        const bool t1 = k1 > T || (k1 == T && eb + b0 < need);
        const bool t2 = k2 > T || (k2 == T && eb + b0 + b1 < need);
        const bool t3 = k3 > T || (k3 == T && eb + b0 + b1 + b2 < need);
        const unsigned long long m0 = __ballot(t0), m1 = __ballot(t1), m2 = __ballot(t2), m3 = __ballot(t3);
        const int kb = __popcll(m0 & below) + __popcll(m1 & below) + __popcll(m2 & below) + __popcll(m3 & below);
        const float wsum = wave_sum((t0 ? sc.x : 0.f) + (t1 ? sc.y : 0.f) + (t2 ? sc.z : 0.f) + (t3 ? sc.w : 0.f));
        const float wn = 2.5f / wsum;
        const int i0 = lane * 4;
        int kk = kb;
        if (t0) { atomicAdd(lh + i0, 1);     tope[tok * 8 + kk] = i0;     topw[tok * 8 + kk] = sc.x * wn; ++kk; }
        if (t1) { atomicAdd(lh + i0 + 1, 1); tope[tok * 8 + kk] = i0 + 1; topw[tok * 8 + kk] = sc.y * wn; ++kk; }
        if (t2) { atomicAdd(lh + i0 + 2, 1); tope[tok * 8 + kk] = i0 + 2; topw[tok * 8 + kk] = sc.z * wn; ++kk; }
        if (t3) { atomicAdd(lh + i0 + 3, 1); tope[tok * 8 + kk] = i0 + 3; topw[tok * 8 + kk] = sc.w * wn; ++kk; }
    }
    __syncthreads();
    ((int*)(p.ws + OFF_HIST))[VB * 256 + tid] = lh[tid];
}
__device__ __forceinline__ void phase_assign(const Params& p, unsigned char* smem) {
    const int tid = opaque_tid(), lane = tid & 63, wid = tid >> 6;
    int* offs = (int*)smem; int* lc = offs + 256;
    const int* hist = (const int*)(p.ws + OFF_HIST);
    int* slot_tok = (int*)(p.ws + OFF_SLOT);
    const int* tope = (const int*)(p.ws + OFF_TOPE); int* rnk = (int*)(p.ws + OFF_RANK);
    {
        int run = 0, mine = 0;
        const int nb = NVB, me = VB;
        for (int b0 = 0; b0 < nb; b0 += 8) {
            int v[8];
#pragma unroll
            for (int j = 0; j < 8; ++j) v[j] = (b0 + j < nb) ? hist[(b0 + j) * 256 + tid] : 0;
#pragma unroll
            for (int j = 0; j < 8; ++j) { if (b0 + j == me) mine = run; run += v[j]; }
        }
        offs[tid] = mine; lc[tid] = 0;
        if (me == 0) { ((int*)(p.ws + OFF_CNT))[tid] = run; lc[256 + tid] = run; }
    }
    __syncthreads();
    if (VB == 0 && tid == 0) {
        int* tab = (int*)(p.ws + OFF_TAB);
        int s = 0, q = 0;
        for (int e = 0; e < 256; ++e) { const int t = (lc[256 + e] + 127) >> 7; tab[e] = s; tab[260 + e] = q; s += t; q += (t + 1) >> 1; }
        tab[256] = s; tab[260 + 256] = q;
    }
    for (int tok = VB * 4 + wid; tok < NTOK; tok += NVB * 4) {
        if (lane < 8) {
            const int e = tope[tok * 8 + lane];
            const int rk = offs[e] + atomicAdd(lc + e, 1);
            rnk[tok * 8 + lane] = rk; slot_tok[(size_t)e * NTOK + rk] = tok;
        }
    }
}

__device__ __forceinline__ int* build_tile_table(const Params& p, unsigned char* smem) {
    int* tstart = (int*)(smem + 73728); int* cn = tstart + 260; int* pstart = cn + 256;
    const int tid = opaque_tid();
    cn[tid] = ((const int*)(p.ws + OFF_CNT))[tid];
    __syncthreads();
    if (tid == 0) {
        int s = 0, q = 0;
        for (int e = 0; e < 256; ++e) { const int t = (cn[e] + 127) >> 7; tstart[e] = s; pstart[e] = q; s += t; q += (t + 1) >> 1; }
        tstart[256] = s; pstart[256] = q;
    }
    __syncthreads();
    return tstart;
}
__device__ __forceinline__ int find_pair_expert(const int* pstart, int mp) {
    int lo = 0, hi = 256;
    while (hi - lo > 1) { const int mid = (lo + hi) >> 1; if (pstart[mid] <= mp) lo = mid; else hi = mid; }
    return lo;
}

__device__ __forceinline__ void gemm_core_m256(f32x16 (&acc)[4][2], const u16* abase, const int (&roff)[8], const float* bsrc, const size_t ldb, const int nk,
                                               unsigned char* smem, const int tid, const int lane, const int wr, const int wc) {
    typedef __attribute__((address_space(3))) unsigned lds_u32;
    unsigned char* Bs = smem + 65536;
    f32x4 br[8];
#pragma unroll
    for (int i = 0; i < 8; ++i) br[i] = *(const f32x4*)(bsrc + (size_t)i * ldb);
    {
        unsigned char* sa = smem + tid * 16;
#pragma unroll
        for (int i = 0; i < 8; ++i) __builtin_amdgcn_global_load_lds((const unsigned*)(abase + roff[i]), (lds_u32*)(sa + i * 4096), 16, 0, 0);
    }
    const int arow = tid >> 3, ach = tid & 7;
    const int r = lane & 31, hh = lane >> 5;
    for (int kt = 0; kt < nk; ++kt) {
#pragma unroll
        for (int cc = 0; cc < 4; ++cc) {
            u32x4 w; w.x = pk2(br[0][cc], br[1][cc]); w.y = pk2(br[2][cc], br[3][cc]); w.z = pk2(br[4][cc], br[5][cc]); w.w = pk2(br[6][cc], br[7][cc]);
            const int row = arow * 4 + cc;
            *(u32x4*)(Bs + row * 128 + ((ach ^ ((row >> 1) & 7)) * 16)) = w;
        }
        __syncthreads();
        if (kt + 1 < nk) {
            unsigned char* sa = smem + ((kt + 1) & 1) * 32768 + tid * 16;
#pragma unroll
            for (int i = 0; i < 8; ++i) __builtin_amdgcn_global_load_lds((const unsigned*)(abase + roff[i] + (kt + 1) * 64), (lds_u32*)(sa + i * 4096), 16, 0, 0);
            const float* bp = bsrc + (size_t)(kt + 1) * 64 * ldb;
#pragma unroll
            for (int i = 0; i < 8; ++i) br[i] = *(const f32x4*)(bp + (size_t)i * ldb);
        }
        const unsigned char* sa = smem + (kt & 1) * 32768;
        __builtin_amdgcn_s_setprio(1);
#pragma unroll 1
        for (int kk = 0; kk < 4; ++kk) {
            bf16x8 a[4], b[2];
            const int ch = ((kk * 2 + hh) ^ ((r >> 1) & 7)) * 16;
#pragma unroll
            for (int mi = 0; mi < 4; ++mi) a[mi] = *(const bf16x8*)(sa + (wr * 128 + mi * 32 + r) * 128 + ch);
#pragma unroll
            for (int ni = 0; ni < 2; ++ni) b[ni] = *(const bf16x8*)(Bs + (wc * 64 + ni * 32 + r) * 128 + ch);
#pragma unroll
            for (int mi = 0; mi < 4; ++mi)
#pragma unroll
                for (int ni = 0; ni < 2; ++ni) acc[mi][ni] = mfma32(b[ni], a[mi], acc[mi][ni]);
        }
        __builtin_amdgcn_s_setprio(0);
        __syncthreads();
    }
}

__device__ __forceinline__ void phase_moe1(const Params& p, unsigned char* smem) {
    const int* tstart = (const int*)(p.ws + OFF_TAB); const int* pstart = tstart + 260; const int* cn = (const int*)(p.ws + OFF_CNT);
    const u16* H2 = (const u16*)(p.ws + OFF_H);
    const int* slot_tok = (const int*)(p.ws + OFF_SLOT);
    u16* HID = (u16*)(p.ws + OFF_HID);
    const int tid = opaque_tid(), lane = tid & 63, wid = tid >> 6, wr = wid >> 1, wc = wid & 1;
    const int r = lane & 31, hh = lane >> 5;
    const int totalp = pstart[256];
    const int nitems = totalp * 4 + 512;
    const int sw = ((tid & 7) ^ ((tid >> 4) & 7)) * 8;
    for (int ii = 0, nii = sched_rounds(nitems); ii < nii; ++ii) {
        const int it = min(xcd_index(ii), nitems - 1);
        const bool shared = it >= totalp * 4;
        const int idx = shared ? it - totalp * 4 : it;
        const int mp = idx >> 2, nq = idx & 3;
        int e = 0, jp = 0, cnt_e = 0, vrows = 256;
        size_t hrow0;
        if (!shared) {
            e = find_pair_expert(pstart, mp); jp = mp - pstart[e]; cnt_e = cn[e];
            const int te = (cnt_e + 127) >> 7;
            vrows = (2 * jp + 1 < te) ? 256 : 128;
            hrow0 = (size_t)tstart[e] * 128 + jp * 256;
        } else hrow0 = (size_t)SH_BASE + mp * 256;
        int roff[8];
#pragma unroll
        for (int i = 0; i < 8; ++i) {
            const int ri = (tid >> 3) + 32 * i;
            int tok;
            if (shared) tok = mp * 256 + ri;
            else { const int pos = jp * 256 + ri; tok = pos < cnt_e ? slot_tok[(size_t)e * NTOK + pos] : 0; }
            roff[i] = tok * 1024 + sw;
        }
        const int R0 = (tid >> 3) * 4, bwc = R0 >> 6, bni = (R0 >> 5) & 1, bj = R0 & 31;
        const float* wsel = shared ? (bni ? p.w_sh_up : p.w_sh_gate) : ((bni ? p.w_exp_up : p.w_exp_gate) + (size_t)e * 1024 * 256);
        const float* bsrc = wsel + (size_t)((tid & 7) * 8) * 256 + nq * 64 + bwc * 32 + bj;
        f32x16 acc[4][2] = {};
        gemm_core_m256(acc, H2, roff, bsrc, 256, 16, smem, tid, lane, wr, wc);
        u16* Ct = (u16*)smem;
#pragma unroll
        for (int mi = 0; mi < 4; ++mi) {
            u16* base = Ct + (wr * 128 + mi * 32 + r) * LDT + wc * 32 + 4 * hh;
#pragma unroll
            for (int g = 0; g < 4; ++g) {
                float hv[4];
#pragma unroll
                for (int j = 0; j < 4; ++j) { const float gt = acc[mi][0][4 * g + j], u = acc[mi][1][4 * g + j]; hv[j] = gt * sigmoid_(gt) * u; }
                u32x2 w; w.x = pk2(hv[0], hv[1]); w.y = pk2(hv[2], hv[3]);
                *(u32x2*)(base + 8 * g) = w;
            }
        }
        __syncthreads();
#pragma unroll
        for (int i = 0; i < 8; ++i) {
            const int id2 = tid + i * 256, row = id2 >> 3, ch = id2 & 7;
            if (row < vrows) *(u32x4*)(HID + (hrow0 + row) * 256 + nq * 64 + ch * 8) = *(const u32x4*)(Ct + row * LDT + ch * 8);
        }
        __syncthreads();
    }
}

__device__ __forceinline__ void phase_moe2(const Params& p, unsigned char* smem) {
    const int* tstart = (const int*)(p.ws + OFF_TAB); const int* pstart = tstart + 260; const int* cn = (const int*)(p.ws + OFF_CNT);
    const u16* HID = (const u16*)(p.ws + OFF_HID);
    u16* Y = (u16*)(p.ws + OFF_Y);
    const int tid = opaque_tid(), lane = tid & 63, wid = tid >> 6, wr = wid >> 1, wc = wid & 1;
    const int r = lane & 31, hh = lane >> 5;
    const int totalp = pstart[256];
    const int nitems = totalp * 8 + 1024;
    const int sw = ((tid & 7) ^ ((tid >> 4) & 7)) * 8;
    for (int ii = 0, nii = sched_rounds(nitems); ii < nii; ++ii) {
        const int it = min(xcd_index(ii), nitems - 1);
        const bool shared = it >= totalp * 8;
        const int idx = shared ? it - totalp * 8 : it;
        const int mp = idx >> 3, nt = idx & 7;
        int e = 0, vrows = 256;
        size_t hrow0;
        if (!shared) {
            e = find_pair_expert(pstart, mp); const int jp = mp - pstart[e];
            const int te = (cn[e] + 127) >> 7;
            vrows = (2 * jp + 1 < te) ? 256 : 128;
            hrow0 = (size_t)tstart[e] * 128 + jp * 256;
        } else hrow0 = (size_t)SH_BASE + mp * 256;
        int roff[8];
#pragma unroll
        for (int i = 0; i < 8; ++i) {
            const int ri = (tid >> 3) + 32 * i;
            roff[i] = (int)(hrow0 + (ri < vrows ? ri : ri - 128)) * 256 + sw;
        }
        const float* wsel = shared ? p.w_sh_down : p.w_exp_down + (size_t)e * 256 * 1024;
        const float* bsrc = wsel + (size_t)((tid & 7) * 8) * 1024 + nt * 128 + (tid >> 3) * 4;
        f32x16 acc[4][2] = {};
        gemm_core_m256(acc, HID, roff, bsrc, 1024, 4, smem, tid, lane, wr, wc);
        u16* Ct = (u16*)smem;
#pragma unroll
        for (int mi = 0; mi < 4; ++mi)
#pragma unroll
            for (int ni = 0; ni < 2; ++ni) {
                u16* base = Ct + (wr * 128 + mi * 32 + r) * CT_LD + wc * 64 + ni * 32 + 4 * hh;
#pragma unroll
                for (int g = 0; g < 4; ++g) {
                    u32x2 w; w.x = pk2(acc[mi][ni][4 * g], acc[mi][ni][4 * g + 1]); w.y = pk2(acc[mi][ni][4 * g + 2], acc[mi][ni][4 * g + 3]);
                    *(u32x2*)(base + 8 * g) = w;
                }
            }
        __syncthreads();
#pragma unroll 4
        for (int i = 0; i < 16; ++i) {
            const int id2 = tid + i * 256, row = id2 >> 4, ch = id2 & 15;
            if (row < vrows) *(u32x4*)(Y + (hrow0 + row) * 1024 + nt * 128 + ch * 8) = *(const u32x4*)(Ct + row * CT_LD + ch * 8);
        }
        __syncthreads();
    }
}

__device__ __forceinline__ void gemm_core_m256w8(f32x16 (&acc)[4][2], const u16* abase, const int (&roff)[4], const float* bsrc, const size_t ldb, const int nk,
                                                 unsigned char* lds, const int t512, const int lane, const int wr, const int wc) {
    typedef __attribute__((address_space(3))) unsigned lds_u32;
    f32x4 br[8];
#pragma unroll
    for (int i = 0; i < 8; ++i) br[i] = *(const f32x4*)(bsrc + (size_t)i * ldb);
    {
        unsigned char* sa = lds + t512 * 16;
#pragma unroll
        for (int i = 0; i < 4; ++i) __builtin_amdgcn_global_load_lds((const unsigned*)(abase + roff[i]), (lds_u32*)(sa + i * 8192), 16, 0, 0);
    }
    const int arow = t512 >> 3, ach = t512 & 7;
    const int r = lane & 31, hh = lane >> 5;
    for (int kt = 0; kt < nk; ++kt) {
        unsigned char* Bs = lds + 65536 + (kt & 1) * 32768;
#pragma unroll
        for (int cc = 0; cc < 4; ++cc) {
            u32x4 w; w.x = pk2(br[0][cc], br[1][cc]); w.y = pk2(br[2][cc], br[3][cc]); w.z = pk2(br[4][cc], br[5][cc]); w.w = pk2(br[6][cc], br[7][cc]);
            const int row = arow * 4 + cc;
            *(u32x4*)(Bs + row * 128 + ((ach ^ ((row >> 1) & 7)) * 16)) = w;
        }
        __syncthreads();
        if (kt + 1 < nk) {
            unsigned char* sa = lds + ((kt + 1) & 1) * 32768 + t512 * 16;
#pragma unroll
            for (int i = 0; i < 4; ++i) __builtin_amdgcn_global_load_lds((const unsigned*)(abase + roff[i] + (kt + 1) * 64), (lds_u32*)(sa + i * 8192), 16, 0, 0);
            const float* bp = bsrc + (size_t)(kt + 1) * 64 * ldb;
#pragma unroll
            for (int i = 0; i < 8; ++i) br[i] = *(const f32x4*)(bp + (size_t)i * ldb);
        }
        const unsigned char* sa = lds + (kt & 1) * 32768;
        __builtin_amdgcn_s_setprio(1);
#pragma unroll 1
        for (int kk = 0; kk < 4; ++kk) {
            bf16x8 a[4], b[2];
            const int ch = ((kk * 2 + hh) ^ ((r >> 1) & 7)) * 16;
#pragma unroll
            for (int mi = 0; mi < 4; ++mi) a[mi] = *(const bf16x8*)(sa + (wr * 128 + mi * 32 + r) * 128 + ch);
#pragma unroll
            for (int ni = 0; ni < 2; ++ni) b[ni] = *(const bf16x8*)(Bs + (wc * 64 + ni * 32 + r) * 128 + ch);
#pragma unroll
            for (int mi = 0; mi < 4; ++mi)
#pragma unroll
                for (int ni = 0; ni < 2; ++ni) acc[mi][ni] = mfma32(b[ni], a[mi], acc[mi][ni]);
        }
        __builtin_amdgcn_s_setprio(0);
    }
    __syncthreads();
}
__device__ __forceinline__ int opaque_t512() { int t = threadIdx.x; asm volatile("" : "+v"(t)); return t; }

__device__ __forceinline__ void phase_moe1w8(const Params& p, unsigned char* lds) {
    const int* tstart = (const int*)(p.ws + OFF_TAB); const int* pstart = tstart + 260; const int* cn = (const int*)(p.ws + OFF_CNT);
    const u16* H2 = (const u16*)(p.ws + OFF_H);
    const int* slot_tok = (const int*)(p.ws + OFF_SLOT);
    u16* HID = (u16*)(p.ws + OFF_HID);
    const int t512 = opaque_t512(), lane = t512 & 63, wid = t512 >> 6, wr = wid >> 2, wc = wid & 3;
    const int r = lane & 31, hh = lane >> 5;
    const int totalp = pstart[256];
    const int nitems = totalp * 2 + 256;
    const int sw = ((t512 & 7) ^ ((t512 >> 4) & 7)) * 8;
    for (int ii = 0;; ++ii) {
        const int it = ((blockIdx.x & 7) + 8 * ii) * (gridDim.x >> 3) + (blockIdx.x >> 3);
        if (it >= nitems) break;
        const bool shared = it >= totalp * 2;
        const int idx = shared ? it - totalp * 2 : it;
        const int mp = idx >> 1, nq = idx & 1;
        int e = 0, jp = 0, cnt_e = 0, vrows = 256;
        size_t hrow0;
        if (!shared) {
            e = find_pair_expert(pstart, mp); jp = mp - pstart[e]; cnt_e = cn[e];
            const int te = (cnt_e + 127) >> 7;
            vrows = (2 * jp + 1 < te) ? 256 : 128;
            hrow0 = (size_t)tstart[e] * 128 + jp * 256;
        } else hrow0 = (size_t)SH_BASE + mp * 256;
        int roff[4];
#pragma unroll
        for (int i = 0; i < 4; ++i) {
            const int ri = (t512 >> 3) + 64 * i;
            int tok;
            if (shared) tok = mp * 256 + ri;
            else { const int pos = jp * 256 + ri; tok = pos < cnt_e ? slot_tok[(size_t)e * NTOK + pos] : 0; }
            roff[i] = tok * 1024 + sw;
        }
        const int R0 = (t512 >> 3) * 4, bwc = R0 >> 6, bni = (R0 >> 5) & 1, bj = R0 & 31;
        const float* wsel = shared ? (bni ? p.w_sh_up : p.w_sh_gate) : ((bni ? p.w_exp_up : p.w_exp_gate) + (size_t)e * 1024 * 256);
        const float* bsrc = wsel + (size_t)((t512 & 7) * 8) * 256 + nq * 128 + bwc * 32 + bj;
        f32x16 acc[4][2] = {};
        gemm_core_m256w8(acc, H2, roff, bsrc, 256, 16, lds, t512, lane, wr, wc);
        u16* Ct = (u16*)lds;
#pragma unroll
        for (int mi = 0; mi < 4; ++mi) {
            u16* base = Ct + (wr * 128 + mi * 32 + r) * CT_LD + wc * 32 + 4 * hh;
#pragma unroll
            for (int g = 0; g < 4; ++g) {
                float hv[4];
#pragma unroll
                for (int j = 0; j < 4; ++j) { const float gt = acc[mi][0][4 * g + j], u = acc[mi][1][4 * g + j]; hv[j] = gt * sigmoid_(gt) * u; }
                u32x2 w; w.x = pk2(hv[0], hv[1]); w.y = pk2(hv[2], hv[3]);
                *(u32x2*)(base + 8 * g) = w;
            }
        }
        __syncthreads();
#pragma unroll
        for (int i = 0; i < 8; ++i) {
            const int id2 = t512 + i * 512, row = id2 >> 4, ch = id2 & 15;
            if (row < vrows) *(u32x4*)(HID + (hrow0 + row) * 256 + nq * 128 + ch * 8) = *(const u32x4*)(Ct + row * CT_LD + ch * 8);
        }
        __syncthreads();
    }
}

constexpr int CT8_LD = 264;
__device__ __forceinline__ void phase_moe2w8(const Params& p, unsigned char* lds) {
    const int* tstart = (const int*)(p.ws + OFF_TAB); const int* pstart = tstart + 260; const int* cn = (const int*)(p.ws + OFF_CNT);
    const u16* HID = (const u16*)(p.ws + OFF_HID);
    u16* Y = (u16*)(p.ws + OFF_Y);
    const int t512 = opaque_t512(), lane = t512 & 63, wid = t512 >> 6, wr = wid >> 2, wc = wid & 3;
    const int r = lane & 31, hh = lane >> 5;
    const int totalp = pstart[256];
    const int nitems = totalp * 4 + 512;
    const int sw = ((t512 & 7) ^ ((t512 >> 4) & 7)) * 8;
    for (int ii = 0;; ++ii) {
        const int it = ((blockIdx.x & 7) + 8 * ii) * (gridDim.x >> 3) + (blockIdx.x >> 3);
        if (it >= nitems) break;
        const bool shared = it >= totalp * 4;
        const int idx = shared ? it - totalp * 4 : it;
        const int mp = idx >> 2, nt = idx & 3;
        int e = 0, vrows = 256;
        size_t hrow0;
        if (!shared) {
            e = find_pair_expert(pstart, mp); const int jp = mp - pstart[e];
            const int te = (cn[e] + 127) >> 7;
            vrows = (2 * jp + 1 < te) ? 256 : 128;
            hrow0 = (size_t)tstart[e] * 128 + jp * 256;
        } else hrow0 = (size_t)SH_BASE + mp * 256;
        int roff[4];
#pragma unroll
        for (int i = 0; i < 4; ++i) {
            const int ri = (t512 >> 3) + 64 * i;
            roff[i] = (int)(hrow0 + (ri < vrows ? ri : ri - 128)) * 256 + sw;
        }
        const float* wsel = shared ? p.w_sh_down : p.w_exp_down + (size_t)e * 256 * 1024;
        const float* bsrc = wsel + (size_t)((t512 & 7) * 8) * 1024 + nt * 256 + (t512 >> 3) * 4;
        f32x16 acc[4][2] = {};
        gemm_core_m256w8(acc, HID, roff, bsrc, 1024, 4, lds, t512, lane, wr, wc);
        u16* Ct = (u16*)lds;
#pragma unroll
        for (int mi = 0; mi < 4; ++mi)
#pragma unroll
            for (int ni = 0; ni < 2; ++ni) {
                u16* base = Ct + (wr * 128 + mi * 32 + r) * CT8_LD + wc * 64 + ni * 32 + 4 * hh;
#pragma unroll
                for (int g = 0; g < 4; ++g) {
                    u32x2 w; w.x = pk2(acc[mi][ni][4 * g], acc[mi][ni][4 * g + 1]); w.y = pk2(acc[mi][ni][4 * g + 2], acc[mi][ni][4 * g + 3]);
                    *(u32x2*)(base + 8 * g) = w;
                }
            }
        __syncthreads();
#pragma unroll 4
        for (int i = 0; i < 16; ++i) {
            const int id2 = t512 + i * 512, row = id2 >> 5, ch = id2 & 31;
            if (row < vrows) *(u32x4*)(Y + (hrow0 + row) * 1024 + nt * 256 + ch * 8) = *(const u32x4*)(Ct + row * CT8_LD + ch * 8);
        }
        __syncthreads();
    }
}

__device__ __forceinline__ void phase_combine(const Params& p, unsigned char* smem) {
    const int* tstart = build_tile_table(p, smem);
    float* g2t = (float*)smem;
    const int tid = opaque_tid(), lane = tid & 63, wid = tid >> 6;
    for (int j = tid; j < 2048; j += 256) g2t[j] = mod_val(p, j >> 10, 5120 + (j & 1023));
    __syncthreads();
    const u16* Y = (const u16*)(p.ws + OFF_Y);
    const int* tope = (const int*)(p.ws + OFF_TOPE); const int* rnk = (const int*)(p.ws + OFF_RANK); const float* topw = (const float*)(p.ws + OFF_TOPW);
    for (int tok = VB * 4 + wid; tok < NTOK; tok += NVB * 4) {
        int myrow = 0; float myw = 0.f;
        if (lane < 8) { const int e = tope[tok * 8 + lane]; myrow = tstart[e] * 128 + rnk[tok * 8 + lane]; myw = topw[tok * 8 + lane]; }
        if (lane == 8) { myrow = SH_BASE + tok; myw = 1.f; }
        const float* g2 = g2t + (tok >> 14) * 1024;
        f32x4 a[4];
#pragma unroll
        for (int j = 0; j < 4; ++j) a[j] = (f32x4){0.f, 0.f, 0.f, 0.f};
#pragma unroll
        for (int k = 0; k < 9; ++k) {
            const int row = __shfl(myrow, k); const float w = __shfl(myw, k);
            const u16* yr = Y + (size_t)row * 1024 + lane * 4;
#pragma unroll
            for (int j = 0; j < 4; ++j) {
                const u32x2 v = *(const u32x2*)(yr + j * 256);
                a[j].x += w * bf_lo(v.x); a[j].y += w * bf_hi(v.x); a[j].z += w * bf_lo(v.y); a[j].w += w * bf_hi(v.y);
            }
        }
#pragma unroll
        for (int j = 0; j < 4; ++j) {
            const int col = j * 256 + lane * 4;
            float* op = p.out + (size_t)tok * 1024 + col;
            const f32x4 x1 = *(const f32x4*)op, g = *(const f32x4*)(g2 + col);
            f32x4 o; o.x = x1.x + g.x * a[j].x; o.y = x1.y + g.y * a[j].y; o.z = x1.z + g.z * a[j].z; o.w = x1.w + g.w * a[j].w;
            *(f32x4*)op = o;
        }
    }
}

#define XB_TMO      128
#define XB_XCNT(j)  (256  + 64 * (j))
#define XB_XSUB(j)  (1280 + 64 * (j))
#define XB_XGEN(j)  (2304 + 64 * (j))
#define XB_TOP      3328
#define XB_TOPGEN   3392
#define XCD_BAR_WORDS 3456
#define XB_SPIN_CAP (1u << 24)
__device__ __forceinline__ unsigned xb_ld(unsigned* p)              { return __hip_atomic_load(p, __ATOMIC_RELAXED, __HIP_MEMORY_SCOPE_AGENT); }
__device__ __forceinline__ unsigned xb_add(unsigned* p, unsigned v) { return __hip_atomic_fetch_add(p, v, __ATOMIC_RELAXED, __HIP_MEMORY_SCOPE_AGENT); }
__device__ __forceinline__ unsigned xb_xcc_id() { return (unsigned)__builtin_amdgcn_s_getreg((3 << 11) | 20) & 0xFu; }
#define XB_SPIN(cond, bar) do { unsigned _sp = 0; while (cond) { __builtin_amdgcn_s_sleep(1); \
    if ((++_sp & 255u) == 0u) { if (xb_ld(&(bar)[XB_TMO])) break; if (_sp > XB_SPIN_CAP) { atomicAdd(&(bar)[XB_TMO], 1u); break; } } } } while (0)
struct XcdBarrier { unsigned* bar; unsigned x; unsigned* st; };
__device__ __forceinline__ XcdBarrier xcd_barrier_post(unsigned* bar, unsigned* st) {
    XcdBarrier b; b.bar = bar; b.x = xb_xcc_id(); b.st = st;
    if (threadIdx.x == 0) (void)xb_add(&bar[XB_XCNT(b.x)], 1u);
    return b;
}
__device__ __forceinline__ void xcd_barrier_complete(unsigned* bar, unsigned x, unsigned& nloc, unsigned& nx) {
    const unsigned G = gridDim.x * gridDim.y * gridDim.z;
    unsigned sum, cnt, mine, sp = 0u;
    for (;;) {
        sum = 0u; cnt = 0u; mine = 0u;
#pragma unroll
        for (unsigned j = 0; j < 16; ++j) { const unsigned c = xb_ld(&bar[XB_XCNT(j)]); sum += c; cnt += (c > 0u) ? 1u : 0u; mine = (j == x) ? c : mine; }
        if (sum == G) break;
        __builtin_amdgcn_s_sleep(1);
        if ((++sp & 255u) == 0u) { if (xb_ld(&bar[XB_TMO])) break; if (sp > XB_SPIN_CAP) { atomicAdd(&bar[XB_TMO], 1u); break; } }
    }
    nloc = mine > 0u ? mine : 1u; nx = cnt > 0u ? cnt : 1u;
}
__device__ __forceinline__ void xcd_barrier(const XcdBarrier& b) {
    asm volatile("s_waitcnt vmcnt(0)" ::: "memory");
    __syncthreads();
    if (threadIdx.x == 0) {
        unsigned* bar = b.bar;
        __builtin_amdgcn_s_waitcnt(0);
        unsigned nloc = xb_ld(b.st), nx = xb_ld(b.st + 1);
        if (nloc == 0u) { xcd_barrier_complete(bar, b.x, nloc, nx); __hip_atomic_store(b.st, nloc, __ATOMIC_RELAXED, __HIP_MEMORY_SCOPE_AGENT); __hip_atomic_store(b.st + 1, nx, __ATOMIC_RELAXED, __HIP_MEMORY_SCOPE_AGENT); }
        const unsigned old = xb_add(&bar[XB_XSUB(b.x)], 1u);
        const unsigned gen = old / nloc;
        if (old + 1u == (gen + 1u) * nloc) {
            __builtin_amdgcn_fence(__ATOMIC_RELEASE, "agent");
            asm volatile("s_waitcnt vmcnt(0)" ::: "memory");
            const unsigned og = xb_add(&bar[XB_TOP], 1u);
            const unsigned tg = og / nx;
            if (og + 1u == (tg + 1u) * nx) xb_add(&bar[XB_TOPGEN], 1u);
            else XB_SPIN(xb_ld(&bar[XB_TOPGEN]) == tg, bar);
            __builtin_amdgcn_fence(__ATOMIC_ACQUIRE, "agent");
            xb_add(&bar[XB_XGEN(b.x)], 1u);
            asm volatile("s_waitcnt vmcnt(0)" ::: "memory");
        } else {
            XB_SPIN(xb_ld(&bar[XB_XGEN(b.x)]) == gen, bar);
            __builtin_amdgcn_fence(__ATOMIC_ACQUIRE, "agent");
            asm volatile("s_waitcnt vmcnt(0)" ::: "memory");
        }
    }
    __syncthreads();
}

__global__ void __launch_bounds__(512, 2) mega(Params p) {
    extern __shared__ __attribute__((aligned(16))) unsigned char smem_all[];
    unsigned char* smem = smem_all + __builtin_amdgcn_readfirstlane(threadIdx.x >> 8) * HALF_LDS;
    cg::grid_group grid = cg::this_grid();
    if (p.ph_lo < 0) grid.sync();
    const XcdBarrier xb = xcd_barrier_post((unsigned*)(p.ws + OFF_BAR), (unsigned*)(p.ws + OFF_BAR + 16384) + blockIdx.x * 2);
#define GSYNC() xcd_barrier(xb)
#define PHASE_BEGIN(k) if (p.ph_lo <= (k) && (k) < p.ph_hi) {
#define PHASE_END(k) if ((k) + 1 < p.ph_hi) GSYNC(); }
    PHASE_BEGIN(0) phase_ada(p, smem); if (DUP_PHASE == 0) { GSYNC(); phase_ada(p, smem); } PHASE_END(0)
    PHASE_BEGIN(1) phase_norm(p, smem, false); if (DUP_PHASE == 1) { GSYNC(); phase_norm(p, smem, false); } PHASE_END(1)
    PHASE_BEGIN(2) phase_inproj8(p, smem_all); if (DUP_PHASE == 2) { GSYNC(); phase_inproj8(p, smem_all); } PHASE_END(2)
    PHASE_BEGIN(3)
        for (int it = VB; it < 2080; it += NVB) mlstm_passA(p, smem, it);
        if (DUP_PHASE == 3) { GSYNC(); for (int it = VB; it < 2080; it += NVB) mlstm_passA(p, smem, it); }

    PHASE_END(3)
    PHASE_BEGIN(4)
        unsigned hb = 0;
        if ((threadIdx.x & 255) == 0) *(volatile LAS unsigned*)(smem + HB_OFF) = 0u;
        __syncthreads();
        const int vb2 = (int)blockIdx.x + (int)gridDim.x * (int)__builtin_amdgcn_readfirstlane(threadIdx.x >> 8);
        if (threadIdx.x < 256) { phase_scan(p, smem, hb); for (int it = vb2; it < 4096; it += NVB) na_item(p, smem, it, hb); }
        else { for (int it = vb2; it < 4096; it += NVB) na_item(p, smem, it, hb); phase_scan(p, smem, hb); }
 PHASE_END(4)
    PHASE_BEGIN(5) for (int it = VB; it < 2048; it += NVB) mlstm_passC(p, smem, it); if (DUP_PHASE == 5) { GSYNC(); for (int it = VB; it < 2048; it += NVB) mlstm_passC(p, smem, it); } PHASE_END(5)
    PHASE_BEGIN(6) phase_merge8(p, smem_all); if (DUP_PHASE == 6) { GSYNC(); phase_merge8(p, smem_all); } PHASE_END(6)
    PHASE_BEGIN(7) phase_outproj8(p, smem_all); if (DUP_PHASE == 7) { GSYNC(); phase_outproj8(p, smem_all); } PHASE_END(7)
    PHASE_BEGIN(8) phase_norm(p, smem, true); if (DUP_PHASE == 8) { GSYNC(); phase_norm(p, smem, true); } PHASE_END(8)
    PHASE_BEGIN(9) phase_router8(p, smem_all); if (DUP_PHASE == 9) { GSYNC(); phase_router8(p, smem_all); } PHASE_END(9)
    PHASE_BEGIN(10) phase_route(p, smem); PHASE_END(10)
    PHASE_BEGIN(11) phase_assign(p, smem); PHASE_END(11)
    PHASE_BEGIN(12) phase_moe1w8(p, smem_all); if (DUP_PHASE == 12) { GSYNC(); phase_moe1w8(p, smem_all); } PHASE_END(12)
    PHASE_BEGIN(13) phase_moe2w8(p, smem_all); if (DUP_PHASE == 13) { GSYNC(); phase_moe2w8(p, smem_all); } PHASE_END(13)
    PHASE_BEGIN(14) phase_combine(p, smem);
        if (DUP_PHASE == 200) { for (int q = 0; q < 20; ++q) GSYNC(); }
        if (DUP_PHASE == 100) { GSYNC(); phase_route(p, smem); GSYNC(); phase_assign(p, smem); }
    PHASE_END(14)
}

extern "C" void kernel_launch(void* const* d_in, const int* in_sizes, int n_in, void* d_out, int out_size, void* d_ws, size_t ws_size, hipStream_t stream) {
    static int grid_blocks = 0;
    if (!grid_blocks) {
        int dev = 0, cus = 0, per_cu = 0;
        (void)hipGetDevice(&dev);
        (void)hipDeviceGetAttribute(&cus, hipDeviceAttributeMultiprocessorCount, dev);
        (void)hipFuncSetAttribute((const void*)mega, hipFuncAttributeMaxDynamicSharedMemorySize, LDS_BYTES);
        (void)hipOccupancyMaxActiveBlocksPerMultiprocessor(&per_cu, mega, 512, LDS_BYTES);
        if (per_cu > 1) per_cu = 1;
        if (per_cu < 1) per_cu = 1;
        grid_blocks = cus * per_cu;
        if (ws_size < WS_END) fprintf(stderr, "kernel_launch: workspace too small: %zu < %zu\n", ws_size, (size_t)WS_END);
    }
    (void)hipMemsetAsync((char*)d_ws + OFF_BAR, 0, 32768, stream);
    Params p{};
    const float** pp = (const float**)&p;
    for (int i = 0; i < 23; ++i) pp[i] = (const float*)d_in[i];
    p.out = (float*)d_out; p.ws = (unsigned char*)d_ws;
#if MULTI_LAUNCH
    for (int ph = 0; ph < NPH; ++ph) {
        p.ph_lo = ph; p.ph_hi = ph + 1;
        void* args[] = {&p};
        hipError_t e = hipLaunchCooperativeKernel((void*)mega, dim3(grid_blocks), dim3(512), args, LDS_BYTES, stream);
        if (e != hipSuccess) fprintf(stderr, "cooperative launch failed: %s (grid %d)\n", hipGetErrorString(e), grid_blocks);
    }
#else
    p.ph_lo = 0; p.ph_hi = NPH;
    void* args[] = {&p};
    hipError_t e = hipLaunchCooperativeKernel((void*)mega, dim3(grid_blocks), dim3(512), args, LDS_BYTES, stream);
    if (e != hipSuccess) fprintf(stderr, "cooperative launch failed: %s (grid %d)\n", hipGetErrorString(e), grid_blocks);
#endif
}
```
